# Optimizing an MI355X kernel written in HIP

```python
import jax, jax.numpy as jnp
from jax import lax
import numpy as np

D_MODEL = 1024
BATCH = 32
SEQ = 256
DEPTH = 1
DEC_BATCH = 2
DEC_SEQ = 4096
PAST_LEN = 512

GRID_W = 64
CHUNK = 128
D_G = 1024
G_HEADS = 8
G_DIM = D_G // G_HEADS
D_RNN = 1024
LRU_HEADS = 16
LRU_DIM = D_RNN // LRU_HEADS
CONV_W = 4
CONV_PAD_L = 2
LRU_C = 8.0
D_FF = 4 * D_MODEL
N_MOD = 6
EPS = 1e-6
SPLITS = [D_G, 2 * D_G, 2 * D_G + D_RNN, 2 * D_G + 2 * D_RNN, 2 * D_G + 2 * D_RNN + D_MODEL]
IN_COLS = 2 * D_G + 2 * D_RNN + 2 * D_MODEL

kernel_name = "hybrid_gmlp_rglru_diffusion_step"


def _rmsnorm(x, g):
    xf = x.astype(jnp.float32)
    y = xf * lax.rsqrt(jnp.mean(xf * xf, axis=-1, keepdims=True) + EPS)
    return (y * g.astype(jnp.float32)).astype(x.dtype)


def _centred_dwconv(x, w, b):
    L = x.shape[1]
    xp = jnp.pad(x, ((0, 0), (CONV_PAD_L, CONV_W - 1 - CONV_PAD_L), (0, 0)))
    y = xp[:, 0:L] * w[0]
    for k in range(1, CONV_W):
        y = y + xp[:, k:k + L] * w[k]
    return y + b


def _lru_combine(e1, e2):
    a1, b1 = e1
    a2, b2 = e2
    return a1 * a2, a2 * b1 + b2


def _scan_dir(a, bx, h0, reverse):
    a_cum, h_zero = lax.associative_scan(_lru_combine, (a, bx), axis=1, reverse=reverse)
    return h_zero + a_cum * h0[:, None, :]


def _sgu(u, v, g_sgu, w_sp, b_sp):
    B, L, _ = v.shape
    vn = _rmsnorm(v, g_sgu).reshape(B, L // CHUNK, CHUNK, G_HEADS, G_DIM)
    s = jnp.einsum('gqp,bnpgc->bnqgc', w_sp, vn) + b_sp.T[None, None, :, :, None]
    return u * s.reshape(B, L, D_G)


def _rglru(xr, h0_f, h0_b, conv_w, conv_b, w_ra, b_ra, w_ri, b_ri, lam):
    B, L, _ = xr.shape
    xc = _centred_dwconv(xr, conv_w, conv_b)
    xh = xc.reshape(B, L, LRU_HEADS, LRU_DIM)
    r = jax.nn.sigmoid((jnp.einsum('blhi,dhij->bldhj', xh, w_ra).reshape(B, L, 2, D_RNN) + b_ra).astype(jnp.float32))
    ig = jax.nn.sigmoid((jnp.einsum('blhi,dhij->bldhj', xh, w_ri).reshape(B, L, 2, D_RNN) + b_ri).astype(jnp.float32))
    log_a = -LRU_C * r * jax.nn.softplus(-lam.astype(jnp.float32))
    a = jnp.exp(log_a)
    bx = jnp.sqrt(jnp.maximum(-jnp.expm1(2.0 * log_a), 1e-12)) * ig * xc.astype(jnp.float32)[:, :, None, :]
    h_f = _scan_dir(a[:, :, 0], bx[:, :, 0], h0_f, False)
    h_b = _scan_dir(a[:, :, 1], bx[:, :, 1], h0_b, True)
    return h_f + h_b, h_f[:, -1], h_b[:, 0]


def _layer(x, c_vec, h0_f, h0_b, p):
    mod = (jax.nn.silu(c_vec) @ p['w_ada'] + p['b_ada'])[:, None, :]
    sh1, sc1, g1, sh2, sc2, g2 = jnp.split(mod, N_MOD, axis=-1)
    h = _rmsnorm(x, p['g_pre_mix']) * (1.0 + sc1) + sh1
    z = h @ p['w_in']
    u, v, xr, gr, ga, gb = jnp.split(z, SPLITS, axis=-1)
    y_g = _sgu(jax.nn.gelu(u), jax.nn.gelu(v), p['g_sgu'], p['w_sp'], p['b_sp'])
    h_rnn, hf, hb = _rglru(xr, h0_f, h0_b, p['conv_w'], p['conv_b'], p['w_ra'], p['b_ra'],
                           p['w_ri'], p['b_ri'], p['lam'])
    y_r = h_rnn.astype(x.dtype) * jax.nn.gelu(gr)
    merged = jax.nn.sigmoid(ga) * (y_g @ p['w_br_g']) + jax.nn.sigmoid(gb) * (y_r @ p['w_br_r'])
    x = x + g1 * _rmsnorm(merged @ p['w_out'], p['g_post_mix'])
    h = _rmsnorm(x, p['g_pre_mlp']) * (1.0 + sc2) + sh2
    f = jnp.square(jax.nn.relu(h @ p['w_ff1'])) @ p['w_ff2']
    x = x + g2 * _rmsnorm(f, p['g_post_mlp'])
    return x, hf, hb


def setup_inputs(seed: int = 0) -> dict:
    key = jax.random.key(seed)
    ks = jax.random.split(key, 32)
    nrm = lambda k, s, sc: jax.random.normal(k, s, jnp.float32) * sc
    p_lam = jax.random.uniform(ks[20], (DEPTH, 2, D_RNN), jnp.float32, 0.9, 0.999)
    return {
        'x_prompt': nrm(ks[0], (BATCH, SEQ, D_MODEL), 1.0),
        'x_sample': nrm(ks[1], (DEC_BATCH, DEC_SEQ, D_MODEL), 1.0),
        'state_lru': nrm(ks[2], (DEC_BATCH, DEPTH, 2, D_RNN), 0.5),
        'c': nrm(ks[3], (DEC_BATCH, D_MODEL), 1.0),
        'c_ctx': nrm(ks[4], (D_MODEL,), 1.0),
        'w_ada': nrm(ks[5], (DEPTH, D_MODEL, N_MOD * D_MODEL), 0.5 * D_MODEL ** -0.5),
        'b_ada': nrm(ks[6], (DEPTH, N_MOD * D_MODEL), 0.01),
        'g_pre_mix': 1.0 + nrm(ks[7], (DEPTH, D_MODEL), 0.05),
        'g_post_mix': 1.0 + nrm(ks[8], (DEPTH, D_MODEL), 0.05),
        'g_pre_mlp': 1.0 + nrm(ks[9], (DEPTH, D_MODEL), 0.05),
        'g_post_mlp': 1.0 + nrm(ks[10], (DEPTH, D_MODEL), 0.05),
        'w_in': nrm(ks[11], (DEPTH, D_MODEL, IN_COLS), D_MODEL ** -0.5),
        'g_sgu': 1.0 + nrm(ks[12], (DEPTH, D_G), 0.05),
        'w_sp': nrm(ks[13], (DEPTH, G_HEADS, CHUNK, CHUNK), CHUNK ** -0.5),
        'b_sp': 1.0 + nrm(ks[14], (DEPTH, G_HEADS, CHUNK), 0.05),
        'conv_w': nrm(ks[15], (DEPTH, CONV_W, D_RNN), CONV_W ** -0.5),
        'conv_b': nrm(ks[16], (DEPTH, D_RNN), 0.01),
        'w_ra': nrm(ks[17], (DEPTH, 2, LRU_HEADS, LRU_DIM, LRU_DIM), LRU_DIM ** -0.5),
        'b_ra': nrm(ks[18], (DEPTH, 2, D_RNN), 0.1),
        'w_ri': nrm(ks[19], (DEPTH, 2, LRU_HEADS, LRU_DIM, LRU_DIM), LRU_DIM ** -0.5),
        'b_ri': nrm(ks[21], (DEPTH, 2, D_RNN), 0.1),
        'lam': jnp.log(p_lam) - jnp.log1p(-p_lam),
        'w_br_g': nrm(ks[22], (DEPTH, D_G, D_MODEL), D_G ** -0.5),
        'w_br_r': nrm(ks[23], (DEPTH, D_RNN, D_MODEL), D_RNN ** -0.5),
        'w_out': nrm(ks[24], (DEPTH, D_MODEL, D_MODEL), D_MODEL ** -0.5),
        'w_ff1': nrm(ks[25], (DEPTH, D_MODEL, D_FF), D_MODEL ** -0.5),
        'w_ff2': nrm(ks[26], (DEPTH, D_FF, D_MODEL), D_FF ** -0.5),
    }


def reference(x_prompt, x_sample, state_lru, c, c_ctx, w_ada, b_ada, g_pre_mix, g_post_mix,
              g_pre_mlp, g_post_mlp, w_in, g_sgu, w_sp, b_sp, conv_w, conv_b, w_ra, b_ra,
              w_ri, b_ri, lam, w_br_g, w_br_r, w_out, w_ff1, w_ff2):
    y_prompt = x_prompt
    y_sample = x_sample
    B_ctx = x_prompt.shape[0]
    zeros_h = jnp.zeros((B_ctx, D_RNN), jnp.float32)
    ctx_states = []
    for l in range(DEPTH):
        p = {
            'w_ada': w_ada[l], 'b_ada': b_ada[l], 'g_pre_mix': g_pre_mix[l], 'g_post_mix': g_post_mix[l],
            'g_pre_mlp': g_pre_mlp[l], 'g_post_mlp': g_post_mlp[l], 'w_in': w_in[l], 'g_sgu': g_sgu[l],
            'w_sp': w_sp[l], 'b_sp': b_sp[l], 'conv_w': conv_w[l], 'conv_b': conv_b[l],
            'w_ra': w_ra[l], 'b_ra': b_ra[l], 'w_ri': w_ri[l], 'b_ri': b_ri[l], 'lam': lam[l],
            'w_br_g': w_br_g[l], 'w_br_r': w_br_r[l], 'w_out': w_out[l],
            'w_ff1': w_ff1[l], 'w_ff2': w_ff2[l],
        }
        y_prompt, hf, hb = _layer(y_prompt, c_ctx[None, :], zeros_h, zeros_h, p)
        ctx_states.append(jnp.stack([hf, hb], axis=1).astype(x_prompt.dtype))
        h0 = state_lru[:, l].astype(jnp.float32)
        y_sample, _, _ = _layer(y_sample, c, h0[:, 0], h0[:, 1], p)
    new_state_lru = jnp.stack(ctx_states, axis=1)
    return (y_prompt, y_sample, new_state_lru)
```

```cpp
#include <hip/hip_runtime.h>
#include <hip/hip_cooperative_groups.h>
#include <cstdio>
#include <cstdint>
namespace cg = cooperative_groups;
namespace pg8 {
#define PG8_LAS __attribute__((address_space(3)))
typedef unsigned short bf16_t;
typedef short bf16x8 __attribute__((ext_vector_type(8)));
typedef float f32x4 __attribute__((ext_vector_type(4)));
typedef unsigned u32x4 __attribute__((ext_vector_type(4)));
constexpr int BM = 256, BK = 64, HALF = 128, HTB = HALF * BK * 2  , STAGE_BYTES = 8 * HTB, NXCD = 8, WGM = 8;

__host__ __device__ __forceinline__ int lds_byte(int r, int c) { const int st = (r >> 4) * 2 + (c >> 5), rr = r & 15, cc = c & 31, ob = rr * 64 + cc * 2; return st * 1024 + (ob ^ (((ob >> 9) & 1) << 5)); }
__host__ __device__ __forceinline__ void stage_rc(int b, int& R, int& C) { const int st = b / 1024, sb = b % 1024, swz = sb ^ (((sb >> 9) & 1) << 5); R = (st >> 1) * 16 + swz / 64; C = (st & 1) * 32 + (swz % 64) / 2; }
__host__ __device__ __forceinline__ int perm32(int rho) { const int n = rho >> 4, i = rho & 15; return 8 * (i >> 2) + 4 * n + (i & 3); }

struct Unit { int pm, pn; };
struct Gemm { const bf16_t* A; const bf16_t* Bt; int M, N, K; };

struct StaticOrder {
    int nM, nN, nwg, G, c, wgm;
    __host__ __device__ void init(int M, int N, int G_, int c_, int wgm_ = 8) { nM = M / BM; nN = N / BM; nwg = nM * nN; G = G_; c = c_; wgm = wgm_; }
    __host__ __device__ bool next(int i, Unit& u) const {
        const long L = (long)i * G + c; if (L >= nwg) return false;
        int wgid = (int)L; { const int q = nwg / NXCD, r = nwg % NXCD, xcd = wgid % NXCD, off = wgid / NXCD; wgid = (xcd < r ? xcd * (q + 1) : r * (q + 1) + (xcd - r) * q) + off; }
        const int nig = wgm * nN, gid = wgid / nig, fm = gid * wgm, gsz = (nM - fm) < wgm ? (nM - fm) : wgm;
        u.pm = fm + ((wgid % nig) % gsz); u.pn = (wgid % nig) / gsz; return true;
    }
    __device__ __forceinline__ void a_ready(const Unit&) const {}
    __device__ __forceinline__ void done(const Unit&) const {}
};

typedef __bf16 bf16x2_cvt __attribute__((ext_vector_type(2)));
typedef float f32x2_cvt __attribute__((ext_vector_type(2)));
__device__ __forceinline__ unsigned cvt_pk_bf16(float lo, float hi) { const f32x2_cvt v = {lo, hi}; const bf16x2_cvt b = __builtin_convertvector(v, bf16x2_cvt); return __builtin_bit_cast(unsigned, b); }
__device__ __forceinline__ float sigmoid_f(float x) { return __builtin_amdgcn_rcpf(1.f + __builtin_amdgcn_exp2f(-1.4426950409f * x)); }
__device__ __forceinline__ float gelu_tanh_f(float x) { const float u = x * (-2.3022081985f - 0.10294324f * (x * x)); return x * __builtin_amdgcn_rcpf(1.f + __builtin_amdgcn_exp2f(u)); }
__device__ __forceinline__ float bflo(unsigned w) { return __builtin_bit_cast(float, w << 16); }
__device__ __forceinline__ float bfhi(unsigned w) { return __builtin_bit_cast(float, w & 0xffff0000u); }
template <int MODE> struct Epi {
    static constexpr bool PERM = true, AFTER_DRAIN = false, HOOK = false;
    bf16_t* Ob; float* Of; const bf16_t* G; float* SS; int ldc;
    bf16_t *s0, *s1, *s2, *s3, *s4, *s5;
    __device__ __forceinline__ void operator()(const f32x4 (&acc)[2][2][4][2], const Unit& u, int wr, int wc, int fr, int fq) const {
        const int row0 = u.pm * BM + wr * 64 + fr;
        if constexpr (MODE == 1) {
            const int t = u.pn >> 2;
            bf16_t* base = t == 0 ? s0 : t == 1 ? s1 : t == 2 ? s2 : t == 3 ? s3 : t == 4 ? s4 : s5;
            const int col0 = (u.pn & 3) * BM + wc * 32 + 8 * fq;
#pragma unroll
            for (int ai = 0; ai < 2; ++ai)
#pragma unroll
                for (int m = 0; m < 4; ++m) {
                    const int row = row0 + ai * HALF + m * 16; bf16_t* rowp = base + (size_t)row * ((t == 0 || t == 3) ? 2048 : 1024) + col0; float ss = 0.f;
#pragma unroll
                    for (int bj = 0; bj < 2; ++bj) {
                        f32x4 v0 = acc[ai][bj][m][0], v1 = acc[ai][bj][m][1];
                        if (t >= 4) {
#pragma unroll
                            for (int j = 0; j < 4; ++j) { v0[j] = sigmoid_f(v0[j]); v1[j] = sigmoid_f(v1[j]); }
                        } else if (t != 2) {
#pragma unroll
                            for (int j = 0; j < 4; ++j) { v0[j] = gelu_tanh_f(v0[j]); v1[j] = gelu_tanh_f(v1[j]); }
                        }
                        if (t == 1) {
#pragma unroll
                            for (int j = 0; j < 4; ++j) ss += v0[j] * v0[j] + v1[j] * v1[j];
                        }
                        u32x4 w; w.x = cvt_pk_bf16(v0[0], v0[1]); w.y = cvt_pk_bf16(v0[2], v0[3]); w.z = cvt_pk_bf16(v1[0], v1[1]); w.w = cvt_pk_bf16(v1[2], v1[3]);
                        *(u32x4*)(rowp + bj * HALF) = w;
                    }
                    if (t == 1) { ss += __shfl_xor(ss, 16); ss += __shfl_xor(ss, 32); if (fq == 0) atomicAdd(SS + row, ss); }
                }
        } else {
            const int col0 = u.pn * BM + wc * 32 + 8 * fq;
#pragma unroll
            for (int ai = 0; ai < 2; ++ai)
#pragma unroll
                for (int m = 0; m < 4; ++m) {
                    const int row = row0 + ai * HALF + m * 16; float ss = 0.f;
#pragma unroll
                    for (int bj = 0; bj < 2; ++bj) {
                        f32x4 v0 = acc[ai][bj][m][0], v1 = acc[ai][bj][m][1];
                        const size_t off = (size_t)row * ldc + col0 + bj * HALF;
                        if constexpr (MODE == 2 || MODE == 3) {
                            const u32x4 g = *(const u32x4*)(G + off);
                            v0[0] *= bflo(g.x); v0[1] *= bfhi(g.x); v0[2] *= bflo(g.y); v0[3] *= bfhi(g.y);
                            v1[0] *= bflo(g.z); v1[1] *= bfhi(g.z); v1[2] *= bflo(g.w); v1[3] *= bfhi(g.w);
                        }
                        if constexpr (MODE == 3) { v0 = v0 + *(const f32x4*)(Of + off); v1 = v1 + *(const f32x4*)(Of + off + 4); }
                        if constexpr (MODE == 5) {
#pragma unroll
                            for (int j = 0; j < 4; ++j) { const float a = fmaxf(v0[j], 0.f), b = fmaxf(v1[j], 0.f); v0[j] = a * a; v1[j] = b * b; }
                        }
                        if constexpr (MODE == 4) {
#pragma unroll
                            for (int j = 0; j < 4; ++j) ss += v0[j] * v0[j] + v1[j] * v1[j];
                        }
                        if constexpr (MODE == 2 || MODE == 4) { *(f32x4*)(Of + off) = v0; *(f32x4*)(Of + off + 4) = v1; }
                        else { u32x4 w; w.x = cvt_pk_bf16(v0[0], v0[1]); w.y = cvt_pk_bf16(v0[2], v0[3]); w.z = cvt_pk_bf16(v1[0], v1[1]); w.w = cvt_pk_bf16(v1[2], v1[3]);
                            *(u32x4*)(Ob + off) = w; }
                    }
                    if constexpr (MODE == 4) { ss += __shfl_xor(ss, 16); ss += __shfl_xor(ss, 32); if (fq == 0) atomicAdd(SS + row, ss); }
                }
        }
    }
};

struct EpiMerge {
    static constexpr bool PERM = true, AFTER_DRAIN = false, HOOK = true;
    bf16_t* Ob; const bf16_t* GA; const bf16_t* GB;
    __device__ __forceinline__ void mid(f32x4 (&acc)[2][2][4][2], const Unit& u, int wr, int wc, int fr, int fq) const {
        int row0 = u.pm * BM + wr * 64 + fr, col0 = u.pn * BM + wc * 32 + 8 * fq;
        asm volatile("" : "+v"(row0), "+v"(col0));
#pragma unroll
        for (int ai = 0; ai < 2; ++ai)
#pragma unroll
            for (int m = 0; m < 4; ++m) {
                if ((m & 1) == 0) asm volatile("" ::: "memory");
#pragma unroll
                for (int bj = 0; bj < 2; ++bj) {
                    const size_t off = (size_t)(row0 + ai * HALF + m * 16) * 1024 + col0 + bj * HALF;
                    const u32x4 a = *(const u32x4*)(GA + off), b = *(const u32x4*)(GB + off);
                    f32x4 r0, r1;
                    r0[0] = bflo(a.x) * __builtin_amdgcn_rcpf(fmaxf(bflo(b.x), 1e-30f)); r0[1] = bfhi(a.x) * __builtin_amdgcn_rcpf(fmaxf(bfhi(b.x), 1e-30f));
                    r0[2] = bflo(a.y) * __builtin_amdgcn_rcpf(fmaxf(bflo(b.y), 1e-30f)); r0[3] = bfhi(a.y) * __builtin_amdgcn_rcpf(fmaxf(bfhi(b.y), 1e-30f));
                    r1[0] = bflo(a.z) * __builtin_amdgcn_rcpf(fmaxf(bflo(b.z), 1e-30f)); r1[1] = bfhi(a.z) * __builtin_amdgcn_rcpf(fmaxf(bfhi(b.z), 1e-30f));
                    r1[2] = bflo(a.w) * __builtin_amdgcn_rcpf(fmaxf(bflo(b.w), 1e-30f)); r1[3] = bfhi(a.w) * __builtin_amdgcn_rcpf(fmaxf(bfhi(b.w), 1e-30f));
                    acc[ai][bj][m][0] = acc[ai][bj][m][0] * r0; acc[ai][bj][m][1] = acc[ai][bj][m][1] * r1;
                }
            }
    }
    __device__ __forceinline__ void operator()(const f32x4 (&acc)[2][2][4][2], const Unit& u, int wr, int wc, int fr, int fq) const {
        const int row0 = u.pm * BM + wr * 64 + fr, col0 = u.pn * BM + wc * 32 + 8 * fq;
#pragma unroll
        for (int ai = 0; ai < 2; ++ai)
#pragma unroll
            for (int m = 0; m < 4; ++m)
#pragma unroll
                for (int bj = 0; bj < 2; ++bj) {
                    const size_t off = (size_t)(row0 + ai * HALF + m * 16) * 1024 + col0 + bj * HALF;
                    const u32x4 b = *(const u32x4*)(GB + off);
                    const f32x4 v0 = acc[ai][bj][m][0], v1 = acc[ai][bj][m][1];
                    u32x4 w; w.x = cvt_pk_bf16(v0[0] * bflo(b.x), v0[1] * bfhi(b.x)); w.y = cvt_pk_bf16(v0[2] * bflo(b.y), v0[3] * bfhi(b.y));
                    w.z = cvt_pk_bf16(v1[0] * bflo(b.z), v1[1] * bfhi(b.z)); w.w = cvt_pk_bf16(v1[2] * bflo(b.w), v1[3] * bfhi(b.w));
                    *(u32x4*)(Ob + off) = w;
                }
    }
};

template <class Epi, class Sched, bool ALIGN_EPI = false, bool SP2 = false>
__device__ __forceinline__ void gemm_phase(PG8_LAS unsigned char* lds, const Gemm g, const Sched& S, const Epi& E) {
    const int tid = threadIdx.x, wid = __builtin_amdgcn_readfirstlane(tid >> 6), lane = tid & 63, wr = wid >> 2, wc = wid & 3, fr = lane & 15, fq = lane >> 4;
    const int K = g.K, nt = K / BK;
    unsigned voffA[2], voffB[2];
#pragma unroll
    for (int i = 0; i < 2; ++i) { int R, C; stage_rc(tid * 16 + i * 8192, R, C); const int Rb = Epi::PERM ? ((R & ~31) + perm32(R & 31)) : R;
        voffA[i] = (unsigned)(R * K + C) * 2u; voffB[i] = (unsigned)(Rb * K + C) * 2u; }
    const size_t kstep = (size_t)(BK * 2);
    const size_t hstep = (size_t)HALF * K * 2;
    const size_t tstep = 2 * hstep;
    const unsigned ldsw = (unsigned)wid * 1024u;
    const int aoff = lds_byte(wr * 64 + fr, fq * 8), boff = lds_byte(wc * 32 + fr, fq * 8);
#define PG8_SA(b, h) (((b) * 2 + (h)) * HTB)
#define PG8_SB(b, h) ((4 + (b) * 2 + (h)) * HTB)
#define PG8_STAGE(bufoff, gbase, voff) do { _Pragma("unroll") for (int _i = 0; _i < 2; ++_i) \
        __builtin_amdgcn_global_load_lds((const unsigned*)((const char*)(gbase) + (voff)[_i]), (PG8_LAS unsigned*)(lds + (bufoff) + ldsw + _i * 8192), 16, 0, 0); } while (0)
#define PG8_LDA(dst, b, h) do { _Pragma("unroll") for (int m = 0; m < 4; ++m) _Pragma("unroll") for (int k = 0; k < 2; ++k) dst[m][k] = *(const PG8_LAS bf16x8*)(lds + PG8_SA(b, h) + aoff + m * 2048 + k * 1024); } while (0)
#define PG8_LDB(dst, b, h) do { _Pragma("unroll") for (int n = 0; n < 2; ++n) _Pragma("unroll") for (int k = 0; k < 2; ++k) dst[n][k] = *(const PG8_LAS bf16x8*)(lds + PG8_SB(b, h) + boff + n * 2048 + k * 1024); } while (0)
#define PG8_MMA(ai, bj, At, Bt) do { __builtin_amdgcn_s_setprio(1); _Pragma("unroll") for (int m = 0; m < 4; ++m) _Pragma("unroll") for (int n = 0; n < 2; ++n) _Pragma("unroll") for (int k = 0; k < 2; ++k) \
        acc[ai][bj][m][n] = __builtin_amdgcn_mfma_f32_16x16x32_bf16(Bt[n][k], At[m][k], acc[ai][bj][m][n], 0, 0, 0); __builtin_amdgcn_s_setprio(0); } while (0)
#define PG8_WAIT_V(n) asm volatile("s_waitcnt vmcnt(" #n ")" ::: "memory")
#define PG8_WAIT_L(n) asm volatile("s_waitcnt lgkmcnt(" #n ")" ::: "memory")
#define PG8_BAR __builtin_amdgcn_s_barrier()
#define PG8_SCHED __builtin_amdgcn_sched_barrier(0)
    Unit cur, nxt; int ui = 0;
    if (!S.next(0, cur)) return;
    f32x4 acc[2][2][4][2];
#pragma unroll
    for (int a = 0; a < 2; ++a)
#pragma unroll
        for (int b = 0; b < 2; ++b)
#pragma unroll
            for (int m = 0; m < 4; ++m)
#pragma unroll
                for (int n = 0; n < 2; ++n) acc[a][b][m][n] = (f32x4){0.f, 0.f, 0.f, 0.f};
    bf16x8 At[4][2], B0[2][2], B1[2][2];
    const char* cA = (const char*)g.A + (size_t)cur.pm * tstep; const char* cB = (const char*)g.Bt + (size_t)cur.pn * tstep;
    S.a_ready(cur);
    if constexpr (SP2) {
        PG8_STAGE(PG8_SB(0, 0), cB, voffB); PG8_STAGE(PG8_SB(0, 1), cB + hstep, voffB); PG8_STAGE(PG8_SA(0, 0), cA, voffA); PG8_STAGE(PG8_SA(0, 1), cA + hstep, voffA);
        if (wr == 1) PG8_BAR;
        PG8_WAIT_V(2); PG8_BAR;
        PG8_STAGE(PG8_SB(1, 0), cB + kstep, voffB); PG8_STAGE(PG8_SA(1, 0), cA + kstep, voffA); PG8_STAGE(PG8_SB(1, 1), cB + hstep + kstep, voffB);
        PG8_WAIT_V(6); PG8_BAR;
    } else {
        PG8_STAGE(PG8_SB(0, 0), cB, voffB); PG8_STAGE(PG8_SA(0, 0), cA, voffA); PG8_STAGE(PG8_SB(0, 1), cB + hstep, voffB); PG8_STAGE(PG8_SA(0, 1), cA + hstep, voffA);
        if (wr == 1) PG8_BAR;
        PG8_WAIT_V(4); PG8_BAR;
        PG8_STAGE(PG8_SB(1, 0), cB + kstep, voffB); PG8_STAGE(PG8_SA(1, 0), cA + kstep, voffA); PG8_STAGE(PG8_SB(1, 1), cB + hstep + kstep, voffB);
        PG8_WAIT_V(6); PG8_BAR;
    }
    for (;;) {
        const bool has_next = S.next(ui + 1, nxt);
        const char* nA = has_next ? (const char*)g.A + (size_t)nxt.pm * tstep : cA; const char* nB = has_next ? (const char*)g.Bt + (size_t)nxt.pn * tstep : cB;
        for (int t = 0; t < nt; t += 2) {
            if constexpr (Epi::HOOK) { if (t == (nt >> 1)) E.mid(acc, cur, wr, wc, fr, fq); }
            const bool last = (t == nt - 2);
            const char* a1 = cA + (size_t)(t + 1) * kstep;
            const char* a2 = last ? nA : cA + (size_t)(t + 2) * kstep; const char* b2 = last ? nB : cB + (size_t)(t + 2) * kstep;
            const char* a3 = a2 + kstep; const char* b3 = b2 + kstep;
            if (last && has_next) S.a_ready(nxt);
            if constexpr (SP2) {
            PG8_LDB(B0, 0, 0); PG8_LDB(B1, 0, 1); PG8_SCHED; PG8_LDA(At, 0, 0); PG8_STAGE(PG8_SA(1, 1), a1 + hstep, voffA);
            PG8_WAIT_V(8); PG8_WAIT_L(0); PG8_BAR; PG8_MMA(0, 0, At, B0); PG8_MMA(0, 1, At, B1); PG8_BAR; PG8_SCHED;
            PG8_LDA(At, 0, 1); PG8_STAGE(PG8_SB(0, 0), b2, voffB); PG8_STAGE(PG8_SB(0, 1), b2 + hstep, voffB); PG8_STAGE(PG8_SA(0, 0), a2, voffA);
            PG8_WAIT_V(8); PG8_WAIT_L(0); PG8_BAR; PG8_MMA(1, 0, At, B0); PG8_MMA(1, 1, At, B1); PG8_BAR; PG8_SCHED;
            PG8_LDB(B0, 1, 0); PG8_LDB(B1, 1, 1); PG8_SCHED; PG8_LDA(At, 1, 0); PG8_STAGE(PG8_SA(0, 1), a2 + hstep, voffA);
            PG8_WAIT_V(8); PG8_WAIT_L(0); PG8_BAR; PG8_MMA(0, 0, At, B0); PG8_MMA(0, 1, At, B1); PG8_BAR; PG8_SCHED;
            PG8_LDA(At, 1, 1); PG8_STAGE(PG8_SB(1, 0), b3, voffB); PG8_STAGE(PG8_SB(1, 1), b3 + hstep, voffB); PG8_STAGE(PG8_SA(1, 0), a3, voffA);
            PG8_WAIT_V(8); PG8_WAIT_L(0); PG8_BAR; PG8_MMA(1, 0, At, B0); PG8_MMA(1, 1, At, B1); PG8_BAR; PG8_SCHED;
            } else {
            PG8_LDB(B0, 0, 0); PG8_SCHED; PG8_LDA(At, 0, 0); PG8_STAGE(PG8_SA(1, 1), a1 + hstep, voffA);
            PG8_WAIT_L(8); PG8_BAR; PG8_WAIT_L(0); PG8_MMA(0, 0, At, B0); PG8_BAR; PG8_SCHED;
            PG8_LDB(B1, 0, 1); PG8_STAGE(PG8_SB(0, 0), b2, voffB);
            PG8_BAR; PG8_WAIT_L(0); PG8_MMA(0, 1, At, B1); PG8_BAR;
            PG8_LDA(At, 0, 1); PG8_STAGE(PG8_SA(0, 0), a2, voffA);
            PG8_BAR; PG8_WAIT_L(0); PG8_MMA(1, 0, At, B0); PG8_BAR; PG8_SCHED;
            PG8_STAGE(PG8_SB(0, 1), b2 + hstep, voffB);
            PG8_WAIT_V(6); PG8_BAR; PG8_MMA(1, 1, At, B1); PG8_BAR;
            PG8_LDB(B0, 1, 0); PG8_SCHED; PG8_LDA(At, 1, 0); PG8_STAGE(PG8_SA(0, 1), a2 + hstep, voffA);
            PG8_WAIT_L(8); PG8_BAR; PG8_WAIT_L(0); PG8_MMA(0, 0, At, B0); PG8_BAR; PG8_SCHED;
            PG8_LDB(B1, 1, 1); PG8_STAGE(PG8_SB(1, 0), b3, voffB);
            PG8_BAR; PG8_WAIT_L(0); PG8_MMA(0, 1, At, B1); PG8_BAR;
            PG8_LDA(At, 1, 1); PG8_STAGE(PG8_SA(1, 0), a3, voffA);
            PG8_BAR; PG8_WAIT_L(0); PG8_MMA(1, 0, At, B0); PG8_BAR; PG8_SCHED;
            PG8_STAGE(PG8_SB(1, 1), b3 + hstep, voffB);
            PG8_WAIT_V(6); PG8_BAR; PG8_MMA(1, 1, At, B1); PG8_BAR;
            }
        }
        if constexpr (ALIGN_EPI) { if (wr == 0) PG8_BAR; }
        if constexpr (!Epi::AFTER_DRAIN) { E(acc, cur, wr, wc, fr, fq); S.done(cur); }
        if (!has_next) break;
#pragma unroll
        for (int a = 0; a < 2; ++a)
#pragma unroll
            for (int b = 0; b < 2; ++b)
#pragma unroll
                for (int m = 0; m < 4; ++m)
#pragma unroll
                    for (int n = 0; n < 2; ++n) acc[a][b][m][n] = (f32x4){0.f, 0.f, 0.f, 0.f};
        cur = nxt; cA = nA; cB = nB; ++ui;
        if constexpr (ALIGN_EPI) { if (wr == 1) PG8_BAR; }
    }
    PG8_WAIT_V(0);
    if constexpr (!ALIGN_EPI) { if (wr == 0) PG8_BAR; }
    PG8_BAR;
    if constexpr (Epi::AFTER_DRAIN) { E.fused(acc, cur, wr, wc, fr, fq, lds, wid, lane); S.done(cur); }
#undef PG8_SA
#undef PG8_SB
#undef PG8_STAGE
#undef PG8_LDA
#undef PG8_LDB
#undef PG8_MMA
#undef PG8_WAIT_V
#undef PG8_WAIT_L
#undef PG8_BAR
#undef PG8_SCHED
}
}

constexpr int NWAVES = 8, NTHR = NWAVES * 64;
constexpr int D = 1024, M = 16384, MCTX = 8192, INC = 6144, FF = 4096;
constexpr float EPS = 1e-6f, LOG2E = 1.4426950408889634f;
constexpr size_t MiB = 1u << 20;
constexpr size_t WS_CTL = 0, CTL_ZERO_BYTES = 1 * MiB;
constexpr size_t CTL_VSS = 64 * 1024, CTL_OSS = 128 * 1024, CTL_FSS = 192 * 1024, CTL_MOD = 256 * 1024, CTL_XSS = 384 * 1024;
constexpr size_t CTL_CNT = 16 * 1024;
constexpr size_t WS_GC = 1 * MiB;
constexpr size_t WS_AGG = 2 * MiB;
constexpr size_t WS_CAR = 4 * MiB;
constexpr size_t WS_WG = 5 * MiB;
constexpr size_t WS_WSP = 5 * MiB + 512 * 1024;
constexpr size_t WS_WFF2 = 6 * MiB, WS_WFF1 = 14 * MiB, WS_WIN = 22 * MiB, WS_WBG = 34 * MiB, WS_WBR = 36 * MiB, WS_WOUT = 38 * MiB;
constexpr size_t WS_H = 40 * MiB;
constexpr size_t WS_F = 64 * MiB;
constexpr size_t WS_GU = 128 * MiB, WS_GGR = 160 * MiB, WS_SGA = 192 * MiB, WS_SGB = 224 * MiB;
constexpr size_t WS_F1 = 128 * MiB;
constexpr size_t WS_END = 256 * MiB;
constexpr int LDS_BYTES = 147456, LDS_BAR_OFF = 139264;
#ifndef WG_IN
#define WG_IN 4
#endif
#ifndef WG_FF1
#define WG_FF1 2
#endif
#ifndef DUP
#define DUP 0
#endif

#define GAS __attribute__((address_space(1)))
#define LAS __attribute__((address_space(3)))
typedef unsigned short bf16;
typedef unsigned v4u __attribute__((ext_vector_type(4)));
typedef unsigned v2u __attribute__((ext_vector_type(2)));
typedef float f32x4 __attribute__((ext_vector_type(4)));
typedef float f32x2 __attribute__((ext_vector_type(2)));
typedef short bf16x8 __attribute__((ext_vector_type(8)));
#define LDS_WAIT() asm volatile("s_waitcnt lgkmcnt(0)" ::: "memory")
__device__ __forceinline__ unsigned f2bf(float f) { unsigned u = __builtin_bit_cast(unsigned, f); return (u + 0x7fffu + ((u >> 16) & 1u)) >> 16; }
__device__ __forceinline__ unsigned pk2(float lo, float hi) { return pg8::cvt_pk_bf16(lo, hi); }
__device__ __forceinline__ float bf2f(bf16 b) { return __builtin_bit_cast(float, (unsigned)b << 16); }
using pg8::bflo; using pg8::bfhi;

struct Args { const float* in[27]; float* out; unsigned char* ws; int ph_lo, ph_hi; };
enum { I_XP = 0, I_XS, I_STATE, I_C, I_CCTX, I_WADA, I_BADA, I_GPREMIX, I_GPOSTMIX, I_GPREMLP, I_GPOSTMLP, I_WIN, I_GSGU, I_WSP, I_BSP, I_CONVW, I_CONVB,
       I_WRA, I_BRA, I_WRI, I_BRI, I_LAM, I_WBRG, I_WBRR, I_WOUT, I_WFF1, I_WFF2 };

__device__ __forceinline__ float wave_sum(float v) {
#pragma unroll
    for (int o = 1; o < 64; o <<= 1) v += __shfl_xor(v, o);
    return v;
}
__device__ __forceinline__ void p0_transpose_item(const float* W, int K, int N, bf16* WT, LAS float* scr, int item, int lane, int ldk = 0, int koff = 0) {
    if (ldk == 0) ldk = K;
    const int nblk = N / 32, kb = item / nblk, nb = item % nblk, k0 = 64 * kb, n0 = 32 * nb;
#pragma unroll
    for (int i = 0; i < 8; ++i) { const int kk = 8 * i + (lane >> 3);
        const f32x4 v = *(const f32x4*)(W + (size_t)(k0 + kk) * N + n0 + (lane & 7) * 4);
        LAS float* dd = scr + kk * 33 + (lane & 7) * 4; dd[0] = v[0]; dd[1] = v[1]; dd[2] = v[2]; dd[3] = v[3]; }
    LDS_WAIT(); asm volatile("" ::: "memory");
    const int c = lane & 7;
#pragma unroll
    for (int j = 0; j < 4; ++j) { const int n = (lane >> 3) + 8 * j; const LAS float* s = scr + (8 * c) * 33 + n;
        v4u o; o.x = pk2(s[0 * 33], s[1 * 33]); o.y = pk2(s[2 * 33], s[3 * 33]); o.z = pk2(s[4 * 33], s[5 * 33]); o.w = pk2(s[6 * 33], s[7 * 33]);
        *(v4u*)(WT + (size_t)(n0 + n) * ldk + koff + k0 + 8 * c) = o; }
    LDS_WAIT(); asm volatile("" ::: "memory");
}

__device__ __forceinline__ void phase_prep(const Args& a, LAS unsigned char* lds, int gw, int NGW, int wave, int lane, float* MOD) {
    unsigned char* ws = a.ws;
    LAS float* scr = (LAS float*)(lds + wave * 16384);
    constexpr int I_IN = 16 * (INC / 32), I_SQ = 16 * (D / 32), I_F1 = 16 * (FF / 32), I_F2 = (FF / 64) * (D / 32);
    constexpr int NT = I_IN + 3 * I_SQ + I_F1 + I_F2;
    for (int it = gw; it < NT; it += NGW) {
        int r = it;
        if (r < I_IN) { p0_transpose_item(a.in[I_WIN], D, INC, (bf16*)(ws + WS_WIN), scr, r, lane); continue; } r -= I_IN;
        if (r < I_SQ) { p0_transpose_item(a.in[I_WBRG], D, D, (bf16*)(ws + WS_WBG), scr, r, lane, 2 * D, 0); continue; } r -= I_SQ;
        if (r < I_SQ) { p0_transpose_item(a.in[I_WBRR], D, D, (bf16*)(ws + WS_WBG), scr, r, lane, 2 * D, D); continue; } r -= I_SQ;
        if (r < I_SQ) { p0_transpose_item(a.in[I_WOUT], D, D, (bf16*)(ws + WS_WOUT), scr, r, lane); continue; } r -= I_SQ;
        if (r < I_F1) { p0_transpose_item(a.in[I_WFF1], D, FF, (bf16*)(ws + WS_WFF1), scr, r, lane); continue; } r -= I_F1;
        p0_transpose_item(a.in[I_WFF2], FF, D, (bf16*)(ws + WS_WFF2), scr, r, lane);
    }
    {
        const float* wada = a.in[I_WADA]; const float* cctx = a.in[I_CCTX]; const float* cc = a.in[I_C];
        for (int it = gw; it < 64 * 24; it += NGW) {
            const int kc = it / 24, nb = it % 24, n = nb * 256 + lane * 4;
            f32x4 a0 = {0.f, 0.f, 0.f, 0.f}, a1 = a0, a2 = a0;
#pragma unroll
            for (int kk = 0; kk < 16; ++kk) {
                const int k = kc * 16 + kk;
                const f32x4 w = *(const f32x4*)(wada + (size_t)k * INC + n);
                const float c0 = cctx[k], c1 = cc[k], c2 = cc[D + k];
                const float s0 = c0 * pg8::sigmoid_f(c0), s1 = c1 * pg8::sigmoid_f(c1), s2 = c2 * pg8::sigmoid_f(c2);
                a0 += w * s0; a1 += w * s1; a2 += w * s2;
            }
#pragma unroll
            for (int j = 0; j < 4; ++j) { atomicAdd(MOD + n + j, a0[j]); atomicAdd(MOD + INC + n + j, a1[j]); atomicAdd(MOD + 2 * INC + n + j, a2[j]); }
        }
    }
    {
        const int gt = gw * 64 + lane, NGT = NGW * 64;
        bf16* WG = (bf16*)(ws + WS_WG);
        for (int it = gt; it < 16 * 16 * 2 * 64; it += NGT) {
            const int ln = it & 63, ks = (it >> 6) & 1, cbi = (it >> 7) & 15, h = it >> 11;
            const int fr = ln & 15, fq = ln >> 4, type = cbi >> 3, d = (cbi >> 2) & 1, cb = cbi & 3;
            const float* W = type ? a.in[I_WRI] : a.in[I_WRA];
            const float* src = W + ((size_t)(d * 16 + h) * 64 + ks * 32 + fq * 8) * 64 + cb * 16 + fr;
            v4u o; o.x = pk2(-LOG2E * src[0], -LOG2E * src[64]); o.y = pk2(-LOG2E * src[128], -LOG2E * src[192]);
            o.z = pk2(-LOG2E * src[256], -LOG2E * src[320]); o.w = pk2(-LOG2E * src[384], -LOG2E * src[448]);
            *(v4u*)(WG + (size_t)it * 8) = o;
        }
        bf16* WSP = (bf16*)(ws + WS_WSP); const float* wsp = a.in[I_WSP];
        for (int it = gt; it < 8 * 128 * 128 / 8; it += NGT) {
            const f32x4 x0 = *(const f32x4*)(wsp + (size_t)it * 8), x1 = *(const f32x4*)(wsp + (size_t)it * 8 + 4);
            v4u o; o.x = pk2(x0[0], x0[1]); o.y = pk2(x0[2], x0[3]); o.z = pk2(x1[0], x1[1]); o.w = pk2(x1[2], x1[3]);
            *(v4u*)(WSP + (size_t)it * 8) = o;
        }
        float* GC = (float*)(ws + WS_GC);
        for (int it = gt; it < 2048; it += NGT) {
            const float lamv = a.in[I_LAM][it]; const float sp = log1pf(expf(-lamv));
            f32x4 o; o[0] = exp2f(-LOG2E * a.in[I_BRA][it]); o[1] = exp2f(-LOG2E * a.in[I_BRI][it]); o[2] = -8.f * sp * LOG2E; o[3] = 0.f;
            *(f32x4*)(GC + (size_t)it * 4) = o;
        }
    }
}

__device__ __forceinline__ f32x4 modv(const float* MOD, const float* bada, int cv, int part, int c) {
    return *(const f32x4*)(MOD + cv * INC + part * D + c) + *(const f32x4*)(bada + part * D + c);
}
__device__ __forceinline__ int cv_of(int m) { return m < MCTX ? 0 : (m < MCTX + 4096 ? 1 : 2); }
__device__ __forceinline__ const float* xrow_of(const Args& a, int m) { return m < MCTX ? a.in[I_XP] + (size_t)m * D : a.in[I_XS] + (size_t)(m - MCTX) * D; }
__device__ __forceinline__ void store_bf4(bf16* p, f32x4 v) { v2u o; o.x = pk2(v[0], v[1]); o.y = pk2(v[2], v[3]); *(v2u*)p = o; }

__device__ __forceinline__ void phase_norm1(const Args& a, int gw, int NGW, int lane) {
    const float* MOD = (const float*)(a.ws + CTL_MOD); const float* bada = a.in[I_BADA]; const float* g = a.in[I_GPREMIX];
    bf16* H = (bf16*)(a.ws + WS_H);
    const int RPW = M / NGW;
    if (RPW * NGW == M && (MCTX % RPW) == 0 && (4096 % RPW) == 0) {
        const int m0 = gw * RPW, cv = cv_of(m0);
        f32x4 cc[4], sh[4];
#pragma unroll
        for (int j = 0; j < 4; ++j) { const int c = 4 * lane + 256 * j; cc[j] = *(const f32x4*)(g + c) * (modv(MOD, bada, cv, 1, c) + 1.f); sh[j] = modv(MOD, bada, cv, 0, c); }
        for (int m = m0; m < m0 + RPW; ++m) {
            const float* xr = xrow_of(a, m);
            f32x4 v[4]; float s = 0.f;
#pragma unroll
            for (int j = 0; j < 4; ++j) { v[j] = *(const f32x4*)(xr + 4 * lane + 256 * j); s += (v[j][0] * v[j][0] + v[j][1] * v[j][1]) + (v[j][2] * v[j][2] + v[j][3] * v[j][3]); }
            const float rstd = rsqrtf(wave_sum(s) * (1.f / D) + EPS);
#pragma unroll
            for (int j = 0; j < 4; ++j) store_bf4(H + (size_t)m * D + 4 * lane + 256 * j, v[j] * rstd * cc[j] + sh[j]);
        }
        return;
    }
    for (int m = gw; m < M; m += NGW) {
        const float* xr = xrow_of(a, m); const int cv = cv_of(m);
        f32x4 v[4]; float s = 0.f;
#pragma unroll
        for (int j = 0; j < 4; ++j) { v[j] = *(const f32x4*)(xr + 4 * lane + 256 * j); s += (v[j][0] * v[j][0] + v[j][1] * v[j][1]) + (v[j][2] * v[j][2] + v[j][3] * v[j][3]); }
        const float rstd = rsqrtf(wave_sum(s) * (1.f / D) + EPS);
#pragma unroll
        for (int j = 0; j < 4; ++j) { const int c = 4 * lane + 256 * j;
            const f32x4 gg = *(const f32x4*)(g + c), sh = modv(MOD, bada, cv, 0, c), sc = modv(MOD, bada, cv, 1, c);
            store_bf4(H + (size_t)m * D + c, v[j] * rstd * gg * (sc + 1.f) + sh); }
    }
}
__device__ __forceinline__ void phase_mid(const Args& a, int gw, int NGW, int lane, float* xout, bf16* H) {
    const float* MOD = (const float*)(a.ws + CTL_MOD); const float* bada = a.in[I_BADA];
    const float* gpm = a.in[I_GPOSTMIX]; const float* gpl = a.in[I_GPREMLP]; const float* OSS = (const float*)(a.ws + CTL_OSS);
    const float* out = a.out;
    for (int m = gw; m < M; m += NGW) {
        const float* xr = xrow_of(a, m); const int cv = cv_of(m);
        const float rstd_o = rsqrtf(OSS[m] * (1.f / D) + EPS);
        f32x4 v[4]; float s = 0.f;
#pragma unroll
        for (int j = 0; j < 4; ++j) { const int c = 4 * lane + 256 * j;
            const f32x4 o = *(const f32x4*)(out + (size_t)m * D + c), x = *(const f32x4*)(xr + c);
            const f32x4 g1 = modv(MOD, bada, cv, 2, c), gg = *(const f32x4*)(gpm + c);
            v[j] = x + g1 * (o * rstd_o * gg);
            *(f32x4*)(xout + (size_t)m * D + c) = v[j];
            s += (v[j][0] * v[j][0] + v[j][1] * v[j][1]) + (v[j][2] * v[j][2] + v[j][3] * v[j][3]); }
        const float rstd = rsqrtf(wave_sum(s) * (1.f / D) + EPS);
#pragma unroll
        for (int j = 0; j < 4; ++j) { const int c = 4 * lane + 256 * j;
            const f32x4 gg = *(const f32x4*)(gpl + c), sh = modv(MOD, bada, cv, 3, c), sc = modv(MOD, bada, cv, 4, c);
            store_bf4(H + (size_t)m * D + c, v[j] * rstd * gg * (sc + 1.f) + sh); }
    }
}
__device__ __forceinline__ void phase_final(const Args& a, int gw, int NGW, int lane, float* yout) {
    const float* MOD = (const float*)(a.ws + CTL_MOD); const float* bada = a.in[I_BADA];
    const float* gpm = a.in[I_GPOSTMLP]; const float* FSS = (const float*)(a.ws + CTL_FSS); const float* F = (const float*)(a.ws + WS_F); const float* out = a.out;
    for (int m = gw; m < M; m += NGW) {
        const int cv = cv_of(m); const float rstd_f = rsqrtf(FSS[m] * (1.f / D) + EPS);
#pragma unroll
        for (int j = 0; j < 4; ++j) { const int c = 4 * lane + 256 * j;
            const f32x4 f = *(const f32x4*)(F + (size_t)m * D + c), x1 = *(const f32x4*)(out + (size_t)m * D + c);
            const f32x4 g2 = modv(MOD, bada, cv, 5, c), gg = *(const f32x4*)(gpm + c);
            *(f32x4*)(yout + (size_t)m * D + c) = x1 + g2 * (f * rstd_f * gg); }
    }
}

__device__ __forceinline__ void panel_sync(unsigned* cnt) {
    asm volatile("s_waitcnt vmcnt(0)" ::: "memory");
    __syncthreads();
    if (threadIdx.x == 0) {
        __hip_atomic_fetch_add(cnt, 1u, __ATOMIC_RELAXED, __HIP_MEMORY_SCOPE_AGENT);
        unsigned sp = 0;
        while (__hip_atomic_load(cnt, __ATOMIC_RELAXED, __HIP_MEMORY_SCOPE_AGENT) < 4u) { __builtin_amdgcn_s_sleep(1); if (++sp > (1u << 22)) break; }
    }
    __syncthreads();
}
__device__ __forceinline__ float ld_agent(const float* p) { return __builtin_bit_cast(float, __hip_atomic_load((const unsigned*)p, __ATOMIC_RELAXED, __HIP_MEMORY_SCOPE_AGENT)); }
__device__ __forceinline__ float sumsq4(f32x4 v) { return (v[0] * v[0] + v[1] * v[1]) + (v[2] * v[2] + v[3] * v[3]); }
template <int MODE> struct EpiFused {
    static constexpr bool PERM = true, AFTER_DRAIN = true, HOOK = false;
    float* out; const float* xp; const float* xs; bf16* H; float* SS1; float* SS2; unsigned* cnt1; unsigned* cnt2;
    const float* MOD; const float* bada; const float* gpost; const float* gpre;
    __device__ __forceinline__ void fused(f32x4 (&acc)[2][2][4][2], const pg8::Unit& u, int wr, int wc, int fr, int fq, LAS unsigned char*, int, int) const {
        const int row0 = u.pm * 256 + wr * 64 + fr, col0 = u.pn * 256 + wc * 32 + 8 * fq;
        const int cv = u.pm < 32 ? 0 : (u.pm < 48 ? 1 : 2);
#pragma unroll
        for (int ai = 0; ai < 2; ++ai)
#pragma unroll
            for (int m = 0; m < 4; ++m) {
                float ss = (sumsq4(acc[ai][0][m][0]) + sumsq4(acc[ai][0][m][1])) + (sumsq4(acc[ai][1][m][0]) + sumsq4(acc[ai][1][m][1]));
                ss += __shfl_xor(ss, 16); ss += __shfl_xor(ss, 32);
                if (fq == 0) atomicAdd(SS1 + row0 + ai * 128 + m * 16, ss);
            }
        panel_sync(cnt1 + 64 * u.pm);
        f32x4 ga[2][2];
#pragma unroll
        for (int bj = 0; bj < 2; ++bj)
#pragma unroll
            for (int n = 0; n < 2; ++n) { const int c = col0 + bj * 128 + 4 * n; ga[bj][n] = modv(MOD, bada, cv, MODE == 6 ? 2 : 5, c) * *(const f32x4*)(gpost + c); }
        float rs1[2][4];
#pragma unroll
        for (int ai = 0; ai < 2; ++ai)
#pragma unroll
            for (int m = 0; m < 4; ++m) rs1[ai][m] = ld_agent(SS1 + row0 + ai * 128 + m * 16);
#pragma unroll
        for (int ai = 0; ai < 2; ++ai)
#pragma unroll
            for (int m = 0; m < 4; ++m) {
                const int row = row0 + ai * 128 + m * 16;
                const float rstd = rsqrtf(rs1[ai][m] * (1.f / D) + EPS);
                const float* xrow = MODE == 6 ? (row < MCTX ? xp + (size_t)row * D : xs + (size_t)(row - MCTX) * D) : out + (size_t)row * D;
                float ss = 0.f;
#pragma unroll
                for (int bj = 0; bj < 2; ++bj)
#pragma unroll
                    for (int n = 0; n < 2; ++n) { const int c = col0 + bj * 128 + 4 * n;
                        const f32x4 v = *(const f32x4*)(xrow + c) + ga[bj][n] * (acc[ai][bj][m][n] * rstd);
                        *(f32x4*)(out + (size_t)row * D + c) = v; acc[ai][bj][m][n] = v; ss += sumsq4(v); }
                if constexpr (MODE == 6) { ss += __shfl_xor(ss, 16); ss += __shfl_xor(ss, 32); if (fq == 0) atomicAdd(SS2 + row, ss); }
            }
        if constexpr (MODE == 6) {
            panel_sync(cnt2 + 64 * u.pm);
            f32x4 cc[2][2], sh[2][2];
#pragma unroll
            for (int bj = 0; bj < 2; ++bj)
#pragma unroll
                for (int n = 0; n < 2; ++n) { const int c = col0 + bj * 128 + 4 * n; cc[bj][n] = *(const f32x4*)(gpre + c) * (modv(MOD, bada, cv, 4, c) + 1.f); sh[bj][n] = modv(MOD, bada, cv, 3, c); }
            float rs2[2][4];
#pragma unroll
            for (int ai = 0; ai < 2; ++ai)
#pragma unroll
                for (int m = 0; m < 4; ++m) rs2[ai][m] = ld_agent(SS2 + row0 + ai * 128 + m * 16);
#pragma unroll
            for (int ai = 0; ai < 2; ++ai)
#pragma unroll
                for (int m = 0; m < 4; ++m) {
                    const int row = row0 + ai * 128 + m * 16;
                    const float rstd = rsqrtf(rs2[ai][m] * (1.f / D) + EPS);
#pragma unroll
                    for (int bj = 0; bj < 2; ++bj) {
                        const f32x4 h0 = acc[ai][bj][m][0] * rstd * cc[bj][0] + sh[bj][0], h1 = acc[ai][bj][m][1] * rstd * cc[bj][1] + sh[bj][1];
                        v4u w; w.x = pg8::cvt_pk_bf16(h0[0], h0[1]); w.y = pg8::cvt_pk_bf16(h0[2], h0[3]); w.z = pg8::cvt_pk_bf16(h1[0], h1[1]); w.w = pg8::cvt_pk_bf16(h1[2], h1[3]);
                        *(v4u*)(H + (size_t)row * D + col0 + bj * 128) = w; }
                }
        }
    }
};

constexpr int YLD = 2048;
constexpr int SG_W = 0, SG_V = 34816, SG_U = 69632, SG_ST = 272;
__device__ __forceinline__ void sgu_load(const bf16* GV, const bf16* GU, const float* VSS, int item, int tid, v4u (&rv)[4], v4u (&ru)[4], float (&rss)[4]) {
    const int g = item & 7, t0 = (item >> 3) * 128;
#pragma unroll
    for (int i = 0; i < 4; ++i) { const int idx = tid + i * NTHR, p = idx >> 4, c8 = (idx & 15) * 8;
        rv[i] = *(const v4u*)(GV + (size_t)(t0 + p) * D + g * 128 + c8); ru[i] = *(const v4u*)(GU + (size_t)(t0 + p) * YLD + g * 128 + c8); rss[i] = VSS[t0 + p]; }
}
__device__ __forceinline__ void phase_sgu(const Args& a, LAS unsigned char* lds, int tid, int wave, int lane, bf16* YG) {
    const bf16* GV = (const bf16*)a.out; const bf16* GU = (const bf16*)(a.ws + WS_GU); const bf16* WSP = (const bf16*)(a.ws + WS_WSP);
    const float* VSS = (const float*)(a.ws + CTL_VSS); const float* gsgu = a.in[I_GSGU]; const float* bsp = a.in[I_BSP];
    const int fr = lane & 15, fq = lane >> 4;
    int last_g = -1;
    v4u rv[4], ru[4]; float rss[4];
    for (int item = blockIdx.x; item < 128 * 8; item += gridDim.x) {
        const int g = item & 7, n = item >> 3, t0 = n * 128;
        if (g != last_g) {
#pragma unroll
            for (int i = 0; i < 4; ++i) { const int idx = tid + i * NTHR, row = idx >> 4, c16 = idx & 15;
                *(LAS v4u*)(lds + SG_W + row * SG_ST + c16 * 16) = *(const v4u*)(WSP + (size_t)(g * 128 + row) * 128 + c16 * 8); }
            last_g = g;
        }
        if (item == (int)blockIdx.x) sgu_load(GV, GU, VSS, item, tid, rv, ru, rss);
#pragma unroll
        for (int i = 0; i < 4; ++i) {
            const int idx = tid + i * NTHR, p = idx >> 4, c8 = (idx & 15) * 8;
            const v4u r = rv[i]; const v4u uu = ru[i];
            const float rs = rsqrtf(rss[i] * (1.f / D) + EPS);
            const f32x4 g0 = *(const f32x4*)(gsgu + g * 128 + c8) * rs, g1 = *(const f32x4*)(gsgu + g * 128 + c8 + 4) * rs;
            v4u o; o.x = pk2(bflo(r.x) * g0[0], bfhi(r.x) * g0[1]); o.y = pk2(bflo(r.y) * g0[2], bfhi(r.y) * g0[3]);
            o.z = pk2(bflo(r.z) * g1[0], bfhi(r.z) * g1[1]); o.w = pk2(bflo(r.w) * g1[2], bfhi(r.w) * g1[3]);
            *(LAS v4u*)(lds + SG_V + p * SG_ST + c8 * 2) = o;
            *(LAS v4u*)(lds + SG_U + p * SG_ST + c8 * 2) = uu;
        }
        if (item + (int)gridDim.x < 128 * 8) sgu_load(GV, GU, VSS, item + gridDim.x, tid, rv, ru, rss);
        float bias8[8];
#pragma unroll
        for (int qb = 0; qb < 8; ++qb) bias8[qb] = bsp[g * 128 + qb * 16 + fr];
        __syncthreads();
        bf16x8 af[4];
#pragma unroll
        for (int ks = 0; ks < 4; ++ks) {
            unsigned short e[8];
#pragma unroll
            for (int j = 0; j < 8; ++j) e[j] = *(const LAS unsigned short*)(lds + SG_V + (ks * 32 + fq * 8 + j) * SG_ST + (wave * 16 + fr) * 2);
            v4u o; o.x = e[0] | ((unsigned)e[1] << 16); o.y = e[2] | ((unsigned)e[3] << 16); o.z = e[4] | ((unsigned)e[5] << 16); o.w = e[6] | ((unsigned)e[7] << 16);
            af[ks] = __builtin_bit_cast(bf16x8, o);
        }
#pragma unroll
        for (int qb = 0; qb < 8; ++qb) {
            const int q = qb * 16 + fr;
            f32x4 acc = {0.f, 0.f, 0.f, 0.f};
#pragma unroll
            for (int ks = 0; ks < 4; ++ks) { const bf16x8 b = *(const LAS bf16x8*)(lds + SG_W + q * SG_ST + (ks * 32 + fq * 8) * 2);
                acc = __builtin_amdgcn_mfma_f32_16x16x32_bf16(af[ks], b, acc, 0, 0, 0); }
            const float bias = bias8[qb];
            LAS v2u* up = (LAS v2u*)(lds + SG_U + q * SG_ST + (wave * 16 + fq * 4) * 2);
            const v2u gu = *up;
            v2u y; y.x = pk2(bflo(gu.x) * (acc[0] + bias), bfhi(gu.x) * (acc[1] + bias)); y.y = pk2(bflo(gu.y) * (acc[2] + bias), bfhi(gu.y) * (acc[3] + bias));
            *up = y;
        }
        __syncthreads();
#pragma unroll
        for (int i = 0; i < 4; ++i) { const int idx = tid + i * NTHR, p = idx >> 4, c8 = (idx & 15) * 8;
            *(v4u*)(YG + (size_t)(t0 + p) * YLD + g * 128 + c8) = *(const LAS v4u*)(lds + SG_U + p * SG_ST + c8 * 2); }
        __syncthreads();
    }
}

constexpr int RG_WB = 0, RG_XA = 32768, RG_XF = 51200, RG_AGL = 86016, RG_GCL = 94208, RG_CWL = 96256, RG_CARL = 97536;
__device__ __forceinline__ void rg_load_raw(const bf16* XR, int item, int tid, v4u (&xr)[2][4]) {
    const int h = item & 15, t0 = (item >> 4) * 128;
    const int seq_lo = t0 < MCTX ? (t0 & ~255) : MCTX + ((t0 - MCTX) & ~4095), seq_hi = seq_lo + (t0 < MCTX ? 256 : 4096);
#pragma unroll
    for (int i = 0; i < 2; ++i) {
        const int idx = tid + i * NTHR, tk = idx >> 3, chb = h * 64 + (idx & 7) * 8;
#pragma unroll
        for (int tap = 0; tap < 4; ++tap) {
            const int t = t0 + tk + tap - 2; const bool ok = (t >= seq_lo) && (t < seq_hi); const int tc = ok ? t : t0;
            xr[i][tap] = *(const v4u*)(XR + (size_t)tc * D + chb);
        }
    }
}
template <int MODE> __device__ __forceinline__ int rg_item(int k) {
    const int h = blockIdx.x & 15, q = blockIdx.x >> 4;
    int tt;
    if (MODE == 1) tt = k < 4 ? 2 * (q + 16 * (k >> 1)) + (k & 1) : 64 + q + 16 * (k - 4);
    else tt = k < 2 ? 2 * (q + 16 * k) + 1 : 64 + q + 16 * (k - 2);
    return tt * 16 + h;
}
template <int MODE>
__device__ __forceinline__ void phase_rg(const Args& a, LAS unsigned char* lds, int tid, int wave, int lane, bf16* YR) {
    const bf16* XR = (const bf16*)((const unsigned char*)a.out + 32 * MiB); const bf16* GGR = (const bf16*)(a.ws + WS_GU) + D;
    const float* GC = (const float*)(a.ws + WS_GC); const bf16* WG = (const bf16*)(a.ws + WS_WG);
    f32x2* AGG = (f32x2*)(a.ws + WS_AGG); const float* CAR = (const float*)(a.ws + WS_CAR); float* nstate = a.out + (size_t)M * D;
    const float* convw = a.in[I_CONVW]; const float* convb = a.in[I_CONVB];
    const int fr = lane & 15, fq = lane >> 4;
    int last_h = -1;
    v4u xr[2][4];
    constexpr int NK = MODE == 1 ? 8 : 6;
    rg_load_raw(XR, rg_item<MODE>(0), tid, xr);
    if constexpr (MODE == 1) {
        const float* st0 = a.in[I_STATE];
#pragma unroll 1
        for (int kk = tid >> 7; kk < 8; kk += 4) {
            const int it = rg_item<1>(kk);
            {
                const int d = (tid >> 6) & 1, cl = tid & 63, h = it & 15, tt = it >> 4;
                float hc;
                if (tt < 64) {
                    const f32x2 g = AGG[((size_t)((tt | 1) * 16 + h) * 2 + 1) * 64 + cl];
                    hc = ((tt & 1) == 0 && d == 1) ? g[1] : 0.f;
                } else {
                    const int b = (tt - 64) >> 5, j = (tt - 64) & 31, tt0 = 64 + b * 32;
                    f32x2 ag[31];
#pragma unroll
                    for (int sI = 0; sI < 31; ++sI) { const int ti = d ? 31 - sI : sI; ag[sI] = AGG[((size_t)((tt0 + ti) * 16 + h) * 2 + d) * 64 + cl]; }
                    hc = st0[(size_t)b * 2048 + d * 1024 + h * 64 + cl];
#pragma unroll
                    for (int sI = 0; sI < 31; ++sI) { const int ti = d ? 31 - sI : sI; if (d ? (ti > j) : (ti < j)) hc = ag[sI][0] * hc + ag[sI][1]; }
                }
                *(LAS float*)(lds + RG_CARL + ((kk * 2 + d) * 64 + cl) * 4) = hc;
            }
        }
        __syncthreads();
    }
    for (int kitem = 0; kitem < NK; ++kitem) {
        const int item = rg_item<MODE>(kitem);
        const int h = item & 15, tt = item >> 4, t0 = tt * 128;
        if (h != last_h) {
#pragma unroll
            for (int i = 0; i < 4; ++i) { const int o = (tid + i * NTHR) * 16; *(LAS v4u*)(lds + RG_WB + o) = *(const v4u*)((const unsigned char*)WG + (size_t)h * 32768 + o); }
            if (tid < 128) *(LAS f32x4*)(lds + RG_GCL + tid * 16) = *(const f32x4*)(GC + (size_t)((tid >> 6) * D + h * 64 + (tid & 63)) * 4);
            if (tid < 80) { const int row = tid >> 4, c4 = (tid & 15) * 4;
                *(LAS f32x4*)(lds + RG_CWL + (row * 64 + c4) * 4) = *(const f32x4*)((row < 4 ? convw + row * D : convb) + h * 64 + c4); }
            last_h = h;
            __syncthreads();
        }
        const int seq_lo = t0 < MCTX ? (t0 & ~255) : MCTX + ((t0 - MCTX) & ~4095), seq_hi = seq_lo + (t0 < MCTX ? 256 : 4096);
        float car[2][4]; v4u ggr[2];
        if constexpr (MODE == 1) {
#pragma unroll
            for (int d = 0; d < 2; ++d)
#pragma unroll
                for (int cb = 0; cb < 4; ++cb) car[d][cb] = *(const LAS float*)(lds + RG_CARL + ((kitem * 2 + d) * 64 + cb * 16 + fr) * 4);
#pragma unroll
            for (int i = 0; i < 2; ++i) { const int idx = tid + i * NTHR; ggr[i] = *(const v4u*)(GGR + (size_t)(t0 + (idx >> 3)) * YLD + h * 64 + (idx & 7) * 8); }
        }
        {
            const int c8 = (tid & 7) * 8;
            f32x4 w0[4], w1[4];
#pragma unroll
            for (int tap = 0; tap < 4; ++tap) { w0[tap] = *(const LAS f32x4*)(lds + RG_CWL + (tap * 64 + c8) * 4); w1[tap] = *(const LAS f32x4*)(lds + RG_CWL + (tap * 64 + c8 + 4) * 4); }
            const f32x4 b0 = *(const LAS f32x4*)(lds + RG_CWL + (4 * 64 + c8) * 4), b1 = *(const LAS f32x4*)(lds + RG_CWL + (4 * 64 + c8 + 4) * 4);
#pragma unroll
            for (int i = 0; i < 2; ++i) {
                const int idx = tid + i * NTHR, tk = idx >> 3, cg8 = idx & 7;
                f32x4 x0 = b0, x1 = b1;
#pragma unroll
                for (int tap = 0; tap < 4; ++tap) { const int t = t0 + tk + tap - 2; const bool ok = (t >= seq_lo) && (t < seq_hi);
                    v4u r = xr[i][tap]; r.x = ok ? r.x : 0u; r.y = ok ? r.y : 0u; r.z = ok ? r.z : 0u; r.w = ok ? r.w : 0u;
                    x0[0] += w0[tap][0] * bflo(r.x); x0[1] += w0[tap][1] * bfhi(r.x); x0[2] += w0[tap][2] * bflo(r.y); x0[3] += w0[tap][3] * bfhi(r.y);
                    x1[0] += w1[tap][0] * bflo(r.z); x1[1] += w1[tap][1] * bfhi(r.z); x1[2] += w1[tap][2] * bflo(r.w); x1[3] += w1[tap][3] * bfhi(r.w); }
                v4u o; o.x = pk2(x0[0], x0[1]); o.y = pk2(x0[2], x0[3]); o.z = pk2(x1[0], x1[1]); o.w = pk2(x1[2], x1[3]);
                *(LAS v4u*)(lds + RG_XA + tk * 144 + cg8 * 16) = o;
                *(LAS f32x4*)(lds + RG_XF + (tk * 68 + cg8 * 8) * 4) = x0; *(LAS f32x4*)(lds + RG_XF + (tk * 68 + cg8 * 8 + 4) * 4) = x1;
            }
        }
        if (kitem + 1 < NK) rg_load_raw(XR, rg_item<MODE>(kitem + 1), tid, xr);
        __syncthreads();
        const int tokb = wave * 16;
        bf16x8 afr[2];
#pragma unroll
        for (int ks = 0; ks < 2; ++ks) afr[ks] = *(const LAS bf16x8*)(lds + RG_XA + (tokb + fr) * 144 + (ks * 32 + fq * 8) * 2);
        f32x4 gcv[2][4];
#pragma unroll
        for (int d = 0; d < 2; ++d)
#pragma unroll
            for (int cb = 0; cb < 4; ++cb) gcv[d][cb] = *(const LAS f32x4*)(lds + RG_GCL + (d * 64 + cb * 16 + fr) * 16);
        float av[2][4][4], bv[2][4][4], Ap[2][4], Hp[2][4];
        const bool ctx = t0 < MCTX;
#pragma unroll
        for (int d = 0; d < 2; ++d) {
            if (MODE == 0 && ctx && d != (tt & 1)) continue;
#pragma unroll
            for (int cb = 0; cb < 4; ++cb) {
                const f32x4 gc = gcv[d][cb];
                f32x4 ar = {0.f, 0.f, 0.f, 0.f}, ai = {0.f, 0.f, 0.f, 0.f};
#pragma unroll
                for (int ks = 0; ks < 2; ++ks) {
                    const bf16x8 b0 = *(const LAS bf16x8*)(lds + RG_WB + (((0 * 8 + d * 4 + cb) * 2 + ks) * 64 + lane) * 16);
                    const bf16x8 b1 = *(const LAS bf16x8*)(lds + RG_WB + (((1 * 8 + d * 4 + cb) * 2 + ks) * 64 + lane) * 16);
                    ar = __builtin_amdgcn_mfma_f32_16x16x32_bf16(afr[ks], b0, ar, 0, 0, 0);
                    ai = __builtin_amdgcn_mfma_f32_16x16x32_bf16(afr[ks], b1, ai, 0, 0, 0);
                }
#pragma unroll
                for (int r = 0; r < 4; ++r) {
                    const float xcv = *(const LAS float*)(lds + RG_XF + ((tokb + fq * 4 + r) * 68 + cb * 16 + fr) * 4);
                    const float rr = __builtin_amdgcn_rcpf(__builtin_fmaf(__builtin_amdgcn_exp2f(ar[r]), gc[0], 1.f)), ii = __builtin_amdgcn_rcpf(__builtin_fmaf(__builtin_amdgcn_exp2f(ai[r]), gc[1], 1.f));
                    const float aa = __builtin_amdgcn_exp2f(rr * gc[2]);
                    const float om = fmaxf(1.f - aa * aa, 1e-12f);
                    av[d][cb][r] = aa; bv[d][cb][r] = __builtin_amdgcn_sqrtf(om) * ii * xcv;
                }
                float A = 1.f, Hh = 0.f;
#pragma unroll
                for (int rr = 0; rr < 4; ++rr) { const int r = d ? 3 - rr : rr; Hh = av[d][cb][r] * Hh + bv[d][cb][r]; A *= av[d][cb][r]; }
                float Aw = 1.f, Hw = 0.f, Apl = 1.f, Hpl = 0.f;
#pragma unroll
                for (int gg = 0; gg < 4; ++gg) { const int g = d ? 3 - gg : gg;
                    const float Ag = __shfl(A, g * 16 + fr), Hg = __shfl(Hh, g * 16 + fr);
                    if (g == fq) { Apl = Aw; Hpl = Hw; }
                    Hw = Ag * Hw + Hg; Aw *= Ag; }
                Ap[d][cb] = Apl; Hp[d][cb] = Hpl;
                if (fq == 0) *(LAS f32x2*)(lds + RG_AGL + ((wave * 2 + d) * 64 + cb * 16 + fr) * 8) = (f32x2){Aw, Hw};
            }
        }
        __syncthreads();
        if constexpr (MODE == 0) {
            if (tid < 128 && !(ctx && (tid >> 6) != (tt & 1))) {
                const int d = tid >> 6, cl = tid & 63; float A = 1.f, Hh = 0.f;
#pragma unroll
                for (int ww = 0; ww < 8; ++ww) { const int w2 = d ? 7 - ww : ww; const f32x2 sg = *(const LAS f32x2*)(lds + RG_AGL + ((w2 * 2 + d) * 64 + cl) * 8); Hh = sg[0] * Hh + sg[1]; A *= sg[0]; }
                AGG[((size_t)(tt * 16 + h) * 2 + d) * 64 + cl] = (f32x2){A, Hh};
            }
        } else {
            if (ctx && (tt & 1) == 0 && tid < 64) {
                float Hh = 0.f;
#pragma unroll
                for (int w2 = 0; w2 < 8; ++w2) { const f32x2 sg = *(const LAS f32x2*)(lds + RG_AGL + ((w2 * 2 + 0) * 64 + tid) * 8); Hh = sg[0] * Hh + sg[1]; }
                *(LAS float*)(lds + RG_CARL + (((kitem + 1) * 2 + 0) * 64 + tid) * 4) = Hh;
            }
            float hs[4][4];
#pragma unroll
            for (int cb = 0; cb < 4; ++cb)
#pragma unroll
                for (int r = 0; r < 4; ++r) hs[cb][r] = 0.f;
#pragma unroll
            for (int d = 0; d < 2; ++d)
#pragma unroll
                for (int cb = 0; cb < 4; ++cb) {
                    const int cl = cb * 16 + fr;
                    float hin = car[d][cb];
                    f32x2 sg[8];
#pragma unroll
                    for (int w2 = 0; w2 < 8; ++w2) sg[w2] = *(const LAS f32x2*)(lds + RG_AGL + ((w2 * 2 + d) * 64 + cl) * 8);
#pragma unroll
                    for (int ww = 0; ww < 8; ++ww) { const int w2 = d ? 7 - ww : ww; if (d ? (w2 > wave) : (w2 < wave)) hin = sg[w2][0] * hin + sg[w2][1]; }
                    float hh = Ap[d][cb] * hin + Hp[d][cb];
#pragma unroll
                    for (int rr = 0; rr < 4; ++rr) { const int r = d ? 3 - rr : rr; hh = av[d][cb][r] * hh + bv[d][cb][r]; hs[cb][r] += hh; }
                    if (ctx && (tt & 1) == (d ? 0 : 1) && wave == (d ? 0 : 7) && fq == (d ? 0 : 3)) nstate[(size_t)(tt >> 1) * 2048 + d * 1024 + h * 64 + cl] = hh;
                }
#pragma unroll
            for (int cb = 0; cb < 4; ++cb)
#pragma unroll
                for (int r = 0; r < 4; ++r) *(LAS float*)(lds + RG_XF + ((tokb + fq * 4 + r) * 68 + cb * 16 + fr) * 4) = hs[cb][r];
            __syncthreads();
#pragma unroll
            for (int i = 0; i < 2; ++i) {
                const int idx = tid + i * NTHR, tk = idx >> 3, cg8 = idx & 7;
                const f32x4 y0 = *(const LAS f32x4*)(lds + RG_XF + (tk * 68 + cg8 * 8) * 4), y1 = *(const LAS f32x4*)(lds + RG_XF + (tk * 68 + cg8 * 8 + 4) * 4);
                const v4u g = ggr[i];
                v4u o; o.x = pk2(y0[0] * bflo(g.x), y0[1] * bfhi(g.x)); o.y = pk2(y0[2] * bflo(g.y), y0[3] * bfhi(g.y));
                o.z = pk2(y1[0] * bflo(g.z), y1[1] * bfhi(g.z)); o.w = pk2(y1[2] * bflo(g.w), y1[3] * bfhi(g.w));
                *(v4u*)(YR + (size_t)(t0 + tk) * YLD + h * 64 + cg8 * 8) = o;
            }
        }
        __syncthreads();
    }
}

template <int NT>
__device__ __forceinline__ float carry_chain(const f32x2* AGG, float* CAR, int tt0, int h, int d, int cl, float h0) {
    f32x2 ag[NT];
#pragma unroll
    for (int i = 0; i < NT; ++i) ag[i] = AGG[((size_t)((tt0 + i) * 16 + h) * 2 + d) * 64 + cl];
    float hc = h0;
#pragma unroll
    for (int ii = 0; ii < NT; ++ii) { const int i = d ? NT - 1 - ii : ii;
        CAR[((size_t)((tt0 + i) * 16 + h) * 2 + d) * 64 + cl] = hc; hc = ag[i][0] * hc + ag[i][1]; }
    return hc;
}
__device__ __forceinline__ void phase_carry(const Args& a, int gw, int NGW, int lane) {
    const f32x2* AGG = (const f32x2*)(a.ws + WS_AGG); float* CAR = (float*)(a.ws + WS_CAR);
    for (int wi = gw; wi < 34 * 2 * 16; wi += NGW) {
        const int s = wi >> 5, d = (wi >> 4) & 1, h = wi & 15, ch = h * 64 + lane;
        if (s < 32) {
            const size_t i0 = ((size_t)((2 * s) * 16 + h) * 2 + d) * 64 + lane, i1 = ((size_t)((2 * s + 1) * 16 + h) * 2 + d) * 64 + lane;
            if (d == 0) { CAR[i0] = 0.f; CAR[i1] = AGG[i0][1]; }
            else { CAR[i1] = 0.f; CAR[i0] = AGG[i1][1]; }
        } else {
            const int b = s - 32; const float h0 = a.in[I_STATE][(size_t)b * 2048 + d * 1024 + ch];
            if (d == 0) (void)carry_chain<32>(AGG, CAR, 64 + b * 32, h, 0, lane, h0);
            else (void)carry_chain<32>(AGG, CAR, 64 + b * 32, h, 1, lane, h0);
        }
    }
}

#define RLX_AGENT __ATOMIC_RELAXED, __HIP_MEMORY_SCOPE_AGENT
#define XB_TMO      128
#define XB_XCNT(j)  (256  + 64 * (j))
#define XB_XSUB(j)  (1280 + 64 * (j))
#define XB_XGEN(j)  (2304 + 64 * (j))
#define XB_TOP      3328
#define XB_TOPGEN   3392
#define XCD_BAR_WORDS 3456
#define XB_SPIN_CAP (1u << 18)

__device__ __forceinline__ unsigned xb_ld(unsigned* p)              { return __hip_atomic_load(p, __ATOMIC_RELAXED, __HIP_MEMORY_SCOPE_AGENT); }
__device__ __forceinline__ unsigned xb_add(unsigned* p, unsigned v) { return __hip_atomic_fetch_add(p, v, __ATOMIC_RELAXED, __HIP_MEMORY_SCOPE_AGENT); }
__device__ __forceinline__ unsigned xb_xcc_id() { return (unsigned)__builtin_amdgcn_s_getreg((3 << 11) | 20) & 0xFu; }
#define XB_SPIN(cond, bar) do { unsigned _sp = 0; while (cond) { __builtin_amdgcn_s_sleep(1); \
    if ((++_sp & 255u) == 0u) { if (xb_ld(&(bar)[XB_TMO])) break; if (_sp > XB_SPIN_CAP) { atomicAdd(&(bar)[XB_TMO], 1u); break; } } } } while (0)

struct XcdBarrier {
    unsigned* bar; unsigned x;
    volatile LAS unsigned* st;
};

__device__ __forceinline__ XcdBarrier xcd_barrier_post(unsigned* bar, volatile LAS unsigned* st) {
    XcdBarrier b; b.bar = bar; b.x = xb_xcc_id(); b.st = st;
    if (threadIdx.x == 0) (void)xb_add(&bar[XB_XCNT(b.x)], 1u);
    return b;
}
__device__ __forceinline__ void xcd_barrier_complete(unsigned* bar, unsigned x, unsigned& nloc, unsigned& nx) {
    const unsigned G = gridDim.x * gridDim.y * gridDim.z;
    unsigned sum, cnt, mine, sp = 0u;
    for (;;) {
        sum = 0u; cnt = 0u; mine = 0u;
#pragma unroll
        for (unsigned j = 0; j < 16; ++j) { const unsigned c = xb_ld(&bar[XB_XCNT(j)]); sum += c; cnt += (c > 0u) ? 1u : 0u; mine = (j == x) ? c : mine; }
        if (sum == G) break;
        __builtin_amdgcn_s_sleep(1);
        if ((++sp & 255u) == 0u) { if (xb_ld(&bar[XB_TMO])) break; if (sp > XB_SPIN_CAP) { atomicAdd(&bar[XB_TMO], 1u); break; } }
    }
    nloc = mine > 0u ? mine : 1u; nx = cnt > 0u ? cnt : 1u;
}

__device__ __forceinline__ void xcd_barrier(const XcdBarrier& b) {
    asm volatile("s_waitcnt vmcnt(0)" ::: "memory");
    __syncthreads();
    if (threadIdx.x == 0) {
        unsigned* bar = b.bar;
        __builtin_amdgcn_s_waitcnt(0);
        unsigned nloc = b.st[0], nx = b.st[1];
        if (nloc == 0u) { xcd_barrier_complete(bar, b.x, nloc, nx); b.st[0] = nloc; b.st[1] = nx; }
        const unsigned old = xb_add(&bar[XB_XSUB(b.x)], 1u);
        const unsigned gen = old / nloc;
        if (old + 1u == (gen + 1u) * nloc) {
            __builtin_amdgcn_fence(__ATOMIC_RELEASE, "agent");
            asm volatile("s_waitcnt vmcnt(0)" ::: "memory");
            const unsigned og = xb_add(&bar[XB_TOP], 1u);
            const unsigned tg = og / nx;
            if (og + 1u == (tg + 1u) * nx) xb_add(&bar[XB_TOPGEN], 1u);
            else XB_SPIN(xb_ld(&bar[XB_TOPGEN]) == tg, bar);
            __builtin_amdgcn_fence(__ATOMIC_ACQUIRE, "agent");
            xb_add(&bar[XB_XGEN(b.x)], 1u);
            asm volatile("s_waitcnt vmcnt(0)" ::: "memory");
        } else {
            XB_SPIN(xb_ld(&bar[XB_XGEN(b.x)]) == gen, bar);
            __builtin_amdgcn_fence(__ATOMIC_ACQUIRE, "agent");
            asm volatile("s_waitcnt vmcnt(0)" ::: "memory");
        }
    }
    __syncthreads();
}

__global__ void __launch_bounds__(NTHR, 2) fwd_megakernel(Args a) {
    extern __shared__ __attribute__((aligned(16))) unsigned char lds_raw[];
    LAS unsigned char* lds = (LAS unsigned char*)lds_raw;
    const int tid = threadIdx.x, lane = tid & 63, wave = __builtin_amdgcn_readfirstlane(tid >> 6);
    const int G = gridDim.x, gw = blockIdx.x * NWAVES + wave, NGW = G * NWAVES;
    unsigned char* ws = a.ws;
    const int lo = a.ph_lo, hi = a.ph_hi;
    volatile LAS unsigned* bst = (volatile LAS unsigned*)(lds + LDS_BAR_OFF);
    if (tid < 2) bst[tid] = 0u;
    __syncthreads();
    XcdBarrier bar = xcd_barrier_post((unsigned*)(ws + WS_CTL), bst);
#define IN(k) (lo <= (k) && (k) < hi)
#define SEAM(k) do { if (IN(k) && IN((k) + 1)) { xcd_barrier(bar); if (DUP >> 12 & 1) xcd_barrier(bar); } } while (0)
    float* const DUMSS = (float*)(ws + 1 * MiB + 512 * 1024);
#define REP(k) for (int rep_ = ((DUP >> (k)) & 1); rep_ >= 0; --rep_)
#define ISDUP (rep_ > 0)
    if (IN(0)) REP(0) phase_prep(a, lds, gw, NGW, wave, lane, ISDUP ? (float*)(ws + 1 * MiB + 256 * 1024) : (float*)(ws + CTL_MOD));
    SEAM(0);
    if (IN(1)) REP(1) phase_norm1(a, gw, NGW, lane);
    SEAM(1);
    if (IN(2)) REP(2) {
        pg8::Gemm g{(const pg8::bf16_t*)(ws + WS_H), (const pg8::bf16_t*)(ws + WS_WIN), M, INC, D}; pg8::StaticOrder S; S.init(M, INC, G, (int)blockIdx.x, WG_IN);
        pg8::Epi<1> E{nullptr, nullptr, nullptr, ISDUP ? DUMSS : (float*)(ws + CTL_VSS), D, (bf16*)(ws + WS_GU), (bf16*)a.out, (bf16*)((unsigned char*)a.out + 32 * MiB), (bf16*)(ws + WS_GU) + D, (bf16*)(ws + WS_SGA), (bf16*)(ws + WS_SGB)};
        pg8::gemm_phase<pg8::Epi<1>, pg8::StaticOrder, true, true>(lds, g, S, E);
    }
    SEAM(2);
    if (IN(3)) REP(3) { phase_rg<0>(a, lds, tid, wave, lane, nullptr); phase_sgu(a, lds, tid, wave, lane, ISDUP ? (bf16*)(ws + WS_F) : (bf16*)(ws + WS_GU)); }
    SEAM(3);
    if (IN(5)) REP(5) phase_rg<1>(a, lds, tid, wave, lane, ISDUP ? (bf16*)(ws + WS_F) + D : (bf16*)(ws + WS_GU) + D);
    SEAM(5);
    if (IN(6)) REP(6) {
        pg8::Gemm g{(const pg8::bf16_t*)(ws + WS_GU), (const pg8::bf16_t*)(ws + WS_WBG), M, D, 2 * D}; pg8::StaticOrder S; S.init(M, D, G, (int)blockIdx.x);
        pg8::EpiMerge E{(bf16*)(ws + WS_H), (const bf16*)(ws + WS_SGA), (const bf16*)(ws + WS_SGB)};
        pg8::gemm_phase<pg8::EpiMerge, pg8::StaticOrder, false, true>(lds, g, S, E);
    }
    SEAM(6);
    if (IN(7)) {
        pg8::Gemm g{(const pg8::bf16_t*)(ws + WS_H), (const pg8::bf16_t*)(ws + WS_WOUT), M, D, D}; pg8::StaticOrder S; S.init(M, D, G, (int)blockIdx.x);
        EpiFused<6> E{a.out, a.in[I_XP], a.in[I_XS], (bf16*)(ws + WS_H), (float*)(ws + CTL_OSS), (float*)(ws + CTL_XSS), (unsigned*)(ws + CTL_CNT), (unsigned*)(ws + CTL_CNT + 16384),
                      (const float*)(ws + CTL_MOD), a.in[I_BADA], a.in[I_GPOSTMIX], a.in[I_GPREMLP]};
        pg8::gemm_phase<EpiFused<6>, pg8::StaticOrder, false, true>(lds, g, S, E);
    }
    SEAM(7);
    if (IN(8)) REP(8) {
        pg8::Gemm g{(const pg8::bf16_t*)(ws + WS_H), (const pg8::bf16_t*)(ws + WS_WFF1), M, FF, D}; pg8::StaticOrder S; S.init(M, FF, G, (int)blockIdx.x, WG_FF1);
        pg8::Epi<5> E{(bf16*)(ws + WS_F1), nullptr, nullptr, nullptr, FF, nullptr, nullptr, nullptr, nullptr, nullptr, nullptr};
        pg8::gemm_phase<pg8::Epi<5>, pg8::StaticOrder, true, true>(lds, g, S, E);
    }
    SEAM(8);
    if (IN(9)) {
        pg8::Gemm g{(const pg8::bf16_t*)(ws + WS_F1), (const pg8::bf16_t*)(ws + WS_WFF2), M, D, FF}; pg8::StaticOrder S; S.init(M, D, G, (int)blockIdx.x);
        EpiFused<7> E{a.out, nullptr, nullptr, nullptr, (float*)(ws + CTL_FSS), nullptr, (unsigned*)(ws + CTL_CNT + 32768), nullptr,
                      (const float*)(ws + CTL_MOD), a.in[I_BADA], a.in[I_GPOSTMLP], nullptr};
        pg8::gemm_phase<EpiFused<7>, pg8::StaticOrder, false, true>(lds, g, S, E);
    }
#undef IN
#undef SEAM
}

constexpr int N_PHASES = 10;
extern "C" void kernel_launch(void* const* d_in, const int* in_sizes, int n_in, void* d_out, int out_size, void* d_ws, size_t ws_size, hipStream_t stream) {
    static int grid = 0;
    if (grid == 0) {
        if (n_in != 27 || ws_size < WS_END) { fprintf(stderr, "kernel_launch: need 27 inputs and >= %zu B of workspace; got %d, %zu\n", (size_t)WS_END, n_in, ws_size); grid = -1; return; }
        int dev = 0, cus = 0, per_cu = 0;
        if (hipGetDevice(&dev) != hipSuccess || hipDeviceGetAttribute(&cus, hipDeviceAttributeMultiprocessorCount, dev) != hipSuccess) { grid = -1; return; }
        if (hipFuncSetAttribute((const void*)fwd_megakernel, hipFuncAttributeMaxDynamicSharedMemorySize, LDS_BYTES) != hipSuccess) { fprintf(stderr, "kernel_launch: hipFuncSetAttribute failed\n"); grid = -1; return; }
        if (hipOccupancyMaxActiveBlocksPerMultiprocessor(&per_cu, (const void*)fwd_megakernel, NTHR, LDS_BYTES) != hipSuccess || per_cu < 1) { fprintf(stderr, "kernel_launch: occupancy query says %d\n", per_cu); per_cu = 1; }
        (void)hipGetLastError();
        grid = cus * per_cu;
        if (grid < 256) { fprintf(stderr, "kernel_launch: this kernel's work split needs 256 co-resident workgroups; the device offers %d\n", grid); grid = -1; return; }
        grid = 256;
    }
    if (grid < 0) return;
    (void)hipMemsetAsync((char*)d_ws + WS_CTL, 0, CTL_ZERO_BYTES, stream);
    Args a{};
    for (int i = 0; i < 27; ++i) a.in[i] = (const float*)d_in[i];
    a.out = (float*)d_out; a.ws = (unsigned char*)d_ws; a.ph_lo = 0; a.ph_hi = N_PHASES;
    void* args[] = {&a};
    hipError_t e = hipLaunchCooperativeKernel((const void*)fwd_megakernel, dim3(grid), dim3(NTHR), args, LDS_BYTES, stream);
    if (e != hipSuccess) fprintf(stderr, "kernel_launch: cooperative launch failed: %s (grid %d)\n", hipGetErrorString(e), grid);
}
```

```cpp
#include <hip/hip_runtime.h>
#include <hip/hip_cooperative_groups.h>
#include <cstdio>
#include <cstdint>
namespace cg = cooperative_groups;
namespace pg8 {
#define PG8_LAS __attribute__((address_space(3)))
typedef unsigned short bf16_t;
typedef short bf16x8 __attribute__((ext_vector_type(8)));
typedef float f32x4 __attribute__((ext_vector_type(4)));
typedef unsigned u32x4 __attribute__((ext_vector_type(4)));
constexpr int BM = 256, BK = 64, HALF = 128, HTB = HALF * BK * 2  , STAGE_BYTES = 8 * HTB, NXCD = 8, WGM = 8;

__host__ __device__ __forceinline__ int lds_byte(int r, int c) { const int st = (r >> 4) * 2 + (c >> 5), rr = r & 15, cc = c & 31, ob = rr * 64 + cc * 2; return st * 1024 + (ob ^ (((ob >> 9) & 1) << 5)); }
__host__ __device__ __forceinline__ void stage_rc(int b, int& R, int& C) { const int st = b / 1024, sb = b % 1024, swz = sb ^ (((sb >> 9) & 1) << 5); R = (st >> 1) * 16 + swz / 64; C = (st & 1) * 32 + (swz % 64) / 2; }
__host__ __device__ __forceinline__ int perm32(int rho) { const int n = rho >> 4, i = rho & 15; return 8 * (i >> 2) + 4 * n + (i & 3); }

struct Unit { int pm, pn; };
struct Gemm { const bf16_t* A; const bf16_t* Bt; int M, N, K; };

struct StaticOrder {
    int nM, nN, nwg, G, c, wgm;
    __host__ __device__ void init(int M, int N, int G_, int c_, int wgm_ = 8) { nM = M / BM; nN = N / BM; nwg = nM * nN; G = G_; c = c_; wgm = wgm_; }
    __host__ __device__ bool next(int i, Unit& u) const {
        const long L = (long)i * G + c; if (L >= nwg) return false;
        int wgid = (int)L; { const int q = nwg / NXCD, r = nwg % NXCD, xcd = wgid % NXCD, off = wgid / NXCD; wgid = (xcd < r ? xcd * (q + 1) : r * (q + 1) + (xcd - r) * q) + off; }
        const int nig = wgm * nN, gid = wgid / nig, fm = gid * wgm, gsz = (nM - fm) < wgm ? (nM - fm) : wgm;
        u.pm = fm + ((wgid % nig) % gsz); u.pn = (wgid % nig) / gsz; return true;
    }
    __device__ __forceinline__ void a_ready(const Unit&) const {}
    __device__ __forceinline__ void done(const Unit&) const {}
};

typedef __bf16 bf16x2_cvt __attribute__((ext_vector_type(2)));
typedef float f32x2_cvt __attribute__((ext_vector_type(2)));
__device__ __forceinline__ unsigned cvt_pk_bf16(float lo, float hi) { const f32x2_cvt v = {lo, hi}; const bf16x2_cvt b = __builtin_convertvector(v, bf16x2_cvt); return __builtin_bit_cast(unsigned, b); }
__device__ __forceinline__ float sigmoid_f(float x) { return __builtin_amdgcn_rcpf(1.f + __builtin_amdgcn_exp2f(-1.4426950409f * x)); }
__device__ __forceinline__ float gelu_tanh_f(float x) { const float u = x * (-2.3022081985f - 0.10294324f * (x * x)); return x * __builtin_amdgcn_rcpf(1.f + __builtin_amdgcn_exp2f(u)); }
__device__ __forceinline__ float bflo(unsigned w) { return __builtin_bit_cast(float, w << 16); }
__device__ __forceinline__ float bfhi(unsigned w) { return __builtin_bit_cast(float, w & 0xffff0000u); }
template <int MODE> struct Epi {
    static constexpr bool PERM = true, AFTER_DRAIN = false, HOOK = false;
    bf16_t* Ob; float* Of; const bf16_t* G; float* SS; int ldc;
    bf16_t *s0, *s1, *s2, *s3, *s4, *s5;
    __device__ __forceinline__ void operator()(const f32x4 (&acc)[2][2][4][2], const Unit& u, int wr, int wc, int fr, int fq) const {
        const int row0 = u.pm * BM + wr * 64 + fr;
        if constexpr (MODE == 1) {
            const int t = u.pn >> 2;
            bf16_t* base = t == 0 ? s0 : t == 1 ? s1 : t == 2 ? s2 : t == 3 ? s3 : t == 4 ? s4 : s5;
            const int col0 = (u.pn & 3) * BM + wc * 32 + 8 * fq;
#pragma unroll
            for (int ai = 0; ai < 2; ++ai)
#pragma unroll
                for (int m = 0; m < 4; ++m) {
                    const int row = row0 + ai * HALF + m * 16; bf16_t* rowp = base + (size_t)row * ((t == 0 || t == 3) ? 2048 : 1024) + col0; float ss = 0.f;
#pragma unroll
                    for (int bj = 0; bj < 2; ++bj) {
                        f32x4 v0 = acc[ai][bj][m][0], v1 = acc[ai][bj][m][1];
                        if (t >= 4) {
#pragma unroll
                            for (int j = 0; j < 4; ++j) { v0[j] = sigmoid_f(v0[j]); v1[j] = sigmoid_f(v1[j]); }
                        } else if (t != 2) {
#pragma unroll
                            for (int j = 0; j < 4; ++j) { v0[j] = gelu_tanh_f(v0[j]); v1[j] = gelu_tanh_f(v1[j]); }
                        }
                        if (t == 1) {
#pragma unroll
                            for (int j = 0; j < 4; ++j) ss += v0[j] * v0[j] + v1[j] * v1[j];
                        }
                        u32x4 w; w.x = cvt_pk_bf16(v0[0], v0[1]); w.y = cvt_pk_bf16(v0[2], v0[3]); w.z = cvt_pk_bf16(v1[0], v1[1]); w.w = cvt_pk_bf16(v1[2], v1[3]);
                        *(u32x4*)(rowp + bj * HALF) = w;
                    }
                    if (t == 1) { ss += __shfl_xor(ss, 16); ss += __shfl_xor(ss, 32); if (fq == 0) atomicAdd(SS + row, ss); }
                }
        } else {
            const int col0 = u.pn * BM + wc * 32 + 8 * fq;
#pragma unroll
            for (int ai = 0; ai < 2; ++ai)
#pragma unroll
                for (int m = 0; m < 4; ++m) {
                    const int row = row0 + ai * HALF + m * 16; float ss = 0.f;
#pragma unroll
                    for (int bj = 0; bj < 2; ++bj) {
                        f32x4 v0 = acc[ai][bj][m][0], v1 = acc[ai][bj][m][1];
                        const size_t off = (size_t)row * ldc + col0 + bj * HALF;
                        if constexpr (MODE == 2 || MODE == 3) {
                            const u32x4 g = *(const u32x4*)(G + off);
                            v0[0] *= bflo(g.x); v0[1] *= bfhi(g.x); v0[2] *= bflo(g.y); v0[3] *= bfhi(g.y);
                            v1[0] *= bflo(g.z); v1[1] *= bfhi(g.z); v1[2] *= bflo(g.w); v1[3] *= bfhi(g.w);
                        }
                        if constexpr (MODE == 3) { v0 = v0 + *(const f32x4*)(Of + off); v1 = v1 + *(const f32x4*)(Of + off + 4); }
                        if constexpr (MODE == 5) {
#pragma unroll
                            for (int j = 0; j < 4; ++j) { const float a = fmaxf(v0[j], 0.f), b = fmaxf(v1[j], 0.f); v0[j] = a * a; v1[j] = b * b; }
                        }
                        if constexpr (MODE == 4) {
#pragma unroll
                            for (int j = 0; j < 4; ++j) ss += v0[j] * v0[j] + v1[j] * v1[j];
                        }
                        if constexpr (MODE == 2 || MODE == 4) { *(f32x4*)(Of + off) = v0; *(f32x4*)(Of + off + 4) = v1; }
                        else { u32x4 w; w.x = cvt_pk_bf16(v0[0], v0[1]); w.y = cvt_pk_bf16(v0[2], v0[3]); w.z = cvt_pk_bf16(v1[0], v1[1]); w.w = cvt_pk_bf16(v1[2], v1[3]);
                            *(u32x4*)(Ob + off) = w; }
                    }
                    if constexpr (MODE == 4) { ss += __shfl_xor(ss, 16); ss += __shfl_xor(ss, 32); if (fq == 0) atomicAdd(SS + row, ss); }
                }
        }
    }
};

struct EpiMerge {
    static constexpr bool PERM = true, AFTER_DRAIN = false, HOOK = true;
    bf16_t* Ob; const bf16_t* GA; const bf16_t* GB;
    __device__ __forceinline__ void mid(f32x4 (&acc)[2][2][4][2], const Unit& u, int wr, int wc, int fr, int fq) const {
        int row0 = u.pm * BM + wr * 64 + fr, col0 = u.pn * BM + wc * 32 + 8 * fq;
        asm volatile("" : "+v"(row0), "+v"(col0));
#pragma unroll
        for (int ai = 0; ai < 2; ++ai)
#pragma unroll
            for (int m = 0; m < 4; ++m) {
                if ((m & 1) == 0) asm volatile("" ::: "memory");
#pragma unroll
                for (int bj = 0; bj < 2; ++bj) {
                    const size_t off = (size_t)(row0 + ai * HALF + m * 16) * 1024 + col0 + bj * HALF;
                    const u32x4 a = *(const u32x4*)(GA + off), b = *(const u32x4*)(GB + off);
                    f32x4 r0, r1;
                    r0[0] = bflo(a.x) * __builtin_amdgcn_rcpf(fmaxf(bflo(b.x), 1e-30f)); r0[1] = bfhi(a.x) * __builtin_amdgcn_rcpf(fmaxf(bfhi(b.x), 1e-30f));
                    r0[2] = bflo(a.y) * __builtin_amdgcn_rcpf(fmaxf(bflo(b.y), 1e-30f)); r0[3] = bfhi(a.y) * __builtin_amdgcn_rcpf(fmaxf(bfhi(b.y), 1e-30f));
                    r1[0] = bflo(a.z) * __builtin_amdgcn_rcpf(fmaxf(bflo(b.z), 1e-30f)); r1[1] = bfhi(a.z) * __builtin_amdgcn_rcpf(fmaxf(bfhi(b.z), 1e-30f));
                    r1[2] = bflo(a.w) * __builtin_amdgcn_rcpf(fmaxf(bflo(b.w), 1e-30f)); r1[3] = bfhi(a.w) * __builtin_amdgcn_rcpf(fmaxf(bfhi(b.w), 1e-30f));
                    acc[ai][bj][m][0] = acc[ai][bj][m][0] * r0; acc[ai][bj][m][1] = acc[ai][bj][m][1] * r1;
                }
            }
    }
    __device__ __forceinline__ void operator()(const f32x4 (&acc)[2][2][4][2], const Unit& u, int wr, int wc, int fr, int fq) const {
        const int row0 = u.pm * BM + wr * 64 + fr, col0 = u.pn * BM + wc * 32 + 8 * fq;
#pragma unroll
        for (int ai = 0; ai < 2; ++ai)
#pragma unroll
            for (int m = 0; m < 4; ++m)
#pragma unroll
                for (int bj = 0; bj < 2; ++bj) {
                    const size_t off = (size_t)(row0 + ai * HALF + m * 16) * 1024 + col0 + bj * HALF;
                    const u32x4 b = *(const u32x4*)(GB + off);
                    const f32x4 v0 = acc[ai][bj][m][0], v1 = acc[ai][bj][m][1];
                    u32x4 w; w.x = cvt_pk_bf16(v0[0] * bflo(b.x), v0[1] * bfhi(b.x)); w.y = cvt_pk_bf16(v0[2] * bflo(b.y), v0[3] * bfhi(b.y));
                    w.z = cvt_pk_bf16(v1[0] * bflo(b.z), v1[1] * bfhi(b.z)); w.w = cvt_pk_bf16(v1[2] * bflo(b.w), v1[3] * bfhi(b.w));
                    *(u32x4*)(Ob + off) = w;
                }
    }
};

template <class Epi, class Sched, bool ALIGN_EPI = false, bool SP2 = false>
__device__ __forceinline__ void gemm_phase(PG8_LAS unsigned char* lds, const Gemm g, const Sched& S, const Epi& E) {
    const int tid = threadIdx.x, wid = __builtin_amdgcn_readfirstlane(tid >> 6), lane = tid & 63, wr = wid >> 2, wc = wid & 3, fr = lane & 15, fq = lane >> 4;
    const int K = g.K, nt = K / BK;
    unsigned voffA[2], voffB[2];
#pragma unroll
    for (int i = 0; i < 2; ++i) { int R, C; stage_rc(tid * 16 + i * 8192, R, C); const int Rb = Epi::PERM ? ((R & ~31) + perm32(R & 31)) : R;
        voffA[i] = (unsigned)(R * K + C) * 2u; voffB[i] = (unsigned)(Rb * K + C) * 2u; }
    const size_t kstep = (size_t)(BK * 2);
    const size_t hstep = (size_t)HALF * K * 2;
    const size_t tstep = 2 * hstep;
    const unsigned ldsw = (unsigned)wid * 1024u;
    const int aoff = lds_byte(wr * 64 + fr, fq * 8), boff = lds_byte(wc * 32 + fr, fq * 8);
#define PG8_SA(b, h) (((b) * 2 + (h)) * HTB)
#define PG8_SB(b, h) ((4 + (b) * 2 + (h)) * HTB)
#define PG8_STAGE(bufoff, gbase, voff) do { _Pragma("unroll") for (int _i = 0; _i < 2; ++_i) \
        __builtin_amdgcn_global_load_lds((const unsigned*)((const char*)(gbase) + (voff)[_i]), (PG8_LAS unsigned*)(lds + (bufoff) + ldsw + _i * 8192), 16, 0, 0); } while (0)
#define PG8_LDA(dst, b, h) do { _Pragma("unroll") for (int m = 0; m < 4; ++m) _Pragma("unroll") for (int k = 0; k < 2; ++k) dst[m][k] = *(const PG8_LAS bf16x8*)(lds + PG8_SA(b, h) + aoff + m * 2048 + k * 1024); } while (0)
#define PG8_LDB(dst, b, h) do { _Pragma("unroll") for (int n = 0; n < 2; ++n) _Pragma("unroll") for (int k = 0; k < 2; ++k) dst[n][k] = *(const PG8_LAS bf16x8*)(lds + PG8_SB(b, h) + boff + n * 2048 + k * 1024); } while (0)
#define PG8_MMA(ai, bj, At, Bt) do { __builtin_amdgcn_s_setprio(1); _Pragma("unroll") for (int m = 0; m < 4; ++m) _Pragma("unroll") for (int n = 0; n < 2; ++n) _Pragma("unroll") for (int k = 0; k < 2; ++k) \
        acc[ai][bj][m][n] = __builtin_amdgcn_mfma_f32_16x16x32_bf16(Bt[n][k], At[m][k], acc[ai][bj][m][n], 0, 0, 0); __builtin_amdgcn_s_setprio(0); } while (0)
#define PG8_WAIT_V(n) asm volatile("s_waitcnt vmcnt(" #n ")" ::: "memory")
#define PG8_WAIT_L(n) asm volatile("s_waitcnt lgkmcnt(" #n ")" ::: "memory")
#define PG8_BAR __builtin_amdgcn_s_barrier()
#define PG8_SCHED __builtin_amdgcn_sched_barrier(0)
    Unit cur, nxt; int ui = 0;
    if (!S.next(0, cur)) return;
    f32x4 acc[2][2][4][2];
#pragma unroll
    for (int a = 0; a < 2; ++a)
#pragma unroll
        for (int b = 0; b < 2; ++b)
#pragma unroll
            for (int m = 0; m < 4; ++m)
#pragma unroll
                for (int n = 0; n < 2; ++n) acc[a][b][m][n] = (f32x4){0.f, 0.f, 0.f, 0.f};
    bf16x8 At[4][2], B0[2][2], B1[2][2];
    const char* cA = (const char*)g.A + (size_t)cur.pm * tstep; const char* cB = (const char*)g.Bt + (size_t)cur.pn * tstep;
    S.a_ready(cur);
    if constexpr (SP2) {
        PG8_STAGE(PG8_SB(0, 0), cB, voffB); PG8_STAGE(PG8_SB(0, 1), cB + hstep, voffB); PG8_STAGE(PG8_SA(0, 0), cA, voffA); PG8_STAGE(PG8_SA(0, 1), cA + hstep, voffA);
        if (wr == 1) PG8_BAR;
        PG8_WAIT_V(2); PG8_BAR;
        PG8_STAGE(PG8_SB(1, 0), cB + kstep, voffB); PG8_STAGE(PG8_SA(1, 0), cA + kstep, voffA); PG8_STAGE(PG8_SB(1, 1), cB + hstep + kstep, voffB);
        PG8_WAIT_V(6); PG8_BAR;
    } else {
        PG8_STAGE(PG8_SB(0, 0), cB, voffB); PG8_STAGE(PG8_SA(0, 0), cA, voffA); PG8_STAGE(PG8_SB(0, 1), cB + hstep, voffB); PG8_STAGE(PG8_SA(0, 1), cA + hstep, voffA);
        if (wr == 1) PG8_BAR;
        PG8_WAIT_V(4); PG8_BAR;
        PG8_STAGE(PG8_SB(1, 0), cB + kstep, voffB); PG8_STAGE(PG8_SA(1, 0), cA + kstep, voffA); PG8_STAGE(PG8_SB(1, 1), cB + hstep + kstep, voffB);
        PG8_WAIT_V(6); PG8_BAR;
    }
    for (;;) {
        const bool has_next = S.next(ui + 1, nxt);
        const char* nA = has_next ? (const char*)g.A + (size_t)nxt.pm * tstep : cA; const char* nB = has_next ? (const char*)g.Bt + (size_t)nxt.pn * tstep : cB;
        for (int t = 0; t < nt; t += 2) {
            if constexpr (Epi::HOOK) { if (t == (nt >> 1)) E.mid(acc, cur, wr, wc, fr, fq); }
            const bool last = (t == nt - 2);
            const char* a1 = cA + (size_t)(t + 1) * kstep;
            const char* a2 = last ? nA : cA + (size_t)(t + 2) * kstep; const char* b2 = last ? nB : cB + (size_t)(t + 2) * kstep;
            const char* a3 = a2 + kstep; const char* b3 = b2 + kstep;
            if (last && has_next) S.a_ready(nxt);
            if constexpr (SP2) {
            PG8_LDB(B0, 0, 0); PG8_LDB(B1, 0, 1); PG8_SCHED; PG8_LDA(At, 0, 0); PG8_STAGE(PG8_SA(1, 1), a1 + hstep, voffA);
            PG8_WAIT_V(8); PG8_WAIT_L(0); PG8_BAR; PG8_MMA(0, 0, At, B0); PG8_MMA(0, 1, At, B1); PG8_BAR; PG8_SCHED;
            PG8_LDA(At, 0, 1); PG8_STAGE(PG8_SB(0, 0), b2, voffB); PG8_STAGE(PG8_SB(0, 1), b2 + hstep, voffB); PG8_STAGE(PG8_SA(0, 0), a2, voffA);
            PG8_WAIT_V(8); PG8_WAIT_L(0); PG8_BAR; PG8_MMA(1, 0, At, B0); PG8_MMA(1, 1, At, B1); PG8_BAR; PG8_SCHED;
            PG8_LDB(B0, 1, 0); PG8_LDB(B1, 1, 1); PG8_SCHED; PG8_LDA(At, 1, 0); PG8_STAGE(PG8_SA(0, 1), a2 + hstep, voffA);
            PG8_WAIT_V(8); PG8_WAIT_L(0); PG8_BAR; PG8_MMA(0, 0, At, B0); PG8_MMA(0, 1, At, B1); PG8_BAR; PG8_SCHED;
            PG8_LDA(At, 1, 1); PG8_STAGE(PG8_SB(1, 0), b3, voffB); PG8_STAGE(PG8_SB(1, 1), b3 + hstep, voffB); PG8_STAGE(PG8_SA(1, 0), a3, voffA);
            PG8_WAIT_V(8); PG8_WAIT_L(0); PG8_BAR; PG8_MMA(1, 0, At, B0); PG8_MMA(1, 1, At, B1); PG8_BAR; PG8_SCHED;
            } else {
            PG8_LDB(B0, 0, 0); PG8_SCHED; PG8_LDA(At, 0, 0); PG8_STAGE(PG8_SA(1, 1), a1 + hstep, voffA);
            PG8_WAIT_L(8); PG8_BAR; PG8_WAIT_L(0); PG8_MMA(0, 0, At, B0); PG8_BAR; PG8_SCHED;
            PG8_LDB(B1, 0, 1); PG8_STAGE(PG8_SB(0, 0), b2, voffB);
            PG8_BAR; PG8_WAIT_L(0); PG8_MMA(0, 1, At, B1); PG8_BAR;
            PG8_LDA(At, 0, 1); PG8_STAGE(PG8_SA(0, 0), a2, voffA);
            PG8_BAR; PG8_WAIT_L(0); PG8_MMA(1, 0, At, B0); PG8_BAR; PG8_SCHED;
            PG8_STAGE(PG8_SB(0, 1), b2 + hstep, voffB);
            PG8_WAIT_V(6); PG8_BAR; PG8_MMA(1, 1, At, B1); PG8_BAR;
            PG8_LDB(B0, 1, 0); PG8_SCHED; PG8_LDA(At, 1, 0); PG8_STAGE(PG8_SA(0, 1), a2 + hstep, voffA);
            PG8_WAIT_L(8); PG8_BAR; PG8_WAIT_L(0); PG8_MMA(0, 0, At, B0); PG8_BAR; PG8_SCHED;
            PG8_LDB(B1, 1, 1); PG8_STAGE(PG8_SB(1, 0), b3, voffB);
            PG8_BAR; PG8_WAIT_L(0); PG8_MMA(0, 1, At, B1); PG8_BAR;
            PG8_LDA(At, 1, 1); PG8_STAGE(PG8_SA(1, 0), a3, voffA);
            PG8_BAR; PG8_WAIT_L(0); PG8_MMA(1, 0, At, B0); PG8_BAR; PG8_SCHED;
            PG8_STAGE(PG8_SB(1, 1), b3 + hstep, voffB);
            PG8_WAIT_V(6); PG8_BAR; PG8_MMA(1, 1, At, B1); PG8_BAR;
            }
        }
        if constexpr (ALIGN_EPI) { if (wr == 0) PG8_BAR; }
        if constexpr (!Epi::AFTER_DRAIN) { E(acc, cur, wr, wc, fr, fq); S.done(cur); }
        if (!has_next) break;
#pragma unroll
        for (int a = 0; a < 2; ++a)
#pragma unroll
            for (int b = 0; b < 2; ++b)
#pragma unroll
                for (int m = 0; m < 4; ++m)
#pragma unroll
                    for (int n = 0; n < 2; ++n) acc[a][b][m][n] = (f32x4){0.f, 0.f, 0.f, 0.f};
        cur = nxt; cA = nA; cB = nB; ++ui;
        if constexpr (ALIGN_EPI) { if (wr == 1) PG8_BAR; }
    }
    PG8_WAIT_V(0);
    if constexpr (!ALIGN_EPI) { if (wr == 0) PG8_BAR; }
    PG8_BAR;
    if constexpr (Epi::AFTER_DRAIN) { E.fused(acc, cur, wr, wc, fr, fq, lds, wid, lane); S.done(cur); }
#undef PG8_SA
#undef PG8_SB
#undef PG8_STAGE
#undef PG8_LDA
#undef PG8_LDB
#undef PG8_MMA
#undef PG8_WAIT_V
#undef PG8_WAIT_L
#undef PG8_BAR
#undef PG8_SCHED
}
}

constexpr int NWAVES = 8, NTHR = NWAVES * 64;
constexpr int D = 1024, M = 16384, MCTX = 8192, INC = 6144, FF = 4096;
constexpr float EPS = 1e-6f, LOG2E = 1.4426950408889634f;
constexpr size_t MiB = 1u << 20;
constexpr size_t WS_CTL = 0, CTL_ZERO_BYTES = 1 * MiB;
constexpr size_t CTL_VSS = 64 * 1024, CTL_OSS = 128 * 1024, CTL_FSS = 192 * 1024, CTL_MOD = 256 * 1024, CTL_XSS = 384 * 1024;
constexpr size_t CTL_CNT = 16 * 1024;
constexpr size_t WS_GC = 1 * MiB;
constexpr size_t WS_AGG = 2 * MiB;
constexpr size_t WS_CAR = 4 * MiB;
constexpr size_t WS_WG = 5 * MiB;
constexpr size_t WS_WSP = 5 * MiB + 512 * 1024;
constexpr size_t WS_WFF2 = 6 * MiB, WS_WFF1 = 14 * MiB, WS_WIN = 22 * MiB, WS_WBG = 34 * MiB, WS_WBR = 36 * MiB, WS_WOUT = 38 * MiB;
constexpr size_t WS_H = 40 * MiB;
constexpr size_t WS_F = 64 * MiB;
constexpr size_t WS_GU = 128 * MiB, WS_GGR = 160 * MiB, WS_SGA = 192 * MiB, WS_SGB = 224 * MiB;
constexpr size_t WS_F1 = 128 * MiB;
constexpr size_t WS_END = 256 * MiB;
constexpr int LDS_BYTES = 147456, LDS_BAR_OFF = 139264;
#ifndef WG_IN
#define WG_IN 4
#endif
#ifndef WG_FF1
#define WG_FF1 2
#endif
#ifndef DUP
#define DUP 0
#endif

#define GAS __attribute__((address_space(1)))
#define LAS __attribute__((address_space(3)))
typedef unsigned short bf16;
typedef unsigned v4u __attribute__((ext_vector_type(4)));
typedef unsigned v2u __attribute__((ext_vector_type(2)));
typedef float f32x4 __attribute__((ext_vector_type(4)));
typedef float f32x2 __attribute__((ext_vector_type(2)));
typedef short bf16x8 __attribute__((ext_vector_type(8)));
#define LDS_WAIT() asm volatile("s_waitcnt lgkmcnt(0)" ::: "memory")
__device__ __forceinline__ unsigned f2bf(float f) { unsigned u = __builtin_bit_cast(unsigned, f); return (u + 0x7fffu + ((u >> 16) & 1u)) >> 16; }
__device__ __forceinline__ unsigned pk2(float lo, float hi) { return pg8::cvt_pk_bf16(lo, hi); }
__device__ __forceinline__ float bf2f(bf16 b) { return __builtin_bit_cast(float, (unsigned)b << 16); }
using pg8::bflo; using pg8::bfhi;

struct Args { const float* in[27]; float* out; unsigned char* ws; int ph_lo, ph_hi; };
enum { I_XP = 0, I_XS, I_STATE, I_C, I_CCTX, I_WADA, I_BADA, I_GPREMIX, I_GPOSTMIX, I_GPREMLP, I_GPOSTMLP, I_WIN, I_GSGU, I_WSP, I_BSP, I_CONVW, I_CONVB,
       I_WRA, I_BRA, I_WRI, I_BRI, I_LAM, I_WBRG, I_WBRR, I_WOUT, I_WFF1, I_WFF2 };

__device__ __forceinline__ float wave_sum(float v) {
#pragma unroll
    for (int o = 1; o < 64; o <<= 1) v += __shfl_xor(v, o);
    return v;
}
__device__ __forceinline__ void p0_transpose_item(const float* W, int K, int N, bf16* WT, LAS float* scr, int item, int lane, int ldk = 0, int koff = 0) {
    if (ldk == 0) ldk = K;
    const int nblk = N / 32, kb = item / nblk, nb = item % nblk, k0 = 64 * kb, n0 = 32 * nb;
#pragma unroll
    for (int i = 0; i < 8; ++i) { const int kk = 8 * i + (lane >> 3);
        const f32x4 v = *(const f32x4*)(W + (size_t)(k0 + kk) * N + n0 + (lane & 7) * 4);
        LAS float* dd = scr + kk * 33 + (lane & 7) * 4; dd[0] = v[0]; dd[1] = v[1]; dd[2] = v[2]; dd[3] = v[3]; }
    LDS_WAIT(); asm volatile("" ::: "memory");
    const int c = lane & 7;
#pragma unroll
    for (int j = 0; j < 4; ++j) { const int n = (lane >> 3) + 8 * j; const LAS float* s = scr + (8 * c) * 33 + n;
        v4u o; o.x = pk2(s[0 * 33], s[1 * 33]); o.y = pk2(s[2 * 33], s[3 * 33]); o.z = pk2(s[4 * 33], s[5 * 33]); o.w = pk2(s[6 * 33], s[7 * 33]);
        *(v4u*)(WT + (size_t)(n0 + n) * ldk + koff + k0 + 8 * c) = o; }
    LDS_WAIT(); asm volatile("" ::: "memory");
}

__device__ __forceinline__ void phase_prep(const Args& a, LAS unsigned char* lds, int gw, int NGW, int wave, int lane, float* MOD) {
    unsigned char* ws = a.ws;
    LAS float* scr = (LAS float*)(lds + wave * 16384);
    constexpr int I_IN = 16 * (INC / 32), I_SQ = 16 * (D / 32), I_F1 = 16 * (FF / 32), I_F2 = (FF / 64) * (D / 32);
    constexpr int NT = I_IN + 3 * I_SQ + I_F1 + I_F2;
    for (int it = gw; it < NT; it += NGW) {
        int r = it;
        if (r < I_IN) { p0_transpose_item(a.in[I_WIN], D, INC, (bf16*)(ws + WS_WIN), scr, r, lane); continue; } r -= I_IN;
        if (r < I_SQ) { p0_transpose_item(a.in[I_WBRG], D, D, (bf16*)(ws + WS_WBG), scr, r, lane, 2 * D, 0); continue; } r -= I_SQ;
        if (r < I_SQ) { p0_transpose_item(a.in[I_WBRR], D, D, (bf16*)(ws + WS_WBG), scr, r, lane, 2 * D, D); continue; } r -= I_SQ;
        if (r < I_SQ) { p0_transpose_item(a.in[I_WOUT], D, D, (bf16*)(ws + WS_WOUT), scr, r, lane); continue; } r -= I_SQ;
        if (r < I_F1) { p0_transpose_item(a.in[I_WFF1], D, FF, (bf16*)(ws + WS_WFF1), scr, r, lane); continue; } r -= I_F1;
        p0_transpose_item(a.in[I_WFF2], FF, D, (bf16*)(ws + WS_WFF2), scr, r, lane);
    }
    {
        const float* wada = a.in[I_WADA]; const float* cctx = a.in[I_CCTX]; const float* cc = a.in[I_C];
        for (int it = NGW - 1 - gw; it < 16 * 24; it += NGW) {
            const int kc = it / 24, nb = it % 24, n = nb * 256 + lane * 4;
            f32x4 a0 = {0.f, 0.f, 0.f, 0.f}, a1 = a0, a2 = a0;
#pragma unroll 16
            for (int kk = 0; kk < 64; ++kk) {
                const int k = kc * 64 + kk;
                const f32x4 w = *(const f32x4*)(wada + (size_t)k * INC + n);
                const float c0 = cctx[k], c1 = cc[k], c2 = cc[D + k];
                const float s0 = c0 * pg8::sigmoid_f(c0), s1 = c1 * pg8::sigmoid_f(c1), s2 = c2 * pg8::sigmoid_f(c2);
                a0 += w * s0; a1 += w * s1; a2 += w * s2;
            }
#pragma unroll
            for (int j = 0; j < 4; ++j) { atomicAdd(MOD + n + j, a0[j]); atomicAdd(MOD + INC + n + j, a1[j]); atomicAdd(MOD + 2 * INC + n + j, a2[j]); }
        }
    }
    {
        const int gws = (gw + NGW / 2) % NGW, gt = gws * 64 + lane, NGT = NGW * 64;
        bf16* WG = (bf16*)(ws + WS_WG);
        for (int it = gt; it < 16 * 16 * 2 * 64; it += NGT) {
            const int ln = it & 63, ks = (it >> 6) & 1, cbi = (it >> 7) & 15, h = it >> 11;
            const int fr = ln & 15, fq = ln >> 4, type = cbi >> 3, d = (cbi >> 2) & 1, cb = cbi & 3;
            const float* W = type ? a.in[I_WRI] : a.in[I_WRA];
            const float* src = W + ((size_t)(d * 16 + h) * 64 + ks * 32 + fq * 8) * 64 + cb * 16 + fr;
            v4u o; o.x = pk2(-LOG2E * src[0], -LOG2E * src[64]); o.y = pk2(-LOG2E * src[128], -LOG2E * src[192]);
            o.z = pk2(-LOG2E * src[256], -LOG2E * src[320]); o.w = pk2(-LOG2E * src[384], -LOG2E * src[448]);
            *(v4u*)(WG + (size_t)it * 8) = o;
        }
        bf16* WSP = (bf16*)(ws + WS_WSP); const float* wsp = a.in[I_WSP];
        for (int it = gt; it < 8 * 128 * 128 / 8; it += NGT) {
            const f32x4 x0 = *(const f32x4*)(wsp + (size_t)it * 8), x1 = *(const f32x4*)(wsp + (size_t)it * 8 + 4);
            v4u o; o.x = pk2(x0[0], x0[1]); o.y = pk2(x0[2], x0[3]); o.z = pk2(x1[0], x1[1]); o.w = pk2(x1[2], x1[3]);
            *(v4u*)(WSP + (size_t)it * 8) = o;
        }
        float* GC = (float*)(ws + WS_GC);
        for (int it = gt; it < 2048; it += NGT) {
            const float lamv = a.in[I_LAM][it]; const float sp = log1pf(expf(-lamv));
            f32x4 o; o[0] = exp2f(-LOG2E * a.in[I_BRA][it]); o[1] = exp2f(-LOG2E * a.in[I_BRI][it]); o[2] = -8.f * sp * LOG2E; o[3] = 0.f;
            *(f32x4*)(GC + (size_t)it * 4) = o;
        }
    }
}

__device__ __forceinline__ f32x4 modv(const float* MOD, const float* bada, int cv, int part, int c) {
    return *(const f32x4*)(MOD + cv * INC + part * D + c) + *(const f32x4*)(bada + part * D + c);
}
__device__ __forceinline__ int cv_of(int m) { return m < MCTX ? 0 : (m < MCTX + 4096 ? 1 : 2); }
__device__ __forceinline__ const float* xrow_of(const Args& a, int m) { return m < MCTX ? a.in[I_XP] + (size_t)m * D : a.in[I_XS] + (size_t)(m - MCTX) * D; }
__device__ __forceinline__ void store_bf4(bf16* p, f32x4 v) { v2u o; o.x = pk2(v[0], v[1]); o.y = pk2(v[2], v[3]); *(v2u*)p = o; }

__device__ __forceinline__ void phase_norm1(const Args& a, int gw, int NGW, int lane) {
    const float* MOD = (const float*)(a.ws + CTL_MOD); const float* bada = a.in[I_BADA]; const float* g = a.in[I_GPREMIX];
    bf16* H = (bf16*)(a.ws + WS_H);
    const int RPW = M / NGW;
    if (RPW * NGW == M && (MCTX % RPW) == 0 && (4096 % RPW) == 0) {
        const int m0 = gw * RPW, cv = cv_of(m0);
        f32x4 cc[4], sh[4];
#pragma unroll
        for (int j = 0; j < 4; ++j) { const int c = 4 * lane + 256 * j; cc[j] = *(const f32x4*)(g + c) * (modv(MOD, bada, cv, 1, c) + 1.f); sh[j] = modv(MOD, bada, cv, 0, c); }
        for (int m = m0; m < m0 + RPW; ++m) {
            const float* xr = xrow_of(a, m);
            f32x4 v[4]; float s = 0.f;
#pragma unroll
            for (int j = 0; j < 4; ++j) { v[j] = *(const f32x4*)(xr + 4 * lane + 256 * j); s += (v[j][0] * v[j][0] + v[j][1] * v[j][1]) + (v[j][2] * v[j][2] + v[j][3] * v[j][3]); }
            const float rstd = rsqrtf(wave_sum(s) * (1.f / D) + EPS);
#pragma unroll
            for (int j = 0; j < 4; ++j) store_bf4(H + (size_t)m * D + 4 * lane + 256 * j, v[j] * rstd * cc[j] + sh[j]);
        }
        return;
    }
    for (int m = gw; m < M; m += NGW) {
        const float* xr = xrow_of(a, m); const int cv = cv_of(m);
        f32x4 v[4]; float s = 0.f;
#pragma unroll
        for (int j = 0; j < 4; ++j) { v[j] = *(const f32x4*)(xr + 4 * lane + 256 * j); s += (v[j][0] * v[j][0] + v[j][1] * v[j][1]) + (v[j][2] * v[j][2] + v[j][3] * v[j][3]); }
        const float rstd = rsqrtf(wave_sum(s) * (1.f / D) + EPS);
#pragma unroll
        for (int j = 0; j < 4; ++j) { const int c = 4 * lane + 256 * j;
            const f32x4 gg = *(const f32x4*)(g + c), sh = modv(MOD, bada, cv, 0, c), sc = modv(MOD, bada, cv, 1, c);
            store_bf4(H + (size_t)m * D + c, v[j] * rstd * gg * (sc + 1.f) + sh); }
    }
}
__device__ __forceinline__ void phase_mid(const Args& a, int gw, int NGW, int lane, float* xout, bf16* H) {
    const float* MOD = (const float*)(a.ws + CTL_MOD); const float* bada = a.in[I_BADA];
    const float* gpm = a.in[I_GPOSTMIX]; const float* gpl = a.in[I_GPREMLP]; const float* OSS = (const float*)(a.ws + CTL_OSS);
    const float* out = a.out;
    for (int m = gw; m < M; m += NGW) {
        const float* xr = xrow_of(a, m); const int cv = cv_of(m);
        const float rstd_o = rsqrtf(OSS[m] * (1.f / D) + EPS);
        f32x4 v[4]; float s = 0.f;
#pragma unroll
        for (int j = 0; j < 4; ++j) { const int c = 4 * lane + 256 * j;
            const f32x4 o = *(const f32x4*)(out + (size_t)m * D + c), x = *(const f32x4*)(xr + c);
            const f32x4 g1 = modv(MOD, bada, cv, 2, c), gg = *(const f32x4*)(gpm + c);
            v[j] = x + g1 * (o * rstd_o * gg);
            *(f32x4*)(xout + (size_t)m * D + c) = v[j];
            s += (v[j][0] * v[j][0] + v[j][1] * v[j][1]) + (v[j][2] * v[j][2] + v[j][3] * v[j][3]); }
        const float rstd = rsqrtf(wave_sum(s) * (1.f / D) + EPS);
#pragma unroll
        for (int j = 0; j < 4; ++j) { const int c = 4 * lane + 256 * j;
            const f32x4 gg = *(const f32x4*)(gpl + c), sh = modv(MOD, bada, cv, 3, c), sc = modv(MOD, bada, cv, 4, c);
            store_bf4(H + (size_t)m * D + c, v[j] * rstd * gg * (sc + 1.f) + sh); }
    }
}
__device__ __forceinline__ void phase_final(const Args& a, int gw, int NGW, int lane, float* yout) {
    const float* MOD = (const float*)(a.ws + CTL_MOD); const float* bada = a.in[I_BADA];
    const float* gpm = a.in[I_GPOSTMLP]; const float* FSS = (const float*)(a.ws + CTL_FSS); const float* F = (const float*)(a.ws + WS_F); const float* out = a.out;
    for (int m = gw; m < M; m += NGW) {
        const int cv = cv_of(m); const float rstd_f = rsqrtf(FSS[m] * (1.f / D) + EPS);
#pragma unroll
        for (int j = 0; j < 4; ++j) { const int c = 4 * lane + 256 * j;
            const f32x4 f = *(const f32x4*)(F + (size_t)m * D + c), x1 = *(const f32x4*)(out + (size_t)m * D + c);
            const f32x4 g2 = modv(MOD, bada, cv, 5, c), gg = *(const f32x4*)(gpm + c);
            *(f32x4*)(yout + (size_t)m * D + c) = x1 + g2 * (f * rstd_f * gg); }
    }
}

__device__ __forceinline__ void panel_sync(unsigned* cnt) {
    asm volatile("s_waitcnt vmcnt(0)" ::: "memory");
    __syncthreads();
    if (threadIdx.x == 0) {
        __hip_atomic_fetch_add(cnt, 1u, __ATOMIC_RELAXED, __HIP_MEMORY_SCOPE_AGENT);
        unsigned sp = 0;
        while (__hip_atomic_load(cnt, __ATOMIC_RELAXED, __HIP_MEMORY_SCOPE_AGENT) < 4u) { __builtin_amdgcn_s_sleep(1); if (++sp > (1u << 22)) break; }
    }
    __syncthreads();
}
__device__ __forceinline__ float ld_agent(const float* p) { return __builtin_bit_cast(float, __hip_atomic_load((const unsigned*)p, __ATOMIC_RELAXED, __HIP_MEMORY_SCOPE_AGENT)); }
__device__ __forceinline__ float sumsq4(f32x4 v) { return (v[0] * v[0] + v[1] * v[1]) + (v[2] * v[2] + v[3] * v[3]); }
template <int MODE> struct EpiFused {
    static constexpr bool PERM = true, AFTER_DRAIN = true, HOOK = false;
    float* out; const float* xp; const float* xs; bf16* H; float* SS1; float* SS2; unsigned* cnt1; unsigned* cnt2;
    const float* MOD; const float* bada; const float* gpost; const float* gpre;
    __device__ __forceinline__ void fused(f32x4 (&acc)[2][2][4][2], const pg8::Unit& u, int wr, int wc, int fr, int fq, LAS unsigned char*, int, int) const {
        const int row0 = u.pm * 256 + wr * 64 + fr, col0 = u.pn * 256 + wc * 32 + 8 * fq;
        const int cv = u.pm < 32 ? 0 : (u.pm < 48 ? 1 : 2);
#pragma unroll
        for (int ai = 0; ai < 2; ++ai)
#pragma unroll
            for (int m = 0; m < 4; ++m) {
                float ss = (sumsq4(acc[ai][0][m][0]) + sumsq4(acc[ai][0][m][1])) + (sumsq4(acc[ai][1][m][0]) + sumsq4(acc[ai][1][m][1]));
                ss += __shfl_xor(ss, 16); ss += __shfl_xor(ss, 32);
                if (fq == 0) atomicAdd(SS1 + row0 + ai * 128 + m * 16, ss);
            }
        panel_sync(cnt1 + 64 * u.pm);
        f32x4 ga[2][2];
#pragma unroll
        for (int bj = 0; bj < 2; ++bj)
#pragma unroll
            for (int n = 0; n < 2; ++n) { const int c = col0 + bj * 128 + 4 * n; ga[bj][n] = modv(MOD, bada, cv, MODE == 6 ? 2 : 5, c) * *(const f32x4*)(gpost + c); }
        float rs1[2][4];
#pragma unroll
        for (int ai = 0; ai < 2; ++ai)
#pragma unroll
            for (int m = 0; m < 4; ++m) rs1[ai][m] = ld_agent(SS1 + row0 + ai * 128 + m * 16);
#pragma unroll
        for (int ai = 0; ai < 2; ++ai)
#pragma unroll
            for (int m = 0; m < 4; ++m) {
                const int row = row0 + ai * 128 + m * 16;
                const float rstd = rsqrtf(rs1[ai][m] * (1.f / D) + EPS);
                const float* xrow = MODE == 6 ? (row < MCTX ? xp + (size_t)row * D : xs + (size_t)(row - MCTX) * D) : out + (size_t)row * D;
                float ss = 0.f;
#pragma unroll
                for (int bj = 0; bj < 2; ++bj)
#pragma unroll
                    for (int n = 0; n < 2; ++n) { const int c = col0 + bj * 128 + 4 * n;
                        const f32x4 v = *(const f32x4*)(xrow + c) + ga[bj][n] * (acc[ai][bj][m][n] * rstd);
                        *(f32x4*)(out + (size_t)row * D + c) = v; acc[ai][bj][m][n] = v; ss += sumsq4(v); }
                if constexpr (MODE == 6) { ss += __shfl_xor(ss, 16); ss += __shfl_xor(ss, 32); if (fq == 0) atomicAdd(SS2 + row, ss); }
            }
        if constexpr (MODE == 6) {
            panel_sync(cnt2 + 64 * u.pm);
            f32x4 cc[2][2], sh[2][2];
#pragma unroll
            for (int bj = 0; bj < 2; ++bj)
#pragma unroll
                for (int n = 0; n < 2; ++n) { const int c = col0 + bj * 128 + 4 * n; cc[bj][n] = *(const f32x4*)(gpre + c) * (modv(MOD, bada, cv, 4, c) + 1.f); sh[bj][n] = modv(MOD, bada, cv, 3, c); }
            float rs2[2][4];
#pragma unroll
            for (int ai = 0; ai < 2; ++ai)
#pragma unroll
                for (int m = 0; m < 4; ++m) rs2[ai][m] = ld_agent(SS2 + row0 + ai * 128 + m * 16);
#pragma unroll
            for (int ai = 0; ai < 2; ++ai)
#pragma unroll
                for (int m = 0; m < 4; ++m) {
                    const int row = row0 + ai * 128 + m * 16;
                    const float rstd = rsqrtf(rs2[ai][m] * (1.f / D) + EPS);
#pragma unroll
                    for (int bj = 0; bj < 2; ++bj) {
                        const f32x4 h0 = acc[ai][bj][m][0] * rstd * cc[bj][0] + sh[bj][0], h1 = acc[ai][bj][m][1] * rstd * cc[bj][1] + sh[bj][1];
                        v4u w; w.x = pg8::cvt_pk_bf16(h0[0], h0[1]); w.y = pg8::cvt_pk_bf16(h0[2], h0[3]); w.z = pg8::cvt_pk_bf16(h1[0], h1[1]); w.w = pg8::cvt_pk_bf16(h1[2], h1[3]);
                        *(v4u*)(H + (size_t)row * D + col0 + bj * 128) = w; }
                }
        }
    }
};

constexpr int YLD = 2048;
constexpr int SG_W = 0, SG_V = 34816, SG_U = 69632, SG_ST = 272;
__device__ __forceinline__ void sgu_load(const bf16* GV, const bf16* GU, const float* VSS, int item, int tid, v4u (&rv)[4], v4u (&ru)[4], float (&rss)[4]) {
    const int g = item & 7, t0 = (item >> 3) * 128;
#pragma unroll
    for (int i = 0; i < 4; ++i) { const int idx = tid + i * NTHR, p = idx >> 4, c8 = (idx & 15) * 8;
        rv[i] = *(const v4u*)(GV + (size_t)(t0 + p) * D + g * 128 + c8); ru[i] = *(const v4u*)(GU + (size_t)(t0 + p) * YLD + g * 128 + c8); rss[i] = VSS[t0 + p]; }
}
__device__ __forceinline__ void phase_sgu(const Args& a, LAS unsigned char* lds, int tid, int wave, int lane, bf16* YG) {
    const bf16* GV = (const bf16*)a.out; const bf16* GU = (const bf16*)(a.ws + WS_GU); const bf16* WSP = (const bf16*)(a.ws + WS_WSP);
    const float* VSS = (const float*)(a.ws + CTL_VSS); const float* gsgu = a.in[I_GSGU]; const float* bsp = a.in[I_BSP];
    const int fr = lane & 15, fq = lane >> 4;
    int last_g = -1;
    v4u rv[4], ru[4]; float rss[4];
    for (int item = blockIdx.x; item < 128 * 8; item += gridDim.x) {
        const int g = item & 7, n = item >> 3, t0 = n * 128;
        if (g != last_g) {
#pragma unroll
            for (int i = 0; i < 4; ++i) { const int idx = tid + i * NTHR, row = idx >> 4, c16 = idx & 15;
                *(LAS v4u*)(lds + SG_W + row * SG_ST + c16 * 16) = *(const v4u*)(WSP + (size_t)(g * 128 + row) * 128 + c16 * 8); }
            last_g = g;
        }
        if (item == (int)blockIdx.x) sgu_load(GV, GU, VSS, item, tid, rv, ru, rss);
#pragma unroll
        for (int i = 0; i < 4; ++i) {
            const int idx = tid + i * NTHR, p = idx >> 4, c8 = (idx & 15) * 8;
            const v4u r = rv[i]; const v4u uu = ru[i];
            const float rs = rsqrtf(rss[i] * (1.f / D) + EPS);
            const f32x4 g0 = *(const f32x4*)(gsgu + g * 128 + c8) * rs, g1 = *(const f32x4*)(gsgu + g * 128 + c8 + 4) * rs;
            v4u o; o.x = pk2(bflo(r.x) * g0[0], bfhi(r.x) * g0[1]); o.y = pk2(bflo(r.y) * g0[2], bfhi(r.y) * g0[3]);
            o.z = pk2(bflo(r.z) * g1[0], bfhi(r.z) * g1[1]); o.w = pk2(bflo(r.w) * g1[2], bfhi(r.w) * g1[3]);
            *(LAS v4u*)(lds + SG_V + p * SG_ST + c8 * 2) = o;
            *(LAS v4u*)(lds + SG_U + p * SG_ST + c8 * 2) = uu;
        }
        if (item + (int)gridDim.x < 128 * 8) sgu_load(GV, GU, VSS, item + gridDim.x, tid, rv, ru, rss);
        float bias8[8];
#pragma unroll
        for (int qb = 0; qb < 8; ++qb) bias8[qb] = bsp[g * 128 + qb * 16 + fr];
        __syncthreads();
        bf16x8 af[4];
#pragma unroll
        for (int ks = 0; ks < 4; ++ks) {
            unsigned short e[8];
#pragma unroll
            for (int j = 0; j < 8; ++j) e[j] = *(const LAS unsigned short*)(lds + SG_V + (ks * 32 + fq * 8 + j) * SG_ST + (wave * 16 + fr) * 2);
            v4u o; o.x = e[0] | ((unsigned)e[1] << 16); o.y = e[2] | ((unsigned)e[3] << 16); o.z = e[4] | ((unsigned)e[5] << 16); o.w = e[6] | ((unsigned)e[7] << 16);
            af[ks] = __builtin_bit_cast(bf16x8, o);
        }
#pragma unroll
        for (int qb = 0; qb < 8; ++qb) {
            const int q = qb * 16 + fr;
            f32x4 acc = {0.f, 0.f, 0.f, 0.f};
#pragma unroll
            for (int ks = 0; ks < 4; ++ks) { const bf16x8 b = *(const LAS bf16x8*)(lds + SG_W + q * SG_ST + (ks * 32 + fq * 8) * 2);
                acc = __builtin_amdgcn_mfma_f32_16x16x32_bf16(af[ks], b, acc, 0, 0, 0); }
            const float bias = bias8[qb];
            LAS v2u* up = (LAS v2u*)(lds + SG_U + q * SG_ST + (wave * 16 + fq * 4) * 2);
            const v2u gu = *up;
            v2u y; y.x = pk2(bflo(gu.x) * (acc[0] + bias), bfhi(gu.x) * (acc[1] + bias)); y.y = pk2(bflo(gu.y) * (acc[2] + bias), bfhi(gu.y) * (acc[3] + bias));
            *up = y;
        }
        __syncthreads();
#pragma unroll
        for (int i = 0; i < 4; ++i) { const int idx = tid + i * NTHR, p = idx >> 4, c8 = (idx & 15) * 8;
            *(v4u*)(YG + (size_t)(t0 + p) * YLD + g * 128 + c8) = *(const LAS v4u*)(lds + SG_U + p * SG_ST + c8 * 2); }
        __syncthreads();
    }
}

constexpr int RG_WB = 0, RG_XA = 32768, RG_XF = 51200, RG_AGL = 86016, RG_GCL = 94208, RG_CWL = 96256, RG_CARL = 97536;
__device__ __forceinline__ void rg_load_raw(const bf16* XR, int item, int tid, v4u (&xr)[2][4]) {
    const int h = item & 15, t0 = (item >> 4) * 128;
    const int seq_lo = t0 < MCTX ? (t0 & ~255) : MCTX + ((t0 - MCTX) & ~4095), seq_hi = seq_lo + (t0 < MCTX ? 256 : 4096);
#pragma unroll
    for (int i = 0; i < 2; ++i) {
        const int idx = tid + i * NTHR, tk = idx >> 3, chb = h * 64 + (idx & 7) * 8;
#pragma unroll
        for (int tap = 0; tap < 4; ++tap) {
            const int t = t0 + tk + tap - 2; const bool ok = (t >= seq_lo) && (t < seq_hi); const int tc = ok ? t : t0;
            xr[i][tap] = *(const v4u*)(XR + (size_t)tc * D + chb);
        }
    }
}
template <int MODE> __device__ __forceinline__ int rg_item(int k) {
    const int h = blockIdx.x & 15, q = blockIdx.x >> 4;
    int tt;
    if (MODE == 1) tt = k < 4 ? 2 * (q + 16 * (k >> 1)) + (k & 1) : 64 + q + 16 * (k - 4);
    else tt = k < 2 ? 2 * (q + 16 * k) + 1 : 64 + q + 16 * (k - 2);
    return tt * 16 + h;
}
template <int MODE>
__device__ __forceinline__ void phase_rg(const Args& a, LAS unsigned char* lds, int tid, int wave, int lane, bf16* YR) {
    const bf16* XR = (const bf16*)((const unsigned char*)a.out + 32 * MiB); const bf16* GGR = (const bf16*)(a.ws + WS_GU) + D;
    const float* GC = (const float*)(a.ws + WS_GC); const bf16* WG = (const bf16*)(a.ws + WS_WG);
    f32x2* AGG = (f32x2*)(a.ws + WS_AGG); const float* CAR = (const float*)(a.ws + WS_CAR); float* nstate = a.out + (size_t)M * D;
    const float* convw = a.in[I_CONVW]; const float* convb = a.in[I_CONVB];
    const int fr = lane & 15, fq = lane >> 4;
    int last_h = -1;
    v4u xr[2][4];
    constexpr int NK = MODE == 1 ? 8 : 6;
    rg_load_raw(XR, rg_item<MODE>(0), tid, xr);
    if constexpr (MODE == 1) {
        const float* st0 = a.in[I_STATE];
#pragma unroll 1
        for (int kk = tid >> 7; kk < 8; kk += 4) {
            const int it = rg_item<1>(kk);
            {
                const int d = (tid >> 6) & 1, cl = tid & 63, h = it & 15, tt = it >> 4;
                float hc;
                if (tt < 64) {
                    const f32x2 g = AGG[((size_t)((tt | 1) * 16 + h) * 2 + 1) * 64 + cl];
                    hc = ((tt & 1) == 0 && d == 1) ? g[1] : 0.f;
                } else {
                    const int b = (tt - 64) >> 5, j = (tt - 64) & 31, tt0 = 64 + b * 32;
                    f32x2 ag[31];
#pragma unroll
                    for (int sI = 0; sI < 31; ++sI) { const int ti = d ? 31 - sI : sI; ag[sI] = AGG[((size_t)((tt0 + ti) * 16 + h) * 2 + d) * 64 + cl]; }
                    hc = st0[(size_t)b * 2048 + d * 1024 + h * 64 + cl];
#pragma unroll
                    for (int sI = 0; sI < 31; ++sI) { const int ti = d ? 31 - sI : sI; if (d ? (ti > j) : (ti < j)) hc = ag[sI][0] * hc + ag[sI][1]; }
                }
                *(LAS float*)(lds + RG_CARL + ((kk * 2 + d) * 64 + cl) * 4) = hc;
            }
        }
        __syncthreads();
    }
    for (int kitem = 0; kitem < NK; ++kitem) {
        const int item = rg_item<MODE>(kitem);
        const int h = item & 15, tt = item >> 4, t0 = tt * 128;
        if (h != last_h) {
#pragma unroll
            for (int i = 0; i < 4; ++i) { const int o = (tid + i * NTHR) * 16; *(LAS v4u*)(lds + RG_WB + o) = *(const v4u*)((const unsigned char*)WG + (size_t)h * 32768 + o); }
            if (tid < 128) *(LAS f32x4*)(lds + RG_GCL + tid * 16) = *(const f32x4*)(GC + (size_t)((tid >> 6) * D + h * 64 + (tid & 63)) * 4);
            if (tid < 80) { const int row = tid >> 4, c4 = (tid & 15) * 4;
                *(LAS f32x4*)(lds + RG_CWL + (row * 64 + c4) * 4) = *(const f32x4*)((row < 4 ? convw + row * D : convb) + h * 64 + c4); }
            last_h = h;
            __syncthreads();
        }
        const int seq_lo = t0 < MCTX ? (t0 & ~255) : MCTX + ((t0 - MCTX) & ~4095), seq_hi = seq_lo + (t0 < MCTX ? 256 : 4096);
        float car[2][4]; v4u ggr[2];
        if constexpr (MODE == 1) {
#pragma unroll
            for (int d = 0; d < 2; ++d)
#pragma unroll
                for (int cb = 0; cb < 4; ++cb) car[d][cb] = *(const LAS float*)(lds + RG_CARL + ((kitem * 2 + d) * 64 + cb * 16 + fr) * 4);
#pragma unroll
            for (int i = 0; i < 2; ++i) { const int idx = tid + i * NTHR; ggr[i] = *(const v4u*)(GGR + (size_t)(t0 + (idx >> 3)) * YLD + h * 64 + (idx & 7) * 8); }
        }
        {
            const int c8 = (tid & 7) * 8;
            f32x4 w0[4], w1[4];
#pragma unroll
            for (int tap = 0; tap < 4; ++tap) { w0[tap] = *(const LAS f32x4*)(lds + RG_CWL + (tap * 64 + c8) * 4); w1[tap] = *(const LAS f32x4*)(lds + RG_CWL + (tap * 64 + c8 + 4) * 4); }
            const f32x4 b0 = *(const LAS f32x4*)(lds + RG_CWL + (4 * 64 + c8) * 4), b1 = *(const LAS f32x4*)(lds + RG_CWL + (4 * 64 + c8 + 4) * 4);
#pragma unroll
            for (int i = 0; i < 2; ++i) {
                const int idx = tid + i * NTHR, tk = idx >> 3, cg8 = idx & 7;
                f32x4 x0 = b0, x1 = b1;
#pragma unroll
                for (int tap = 0; tap < 4; ++tap) { const int t = t0 + tk + tap - 2; const bool ok = (t >= seq_lo) && (t < seq_hi);
                    v4u r = xr[i][tap]; r.x = ok ? r.x : 0u; r.y = ok ? r.y : 0u; r.z = ok ? r.z : 0u; r.w = ok ? r.w : 0u;
                    x0[0] += w0[tap][0] * bflo(r.x); x0[1] += w0[tap][1] * bfhi(r.x); x0[2] += w0[tap][2] * bflo(r.y); x0[3] += w0[tap][3] * bfhi(r.y);
                    x1[0] += w1[tap][0] * bflo(r.z); x1[1] += w1[tap][1] * bfhi(r.z); x1[2] += w1[tap][2] * bflo(r.w); x1[3] += w1[tap][3] * bfhi(r.w); }
                v4u o; o.x = pk2(x0[0], x0[1]); o.y = pk2(x0[2], x0[3]); o.z = pk2(x1[0], x1[1]); o.w = pk2(x1[2], x1[3]);
                *(LAS v4u*)(lds + RG_XA + tk * 144 + cg8 * 16) = o;
                *(LAS f32x4*)(lds + RG_XF + (tk * 68 + cg8 * 8) * 4) = x0; *(LAS f32x4*)(lds + RG_XF + (tk * 68 + cg8 * 8 + 4) * 4) = x1;
            }
        }
        if (kitem + 1 < NK) rg_load_raw(XR, rg_item<MODE>(kitem + 1), tid, xr);
        __syncthreads();
        const int tokb = wave * 16;
        bf16x8 afr[2];
#pragma unroll
        for (int ks = 0; ks < 2; ++ks) afr[ks] = *(const LAS bf16x8*)(lds + RG_XA + (tokb + fr) * 144 + (ks * 32 + fq * 8) * 2);
        f32x4 gcv[2][4];
#pragma unroll
        for (int d = 0; d < 2; ++d)
#pragma unroll
            for (int cb = 0; cb < 4; ++cb) gcv[d][cb] = *(const LAS f32x4*)(lds + RG_GCL + (d * 64 + cb * 16 + fr) * 16);
        float av[2][4][4], bv[2][4][4], Ap[2][4], Hp[2][4];
        const bool ctx = t0 < MCTX;
#pragma unroll
        for (int d = 0; d < 2; ++d) {
            if (MODE == 0 && ctx && d != (tt & 1)) continue;
#pragma unroll
            for (int cb = 0; cb < 4; ++cb) {
                const f32x4 gc = gcv[d][cb];
                f32x4 ar = {0.f, 0.f, 0.f, 0.f}, ai = {0.f, 0.f, 0.f, 0.f};
#pragma unroll
                for (int ks = 0; ks < 2; ++ks) {
                    const bf16x8 b0 = *(const LAS bf16x8*)(lds + RG_WB + (((0 * 8 + d * 4 + cb) * 2 + ks) * 64 + lane) * 16);
                    const bf16x8 b1 = *(const LAS bf16x8*)(lds + RG_WB + (((1 * 8 + d * 4 + cb) * 2 + ks) * 64 + lane) * 16);
                    ar = __builtin_amdgcn_mfma_f32_16x16x32_bf16(afr[ks], b0, ar, 0, 0, 0);
                    ai = __builtin_amdgcn_mfma_f32_16x16x32_bf16(afr[ks], b1, ai, 0, 0, 0);
                }
#pragma unroll
                for (int r = 0; r < 4; ++r) {
                    const float xcv = *(const LAS float*)(lds + RG_XF + ((tokb + fq * 4 + r) * 68 + cb * 16 + fr) * 4);
                    const float rr = __builtin_amdgcn_rcpf(__builtin_fmaf(__builtin_amdgcn_exp2f(ar[r]), gc[0], 1.f)), ii = __builtin_amdgcn_rcpf(__builtin_fmaf(__builtin_amdgcn_exp2f(ai[r]), gc[1], 1.f));
                    const float aa = __builtin_amdgcn_exp2f(rr * gc[2]);
                    const float om = fmaxf(1.f - aa * aa, 1e-12f);
                    av[d][cb][r] = aa; bv[d][cb][r] = __builtin_amdgcn_sqrtf(om) * ii * xcv;
                }
                float A = 1.f, Hh = 0.f;
#pragma unroll
                for (int rr = 0; rr < 4; ++rr) { const int r = d ? 3 - rr : rr; Hh = av[d][cb][r] * Hh + bv[d][cb][r]; A *= av[d][cb][r]; }
                float Aw = 1.f, Hw = 0.f, Apl = 1.f, Hpl = 0.f;
#pragma unroll
                for (int gg = 0; gg < 4; ++gg) { const int g = d ? 3 - gg : gg;
                    const float Ag = __shfl(A, g * 16 + fr), Hg = __shfl(Hh, g * 16 + fr);
                    if (g == fq) { Apl = Aw; Hpl = Hw; }
                    Hw = Ag * Hw + Hg; Aw *= Ag; }
                Ap[d][cb] = Apl; Hp[d][cb] = Hpl;
                if (fq == 0) *(LAS f32x2*)(lds + RG_AGL + ((wave * 2 + d) * 64 + cb * 16 + fr) * 8) = (f32x2){Aw, Hw};
            }
        }
        __syncthreads();
        if constexpr (MODE == 0) {
            if (tid < 128 && !(ctx && (tid >> 6) != (tt & 1))) {
                const int d = tid >> 6, cl = tid & 63; float A = 1.f, Hh = 0.f;
#pragma unroll
                for (int ww = 0; ww < 8; ++ww) { const int w2 = d ? 7 - ww : ww; const f32x2 sg = *(const LAS f32x2*)(lds + RG_AGL + ((w2 * 2 + d) * 64 + cl) * 8); Hh = sg[0] * Hh + sg[1]; A *= sg[0]; }
                AGG[((size_t)(tt * 16 + h) * 2 + d) * 64 + cl] = (f32x2){A, Hh};
            }
        } else {
            if (ctx && (tt & 1) == 0 && tid < 64) {
                float Hh = 0.f;
#pragma unroll
                for (int w2 = 0; w2 < 8; ++w2) { const f32x2 sg = *(const LAS f32x2*)(lds + RG_AGL + ((w2 * 2 + 0) * 64 + tid) * 8); Hh = sg[0] * Hh + sg[1]; }
                *(LAS float*)(lds + RG_CARL + (((kitem + 1) * 2 + 0) * 64 + tid) * 4) = Hh;
            }
            float hs[4][4];
#pragma unroll
            for (int cb = 0; cb < 4; ++cb)
#pragma unroll
                for (int r = 0; r < 4; ++r) hs[cb][r] = 0.f;
#pragma unroll
            for (int d = 0; d < 2; ++d)
#pragma unroll
                for (int cb = 0; cb < 4; ++cb) {
                    const int cl = cb * 16 + fr;
                    float hin = car[d][cb];
                    f32x2 sg[8];
#pragma unroll
                    for (int w2 = 0; w2 < 8; ++w2) sg[w2] = *(const LAS f32x2*)(lds + RG_AGL + ((w2 * 2 + d) * 64 + cl) * 8);
#pragma unroll
                    for (int ww = 0; ww < 8; ++ww) { const int w2 = d ? 7 - ww : ww; if (d ? (w2 > wave) : (w2 < wave)) hin = sg[w2][0] * hin + sg[w2][1]; }
                    float hh = Ap[d][cb] * hin + Hp[d][cb];
#pragma unroll
                    for (int rr = 0; rr < 4; ++rr) { const int r = d ? 3 - rr : rr; hh = av[d][cb][r] * hh + bv[d][cb][r]; hs[cb][r] += hh; }
                    if (ctx && (tt & 1) == (d ? 0 : 1) && wave == (d ? 0 : 7) && fq == (d ? 0 : 3)) nstate[(size_t)(tt >> 1) * 2048 + d * 1024 + h * 64 + cl] = hh;
                }
#pragma unroll
            for (int cb = 0; cb < 4; ++cb)
#pragma unroll
                for (int r = 0; r < 4; ++r) *(LAS float*)(lds + RG_XF + ((tokb + fq * 4 + r) * 68 + cb * 16 + fr) * 4) = hs[cb][r];
            __syncthreads();
#pragma unroll
            for (int i = 0; i < 2; ++i) {
                const int idx = tid + i * NTHR, tk = idx >> 3, cg8 = idx & 7;
                const f32x4 y0 = *(const LAS f32x4*)(lds + RG_XF + (tk * 68 + cg8 * 8) * 4), y1 = *(const LAS f32x4*)(lds + RG_XF + (tk * 68 + cg8 * 8 + 4) * 4);
                const v4u g = ggr[i];
                v4u o; o.x = pk2(y0[0] * bflo(g.x), y0[1] * bfhi(g.x)); o.y = pk2(y0[2] * bflo(g.y), y0[3] * bfhi(g.y));
                o.z = pk2(y1[0] * bflo(g.z), y1[1] * bfhi(g.z)); o.w = pk2(y1[2] * bflo(g.w), y1[3] * bfhi(g.w));
                *(v4u*)(YR + (size_t)(t0 + tk) * YLD + h * 64 + cg8 * 8) = o;
            }
        }
        __syncthreads();
    }
}

template <int NT>
__device__ __forceinline__ float carry_chain(const f32x2* AGG, float* CAR, int tt0, int h, int d, int cl, float h0) {
    f32x2 ag[NT];
#pragma unroll
    for (int i = 0; i < NT; ++i) ag[i] = AGG[((size_t)((tt0 + i) * 16 + h) * 2 + d) * 64 + cl];
    float hc = h0;
#pragma unroll
    for (int ii = 0; ii < NT; ++ii) { const int i = d ? NT - 1 - ii : ii;
        CAR[((size_t)((tt0 + i) * 16 + h) * 2 + d) * 64 + cl] = hc; hc = ag[i][0] * hc + ag[i][1]; }
    return hc;
}
__device__ __forceinline__ void phase_carry(const Args& a, int gw, int NGW, int lane) {
    const f32x2* AGG = (const f32x2*)(a.ws + WS_AGG); float* CAR = (float*)(a.ws + WS_CAR);
    for (int wi = gw; wi < 34 * 2 * 16; wi += NGW) {
        const int s = wi >> 5, d = (wi >> 4) & 1, h = wi & 15, ch = h * 64 + lane;
        if (s < 32) {
            const size_t i0 = ((size_t)((2 * s) * 16 + h) * 2 + d) * 64 + lane, i1 = ((size_t)((2 * s + 1) * 16 + h) * 2 + d) * 64 + lane;
            if (d == 0) { CAR[i0] = 0.f; CAR[i1] = AGG[i0][1]; }
            else { CAR[i1] = 0.f; CAR[i0] = AGG[i1][1]; }
        } else {
            const int b = s - 32; const float h0 = a.in[I_STATE][(size_t)b * 2048 + d * 1024 + ch];
            if (d == 0) (void)carry_chain<32>(AGG, CAR, 64 + b * 32, h, 0, lane, h0);
            else (void)carry_chain<32>(AGG, CAR, 64 + b * 32, h, 1, lane, h0);
        }
    }
}

#define RLX_AGENT __ATOMIC_RELAXED, __HIP_MEMORY_SCOPE_AGENT
#define XB_TMO      128
#define XB_XCNT(j)  (256  + 64 * (j))
#define XB_XSUB(j)  (1280 + 64 * (j))
#define XB_XGEN(j)  (2304 + 64 * (j))
#define XB_TOP      3328
#define XB_TOPGEN   3392
#define XCD_BAR_WORDS 3456
#define XB_SPIN_CAP (1u << 18)

__device__ __forceinline__ unsigned xb_ld(unsigned* p)              { return __hip_atomic_load(p, __ATOMIC_RELAXED, __HIP_MEMORY_SCOPE_AGENT); }
__device__ __forceinline__ unsigned xb_add(unsigned* p, unsigned v) { return __hip_atomic_fetch_add(p, v, __ATOMIC_RELAXED, __HIP_MEMORY_SCOPE_AGENT); }
__device__ __forceinline__ unsigned xb_xcc_id() { return (unsigned)__builtin_amdgcn_s_getreg((3 << 11) | 20) & 0xFu; }
#define XB_SPIN(cond, bar) do { unsigned _sp = 0; while (cond) { __builtin_amdgcn_s_sleep(1); \
    if ((++_sp & 255u) == 0u) { if (xb_ld(&(bar)[XB_TMO])) break; if (_sp > XB_SPIN_CAP) { atomicAdd(&(bar)[XB_TMO], 1u); break; } } } } while (0)

struct XcdBarrier {
    unsigned* bar; unsigned x;
    volatile LAS unsigned* st;
};

__device__ __forceinline__ XcdBarrier xcd_barrier_post(unsigned* bar, volatile LAS unsigned* st) {
    XcdBarrier b; b.bar = bar; b.x = xb_xcc_id(); b.st = st;
    if (threadIdx.x == 0) (void)xb_add(&bar[XB_XCNT(b.x)], 1u);
    return b;
}
__device__ __forceinline__ void xcd_barrier_complete(unsigned* bar, unsigned x, unsigned& nloc, unsigned& nx) {
    const unsigned G = gridDim.x * gridDim.y * gridDim.z;
    unsigned sum, cnt, mine, sp = 0u;
    for (;;) {
        sum = 0u; cnt = 0u; mine = 0u;
#pragma unroll
        for (unsigned j = 0; j < 16; ++j) { const unsigned c = xb_ld(&bar[XB_XCNT(j)]); sum += c; cnt += (c > 0u) ? 1u : 0u; mine = (j == x) ? c : mine; }
        if (sum == G) break;
        __builtin_amdgcn_s_sleep(1);
        if ((++sp & 255u) == 0u) { if (xb_ld(&bar[XB_TMO])) break; if (sp > XB_SPIN_CAP) { atomicAdd(&bar[XB_TMO], 1u); break; } }
    }
    nloc = mine > 0u ? mine : 1u; nx = cnt > 0u ? cnt : 1u;
}

__device__ __forceinline__ void xcd_barrier(const XcdBarrier& b) {
    asm volatile("s_waitcnt vmcnt(0)" ::: "memory");
    __syncthreads();
    if (threadIdx.x == 0) {
        unsigned* bar = b.bar;
        __builtin_amdgcn_s_waitcnt(0);
        unsigned nloc = b.st[0], nx = b.st[1];
        if (nloc == 0u) { xcd_barrier_complete(bar, b.x, nloc, nx); b.st[0] = nloc; b.st[1] = nx; }
        const unsigned old = xb_add(&bar[XB_XSUB(b.x)], 1u);
        const unsigned gen = old / nloc;
        if (old + 1u == (gen + 1u) * nloc) {
            __builtin_amdgcn_fence(__ATOMIC_RELEASE, "agent");
            asm volatile("s_waitcnt vmcnt(0)" ::: "memory");
            const unsigned og = xb_add(&bar[XB_TOP], 1u);
            const unsigned tg = og / nx;
            if (og + 1u == (tg + 1u) * nx) xb_add(&bar[XB_TOPGEN], 1u);
            else XB_SPIN(xb_ld(&bar[XB_TOPGEN]) == tg, bar);
            __builtin_amdgcn_fence(__ATOMIC_ACQUIRE, "agent");
            xb_add(&bar[XB_XGEN(b.x)], 1u);
            asm volatile("s_waitcnt vmcnt(0)" ::: "memory");
        } else {
            XB_SPIN(xb_ld(&bar[XB_XGEN(b.x)]) == gen, bar);
            __builtin_amdgcn_fence(__ATOMIC_ACQUIRE, "agent");
            asm volatile("s_waitcnt vmcnt(0)" ::: "memory");
        }
    }
    __syncthreads();
}

__global__ void __launch_bounds__(NTHR, 2) fwd_megakernel(Args a) {
    extern __shared__ __attribute__((aligned(16))) unsigned char lds_raw[];
    LAS unsigned char* lds = (LAS unsigned char*)lds_raw;
    const int tid = threadIdx.x, lane = tid & 63, wave = __builtin_amdgcn_readfirstlane(tid >> 6);
    const int G = gridDim.x, gw = blockIdx.x * NWAVES + wave, NGW = G * NWAVES;
    unsigned char* ws = a.ws;
    const int lo = a.ph_lo, hi = a.ph_hi;
    volatile LAS unsigned* bst = (volatile LAS unsigned*)(lds + LDS_BAR_OFF);
    if (tid < 2) bst[tid] = 0u;
    __syncthreads();
    XcdBarrier bar = xcd_barrier_post((unsigned*)(ws + WS_CTL), bst);
#define IN(k) (lo <= (k) && (k) < hi)
#define SEAM(k) do { if (IN(k) && IN((k) + 1)) { xcd_barrier(bar); if (DUP >> 12 & 1) xcd_barrier(bar); } } while (0)
    float* const DUMSS = (float*)(ws + 1 * MiB + 512 * 1024);
#define REP(k) for (int rep_ = ((DUP >> (k)) & 1); rep_ >= 0; --rep_)
#define ISDUP (rep_ > 0)
    if (IN(0)) REP(0) phase_prep(a, lds, gw, NGW, wave, lane, ISDUP ? (float*)(ws + 1 * MiB + 256 * 1024) : (float*)(ws + CTL_MOD));
    SEAM(0);
    if (IN(1)) REP(1) phase_norm1(a, gw, NGW, lane);
    SEAM(1);
    if (IN(2)) REP(2) {
        pg8::Gemm g{(const pg8::bf16_t*)(ws + WS_H), (const pg8::bf16_t*)(ws + WS_WIN), M, INC, D}; pg8::StaticOrder S; S.init(M, INC, G, (int)blockIdx.x, WG_IN);
        pg8::Epi<1> E{nullptr, nullptr, nullptr, ISDUP ? DUMSS : (float*)(ws + CTL_VSS), D, (bf16*)(ws + WS_GU), (bf16*)a.out, (bf16*)((unsigned char*)a.out + 32 * MiB), (bf16*)(ws + WS_GU) + D, (bf16*)(ws + WS_SGA), (bf16*)(ws + WS_SGB)};
        pg8::gemm_phase<pg8::Epi<1>, pg8::StaticOrder, true, true>(lds, g, S, E);
    }
    SEAM(2);
    if (IN(3)) REP(3) { phase_rg<0>(a, lds, tid, wave, lane, nullptr); phase_sgu(a, lds, tid, wave, lane, ISDUP ? (bf16*)(ws + WS_F) : (bf16*)(ws + WS_GU)); }
    SEAM(3);
    if (IN(5)) REP(5) phase_rg<1>(a, lds, tid, wave, lane, ISDUP ? (bf16*)(ws + WS_F) + D : (bf16*)(ws + WS_GU) + D);
    SEAM(5);
    if (IN(6)) REP(6) {
        pg8::Gemm g{(const pg8::bf16_t*)(ws + WS_GU), (const pg8::bf16_t*)(ws + WS_WBG), M, D, 2 * D}; pg8::StaticOrder S; S.init(M, D, G, (int)blockIdx.x);
        pg8::EpiMerge E{(bf16*)(ws + WS_H), (const bf16*)(ws + WS_SGA), (const bf16*)(ws + WS_SGB)};
        pg8::gemm_phase<pg8::EpiMerge, pg8::StaticOrder, false, true>(lds, g, S, E);
    }
    SEAM(6);
    if (IN(7)) {
        pg8::Gemm g{(const pg8::bf16_t*)(ws + WS_H), (const pg8::bf16_t*)(ws + WS_WOUT), M, D, D}; pg8::StaticOrder S; S.init(M, D, G, (int)blockIdx.x);
        EpiFused<6> E{a.out, a.in[I_XP], a.in[I_XS], (bf16*)(ws + WS_H), (float*)(ws + CTL_OSS), (float*)(ws + CTL_XSS), (unsigned*)(ws + CTL_CNT), (unsigned*)(ws + CTL_CNT + 16384),
                      (const float*)(ws + CTL_MOD), a.in[I_BADA], a.in[I_GPOSTMIX], a.in[I_GPREMLP]};
        pg8::gemm_phase<EpiFused<6>, pg8::StaticOrder, false, true>(lds, g, S, E);
    }
    SEAM(7);
    if (IN(8)) REP(8) {
        pg8::Gemm g{(const pg8::bf16_t*)(ws + WS_H), (const pg8::bf16_t*)(ws + WS_WFF1), M, FF, D}; pg8::StaticOrder S; S.init(M, FF, G, (int)blockIdx.x, WG_FF1);
        pg8::Epi<5> E{(bf16*)(ws + WS_F1), nullptr, nullptr, nullptr, FF, nullptr, nullptr, nullptr, nullptr, nullptr, nullptr};
        pg8::gemm_phase<pg8::Epi<5>, pg8::StaticOrder, true, true>(lds, g, S, E);
    }
    SEAM(8);
    if (IN(9)) {
        pg8::Gemm g{(const pg8::bf16_t*)(ws + WS_F1), (const pg8::bf16_t*)(ws + WS_WFF2), M, D, FF}; pg8::StaticOrder S; S.init(M, D, G, (int)blockIdx.x);
        EpiFused<7> E{a.out, nullptr, nullptr, nullptr, (float*)(ws + CTL_FSS), nullptr, (unsigned*)(ws + CTL_CNT + 32768), nullptr,
                      (const float*)(ws + CTL_MOD), a.in[I_BADA], a.in[I_GPOSTMLP], nullptr};
        pg8::gemm_phase<EpiFused<7>, pg8::StaticOrder, false, true>(lds, g, S, E);
    }
#undef IN
#undef SEAM
}

constexpr int N_PHASES = 10;
extern "C" void kernel_launch(void* const* d_in, const int* in_sizes, int n_in, void* d_out, int out_size, void* d_ws, size_t ws_size, hipStream_t stream) {
    static int grid = 0;
    if (grid == 0) {
        if (n_in != 27 || ws_size < WS_END) { fprintf(stderr, "kernel_launch: need 27 inputs and >= %zu B of workspace; got %d, %zu\n", (size_t)WS_END, n_in, ws_size); grid = -1; return; }
        int dev = 0, cus = 0, per_cu = 0;
        if (hipGetDevice(&dev) != hipSuccess || hipDeviceGetAttribute(&cus, hipDeviceAttributeMultiprocessorCount, dev) != hipSuccess) { grid = -1; return; }
        if (hipFuncSetAttribute((const void*)fwd_megakernel, hipFuncAttributeMaxDynamicSharedMemorySize, LDS_BYTES) != hipSuccess) { fprintf(stderr, "kernel_launch: hipFuncSetAttribute failed\n"); grid = -1; return; }
        if (hipOccupancyMaxActiveBlocksPerMultiprocessor(&per_cu, (const void*)fwd_megakernel, NTHR, LDS_BYTES) != hipSuccess || per_cu < 1) { fprintf(stderr, "kernel_launch: occupancy query says %d\n", per_cu); per_cu = 1; }
        (void)hipGetLastError();
        grid = cus * per_cu;
        if (grid < 256) { fprintf(stderr, "kernel_launch: this kernel's work split needs 256 co-resident workgroups; the device offers %d\n", grid); grid = -1; return; }
        grid = 256;
    }
    if (grid < 0) return;
    (void)hipMemsetAsync((char*)d_ws + WS_CTL, 0, CTL_ZERO_BYTES, stream);
    Args a{};
    for (int i = 0; i < 27; ++i) a.in[i] = (const float*)d_in[i];
    a.out = (float*)d_out; a.ws = (unsigned char*)d_ws; a.ph_lo = 0; a.ph_hi = N_PHASES;
    void* args[] = {&a};
    hipError_t e = hipLaunchCooperativeKernel((const void*)fwd_megakernel, dim3(grid), dim3(NTHR), args, LDS_BYTES, stream);
    if (e != hipSuccess) fprintf(stderr, "kernel_launch: cooperative launch failed: %s (grid %d)\n", hipGetErrorString(e), grid);
}
```

```cpp
#include <hip/hip_runtime.h>
#include <hip/hip_cooperative_groups.h>
#include <cstdio>
#include <cstdint>
namespace cg = cooperative_groups;
namespace pg8 {
#define PG8_LAS __attribute__((address_space(3)))
typedef unsigned short bf16_t;
typedef short bf16x8 __attribute__((ext_vector_type(8)));
typedef float f32x4 __attribute__((ext_vector_type(4)));
typedef unsigned u32x4 __attribute__((ext_vector_type(4)));
constexpr int BM = 256, BK = 64, HALF = 128, HTB = HALF * BK * 2  , STAGE_BYTES = 8 * HTB, NXCD = 8, WGM = 8;

__host__ __device__ __forceinline__ int lds_byte(int r, int c) { const int st = (r >> 4) * 2 + (c >> 5), rr = r & 15, cc = c & 31, ob = rr * 64 + cc * 2; return st * 1024 + (ob ^ (((ob >> 9) & 1) << 5)); }
__host__ __device__ __forceinline__ void stage_rc(int b, int& R, int& C) { const int st = b / 1024, sb = b % 1024, swz = sb ^ (((sb >> 9) & 1) << 5); R = (st >> 1) * 16 + swz / 64; C = (st & 1) * 32 + (swz % 64) / 2; }
__host__ __device__ __forceinline__ int perm32(int rho) { const int n = rho >> 4, i = rho & 15; return 8 * (i >> 2) + 4 * n + (i & 3); }

struct Unit { int pm, pn; };
struct Gemm { const bf16_t* A; const bf16_t* Bt; int M, N, K; };

struct StaticOrder {
    int nM, nN, nwg, G, c, wgm;
    __host__ __device__ void init(int M, int N, int G_, int c_, int wgm_ = 8) { nM = M / BM; nN = N / BM; nwg = nM * nN; G = G_; c = c_; wgm = wgm_; }
    __host__ __device__ bool next(int i, Unit& u) const {
        const long L = (long)i * G + c; if (L >= nwg) return false;
        int wgid = (int)L; { const int q = nwg / NXCD, r = nwg % NXCD, xcd = wgid % NXCD, off = wgid / NXCD; wgid = (xcd < r ? xcd * (q + 1) : r * (q + 1) + (xcd - r) * q) + off; }
        const int nig = wgm * nN, gid = wgid / nig, fm = gid * wgm, gsz = (nM - fm) < wgm ? (nM - fm) : wgm;
        u.pm = fm + ((wgid % nig) % gsz); u.pn = (wgid % nig) / gsz; return true;
    }
    __device__ __forceinline__ void a_ready(const Unit&) const {}
    __device__ __forceinline__ void done(const Unit&) const {}
};

typedef __bf16 bf16x2_cvt __attribute__((ext_vector_type(2)));
typedef float f32x2_cvt __attribute__((ext_vector_type(2)));
__device__ __forceinline__ unsigned cvt_pk_bf16(float lo, float hi) { const f32x2_cvt v = {lo, hi}; const bf16x2_cvt b = __builtin_convertvector(v, bf16x2_cvt); return __builtin_bit_cast(unsigned, b); }
__device__ __forceinline__ float sigmoid_f(float x) { return __builtin_amdgcn_rcpf(1.f + __builtin_amdgcn_exp2f(-1.4426950409f * x)); }
__device__ __forceinline__ float gelu_tanh_f(float x) { const float u = x * (-2.3022081985f - 0.10294324f * (x * x)); return x * __builtin_amdgcn_rcpf(1.f + __builtin_amdgcn_exp2f(u)); }
__device__ __forceinline__ float bflo(unsigned w) { return __builtin_bit_cast(float, w << 16); }
__device__ __forceinline__ float bfhi(unsigned w) { return __builtin_bit_cast(float, w & 0xffff0000u); }
template <int MODE> struct Epi {
    static constexpr bool PERM = true, AFTER_DRAIN = false, HOOK = false;
    bf16_t* Ob; float* Of; const bf16_t* G; float* SS; int ldc;
    bf16_t *s0, *s1, *s2, *s3, *s4, *s5;
    __device__ __forceinline__ void operator()(const f32x4 (&acc)[2][2][4][2], const Unit& u, int wr, int wc, int fr, int fq) const {
        const int row0 = u.pm * BM + wr * 64 + fr;
        if constexpr (MODE == 1) {
            const int t = u.pn >> 2;
            bf16_t* base = t == 0 ? s0 : t == 1 ? s1 : t == 2 ? s2 : t == 3 ? s3 : t == 4 ? s4 : s5;
            const int col0 = (u.pn & 3) * BM + wc * 32 + 8 * fq;
#pragma unroll
            for (int ai = 0; ai < 2; ++ai)
#pragma unroll
                for (int m = 0; m < 4; ++m) {
                    const int row = row0 + ai * HALF + m * 16; bf16_t* rowp = base + (size_t)row * ((t == 0 || t == 3) ? 2048 : 1024) + col0; float ss = 0.f;
#pragma unroll
                    for (int bj = 0; bj < 2; ++bj) {
                        f32x4 v0 = acc[ai][bj][m][0], v1 = acc[ai][bj][m][1];
                        if (t >= 4) {
#pragma unroll
                            for (int j = 0; j < 4; ++j) { v0[j] = sigmoid_f(v0[j]); v1[j] = sigmoid_f(v1[j]); }
                        } else if (t != 2) {
#pragma unroll
                            for (int j = 0; j < 4; ++j) { v0[j] = gelu_tanh_f(v0[j]); v1[j] = gelu_tanh_f(v1[j]); }
                        }
                        if (t == 1) {
#pragma unroll
                            for (int j = 0; j < 4; ++j) ss += v0[j] * v0[j] + v1[j] * v1[j];
                        }
                        u32x4 w; w.x = cvt_pk_bf16(v0[0], v0[1]); w.y = cvt_pk_bf16(v0[2], v0[3]); w.z = cvt_pk_bf16(v1[0], v1[1]); w.w = cvt_pk_bf16(v1[2], v1[3]);
                        *(u32x4*)(rowp + bj * HALF) = w;
                    }
                    if (t == 1) { ss += __shfl_xor(ss, 16); ss += __shfl_xor(ss, 32); if (fq == 0) atomicAdd(SS + row, ss); }
                }
        } else {
            const int col0 = u.pn * BM + wc * 32 + 8 * fq;
#pragma unroll
            for (int ai = 0; ai < 2; ++ai)
#pragma unroll
                for (int m = 0; m < 4; ++m) {
                    const int row = row0 + ai * HALF + m * 16; float ss = 0.f;
#pragma unroll
                    for (int bj = 0; bj < 2; ++bj) {
                        f32x4 v0 = acc[ai][bj][m][0], v1 = acc[ai][bj][m][1];
                        const size_t off = (size_t)row * ldc + col0 + bj * HALF;
                        if constexpr (MODE == 2 || MODE == 3) {
                            const u32x4 g = *(const u32x4*)(G + off);
                            v0[0] *= bflo(g.x); v0[1] *= bfhi(g.x); v0[2] *= bflo(g.y); v0[3] *= bfhi(g.y);
                            v1[0] *= bflo(g.z); v1[1] *= bfhi(g.z); v1[2] *= bflo(g.w); v1[3] *= bfhi(g.w);
                        }
                        if constexpr (MODE == 3) { v0 = v0 + *(const f32x4*)(Of + off); v1 = v1 + *(const f32x4*)(Of + off + 4); }
                        if constexpr (MODE == 5) {
#pragma unroll
                            for (int j = 0; j < 4; ++j) { const float a = fmaxf(v0[j], 0.f), b = fmaxf(v1[j], 0.f); v0[j] = a * a; v1[j] = b * b; }
                        }
                        if constexpr (MODE == 4) {
#pragma unroll
                            for (int j = 0; j < 4; ++j) ss += v0[j] * v0[j] + v1[j] * v1[j];
                        }
                        if constexpr (MODE == 2 || MODE == 4) { *(f32x4*)(Of + off) = v0; *(f32x4*)(Of + off + 4) = v1; }
                        else { u32x4 w; w.x = cvt_pk_bf16(v0[0], v0[1]); w.y = cvt_pk_bf16(v0[2], v0[3]); w.z = cvt_pk_bf16(v1[0], v1[1]); w.w = cvt_pk_bf16(v1[2], v1[3]);
                            *(u32x4*)(Ob + off) = w; }
                    }
                    if constexpr (MODE == 4) { ss += __shfl_xor(ss, 16); ss += __shfl_xor(ss, 32); if (fq == 0) atomicAdd(SS + row, ss); }
                }
        }
    }
};

struct EpiMerge {
    static constexpr bool PERM = true, AFTER_DRAIN = false, HOOK = true;
    bf16_t* Ob; const bf16_t* GA; const bf16_t* GB;
    __device__ __forceinline__ void mid(f32x4 (&acc)[2][2][4][2], const Unit& u, int wr, int wc, int fr, int fq) const {
        int row0 = u.pm * BM + wr * 64 + fr, col0 = u.pn * BM + wc * 32 + 8 * fq;
        asm volatile("" : "+v"(row0), "+v"(col0));
#pragma unroll
        for (int ai = 0; ai < 2; ++ai)
#pragma unroll
            for (int m = 0; m < 4; ++m) {
                if ((m & 1) == 0) asm volatile("" ::: "memory");
#pragma unroll
                for (int bj = 0; bj < 2; ++bj) {
                    const size_t off = (size_t)(row0 + ai * HALF + m * 16) * 1024 + col0 + bj * HALF;
                    const u32x4 a = *(const u32x4*)(GA + off), b = *(const u32x4*)(GB + off);
                    f32x4 r0, r1;
                    r0[0] = bflo(a.x) * __builtin_amdgcn_rcpf(fmaxf(bflo(b.x), 1e-30f)); r0[1] = bfhi(a.x) * __builtin_amdgcn_rcpf(fmaxf(bfhi(b.x), 1e-30f));
                    r0[2] = bflo(a.y) * __builtin_amdgcn_rcpf(fmaxf(bflo(b.y), 1e-30f)); r0[3] = bfhi(a.y) * __builtin_amdgcn_rcpf(fmaxf(bfhi(b.y), 1e-30f));
                    r1[0] = bflo(a.z) * __builtin_amdgcn_rcpf(fmaxf(bflo(b.z), 1e-30f)); r1[1] = bfhi(a.z) * __builtin_amdgcn_rcpf(fmaxf(bfhi(b.z), 1e-30f));
                    r1[2] = bflo(a.w) * __builtin_amdgcn_rcpf(fmaxf(bflo(b.w), 1e-30f)); r1[3] = bfhi(a.w) * __builtin_amdgcn_rcpf(fmaxf(bfhi(b.w), 1e-30f));
                    acc[ai][bj][m][0] = acc[ai][bj][m][0] * r0; acc[ai][bj][m][1] = acc[ai][bj][m][1] * r1;
                }
            }
    }
    __device__ __forceinline__ void operator()(const f32x4 (&acc)[2][2][4][2], const Unit& u, int wr, int wc, int fr, int fq) const {
        const int row0 = u.pm * BM + wr * 64 + fr, col0 = u.pn * BM + wc * 32 + 8 * fq;
#pragma unroll
        for (int ai = 0; ai < 2; ++ai)
#pragma unroll
            for (int m = 0; m < 4; ++m)
#pragma unroll
                for (int bj = 0; bj < 2; ++bj) {
                    const size_t off = (size_t)(row0 + ai * HALF + m * 16) * 1024 + col0 + bj * HALF;
                    const u32x4 b = *(const u32x4*)(GB + off);
                    const f32x4 v0 = acc[ai][bj][m][0], v1 = acc[ai][bj][m][1];
                    u32x4 w; w.x = cvt_pk_bf16(v0[0] * bflo(b.x), v0[1] * bfhi(b.x)); w.y = cvt_pk_bf16(v0[2] * bflo(b.y), v0[3] * bfhi(b.y));
                    w.z = cvt_pk_bf16(v1[0] * bflo(b.z), v1[1] * bfhi(b.z)); w.w = cvt_pk_bf16(v1[2] * bflo(b.w), v1[3] * bfhi(b.w));
                    *(u32x4*)(Ob + off) = w;
                }
    }
};

template <class Epi, class Sched, bool ALIGN_EPI = false, bool SP2 = false>
__device__ __forceinline__ void gemm_phase(PG8_LAS unsigned char* lds, const Gemm g, const Sched& S, const Epi& E) {
    const int tid = threadIdx.x, wid = __builtin_amdgcn_readfirstlane(tid >> 6), lane = tid & 63, wr = wid >> 2, wc = wid & 3, fr = lane & 15, fq = lane >> 4;
    const int K = g.K, nt = K / BK;
    unsigned voffA[2], voffB[2];
#pragma unroll
    for (int i = 0; i < 2; ++i) { int R, C; stage_rc(tid * 16 + i * 8192, R, C); const int Rb = Epi::PERM ? ((R & ~31) + perm32(R & 31)) : R;
        voffA[i] = (unsigned)(R * K + C) * 2u; voffB[i] = (unsigned)(Rb * K + C) * 2u; }
    const size_t kstep = (size_t)(BK * 2);
    const size_t hstep = (size_t)HALF * K * 2;
    const size_t tstep = 2 * hstep;
    const unsigned ldsw = (unsigned)wid * 1024u;
    const int aoff = lds_byte(wr * 64 + fr, fq * 8), boff = lds_byte(wc * 32 + fr, fq * 8);
#define PG8_SA(b, h) (((b) * 2 + (h)) * HTB)
#define PG8_SB(b, h) ((4 + (b) * 2 + (h)) * HTB)
#define PG8_STAGE(bufoff, gbase, voff) do { _Pragma("unroll") for (int _i = 0; _i < 2; ++_i) \
        __builtin_amdgcn_global_load_lds((const unsigned*)((const char*)(gbase) + (voff)[_i]), (PG8_LAS unsigned*)(lds + (bufoff) + ldsw + _i * 8192), 16, 0, 0); } while (0)
#define PG8_LDA(dst, b, h) do { _Pragma("unroll") for (int m = 0; m < 4; ++m) _Pragma("unroll") for (int k = 0; k < 2; ++k) dst[m][k] = *(const PG8_LAS bf16x8*)(lds + PG8_SA(b, h) + aoff + m * 2048 + k * 1024); } while (0)
#define PG8_LDB(dst, b, h) do { _Pragma("unroll") for (int n = 0; n < 2; ++n) _Pragma("unroll") for (int k = 0; k < 2; ++k) dst[n][k] = *(const PG8_LAS bf16x8*)(lds + PG8_SB(b, h) + boff + n * 2048 + k * 1024); } while (0)
#define PG8_MMA(ai, bj, At, Bt) do { __builtin_amdgcn_s_setprio(1); _Pragma("unroll") for (int m = 0; m < 4; ++m) _Pragma("unroll") for (int n = 0; n < 2; ++n) _Pragma("unroll") for (int k = 0; k < 2; ++k) \
        acc[ai][bj][m][n] = __builtin_amdgcn_mfma_f32_16x16x32_bf16(Bt[n][k], At[m][k], acc[ai][bj][m][n], 0, 0, 0); __builtin_amdgcn_s_setprio(0); } while (0)
#define PG8_WAIT_V(n) asm volatile("s_waitcnt vmcnt(" #n ")" ::: "memory")
#define PG8_WAIT_L(n) asm volatile("s_waitcnt lgkmcnt(" #n ")" ::: "memory")
#define PG8_BAR __builtin_amdgcn_s_barrier()
#define PG8_SCHED __builtin_amdgcn_sched_barrier(0)
    Unit cur, nxt; int ui = 0;
    if (!S.next(0, cur)) return;
    f32x4 acc[2][2][4][2];
#pragma unroll
    for (int a = 0; a < 2; ++a)
#pragma unroll
        for (int b = 0; b < 2; ++b)
#pragma unroll
            for (int m = 0; m < 4; ++m)
#pragma unroll
                for (int n = 0; n < 2; ++n) acc[a][b][m][n] = (f32x4){0.f, 0.f, 0.f, 0.f};
    bf16x8 At[4][2], B0[2][2], B1[2][2];
    const char* cA = (const char*)g.A + (size_t)cur.pm * tstep; const char* cB = (const char*)g.Bt + (size_t)cur.pn * tstep;
    S.a_ready(cur);
    if constexpr (SP2) {
        PG8_STAGE(PG8_SB(0, 0), cB, voffB); PG8_STAGE(PG8_SB(0, 1), cB + hstep, voffB); PG8_STAGE(PG8_SA(0, 0), cA, voffA); PG8_STAGE(PG8_SA(0, 1), cA + hstep, voffA);
        if (wr == 1) PG8_BAR;
        PG8_WAIT_V(2); PG8_BAR;
        PG8_STAGE(PG8_SB(1, 0), cB + kstep, voffB); PG8_STAGE(PG8_SA(1, 0), cA + kstep, voffA); PG8_STAGE(PG8_SB(1, 1), cB + hstep + kstep, voffB);
        PG8_WAIT_V(6); PG8_BAR;
    } else {
        PG8_STAGE(PG8_SB(0, 0), cB, voffB); PG8_STAGE(PG8_SA(0, 0), cA, voffA); PG8_STAGE(PG8_SB(0, 1), cB + hstep, voffB); PG8_STAGE(PG8_SA(0, 1), cA + hstep, voffA);
        if (wr == 1) PG8_BAR;
        PG8_WAIT_V(4); PG8_BAR;
        PG8_STAGE(PG8_SB(1, 0), cB + kstep, voffB); PG8_STAGE(PG8_SA(1, 0), cA + kstep, voffA); PG8_STAGE(PG8_SB(1, 1), cB + hstep + kstep, voffB);
        PG8_WAIT_V(6); PG8_BAR;
    }
    for (;;) {
        const bool has_next = S.next(ui + 1, nxt);
        const char* nA = has_next ? (const char*)g.A + (size_t)nxt.pm * tstep : cA; const char* nB = has_next ? (const char*)g.Bt + (size_t)nxt.pn * tstep : cB;
        for (int t = 0; t < nt; t += 2) {
            if constexpr (Epi::HOOK) { if (t == (nt >> 1)) E.mid(acc, cur, wr, wc, fr, fq); }
            const bool last = (t == nt - 2);
            const char* a1 = cA + (size_t)(t + 1) * kstep;
            const char* a2 = last ? nA : cA + (size_t)(t + 2) * kstep; const char* b2 = last ? nB : cB + (size_t)(t + 2) * kstep;
            const char* a3 = a2 + kstep; const char* b3 = b2 + kstep;
            if (last && has_next) S.a_ready(nxt);
            if constexpr (SP2) {
            PG8_LDB(B0, 0, 0); PG8_LDB(B1, 0, 1); PG8_SCHED; PG8_LDA(At, 0, 0); PG8_STAGE(PG8_SA(1, 1), a1 + hstep, voffA);
            PG8_WAIT_V(8); PG8_WAIT_L(0); PG8_BAR; PG8_MMA(0, 0, At, B0); PG8_MMA(0, 1, At, B1); PG8_BAR; PG8_SCHED;
            PG8_LDA(At, 0, 1); PG8_STAGE(PG8_SB(0, 0), b2, voffB); PG8_STAGE(PG8_SB(0, 1), b2 + hstep, voffB); PG8_STAGE(PG8_SA(0, 0), a2, voffA);
            PG8_WAIT_V(8); PG8_WAIT_L(0); PG8_BAR; PG8_MMA(1, 0, At, B0); PG8_MMA(1, 1, At, B1); PG8_BAR; PG8_SCHED;
            PG8_LDB(B0, 1, 0); PG8_LDB(B1, 1, 1); PG8_SCHED; PG8_LDA(At, 1, 0); PG8_STAGE(PG8_SA(0, 1), a2 + hstep, voffA);
            PG8_WAIT_V(8); PG8_WAIT_L(0); PG8_BAR; PG8_MMA(0, 0, At, B0); PG8_MMA(0, 1, At, B1); PG8_BAR; PG8_SCHED;
            PG8_LDA(At, 1, 1); PG8_STAGE(PG8_SB(1, 0), b3, voffB); PG8_STAGE(PG8_SB(1, 1), b3 + hstep, voffB); PG8_STAGE(PG8_SA(1, 0), a3, voffA);
            PG8_WAIT_V(8); PG8_WAIT_L(0); PG8_BAR; PG8_MMA(1, 0, At, B0); PG8_MMA(1, 1, At, B1); PG8_BAR; PG8_SCHED;
            } else {
            PG8_LDB(B0, 0, 0); PG8_SCHED; PG8_LDA(At, 0, 0); PG8_STAGE(PG8_SA(1, 1), a1 + hstep, voffA);
            PG8_WAIT_L(8); PG8_BAR; PG8_WAIT_L(0); PG8_MMA(0, 0, At, B0); PG8_BAR; PG8_SCHED;
            PG8_LDB(B1, 0, 1); PG8_STAGE(PG8_SB(0, 0), b2, voffB);
            PG8_BAR; PG8_WAIT_L(0); PG8_MMA(0, 1, At, B1); PG8_BAR;
            PG8_LDA(At, 0, 1); PG8_STAGE(PG8_SA(0, 0), a2, voffA);
            PG8_BAR; PG8_WAIT_L(0); PG8_MMA(1, 0, At, B0); PG8_BAR; PG8_SCHED;
            PG8_STAGE(PG8_SB(0, 1), b2 + hstep, voffB);
            PG8_WAIT_V(6); PG8_BAR; PG8_MMA(1, 1, At, B1); PG8_BAR;
            PG8_LDB(B0, 1, 0); PG8_SCHED; PG8_LDA(At, 1, 0); PG8_STAGE(PG8_SA(0, 1), a2 + hstep, voffA);
            PG8_WAIT_L(8); PG8_BAR; PG8_WAIT_L(0); PG8_MMA(0, 0, At, B0); PG8_BAR; PG8_SCHED;
            PG8_LDB(B1, 1, 1); PG8_STAGE(PG8_SB(1, 0), b3, voffB);
            PG8_BAR; PG8_WAIT_L(0); PG8_MMA(0, 1, At, B1); PG8_BAR;
            PG8_LDA(At, 1, 1); PG8_STAGE(PG8_SA(1, 0), a3, voffA);
            PG8_BAR; PG8_WAIT_L(0); PG8_MMA(1, 0, At, B0); PG8_BAR; PG8_SCHED;
            PG8_STAGE(PG8_SB(1, 1), b3 + hstep, voffB);
            PG8_WAIT_V(6); PG8_BAR; PG8_MMA(1, 1, At, B1); PG8_BAR;
            }
        }
        if constexpr (ALIGN_EPI) { if (wr == 0) PG8_BAR; }
        if constexpr (!Epi::AFTER_DRAIN) { E(acc, cur, wr, wc, fr, fq); S.done(cur); }
        if (!has_next) break;
#pragma unroll
        for (int a = 0; a < 2; ++a)
#pragma unroll
            for (int b = 0; b < 2; ++b)
#pragma unroll
                for (int m = 0; m < 4; ++m)
#pragma unroll
                    for (int n = 0; n < 2; ++n) acc[a][b][m][n] = (f32x4){0.f, 0.f, 0.f, 0.f};
        cur = nxt; cA = nA; cB = nB; ++ui;
        if constexpr (ALIGN_EPI) { if (wr == 1) PG8_BAR; }
    }
    PG8_WAIT_V(0);
    if constexpr (!ALIGN_EPI) { if (wr == 0) PG8_BAR; }
    PG8_BAR;
    if constexpr (Epi::AFTER_DRAIN) { E.fused(acc, cur, wr, wc, fr, fq, lds, wid, lane); S.done(cur); }
#undef PG8_SA
#undef PG8_SB
#undef PG8_STAGE
#undef PG8_LDA
#undef PG8_LDB
#undef PG8_MMA
#undef PG8_WAIT_V
#undef PG8_WAIT_L
#undef PG8_BAR
#undef PG8_SCHED
}
}

constexpr int NWAVES = 8, NTHR = NWAVES * 64;
constexpr int D = 1024, M = 16384, MCTX = 8192, INC = 6144, FF = 4096;
constexpr float EPS = 1e-6f, LOG2E = 1.4426950408889634f;
constexpr size_t MiB = 1u << 20;
constexpr size_t WS_CTL = 0, CTL_ZERO_BYTES = 1 * MiB;
constexpr size_t CTL_VSS = 64 * 1024, CTL_OSS = 128 * 1024, CTL_FSS = 192 * 1024, CTL_MOD = 256 * 1024, CTL_XSS = 384 * 1024;
constexpr size_t CTL_CNT = 16 * 1024;
constexpr size_t WS_GC = 1 * MiB;
constexpr size_t WS_AGG = 2 * MiB;
constexpr size_t WS_CAR = 4 * MiB;
constexpr size_t WS_WG = 5 * MiB;
constexpr size_t WS_WSP = 5 * MiB + 512 * 1024;
constexpr size_t WS_WFF2 = 6 * MiB, WS_WFF1 = 14 * MiB, WS_WIN = 22 * MiB, WS_WBG = 34 * MiB, WS_WBR = 36 * MiB, WS_WOUT = 38 * MiB;
constexpr size_t WS_H = 40 * MiB;
constexpr size_t WS_F = 64 * MiB;
constexpr size_t WS_GU = 128 * MiB, WS_GGR = 160 * MiB, WS_SGA = 192 * MiB, WS_SGB = 224 * MiB;
constexpr size_t WS_F1 = 128 * MiB;
constexpr size_t WS_END = 256 * MiB;
constexpr int LDS_BYTES = 147456, LDS_BAR_OFF = 139264;
#ifndef WG_IN
#define WG_IN 4
#endif
#ifndef WG_FF1
#define WG_FF1 2
#endif
#ifndef DUP
#define DUP 0
#endif

#define GAS __attribute__((address_space(1)))
#define LAS __attribute__((address_space(3)))
typedef unsigned short bf16;
typedef unsigned v4u __attribute__((ext_vector_type(4)));
typedef unsigned v2u __attribute__((ext_vector_type(2)));
typedef float f32x4 __attribute__((ext_vector_type(4)));
typedef float f32x2 __attribute__((ext_vector_type(2)));
typedef short bf16x8 __attribute__((ext_vector_type(8)));
#define LDS_WAIT() asm volatile("s_waitcnt lgkmcnt(0)" ::: "memory")
__device__ __forceinline__ unsigned f2bf(float f) { unsigned u = __builtin_bit_cast(unsigned, f); return (u + 0x7fffu + ((u >> 16) & 1u)) >> 16; }
__device__ __forceinline__ unsigned pk2(float lo, float hi) { return pg8::cvt_pk_bf16(lo, hi); }
__device__ __forceinline__ float bf2f(bf16 b) { return __builtin_bit_cast(float, (unsigned)b << 16); }
using pg8::bflo; using pg8::bfhi;

struct Args { const float* in[27]; float* out; unsigned char* ws; int ph_lo, ph_hi; };
enum { I_XP = 0, I_XS, I_STATE, I_C, I_CCTX, I_WADA, I_BADA, I_GPREMIX, I_GPOSTMIX, I_GPREMLP, I_GPOSTMLP, I_WIN, I_GSGU, I_WSP, I_BSP, I_CONVW, I_CONVB,
       I_WRA, I_BRA, I_WRI, I_BRI, I_LAM, I_WBRG, I_WBRR, I_WOUT, I_WFF1, I_WFF2 };

__device__ __forceinline__ float wave_sum(float v) {
#pragma unroll
    for (int o = 1; o < 64; o <<= 1) v += __shfl_xor(v, o);
    return v;
}
__device__ __forceinline__ void p0_transpose_item(const float* W, int K, int N, bf16* WT, LAS float* scr, int item, int lane, int ldk = 0, int koff = 0) {
    if (ldk == 0) ldk = K;
    const int nblk = N / 32, kb = item / nblk, nb = item % nblk, k0 = 64 * kb, n0 = 32 * nb;
#pragma unroll
    for (int i = 0; i < 8; ++i) { const int kk = 8 * i + (lane >> 3);
        const f32x4 v = *(const f32x4*)(W + (size_t)(k0 + kk) * N + n0 + (lane & 7) * 4);
        LAS float* dd = scr + kk * 33 + (lane & 7) * 4; dd[0] = v[0]; dd[1] = v[1]; dd[2] = v[2]; dd[3] = v[3]; }
    LDS_WAIT(); asm volatile("" ::: "memory");
    const int c = lane & 7;
#pragma unroll
    for (int j = 0; j < 4; ++j) { const int n = (lane >> 3) + 8 * j; const LAS float* s = scr + (8 * c) * 33 + n;
        v4u o; o.x = pk2(s[0 * 33], s[1 * 33]); o.y = pk2(s[2 * 33], s[3 * 33]); o.z = pk2(s[4 * 33], s[5 * 33]); o.w = pk2(s[6 * 33], s[7 * 33]);
        *(v4u*)(WT + (size_t)(n0 + n) * ldk + koff + k0 + 8 * c) = o; }
    LDS_WAIT(); asm volatile("" ::: "memory");
}

__device__ __forceinline__ void phase_prep(const Args& a, LAS unsigned char* lds, int gw, int NGW, int wave, int lane, float* MOD) {
    unsigned char* ws = a.ws;
    LAS float* scr = (LAS float*)(lds + wave * 16384);
    if ((int)blockIdx.x < 192) {
        const float* wada = a.in[I_WADA]; const float* cctx = a.in[I_CCTX]; const float* cc = a.in[I_C];
        const int nb = blockIdx.x % 24, ksl = blockIdx.x / 24, n = nb * 256 + lane * 4, kbase = ksl * 128 + wave * 16;
        f32x4 a0 = {0.f, 0.f, 0.f, 0.f}, a1 = a0, a2 = a0;
#pragma unroll
        for (int kk = 0; kk < 16; ++kk) {
            const int k = kbase + kk;
            const f32x4 w = *(const f32x4*)(wada + (size_t)k * INC + n);
            const float c0 = cctx[k], c1 = cc[k], c2 = cc[D + k];
            const float s0 = c0 * pg8::sigmoid_f(c0), s1 = c1 * pg8::sigmoid_f(c1), s2 = c2 * pg8::sigmoid_f(c2);
            a0 += w * s0; a1 += w * s1; a2 += w * s2;
        }
        LAS float* red = (LAS float*)lds;
        *(LAS f32x4*)(red + (wave * 3 + 0) * 256 + lane * 4) = a0; *(LAS f32x4*)(red + (wave * 3 + 1) * 256 + lane * 4) = a1; *(LAS f32x4*)(red + (wave * 3 + 2) * 256 + lane * 4) = a2;
        __syncthreads();
        const int tid = wave * 64 + lane;
        if (tid < 192) {
            const int v = tid >> 6, c4 = (tid & 63) * 4;
            f32x4 sum = {0.f, 0.f, 0.f, 0.f};
#pragma unroll
            for (int w2 = 0; w2 < 8; ++w2) sum += *(const LAS f32x4*)(red + (w2 * 3 + v) * 256 + c4);
#pragma unroll
            for (int j = 0; j < 4; ++j) atomicAdd(MOD + v * INC + nb * 256 + c4 + j, sum[j]);
        }
        __syncthreads();
    }
    constexpr int I_IN = 16 * (INC / 32), I_SQ = 16 * (D / 32), I_F1 = 16 * (FF / 32), I_F2 = (FF / 64) * (D / 32);
    constexpr int NT = I_IN + 3 * I_SQ + I_F1 + I_F2;
    for (int it = gw; it < NT; it += NGW) {
        int r = it;
        if (r < I_IN) { p0_transpose_item(a.in[I_WIN], D, INC, (bf16*)(ws + WS_WIN), scr, r, lane); continue; } r -= I_IN;
        if (r < I_SQ) { p0_transpose_item(a.in[I_WBRG], D, D, (bf16*)(ws + WS_WBG), scr, r, lane, 2 * D, 0); continue; } r -= I_SQ;
        if (r < I_SQ) { p0_transpose_item(a.in[I_WBRR], D, D, (bf16*)(ws + WS_WBG), scr, r, lane, 2 * D, D); continue; } r -= I_SQ;
        if (r < I_SQ) { p0_transpose_item(a.in[I_WOUT], D, D, (bf16*)(ws + WS_WOUT), scr, r, lane); continue; } r -= I_SQ;
        if (r < I_F1) { p0_transpose_item(a.in[I_WFF1], D, FF, (bf16*)(ws + WS_WFF1), scr, r, lane); continue; } r -= I_F1;
        p0_transpose_item(a.in[I_WFF2], FF, D, (bf16*)(ws + WS_WFF2), scr, r, lane);
    }
    {
        const bool few = gridDim.x > 192;
        if (few && blockIdx.x < 192) return;
        const int gt = few ? ((int)blockIdx.x - 192) * NTHR + wave * 64 + lane : gw * 64 + lane, NGT = few ? ((int)gridDim.x - 192) * NTHR : NGW * 64;
        bf16* WG = (bf16*)(ws + WS_WG);
        for (int it = gt; it < 16 * 16 * 2 * 64; it += NGT) {
            const int ln = it & 63, ks = (it >> 6) & 1, cbi = (it >> 7) & 15, h = it >> 11;
            const int fr = ln & 15, fq = ln >> 4, type = cbi >> 3, d = (cbi >> 2) & 1, cb = cbi & 3;
            const float* W = type ? a.in[I_WRI] : a.in[I_WRA];
            const float* src = W + ((size_t)(d * 16 + h) * 64 + ks * 32 + fq * 8) * 64 + cb * 16 + fr;
            v4u o; o.x = pk2(-LOG2E * src[0], -LOG2E * src[64]); o.y = pk2(-LOG2E * src[128], -LOG2E * src[192]);
            o.z = pk2(-LOG2E * src[256], -LOG2E * src[320]); o.w = pk2(-LOG2E * src[384], -LOG2E * src[448]);
            *(v4u*)(WG + (size_t)it * 8) = o;
        }
        bf16* WSP = (bf16*)(ws + WS_WSP); const float* wsp = a.in[I_WSP];
        for (int it = gt; it < 8 * 128 * 128 / 8; it += NGT) {
            const f32x4 x0 = *(const f32x4*)(wsp + (size_t)it * 8), x1 = *(const f32x4*)(wsp + (size_t)it * 8 + 4);
            v4u o; o.x = pk2(x0[0], x0[1]); o.y = pk2(x0[2], x0[3]); o.z = pk2(x1[0], x1[1]); o.w = pk2(x1[2], x1[3]);
            *(v4u*)(WSP + (size_t)it * 8) = o;
        }
        float* GC = (float*)(ws + WS_GC);
        for (int it = gt; it < 2048; it += NGT) {
            const float lamv = a.in[I_LAM][it]; const float sp = log1pf(expf(-lamv));
            f32x4 o; o[0] = exp2f(-LOG2E * a.in[I_BRA][it]); o[1] = exp2f(-LOG2E * a.in[I_BRI][it]); o[2] = -8.f * sp * LOG2E; o[3] = 0.f;
            *(f32x4*)(GC + (size_t)it * 4) = o;
        }
    }
}

__device__ __forceinline__ f32x4 modv(const float* MOD, const float* bada, int cv, int part, int c) {
    return *(const f32x4*)(MOD + cv * INC + part * D + c) + *(const f32x4*)(bada + part * D + c);
}
__device__ __forceinline__ int cv_of(int m) { return m < MCTX ? 0 : (m < MCTX + 4096 ? 1 : 2); }
__device__ __forceinline__ const float* xrow_of(const Args& a, int m) { return m < MCTX ? a.in[I_XP] + (size_t)m * D : a.in[I_XS] + (size_t)(m - MCTX) * D; }
__device__ __forceinline__ void store_bf4(bf16* p, f32x4 v) { v2u o; o.x = pk2(v[0], v[1]); o.y = pk2(v[2], v[3]); *(v2u*)p = o; }

__device__ __forceinline__ void phase_norm1(const Args& a, int gw, int NGW, int lane) {
    const float* MOD = (const float*)(a.ws + CTL_MOD); const float* bada = a.in[I_BADA]; const float* g = a.in[I_GPREMIX];
    bf16* H = (bf16*)(a.ws + WS_H);
    const int RPW = M / NGW;
    if (RPW * NGW == M && (MCTX % RPW) == 0 && (4096 % RPW) == 0) {
        const int m0 = gw * RPW, cv = cv_of(m0);
        f32x4 cc[4], sh[4];
#pragma unroll
        for (int j = 0; j < 4; ++j) { const int c = 4 * lane + 256 * j; cc[j] = *(const f32x4*)(g + c) * (modv(MOD, bada, cv, 1, c) + 1.f); sh[j] = modv(MOD, bada, cv, 0, c); }
        for (int m = m0; m < m0 + RPW; ++m) {
            const float* xr = xrow_of(a, m);
            f32x4 v[4]; float s = 0.f;
#pragma unroll
            for (int j = 0; j < 4; ++j) { v[j] = *(const f32x4*)(xr + 4 * lane + 256 * j); s += (v[j][0] * v[j][0] + v[j][1] * v[j][1]) + (v[j][2] * v[j][2] + v[j][3] * v[j][3]); }
            const float rstd = rsqrtf(wave_sum(s) * (1.f / D) + EPS);
#pragma unroll
            for (int j = 0; j < 4; ++j) store_bf4(H + (size_t)m * D + 4 * lane + 256 * j, v[j] * rstd * cc[j] + sh[j]);
        }
        return;
    }
    for (int m = gw; m < M; m += NGW) {
        const float* xr = xrow_of(a, m); const int cv = cv_of(m);
        f32x4 v[4]; float s = 0.f;
#pragma unroll
        for (int j = 0; j < 4; ++j) { v[j] = *(const f32x4*)(xr + 4 * lane + 256 * j); s += (v[j][0] * v[j][0] + v[j][1] * v[j][1]) + (v[j][2] * v[j][2] + v[j][3] * v[j][3]); }
        const float rstd = rsqrtf(wave_sum(s) * (1.f / D) + EPS);
#pragma unroll
        for (int j = 0; j < 4; ++j) { const int c = 4 * lane + 256 * j;
            const f32x4 gg = *(const f32x4*)(g + c), sh = modv(MOD, bada, cv, 0, c), sc = modv(MOD, bada, cv, 1, c);
            store_bf4(H + (size_t)m * D + c, v[j] * rstd * gg * (sc + 1.f) + sh); }
    }
}
__device__ __forceinline__ void phase_mid(const Args& a, int gw, int NGW, int lane, float* xout, bf16* H) {
    const float* MOD = (const float*)(a.ws + CTL_MOD); const float* bada = a.in[I_BADA];
    const float* gpm = a.in[I_GPOSTMIX]; const float* gpl = a.in[I_GPREMLP]; const float* OSS = (const float*)(a.ws + CTL_OSS);
    const float* out = a.out;
    for (int m = gw; m < M; m += NGW) {
        const float* xr = xrow_of(a, m); const int cv = cv_of(m);
        const float rstd_o = rsqrtf(OSS[m] * (1.f / D) + EPS);
        f32x4 v[4]; float s = 0.f;
#pragma unroll
        for (int j = 0; j < 4; ++j) { const int c = 4 * lane + 256 * j;
            const f32x4 o = *(const f32x4*)(out + (size_t)m * D + c), x = *(const f32x4*)(xr + c);
            const f32x4 g1 = modv(MOD, bada, cv, 2, c), gg = *(const f32x4*)(gpm + c);
            v[j] = x + g1 * (o * rstd_o * gg);
            *(f32x4*)(xout + (size_t)m * D + c) = v[j];
            s += (v[j][0] * v[j][0] + v[j][1] * v[j][1]) + (v[j][2] * v[j][2] + v[j][3] * v[j][3]); }
        const float rstd = rsqrtf(wave_sum(s) * (1.f / D) + EPS);
#pragma unroll
        for (int j = 0; j < 4; ++j) { const int c = 4 * lane + 256 * j;
            const f32x4 gg = *(const f32x4*)(gpl + c), sh = modv(MOD, bada, cv, 3, c), sc = modv(MOD, bada, cv, 4, c);
            store_bf4(H + (size_t)m * D + c, v[j] * rstd * gg * (sc + 1.f) + sh); }
    }
}
__device__ __forceinline__ void phase_final(const Args& a, int gw, int NGW, int lane, float* yout) {
    const float* MOD = (const float*)(a.ws + CTL_MOD); const float* bada = a.in[I_BADA];
    const float* gpm = a.in[I_GPOSTMLP]; const float* FSS = (const float*)(a.ws + CTL_FSS); const float* F = (const float*)(a.ws + WS_F); const float* out = a.out;
    for (int m = gw; m < M; m += NGW) {
        const int cv = cv_of(m); const float rstd_f = rsqrtf(FSS[m] * (1.f / D) + EPS);
#pragma unroll
        for (int j = 0; j < 4; ++j) { const int c = 4 * lane + 256 * j;
            const f32x4 f = *(const f32x4*)(F + (size_t)m * D + c), x1 = *(const f32x4*)(out + (size_t)m * D + c);
            const f32x4 g2 = modv(MOD, bada, cv, 5, c), gg = *(const f32x4*)(gpm + c);
            *(f32x4*)(yout + (size_t)m * D + c) = x1 + g2 * (f * rstd_f * gg); }
    }
}

__device__ __forceinline__ void panel_sync(unsigned* cnt) {
    asm volatile("s_waitcnt vmcnt(0)" ::: "memory");
    __syncthreads();
    if (threadIdx.x == 0) {
        __hip_atomic_fetch_add(cnt, 1u, __ATOMIC_RELAXED, __HIP_MEMORY_SCOPE_AGENT);
        unsigned sp = 0;
        while (__hip_atomic_load(cnt, __ATOMIC_RELAXED, __HIP_MEMORY_SCOPE_AGENT) < 4u) { __builtin_amdgcn_s_sleep(1); if (++sp > (1u << 22)) break; }
    }
    __syncthreads();
}
__device__ __forceinline__ float ld_agent(const float* p) { return __builtin_bit_cast(float, __hip_atomic_load((const unsigned*)p, __ATOMIC_RELAXED, __HIP_MEMORY_SCOPE_AGENT)); }
__device__ __forceinline__ float sumsq4(f32x4 v) { return (v[0] * v[0] + v[1] * v[1]) + (v[2] * v[2] + v[3] * v[3]); }
template <int MODE> struct EpiFused {
    static constexpr bool PERM = true, AFTER_DRAIN = true, HOOK = false;
    float* out; const float* xp; const float* xs; bf16* H; float* SS1; float* SS2; unsigned* cnt1; unsigned* cnt2;
    const float* MOD; const float* bada; const float* gpost; const float* gpre;
    __device__ __forceinline__ void fused(f32x4 (&acc)[2][2][4][2], const pg8::Unit& u, int wr, int wc, int fr, int fq, LAS unsigned char*, int, int) const {
        const int row0 = u.pm * 256 + wr * 64 + fr, col0 = u.pn * 256 + wc * 32 + 8 * fq;
        const int cv = u.pm < 32 ? 0 : (u.pm < 48 ? 1 : 2);
#pragma unroll
        for (int ai = 0; ai < 2; ++ai)
#pragma unroll
            for (int m = 0; m < 4; ++m) {
                float ss = (sumsq4(acc[ai][0][m][0]) + sumsq4(acc[ai][0][m][1])) + (sumsq4(acc[ai][1][m][0]) + sumsq4(acc[ai][1][m][1]));
                ss += __shfl_xor(ss, 16); ss += __shfl_xor(ss, 32);
                if (fq == 0) atomicAdd(SS1 + row0 + ai * 128 + m * 16, ss);
            }
        panel_sync(cnt1 + 64 * u.pm);
        f32x4 ga[2][2];
#pragma unroll
        for (int bj = 0; bj < 2; ++bj)
#pragma unroll
            for (int n = 0; n < 2; ++n) { const int c = col0 + bj * 128 + 4 * n; ga[bj][n] = modv(MOD, bada, cv, MODE == 6 ? 2 : 5, c) * *(const f32x4*)(gpost + c); }
        float rs1[2][4];
#pragma unroll
        for (int ai = 0; ai < 2; ++ai)
#pragma unroll
            for (int m = 0; m < 4; ++m) rs1[ai][m] = ld_agent(SS1 + row0 + ai * 128 + m * 16);
#pragma unroll
        for (int ai = 0; ai < 2; ++ai)
#pragma unroll
            for (int m = 0; m < 4; ++m) {
                const int row = row0 + ai * 128 + m * 16;
                const float rstd = rsqrtf(rs1[ai][m] * (1.f / D) + EPS);
                const float* xrow = MODE == 6 ? (row < MCTX ? xp + (size_t)row * D : xs + (size_t)(row - MCTX) * D) : out + (size_t)row * D;
                float ss = 0.f;
#pragma unroll
                for (int bj = 0; bj < 2; ++bj)
#pragma unroll
                    for (int n = 0; n < 2; ++n) { const int c = col0 + bj * 128 + 4 * n;
                        const f32x4 v = *(const f32x4*)(xrow + c) + ga[bj][n] * (acc[ai][bj][m][n] * rstd);
                        *(f32x4*)(out + (size_t)row * D + c) = v; acc[ai][bj][m][n] = v; ss += sumsq4(v); }
                if constexpr (MODE == 6) { ss += __shfl_xor(ss, 16); ss += __shfl_xor(ss, 32); if (fq == 0) atomicAdd(SS2 + row, ss); }
            }
        if constexpr (MODE == 6) {
            panel_sync(cnt2 + 64 * u.pm);
            f32x4 cc[2][2], sh[2][2];
#pragma unroll
            for (int bj = 0; bj < 2; ++bj)
#pragma unroll
                for (int n = 0; n < 2; ++n) { const int c = col0 + bj * 128 + 4 * n; cc[bj][n] = *(const f32x4*)(gpre + c) * (modv(MOD, bada, cv, 4, c) + 1.f); sh[bj][n] = modv(MOD, bada, cv, 3, c); }
            float rs2[2][4];
#pragma unroll
            for (int ai = 0; ai < 2; ++ai)
#pragma unroll
                for (int m = 0; m < 4; ++m) rs2[ai][m] = ld_agent(SS2 + row0 + ai * 128 + m * 16);
#pragma unroll
            for (int ai = 0; ai < 2; ++ai)
#pragma unroll
                for (int m = 0; m < 4; ++m) {
                    const int row = row0 + ai * 128 + m * 16;
                    const float rstd = rsqrtf(rs2[ai][m] * (1.f / D) + EPS);
#pragma unroll
                    for (int bj = 0; bj < 2; ++bj) {
                        const f32x4 h0 = acc[ai][bj][m][0] * rstd * cc[bj][0] + sh[bj][0], h1 = acc[ai][bj][m][1] * rstd * cc[bj][1] + sh[bj][1];
                        v4u w; w.x = pg8::cvt_pk_bf16(h0[0], h0[1]); w.y = pg8::cvt_pk_bf16(h0[2], h0[3]); w.z = pg8::cvt_pk_bf16(h1[0], h1[1]); w.w = pg8::cvt_pk_bf16(h1[2], h1[3]);
                        *(v4u*)(H + (size_t)row * D + col0 + bj * 128) = w; }
                }
        }
    }
};

constexpr int YLD = 2048;
constexpr int SG_W = 0, SG_V = 34816, SG_U = 69632, SG_ST = 272;
__device__ __forceinline__ void sgu_load(const bf16* GV, const bf16* GU, const float* VSS, int item, int tid, v4u (&rv)[4], v4u (&ru)[4], float (&rss)[4]) {
    const int g = item & 7, t0 = (item >> 3) * 128;
#pragma unroll
    for (int i = 0; i < 4; ++i) { const int idx = tid + i * NTHR, p = idx >> 4, c8 = (idx & 15) * 8;
        rv[i] = *(const v4u*)(GV + (size_t)(t0 + p) * D + g * 128 + c8); ru[i] = *(const v4u*)(GU + (size_t)(t0 + p) * YLD + g * 128 + c8); rss[i] = VSS[t0 + p]; }
}
__device__ __forceinline__ void phase_sgu(const Args& a, LAS unsigned char* lds, int tid, int wave, int lane, bf16* YG) {
    const bf16* GV = (const bf16*)a.out; const bf16* GU = (const bf16*)(a.ws + WS_GU); const bf16* WSP = (const bf16*)(a.ws + WS_WSP);
    const float* VSS = (const float*)(a.ws + CTL_VSS); const float* gsgu = a.in[I_GSGU]; const float* bsp = a.in[I_BSP];
    const int fr = lane & 15, fq = lane >> 4;
    int last_g = -1;
    v4u rv[4], ru[4]; float rss[4];
    for (int item = blockIdx.x; item < 128 * 8; item += gridDim.x) {
        const int g = item & 7, n = item >> 3, t0 = n * 128;
        if (g != last_g) {
#pragma unroll
            for (int i = 0; i < 4; ++i) { const int idx = tid + i * NTHR, row = idx >> 4, c16 = idx & 15;
                *(LAS v4u*)(lds + SG_W + row * SG_ST + c16 * 16) = *(const v4u*)(WSP + (size_t)(g * 128 + row) * 128 + c16 * 8); }
            last_g = g;
        }
        if (item == (int)blockIdx.x) sgu_load(GV, GU, VSS, item, tid, rv, ru, rss);
#pragma unroll
        for (int i = 0; i < 4; ++i) {
            const int idx = tid + i * NTHR, p = idx >> 4, c8 = (idx & 15) * 8;
            const v4u r = rv[i]; const v4u uu = ru[i];
            const float rs = rsqrtf(rss[i] * (1.f / D) + EPS);
            const f32x4 g0 = *(const f32x4*)(gsgu + g * 128 + c8) * rs, g1 = *(const f32x4*)(gsgu + g * 128 + c8 + 4) * rs;
            v4u o; o.x = pk2(bflo(r.x) * g0[0], bfhi(r.x) * g0[1]); o.y = pk2(bflo(r.y) * g0[2], bfhi(r.y) * g0[3]);
            o.z = pk2(bflo(r.z) * g1[0], bfhi(r.z) * g1[1]); o.w = pk2(bflo(r.w) * g1[2], bfhi(r.w) * g1[3]);
            *(LAS v4u*)(lds + SG_V + p * SG_ST + c8 * 2) = o;
            *(LAS v4u*)(lds + SG_U + p * SG_ST + c8 * 2) = uu;
        }
        if (item + (int)gridDim.x < 128 * 8) sgu_load(GV, GU, VSS, item + gridDim.x, tid, rv, ru, rss);
        float bias8[8];
#pragma unroll
        for (int qb = 0; qb < 8; ++qb) bias8[qb] = bsp[g * 128 + qb * 16 + fr];
        __syncthreads();
        bf16x8 af[4];
#pragma unroll
        for (int ks = 0; ks < 4; ++ks) {
            unsigned short e[8];
#pragma unroll
            for (int j = 0; j < 8; ++j) e[j] = *(const LAS unsigned short*)(lds + SG_V + (ks * 32 + fq * 8 + j) * SG_ST + (wave * 16 + fr) * 2);
            v4u o; o.x = e[0] | ((unsigned)e[1] << 16); o.y = e[2] | ((unsigned)e[3] << 16); o.z = e[4] | ((unsigned)e[5] << 16); o.w = e[6] | ((unsigned)e[7] << 16);
            af[ks] = __builtin_bit_cast(bf16x8, o);
        }
#pragma unroll
        for (int qb = 0; qb < 8; ++qb) {
            const int q = qb * 16 + fr;
            f32x4 acc = {0.f, 0.f, 0.f, 0.f};
#pragma unroll
            for (int ks = 0; ks < 4; ++ks) { const bf16x8 b = *(const LAS bf16x8*)(lds + SG_W + q * SG_ST + (ks * 32 + fq * 8) * 2);
                acc = __builtin_amdgcn_mfma_f32_16x16x32_bf16(af[ks], b, acc, 0, 0, 0); }
            const float bias = bias8[qb];
            LAS v2u* up = (LAS v2u*)(lds + SG_U + q * SG_ST + (wave * 16 + fq * 4) * 2);
            const v2u gu = *up;
            v2u y; y.x = pk2(bflo(gu.x) * (acc[0] + bias), bfhi(gu.x) * (acc[1] + bias)); y.y = pk2(bflo(gu.y) * (acc[2] + bias), bfhi(gu.y) * (acc[3] + bias));
            *up = y;
        }
        __syncthreads();
#pragma unroll
        for (int i = 0; i < 4; ++i) { const int idx = tid + i * NTHR, p = idx >> 4, c8 = (idx & 15) * 8;
            *(v4u*)(YG + (size_t)(t0 + p) * YLD + g * 128 + c8) = *(const LAS v4u*)(lds + SG_U + p * SG_ST + c8 * 2); }
        __syncthreads();
    }
}

constexpr int RG_WB = 0, RG_XA = 32768, RG_XF = 51200, RG_AGL = 86016, RG_GCL = 94208, RG_CWL = 96256, RG_CARL = 97536;
__device__ __forceinline__ void rg_load_raw(const bf16* XR, int item, int tid, v4u (&xr)[2][4]) {
    const int h = item & 15, t0 = (item >> 4) * 128;
    const int seq_lo = t0 < MCTX ? (t0 & ~255) : MCTX + ((t0 - MCTX) & ~4095), seq_hi = seq_lo + (t0 < MCTX ? 256 : 4096);
#pragma unroll
    for (int i = 0; i < 2; ++i) {
        const int idx = tid + i * NTHR, tk = idx >> 3, chb = h * 64 + (idx & 7) * 8;
#pragma unroll
        for (int tap = 0; tap < 4; ++tap) {
            const int t = t0 + tk + tap - 2; const bool ok = (t >= seq_lo) && (t < seq_hi); const int tc = ok ? t : t0;
            xr[i][tap] = *(const v4u*)(XR + (size_t)tc * D + chb);
        }
    }
}
template <int MODE> __device__ __forceinline__ int rg_item(int k) {
    const int h = blockIdx.x & 15, q = blockIdx.x >> 4;
    int tt;
    if (MODE == 1) tt = k < 4 ? 2 * (q + 16 * (k >> 1)) + (k & 1) : 64 + q + 16 * (k - 4);
    else tt = k < 2 ? 2 * (q + 16 * k) + 1 : 64 + q + 16 * (k - 2);
    return tt * 16 + h;
}
template <int MODE>
__device__ __forceinline__ void phase_rg(const Args& a, LAS unsigned char* lds, int tid, int wave, int lane, bf16* YR) {
    const bf16* XR = (const bf16*)((const unsigned char*)a.out + 32 * MiB); const bf16* GGR = (const bf16*)(a.ws + WS_GU) + D;
    const float* GC = (const float*)(a.ws + WS_GC); const bf16* WG = (const bf16*)(a.ws + WS_WG);
    f32x2* AGG = (f32x2*)(a.ws + WS_AGG); const float* CAR = (const float*)(a.ws + WS_CAR); float* nstate = a.out + (size_t)M * D;
    const float* convw = a.in[I_CONVW]; const float* convb = a.in[I_CONVB];
    const int fr = lane & 15, fq = lane >> 4;
    int last_h = -1;
    v4u xr[2][4];
    constexpr int NK = MODE == 1 ? 8 : 6;
    rg_load_raw(XR, rg_item<MODE>(0), tid, xr);
    if constexpr (MODE == 1) {
        const float* st0 = a.in[I_STATE];
#pragma unroll 1
        for (int kk = tid >> 7; kk < 8; kk += 4) {
            const int it = rg_item<1>(kk);
            {
                const int d = (tid >> 6) & 1, cl = tid & 63, h = it & 15, tt = it >> 4;
                float hc;
                if (tt < 64) {
                    const f32x2 g = AGG[((size_t)((tt | 1) * 16 + h) * 2 + 1) * 64 + cl];
                    hc = ((tt & 1) == 0 && d == 1) ? g[1] : 0.f;
                } else {
                    const int b = (tt - 64) >> 5, j = (tt - 64) & 31, tt0 = 64 + b * 32;
                    f32x2 ag[31];
#pragma unroll
                    for (int sI = 0; sI < 31; ++sI) { const int ti = d ? 31 - sI : sI; ag[sI] = AGG[((size_t)((tt0 + ti) * 16 + h) * 2 + d) * 64 + cl]; }
                    hc = st0[(size_t)b * 2048 + d * 1024 + h * 64 + cl];
#pragma unroll
                    for (int sI = 0; sI < 31; ++sI) { const int ti = d ? 31 - sI : sI; if (d ? (ti > j) : (ti < j)) hc = ag[sI][0] * hc + ag[sI][1]; }
                }
                *(LAS float*)(lds + RG_CARL + ((kk * 2 + d) * 64 + cl) * 4) = hc;
            }
        }
        __syncthreads();
    }
    for (int kitem = 0; kitem < NK; ++kitem) {
        const int item = rg_item<MODE>(kitem);
        const int h = item & 15, tt = item >> 4, t0 = tt * 128;
        if (h != last_h) {
#pragma unroll
            for (int i = 0; i < 4; ++i) { const int o = (tid + i * NTHR) * 16; *(LAS v4u*)(lds + RG_WB + o) = *(const v4u*)((const unsigned char*)WG + (size_t)h * 32768 + o); }
            if (tid < 128) *(LAS f32x4*)(lds + RG_GCL + tid * 16) = *(const f32x4*)(GC + (size_t)((tid >> 6) * D + h * 64 + (tid & 63)) * 4);
            if (tid < 80) { const int row = tid >> 4, c4 = (tid & 15) * 4;
                *(LAS f32x4*)(lds + RG_CWL + (row * 64 + c4) * 4) = *(const f32x4*)((row < 4 ? convw + row * D : convb) + h * 64 + c4); }
            last_h = h;
            __syncthreads();
        }
        const int seq_lo = t0 < MCTX ? (t0 & ~255) : MCTX + ((t0 - MCTX) & ~4095), seq_hi = seq_lo + (t0 < MCTX ? 256 : 4096);
        float car[2][4]; v4u ggr[2];
        if constexpr (MODE == 1) {
#pragma unroll
            for (int d = 0; d < 2; ++d)
#pragma unroll
                for (int cb = 0; cb < 4; ++cb) car[d][cb] = *(const LAS float*)(lds + RG_CARL + ((kitem * 2 + d) * 64 + cb * 16 + fr) * 4);
#pragma unroll
            for (int i = 0; i < 2; ++i) { const int idx = tid + i * NTHR; ggr[i] = *(const v4u*)(GGR + (size_t)(t0 + (idx >> 3)) * YLD + h * 64 + (idx & 7) * 8); }
        }
        {
            const int c8 = (tid & 7) * 8;
            f32x4 w0[4], w1[4];
#pragma unroll
            for (int tap = 0; tap < 4; ++tap) { w0[tap] = *(const LAS f32x4*)(lds + RG_CWL + (tap * 64 + c8) * 4); w1[tap] = *(const LAS f32x4*)(lds + RG_CWL + (tap * 64 + c8 + 4) * 4); }
            const f32x4 b0 = *(const LAS f32x4*)(lds + RG_CWL + (4 * 64 + c8) * 4), b1 = *(const LAS f32x4*)(lds + RG_CWL + (4 * 64 + c8 + 4) * 4);
#pragma unroll
            for (int i = 0; i < 2; ++i) {
                const int idx = tid + i * NTHR, tk = idx >> 3, cg8 = idx & 7;
                f32x4 x0 = b0, x1 = b1;
#pragma unroll
                for (int tap = 0; tap < 4; ++tap) { const int t = t0 + tk + tap - 2; const bool ok = (t >= seq_lo) && (t < seq_hi);
                    v4u r = xr[i][tap]; r.x = ok ? r.x : 0u; r.y = ok ? r.y : 0u; r.z = ok ? r.z : 0u; r.w = ok ? r.w : 0u;
                    x0[0] += w0[tap][0] * bflo(r.x); x0[1] += w0[tap][1] * bfhi(r.x); x0[2] += w0[tap][2] * bflo(r.y); x0[3] += w0[tap][3] * bfhi(r.y);
                    x1[0] += w1[tap][0] * bflo(r.z); x1[1] += w1[tap][1] * bfhi(r.z); x1[2] += w1[tap][2] * bflo(r.w); x1[3] += w1[tap][3] * bfhi(r.w); }
                v4u o; o.x = pk2(x0[0], x0[1]); o.y = pk2(x0[2], x0[3]); o.z = pk2(x1[0], x1[1]); o.w = pk2(x1[2], x1[3]);
                *(LAS v4u*)(lds + RG_XA + tk * 144 + cg8 * 16) = o;
                *(LAS f32x4*)(lds + RG_XF + (tk * 68 + cg8 * 8) * 4) = x0; *(LAS f32x4*)(lds + RG_XF + (tk * 68 + cg8 * 8 + 4) * 4) = x1;
            }
        }
        if (kitem + 1 < NK) rg_load_raw(XR, rg_item<MODE>(kitem + 1), tid, xr);
        __syncthreads();
        const int tokb = wave * 16;
        bf16x8 afr[2];
#pragma unroll
        for (int ks = 0; ks < 2; ++ks) afr[ks] = *(const LAS bf16x8*)(lds + RG_XA + (tokb + fr) * 144 + (ks * 32 + fq * 8) * 2);
        f32x4 gcv[2][4];
#pragma unroll
        for (int d = 0; d < 2; ++d)
#pragma unroll
            for (int cb = 0; cb < 4; ++cb) gcv[d][cb] = *(const LAS f32x4*)(lds + RG_GCL + (d * 64 + cb * 16 + fr) * 16);
        float av[2][4][4], bv[2][4][4], Ap[2][4], Hp[2][4];
        const bool ctx = t0 < MCTX;
#pragma unroll
        for (int d = 0; d < 2; ++d) {
            if (MODE == 0 && ctx && d != (tt & 1)) continue;
#pragma unroll
            for (int cb = 0; cb < 4; ++cb) {
                const f32x4 gc = gcv[d][cb];
                f32x4 ar = {0.f, 0.f, 0.f, 0.f}, ai = {0.f, 0.f, 0.f, 0.f};
#pragma unroll
                for (int ks = 0; ks < 2; ++ks) {
                    const bf16x8 b0 = *(const LAS bf16x8*)(lds + RG_WB + (((0 * 8 + d * 4 + cb) * 2 + ks) * 64 + lane) * 16);
                    const bf16x8 b1 = *(const LAS bf16x8*)(lds + RG_WB + (((1 * 8 + d * 4 + cb) * 2 + ks) * 64 + lane) * 16);
                    ar = __builtin_amdgcn_mfma_f32_16x16x32_bf16(afr[ks], b0, ar, 0, 0, 0);
                    ai = __builtin_amdgcn_mfma_f32_16x16x32_bf16(afr[ks], b1, ai, 0, 0, 0);
                }
#pragma unroll
                for (int r = 0; r < 4; ++r) {
                    const float xcv = *(const LAS float*)(lds + RG_XF + ((tokb + fq * 4 + r) * 68 + cb * 16 + fr) * 4);
                    const float rr = __builtin_amdgcn_rcpf(__builtin_fmaf(__builtin_amdgcn_exp2f(ar[r]), gc[0], 1.f)), ii = __builtin_amdgcn_rcpf(__builtin_fmaf(__builtin_amdgcn_exp2f(ai[r]), gc[1], 1.f));
                    const float aa = __builtin_amdgcn_exp2f(rr * gc[2]);
                    const float om = fmaxf(1.f - aa * aa, 1e-12f);
                    av[d][cb][r] = aa; bv[d][cb][r] = __builtin_amdgcn_sqrtf(om) * ii * xcv;
                }
                float A = 1.f, Hh = 0.f;
#pragma unroll
                for (int rr = 0; rr < 4; ++rr) { const int r = d ? 3 - rr : rr; Hh = av[d][cb][r] * Hh + bv[d][cb][r]; A *= av[d][cb][r]; }
                float Aw = 1.f, Hw = 0.f, Apl = 1.f, Hpl = 0.f;
#pragma unroll
                for (int gg = 0; gg < 4; ++gg) { const int g = d ? 3 - gg : gg;
                    const float Ag = __shfl(A, g * 16 + fr), Hg = __shfl(Hh, g * 16 + fr);
                    if (g == fq) { Apl = Aw; Hpl = Hw; }
                    Hw = Ag * Hw + Hg; Aw *= Ag; }
                Ap[d][cb] = Apl; Hp[d][cb] = Hpl;
                if (fq == 0) *(LAS f32x2*)(lds + RG_AGL + ((wave * 2 + d) * 64 + cb * 16 + fr) * 8) = (f32x2){Aw, Hw};
            }
        }
        __syncthreads();
        if constexpr (MODE == 0) {
            if (tid < 128 && !(ctx && (tid >> 6) != (tt & 1))) {
                const int d = tid >> 6, cl = tid & 63; float A = 1.f, Hh = 0.f;
#pragma unroll
                for (int ww = 0; ww < 8; ++ww) { const int w2 = d ? 7 - ww : ww; const f32x2 sg = *(const LAS f32x2*)(lds + RG_AGL + ((w2 * 2 + d) * 64 + cl) * 8); Hh = sg[0] * Hh + sg[1]; A *= sg[0]; }
                AGG[((size_t)(tt * 16 + h) * 2 + d) * 64 + cl] = (f32x2){A, Hh};
            }
        } else {
            if (ctx && (tt & 1) == 0 && tid < 64) {
                float Hh = 0.f;
#pragma unroll
                for (int w2 = 0; w2 < 8; ++w2) { const f32x2 sg = *(const LAS f32x2*)(lds + RG_AGL + ((w2 * 2 + 0) * 64 + tid) * 8); Hh = sg[0] * Hh + sg[1]; }
                *(LAS float*)(lds + RG_CARL + (((kitem + 1) * 2 + 0) * 64 + tid) * 4) = Hh;
            }
            float hs[4][4];
#pragma unroll
            for (int cb = 0; cb < 4; ++cb)
#pragma unroll
                for (int r = 0; r < 4; ++r) hs[cb][r] = 0.f;
#pragma unroll
            for (int d = 0; d < 2; ++d)
#pragma unroll
                for (int cb = 0; cb < 4; ++cb) {
                    const int cl = cb * 16 + fr;
                    float hin = car[d][cb];
                    f32x2 sg[8];
#pragma unroll
                    for (int w2 = 0; w2 < 8; ++w2) sg[w2] = *(const LAS f32x2*)(lds + RG_AGL + ((w2 * 2 + d) * 64 + cl) * 8);
#pragma unroll
                    for (int ww = 0; ww < 8; ++ww) { const int w2 = d ? 7 - ww : ww; if (d ? (w2 > wave) : (w2 < wave)) hin = sg[w2][0] * hin + sg[w2][1]; }
                    float hh = Ap[d][cb] * hin + Hp[d][cb];
#pragma unroll
                    for (int rr = 0; rr < 4; ++rr) { const int r = d ? 3 - rr : rr; hh = av[d][cb][r] * hh + bv[d][cb][r]; hs[cb][r] += hh; }
                    if (ctx && (tt & 1) == (d ? 0 : 1) && wave == (d ? 0 : 7) && fq == (d ? 0 : 3)) nstate[(size_t)(tt >> 1) * 2048 + d * 1024 + h * 64 + cl] = hh;
                }
#pragma unroll
            for (int cb = 0; cb < 4; ++cb)
#pragma unroll
                for (int r = 0; r < 4; ++r) *(LAS float*)(lds + RG_XF + ((tokb + fq * 4 + r) * 68 + cb * 16 + fr) * 4) = hs[cb][r];
            __syncthreads();
#pragma unroll
            for (int i = 0; i < 2; ++i) {
                const int idx = tid + i * NTHR, tk = idx >> 3, cg8 = idx & 7;
                const f32x4 y0 = *(const LAS f32x4*)(lds + RG_XF + (tk * 68 + cg8 * 8) * 4), y1 = *(const LAS f32x4*)(lds + RG_XF + (tk * 68 + cg8 * 8 + 4) * 4);
                const v4u g = ggr[i];
                v4u o; o.x = pk2(y0[0] * bflo(g.x), y0[1] * bfhi(g.x)); o.y = pk2(y0[2] * bflo(g.y), y0[3] * bfhi(g.y));
                o.z = pk2(y1[0] * bflo(g.z), y1[1] * bfhi(g.z)); o.w = pk2(y1[2] * bflo(g.w), y1[3] * bfhi(g.w));
                *(v4u*)(YR + (size_t)(t0 + tk) * YLD + h * 64 + cg8 * 8) = o;
            }
        }
        __syncthreads();
    }
}

template <int NT>
__device__ __forceinline__ float carry_chain(const f32x2* AGG, float* CAR, int tt0, int h, int d, int cl, float h0) {
    f32x2 ag[NT];
#pragma unroll
    for (int i = 0; i < NT; ++i) ag[i] = AGG[((size_t)((tt0 + i) * 16 + h) * 2 + d) * 64 + cl];
    float hc = h0;
#pragma unroll
    for (int ii = 0; ii < NT; ++ii) { const int i = d ? NT - 1 - ii : ii;
        CAR[((size_t)((tt0 + i) * 16 + h) * 2 + d) * 64 + cl] = hc; hc = ag[i][0] * hc + ag[i][1]; }
    return hc;
}
__device__ __forceinline__ void phase_carry(const Args& a, int gw, int NGW, int lane) {
    const f32x2* AGG = (const f32x2*)(a.ws + WS_AGG); float* CAR = (float*)(a.ws + WS_CAR);
    for (int wi = gw; wi < 34 * 2 * 16; wi += NGW) {
        const int s = wi >> 5, d = (wi >> 4) & 1, h = wi & 15, ch = h * 64 + lane;
        if (s < 32) {
            const size_t i0 = ((size_t)((2 * s) * 16 + h) * 2 + d) * 64 + lane, i1 = ((size_t)((2 * s + 1) * 16 + h) * 2 + d) * 64 + lane;
            if (d == 0) { CAR[i0] = 0.f; CAR[i1] = AGG[i0][1]; }
            else { CAR[i1] = 0.f; CAR[i0] = AGG[i1][1]; }
        } else {
            const int b = s - 32; const float h0 = a.in[I_STATE][(size_t)b * 2048 + d * 1024 + ch];
            if (d == 0) (void)carry_chain<32>(AGG, CAR, 64 + b * 32, h, 0, lane, h0);
            else (void)carry_chain<32>(AGG, CAR, 64 + b * 32, h, 1, lane, h0);
        }
    }
}

#define RLX_AGENT __ATOMIC_RELAXED, __HIP_MEMORY_SCOPE_AGENT
#define XB_TMO      128
#define XB_XCNT(j)  (256  + 64 * (j))
#define XB_XSUB(j)  (1280 + 64 * (j))
#define XB_XGEN(j)  (2304 + 64 * (j))
#define XB_TOP      3328
#define XB_TOPGEN   3392
#define XCD_BAR_WORDS 3456
#define XB_SPIN_CAP (1u << 18)

__device__ __forceinline__ unsigned xb_ld(unsigned* p)              { return __hip_atomic_load(p, __ATOMIC_RELAXED, __HIP_MEMORY_SCOPE_AGENT); }
__device__ __forceinline__ unsigned xb_add(unsigned* p, unsigned v) { return __hip_atomic_fetch_add(p, v, __ATOMIC_RELAXED, __HIP_MEMORY_SCOPE_AGENT); }
__device__ __forceinline__ unsigned xb_xcc_id() { return (unsigned)__builtin_amdgcn_s_getreg((3 << 11) | 20) & 0xFu; }
#define XB_SPIN(cond, bar) do { unsigned _sp = 0; while (cond) { __builtin_amdgcn_s_sleep(1); \
    if ((++_sp & 255u) == 0u) { if (xb_ld(&(bar)[XB_TMO])) break; if (_sp > XB_SPIN_CAP) { atomicAdd(&(bar)[XB_TMO], 1u); break; } } } } while (0)

struct XcdBarrier {
    unsigned* bar; unsigned x;
    volatile LAS unsigned* st;
};

__device__ __forceinline__ XcdBarrier xcd_barrier_post(unsigned* bar, volatile LAS unsigned* st) {
    XcdBarrier b; b.bar = bar; b.x = xb_xcc_id(); b.st = st;
    if (threadIdx.x == 0) (void)xb_add(&bar[XB_XCNT(b.x)], 1u);
    return b;
}
__device__ __forceinline__ void xcd_barrier_complete(unsigned* bar, unsigned x, unsigned& nloc, unsigned& nx) {
    const unsigned G = gridDim.x * gridDim.y * gridDim.z;
    unsigned sum, cnt, mine, sp = 0u;
    for (;;) {
        sum = 0u; cnt = 0u; mine = 0u;
#pragma unroll
        for (unsigned j = 0; j < 16; ++j) { const unsigned c = xb_ld(&bar[XB_XCNT(j)]); sum += c; cnt += (c > 0u) ? 1u : 0u; mine = (j == x) ? c : mine; }
        if (sum == G) break;
        __builtin_amdgcn_s_sleep(1);
        if ((++sp & 255u) == 0u) { if (xb_ld(&bar[XB_TMO])) break; if (sp > XB_SPIN_CAP) { atomicAdd(&bar[XB_TMO], 1u); break; } }
    }
    nloc = mine > 0u ? mine : 1u; nx = cnt > 0u ? cnt : 1u;
}

__device__ __forceinline__ void xcd_barrier(const XcdBarrier& b) {
    asm volatile("s_waitcnt vmcnt(0)" ::: "memory");
    __syncthreads();
    if (threadIdx.x == 0) {
        unsigned* bar = b.bar;
        __builtin_amdgcn_s_waitcnt(0);
        unsigned nloc = b.st[0], nx = b.st[1];
        if (nloc == 0u) { xcd_barrier_complete(bar, b.x, nloc, nx); b.st[0] = nloc; b.st[1] = nx; }
        const unsigned old = xb_add(&bar[XB_XSUB(b.x)], 1u);
        const unsigned gen = old / nloc;
        if (old + 1u == (gen + 1u) * nloc) {
            __builtin_amdgcn_fence(__ATOMIC_RELEASE, "agent");
            asm volatile("s_waitcnt vmcnt(0)" ::: "memory");
            const unsigned og = xb_add(&bar[XB_TOP], 1u);
            const unsigned tg = og / nx;
            if (og + 1u == (tg + 1u) * nx) xb_add(&bar[XB_TOPGEN], 1u);
            else XB_SPIN(xb_ld(&bar[XB_TOPGEN]) == tg, bar);
            __builtin_amdgcn_fence(__ATOMIC_ACQUIRE, "agent");
            xb_add(&bar[XB_XGEN(b.x)], 1u);
            asm volatile("s_waitcnt vmcnt(0)" ::: "memory");
        } else {
            XB_SPIN(xb_ld(&bar[XB_XGEN(b.x)]) == gen, bar);
            __builtin_amdgcn_fence(__ATOMIC_ACQUIRE, "agent");
            asm volatile("s_waitcnt vmcnt(0)" ::: "memory");
        }
    }
    __syncthreads();
}

__global__ void __launch_bounds__(NTHR, 2) fwd_megakernel(Args a) {
    extern __shared__ __attribute__((aligned(16))) unsigned char lds_raw[];
    LAS unsigned char* lds = (LAS unsigned char*)lds_raw;
    const int tid = threadIdx.x, lane = tid & 63, wave = __builtin_amdgcn_readfirstlane(tid >> 6);
    const int G = gridDim.x, gw = blockIdx.x * NWAVES + wave, NGW = G * NWAVES;
    unsigned char* ws = a.ws;
    const int lo = a.ph_lo, hi = a.ph_hi;
    volatile LAS unsigned* bst = (volatile LAS unsigned*)(lds + LDS_BAR_OFF);
    if (tid < 2) bst[tid] = 0u;
    __syncthreads();
    XcdBarrier bar = xcd_barrier_post((unsigned*)(ws + WS_CTL), bst);
#define IN(k) (lo <= (k) && (k) < hi)
#define SEAM(k) do { if (IN(k) && IN((k) + 1)) { xcd_barrier(bar); if (DUP >> 12 & 1) xcd_barrier(bar); } } while (0)
    float* const DUMSS = (float*)(ws + 1 * MiB + 512 * 1024);
#define REP(k) for (int rep_ = ((DUP >> (k)) & 1); rep_ >= 0; --rep_)
#define ISDUP (rep_ > 0)
    if (IN(0)) REP(0) phase_prep(a, lds, gw, NGW, wave, lane, ISDUP ? (float*)(ws + 1 * MiB + 256 * 1024) : (float*)(ws + CTL_MOD));
    SEAM(0);
    if (IN(1)) REP(1) phase_norm1(a, gw, NGW, lane);
    SEAM(1);
    if (IN(2)) REP(2) {
        pg8::Gemm g{(const pg8::bf16_t*)(ws + WS_H), (const pg8::bf16_t*)(ws + WS_WIN), M, INC, D}; pg8::StaticOrder S; S.init(M, INC, G, (int)blockIdx.x, WG_IN);
        pg8::Epi<1> E{nullptr, nullptr, nullptr, ISDUP ? DUMSS : (float*)(ws + CTL_VSS), D, (bf16*)(ws + WS_GU), (bf16*)a.out, (bf16*)((unsigned char*)a.out + 32 * MiB), (bf16*)(ws + WS_GU) + D, (bf16*)(ws + WS_SGA), (bf16*)(ws + WS_SGB)};
        pg8::gemm_phase<pg8::Epi<1>, pg8::StaticOrder, true, true>(lds, g, S, E);
    }
    SEAM(2);
    if (IN(3)) REP(3) { phase_rg<0>(a, lds, tid, wave, lane, nullptr); phase_sgu(a, lds, tid, wave, lane, ISDUP ? (bf16*)(ws + WS_F) : (bf16*)(ws + WS_GU)); }
    SEAM(3);
    if (IN(5)) REP(5) phase_rg<1>(a, lds, tid, wave, lane, ISDUP ? (bf16*)(ws + WS_F) + D : (bf16*)(ws + WS_GU) + D);
    SEAM(5);
    if (IN(6)) REP(6) {
        pg8::Gemm g{(const pg8::bf16_t*)(ws + WS_GU), (const pg8::bf16_t*)(ws + WS_WBG), M, D, 2 * D}; pg8::StaticOrder S; S.init(M, D, G, (int)blockIdx.x);
        pg8::EpiMerge E{(bf16*)(ws + WS_H), (const bf16*)(ws + WS_SGA), (const bf16*)(ws + WS_SGB)};
        pg8::gemm_phase<pg8::EpiMerge, pg8::StaticOrder, false, true>(lds, g, S, E);
    }
    SEAM(6);
    if (IN(7)) {
        pg8::Gemm g{(const pg8::bf16_t*)(ws + WS_H), (const pg8::bf16_t*)(ws + WS_WOUT), M, D, D}; pg8::StaticOrder S; S.init(M, D, G, (int)blockIdx.x);
        EpiFused<6> E{a.out, a.in[I_XP], a.in[I_XS], (bf16*)(ws + WS_H), (float*)(ws + CTL_OSS), (float*)(ws + CTL_XSS), (unsigned*)(ws + CTL_CNT), (unsigned*)(ws + CTL_CNT + 16384),
                      (const float*)(ws + CTL_MOD), a.in[I_BADA], a.in[I_GPOSTMIX], a.in[I_GPREMLP]};
        pg8::gemm_phase<EpiFused<6>, pg8::StaticOrder, false, true>(lds, g, S, E);
    }
    SEAM(7);
    if (IN(8)) REP(8) {
        pg8::Gemm g{(const pg8::bf16_t*)(ws + WS_H), (const pg8::bf16_t*)(ws + WS_WFF1), M, FF, D}; pg8::StaticOrder S; S.init(M, FF, G, (int)blockIdx.x, WG_FF1);
        pg8::Epi<5> E{(bf16*)(ws + WS_F1), nullptr, nullptr, nullptr, FF, nullptr, nullptr, nullptr, nullptr, nullptr, nullptr};
        pg8::gemm_phase<pg8::Epi<5>, pg8::StaticOrder, true, true>(lds, g, S, E);
    }
    SEAM(8);
    if (IN(9)) {
        pg8::Gemm g{(const pg8::bf16_t*)(ws + WS_F1), (const pg8::bf16_t*)(ws + WS_WFF2), M, D, FF}; pg8::StaticOrder S; S.init(M, D, G, (int)blockIdx.x);
        EpiFused<7> E{a.out, nullptr, nullptr, nullptr, (float*)(ws + CTL_FSS), nullptr, (unsigned*)(ws + CTL_CNT + 32768), nullptr,
                      (const float*)(ws + CTL_MOD), a.in[I_BADA], a.in[I_GPOSTMLP], nullptr};
        pg8::gemm_phase<EpiFused<7>, pg8::StaticOrder, false, true>(lds, g, S, E);
    }
#undef IN
#undef SEAM
}

constexpr int N_PHASES = 10;
extern "C" void kernel_launch(void* const* d_in, const int* in_sizes, int n_in, void* d_out, int out_size, void* d_ws, size_t ws_size, hipStream_t stream) {
    static int grid = 0;
    if (grid == 0) {
        if (n_in != 27 || ws_size < WS_END) { fprintf(stderr, "kernel_launch: need 27 inputs and >= %zu B of workspace; got %d, %zu\n", (size_t)WS_END, n_in, ws_size); grid = -1; return; }
        int dev = 0, cus = 0, per_cu = 0;
        if (hipGetDevice(&dev) != hipSuccess || hipDeviceGetAttribute(&cus, hipDeviceAttributeMultiprocessorCount, dev) != hipSuccess) { grid = -1; return; }
        if (hipFuncSetAttribute((const void*)fwd_megakernel, hipFuncAttributeMaxDynamicSharedMemorySize, LDS_BYTES) != hipSuccess) { fprintf(stderr, "kernel_launch: hipFuncSetAttribute failed\n"); grid = -1; return; }
        if (hipOccupancyMaxActiveBlocksPerMultiprocessor(&per_cu, (const void*)fwd_megakernel, NTHR, LDS_BYTES) != hipSuccess || per_cu < 1) { fprintf(stderr, "kernel_launch: occupancy query says %d\n", per_cu); per_cu = 1; }
        (void)hipGetLastError();
        grid = cus * per_cu;
        if (grid < 256) { fprintf(stderr, "kernel_launch: this kernel's work split needs 256 co-resident workgroups; the device offers %d\n", grid); grid = -1; return; }
        grid = 256;
    }
    if (grid < 0) return;
    (void)hipMemsetAsync((char*)d_ws + WS_CTL, 0, CTL_ZERO_BYTES, stream);
    Args a{};
    for (int i = 0; i < 27; ++i) a.in[i] = (const float*)d_in[i];
    a.out = (float*)d_out; a.ws = (unsigned char*)d_ws; a.ph_lo = 0; a.ph_hi = N_PHASES;
    void* args[] = {&a};
    hipError_t e = hipLaunchCooperativeKernel((const void*)fwd_megakernel, dim3(grid), dim3(NTHR), args, LDS_BYTES, stream);
    if (e != hipSuccess) fprintf(stderr, "kernel_launch: cooperative launch failed: %s (grid %d)\n", hipGetErrorString(e), grid);
}
```

```cpp
#include <hip/hip_runtime.h>
#include <hip/hip_cooperative_groups.h>
#include <cstdio>
#include <cstdint>
namespace cg = cooperative_groups;
namespace pg8 {
#define PG8_LAS __attribute__((address_space(3)))
typedef unsigned short bf16_t;
typedef short bf16x8 __attribute__((ext_vector_type(8)));
typedef float f32x4 __attribute__((ext_vector_type(4)));
typedef unsigned u32x4 __attribute__((ext_vector_type(4)));
constexpr int BM = 256, BK = 64, HALF = 128, HTB = HALF * BK * 2  , STAGE_BYTES = 8 * HTB, NXCD = 8, WGM = 8;

__host__ __device__ __forceinline__ int lds_byte(int r, int c) { const int st = (r >> 4) * 2 + (c >> 5), rr = r & 15, cc = c & 31, ob = rr * 64 + cc * 2; return st * 1024 + (ob ^ (((ob >> 9) & 1) << 5)); }
__host__ __device__ __forceinline__ void stage_rc(int b, int& R, int& C) { const int st = b / 1024, sb = b % 1024, swz = sb ^ (((sb >> 9) & 1) << 5); R = (st >> 1) * 16 + swz / 64; C = (st & 1) * 32 + (swz % 64) / 2; }
__host__ __device__ __forceinline__ int perm32(int rho) { const int n = rho >> 4, i = rho & 15; return 8 * (i >> 2) + 4 * n + (i & 3); }

struct Unit { int pm, pn; };
struct Gemm { const bf16_t* A; const bf16_t* Bt; int M, N, K; };

struct StaticOrder {
    int nM, nN, nwg, G, c, wgm;
    __host__ __device__ void init(int M, int N, int G_, int c_, int wgm_ = 8) { nM = M / BM; nN = N / BM; nwg = nM * nN; G = G_; c = c_; wgm = wgm_; }
    __host__ __device__ bool next(int i, Unit& u) const {
        const long L = (long)i * G + c; if (L >= nwg) return false;
        int wgid = (int)L; { const int q = nwg / NXCD, r = nwg % NXCD, xcd = wgid % NXCD, off = wgid / NXCD; wgid = (xcd < r ? xcd * (q + 1) : r * (q + 1) + (xcd - r) * q) + off; }
        const int nig = wgm * nN, gid = wgid / nig, fm = gid * wgm, gsz = (nM - fm) < wgm ? (nM - fm) : wgm;
        u.pm = fm + ((wgid % nig) % gsz); u.pn = (wgid % nig) / gsz; return true;
    }
    __device__ __forceinline__ void a_ready(const Unit&) const {}
    __device__ __forceinline__ void done(const Unit&) const {}
};

typedef __bf16 bf16x2_cvt __attribute__((ext_vector_type(2)));
typedef float f32x2_cvt __attribute__((ext_vector_type(2)));
__device__ __forceinline__ unsigned cvt_pk_bf16(float lo, float hi) { const f32x2_cvt v = {lo, hi}; const bf16x2_cvt b = __builtin_convertvector(v, bf16x2_cvt); return __builtin_bit_cast(unsigned, b); }
__device__ __forceinline__ float sigmoid_f(float x) { return __builtin_amdgcn_rcpf(1.f + __builtin_amdgcn_exp2f(-1.4426950409f * x)); }
__device__ __forceinline__ float gelu_tanh_f(float x) { const float u = x * (-2.3022081985f - 0.10294324f * (x * x)); return x * __builtin_amdgcn_rcpf(1.f + __builtin_amdgcn_exp2f(u)); }
__device__ __forceinline__ float bflo(unsigned w) { return __builtin_bit_cast(float, w << 16); }
__device__ __forceinline__ float bfhi(unsigned w) { return __builtin_bit_cast(float, w & 0xffff0000u); }
template <int MODE> struct Epi {
    static constexpr bool PERM = true, AFTER_DRAIN = false, HOOK = false;
    bf16_t* Ob; float* Of; const bf16_t* G; float* SS; int ldc;
    bf16_t *s0, *s1, *s2, *s3, *s4, *s5;
    template <int ACT> __device__ __forceinline__ void act_store(const f32x4 (&acc)[2][2][4][2], bf16_t* base, int ld, int row0, int col0, int fq) const {
#pragma unroll
        for (int ai = 0; ai < 2; ++ai)
#pragma unroll
            for (int m = 0; m < 4; ++m) {
                const int row = row0 + ai * HALF + m * 16; bf16_t* rowp = base + (size_t)row * ld + col0; float ss = 0.f;
#pragma unroll
                for (int bj = 0; bj < 2; ++bj) {
                    f32x4 v0 = acc[ai][bj][m][0], v1 = acc[ai][bj][m][1];
                    if constexpr (ACT == 2) {
#pragma unroll
                        for (int j = 0; j < 4; ++j) { v0[j] = sigmoid_f(v0[j]); v1[j] = sigmoid_f(v1[j]); }
                    } else if constexpr (ACT == 1 || ACT == 3) {
#pragma unroll
                        for (int j = 0; j < 4; ++j) { v0[j] = gelu_tanh_f(v0[j]); v1[j] = gelu_tanh_f(v1[j]); }
                    }
                    if constexpr (ACT == 3) {
#pragma unroll
                        for (int j = 0; j < 4; ++j) ss += v0[j] * v0[j] + v1[j] * v1[j];
                    }
                    u32x4 w; w.x = cvt_pk_bf16(v0[0], v0[1]); w.y = cvt_pk_bf16(v0[2], v0[3]); w.z = cvt_pk_bf16(v1[0], v1[1]); w.w = cvt_pk_bf16(v1[2], v1[3]);
                    *(u32x4*)(rowp + bj * HALF) = w;
                }
                if constexpr (ACT == 3) { ss += __shfl_xor(ss, 16); ss += __shfl_xor(ss, 32); if (fq == 0) atomicAdd(SS + row, ss); }
            }
    }
    __device__ __forceinline__ void operator()(const f32x4 (&acc)[2][2][4][2], const Unit& u, int wr, int wc, int fr, int fq) const {
        const int row0 = u.pm * BM + wr * 64 + fr;
        if constexpr (MODE == 1) {
            const int t = u.pn >> 2;
            bf16_t* base = t == 0 ? s0 : t == 1 ? s1 : t == 2 ? s2 : t == 3 ? s3 : t == 4 ? s4 : s5;
            const int ld = (t == 0 || t == 3) ? 2048 : 1024;
            const int col0 = (u.pn & 3) * BM + wc * 32 + 8 * fq;
            if (t >= 4) act_store<2>(acc, base, ld, row0, col0, fq);
            else if (t == 2) act_store<0>(acc, base, ld, row0, col0, fq);
            else if (t == 1) act_store<3>(acc, base, ld, row0, col0, fq);
            else act_store<1>(acc, base, ld, row0, col0, fq);
        } else {
            const int col0 = u.pn * BM + wc * 32 + 8 * fq;
#pragma unroll
            for (int ai = 0; ai < 2; ++ai)
#pragma unroll
                for (int m = 0; m < 4; ++m) {
                    const int row = row0 + ai * HALF + m * 16; float ss = 0.f;
#pragma unroll
                    for (int bj = 0; bj < 2; ++bj) {
                        f32x4 v0 = acc[ai][bj][m][0], v1 = acc[ai][bj][m][1];
                        const size_t off = (size_t)row * ldc + col0 + bj * HALF;
                        if constexpr (MODE == 2 || MODE == 3) {
                            const u32x4 g = *(const u32x4*)(G + off);
                            v0[0] *= bflo(g.x); v0[1] *= bfhi(g.x); v0[2] *= bflo(g.y); v0[3] *= bfhi(g.y);
                            v1[0] *= bflo(g.z); v1[1] *= bfhi(g.z); v1[2] *= bflo(g.w); v1[3] *= bfhi(g.w);
                        }
                        if constexpr (MODE == 3) { v0 = v0 + *(const f32x4*)(Of + off); v1 = v1 + *(const f32x4*)(Of + off + 4); }
                        if constexpr (MODE == 5) {
#pragma unroll
                            for (int j = 0; j < 4; ++j) { const float a = fmaxf(v0[j], 0.f), b = fmaxf(v1[j], 0.f); v0[j] = a * a; v1[j] = b * b; }
                        }
                        if constexpr (MODE == 4) {
#pragma unroll
                            for (int j = 0; j < 4; ++j) ss += v0[j] * v0[j] + v1[j] * v1[j];
                        }
                        if constexpr (MODE == 2 || MODE == 4) { *(f32x4*)(Of + off) = v0; *(f32x4*)(Of + off + 4) = v1; }
                        else { u32x4 w; w.x = cvt_pk_bf16(v0[0], v0[1]); w.y = cvt_pk_bf16(v0[2], v0[3]); w.z = cvt_pk_bf16(v1[0], v1[1]); w.w = cvt_pk_bf16(v1[2], v1[3]);
                            *(u32x4*)(Ob + off) = w; }
                    }
                    if constexpr (MODE == 4) { ss += __shfl_xor(ss, 16); ss += __shfl_xor(ss, 32); if (fq == 0) atomicAdd(SS + row, ss); }
                }
        }
    }
};

struct EpiMerge {
    static constexpr bool PERM = true, AFTER_DRAIN = false, HOOK = true;
    bf16_t* Ob; const bf16_t* GA; const bf16_t* GB;
    __device__ __forceinline__ void mid(f32x4 (&acc)[2][2][4][2], const Unit& u, int wr, int wc, int fr, int fq) const {
        int row0 = u.pm * BM + wr * 64 + fr, col0 = u.pn * BM + wc * 32 + 8 * fq;
        asm volatile("" : "+v"(row0), "+v"(col0));
#pragma unroll
        for (int ai = 0; ai < 2; ++ai)
#pragma unroll
            for (int m = 0; m < 4; ++m) {
                if ((m & 1) == 0) asm volatile("" ::: "memory");
#pragma unroll
                for (int bj = 0; bj < 2; ++bj) {
                    const size_t off = (size_t)(row0 + ai * HALF + m * 16) * 1024 + col0 + bj * HALF;
                    const u32x4 a = *(const u32x4*)(GA + off), b = *(const u32x4*)(GB + off);
                    f32x4 r0, r1;
                    r0[0] = bflo(a.x) * __builtin_amdgcn_rcpf(fmaxf(bflo(b.x), 1e-30f)); r0[1] = bfhi(a.x) * __builtin_amdgcn_rcpf(fmaxf(bfhi(b.x), 1e-30f));
                    r0[2] = bflo(a.y) * __builtin_amdgcn_rcpf(fmaxf(bflo(b.y), 1e-30f)); r0[3] = bfhi(a.y) * __builtin_amdgcn_rcpf(fmaxf(bfhi(b.y), 1e-30f));
                    r1[0] = bflo(a.z) * __builtin_amdgcn_rcpf(fmaxf(bflo(b.z), 1e-30f)); r1[1] = bfhi(a.z) * __builtin_amdgcn_rcpf(fmaxf(bfhi(b.z), 1e-30f));
                    r1[2] = bflo(a.w) * __builtin_amdgcn_rcpf(fmaxf(bflo(b.w), 1e-30f)); r1[3] = bfhi(a.w) * __builtin_amdgcn_rcpf(fmaxf(bfhi(b.w), 1e-30f));
                    acc[ai][bj][m][0] = acc[ai][bj][m][0] * r0; acc[ai][bj][m][1] = acc[ai][bj][m][1] * r1;
                }
            }
    }
    __device__ __forceinline__ void operator()(const f32x4 (&acc)[2][2][4][2], const Unit& u, int wr, int wc, int fr, int fq) const {
        const int row0 = u.pm * BM + wr * 64 + fr, col0 = u.pn * BM + wc * 32 + 8 * fq;
#pragma unroll
        for (int ai = 0; ai < 2; ++ai)
#pragma unroll
            for (int m = 0; m < 4; ++m)
#pragma unroll
                for (int bj = 0; bj < 2; ++bj) {
                    const size_t off = (size_t)(row0 + ai * HALF + m * 16) * 1024 + col0 + bj * HALF;
                    const u32x4 b = *(const u32x4*)(GB + off);
                    const f32x4 v0 = acc[ai][bj][m][0], v1 = acc[ai][bj][m][1];
                    u32x4 w; w.x = cvt_pk_bf16(v0[0] * bflo(b.x), v0[1] * bfhi(b.x)); w.y = cvt_pk_bf16(v0[2] * bflo(b.y), v0[3] * bfhi(b.y));
                    w.z = cvt_pk_bf16(v1[0] * bflo(b.z), v1[1] * bfhi(b.z)); w.w = cvt_pk_bf16(v1[2] * bflo(b.w), v1[3] * bfhi(b.w));
                    *(u32x4*)(Ob + off) = w;
                }
    }
};

template <class Epi, class Sched, bool ALIGN_EPI = false, bool SP2 = false>
__device__ __forceinline__ void gemm_phase(PG8_LAS unsigned char* lds, const Gemm g, const Sched& S, const Epi& E) {
    const int tid = threadIdx.x, wid = __builtin_amdgcn_readfirstlane(tid >> 6), lane = tid & 63, wr = wid >> 2, wc = wid & 3, fr = lane & 15, fq = lane >> 4;
    const int K = g.K, nt = K / BK;
    unsigned voffA[2], voffB[2];
#pragma unroll
    for (int i = 0; i < 2; ++i) { int R, C; stage_rc(tid * 16 + i * 8192, R, C); const int Rb = Epi::PERM ? ((R & ~31) + perm32(R & 31)) : R;
        voffA[i] = (unsigned)(R * K + C) * 2u; voffB[i] = (unsigned)(Rb * K + C) * 2u; }
    const size_t kstep = (size_t)(BK * 2);
    const size_t hstep = (size_t)HALF * K * 2;
    const size_t tstep = 2 * hstep;
    const unsigned ldsw = (unsigned)wid * 1024u;
    const int aoff = lds_byte(wr * 64 + fr, fq * 8), boff = lds_byte(wc * 32 + fr, fq * 8);
#define PG8_SA(b, h) (((b) * 2 + (h)) * HTB)
#define PG8_SB(b, h) ((4 + (b) * 2 + (h)) * HTB)
#define PG8_STAGE(bufoff, gbase, voff) do { _Pragma("unroll") for (int _i = 0; _i < 2; ++_i) \
        __builtin_amdgcn_global_load_lds((const unsigned*)((const char*)(gbase) + (voff)[_i]), (PG8_LAS unsigned*)(lds + (bufoff) + ldsw + _i * 8192), 16, 0, 0); } while (0)
#define PG8_LDA(dst, b, h) do { _Pragma("unroll") for (int m = 0; m < 4; ++m) _Pragma("unroll") for (int k = 0; k < 2; ++k) dst[m][k] = *(const PG8_LAS bf16x8*)(lds + PG8_SA(b, h) + aoff + m * 2048 + k * 1024); } while (0)
#define PG8_LDB(dst, b, h) do { _Pragma("unroll") for (int n = 0; n < 2; ++n) _Pragma("unroll") for (int k = 0; k < 2; ++k) dst[n][k] = *(const PG8_LAS bf16x8*)(lds + PG8_SB(b, h) + boff + n * 2048 + k * 1024); } while (0)
#define PG8_MMA(ai, bj, At, Bt) do { __builtin_amdgcn_s_setprio(1); _Pragma("unroll") for (int m = 0; m < 4; ++m) _Pragma("unroll") for (int n = 0; n < 2; ++n) _Pragma("unroll") for (int k = 0; k < 2; ++k) \
        acc[ai][bj][m][n] = __builtin_amdgcn_mfma_f32_16x16x32_bf16(Bt[n][k], At[m][k], acc[ai][bj][m][n], 0, 0, 0); __builtin_amdgcn_s_setprio(0); } while (0)
#define PG8_WAIT_V(n) asm volatile("s_waitcnt vmcnt(" #n ")" ::: "memory")
#define PG8_WAIT_L(n) asm volatile("s_waitcnt lgkmcnt(" #n ")" ::: "memory")
#define PG8_BAR __builtin_amdgcn_s_barrier()
#define PG8_SCHED __builtin_amdgcn_sched_barrier(0)
    Unit cur, nxt; int ui = 0;
    if (!S.next(0, cur)) return;
    f32x4 acc[2][2][4][2];
#pragma unroll
    for (int a = 0; a < 2; ++a)
#pragma unroll
        for (int b = 0; b < 2; ++b)
#pragma unroll
            for (int m = 0; m < 4; ++m)
#pragma unroll
                for (int n = 0; n < 2; ++n) acc[a][b][m][n] = (f32x4){0.f, 0.f, 0.f, 0.f};
    bf16x8 At[4][2], B0[2][2], B1[2][2];
    const char* cA = (const char*)g.A + (size_t)cur.pm * tstep; const char* cB = (const char*)g.Bt + (size_t)cur.pn * tstep;
    S.a_ready(cur);
    if constexpr (SP2) {
        PG8_STAGE(PG8_SB(0, 0), cB, voffB); PG8_STAGE(PG8_SB(0, 1), cB + hstep, voffB); PG8_STAGE(PG8_SA(0, 0), cA, voffA); PG8_STAGE(PG8_SA(0, 1), cA + hstep, voffA);
        if (wr == 1) PG8_BAR;
        PG8_WAIT_V(2); PG8_BAR;
        PG8_STAGE(PG8_SB(1, 0), cB + kstep, voffB); PG8_STAGE(PG8_SA(1, 0), cA + kstep, voffA); PG8_STAGE(PG8_SB(1, 1), cB + hstep + kstep, voffB);
        PG8_WAIT_V(6); PG8_BAR;
    } else {
        PG8_STAGE(PG8_SB(0, 0), cB, voffB); PG8_STAGE(PG8_SA(0, 0), cA, voffA); PG8_STAGE(PG8_SB(0, 1), cB + hstep, voffB); PG8_STAGE(PG8_SA(0, 1), cA + hstep, voffA);
        if (wr == 1) PG8_BAR;
        PG8_WAIT_V(4); PG8_BAR;
        PG8_STAGE(PG8_SB(1, 0), cB + kstep, voffB); PG8_STAGE(PG8_SA(1, 0), cA + kstep, voffA); PG8_STAGE(PG8_SB(1, 1), cB + hstep + kstep, voffB);
        PG8_WAIT_V(6); PG8_BAR;
    }
    for (;;) {
        const bool has_next = S.next(ui + 1, nxt);
        const char* nA = has_next ? (const char*)g.A + (size_t)nxt.pm * tstep : cA; const char* nB = has_next ? (const char*)g.Bt + (size_t)nxt.pn * tstep : cB;
        for (int t = 0; t < nt; t += 2) {
            if constexpr (Epi::HOOK) { if (t == (nt >> 1)) E.mid(acc, cur, wr, wc, fr, fq); }
            const bool last = (t == nt - 2);
            const char* a1 = cA + (size_t)(t + 1) * kstep;
            const char* a2 = last ? nA : cA + (size_t)(t + 2) * kstep; const char* b2 = last ? nB : cB + (size_t)(t + 2) * kstep;
            const char* a3 = a2 + kstep; const char* b3 = b2 + kstep;
            if (last && has_next) S.a_ready(nxt);
            if constexpr (SP2) {
            PG8_LDB(B0, 0, 0); PG8_LDB(B1, 0, 1); PG8_SCHED; PG8_LDA(At, 0, 0); PG8_STAGE(PG8_SA(1, 1), a1 + hstep, voffA);
            PG8_WAIT_V(8); PG8_WAIT_L(0); PG8_BAR; PG8_MMA(0, 0, At, B0); PG8_MMA(0, 1, At, B1); PG8_BAR; PG8_SCHED;
            PG8_LDA(At, 0, 1); PG8_STAGE(PG8_SB(0, 0), b2, voffB); PG8_STAGE(PG8_SB(0, 1), b2 + hstep, voffB); PG8_STAGE(PG8_SA(0, 0), a2, voffA);
            PG8_WAIT_V(8); PG8_WAIT_L(0); PG8_BAR; PG8_MMA(1, 0, At, B0); PG8_MMA(1, 1, At, B1); PG8_BAR; PG8_SCHED;
            PG8_LDB(B0, 1, 0); PG8_LDB(B1, 1, 1); PG8_SCHED; PG8_LDA(At, 1, 0); PG8_STAGE(PG8_SA(0, 1), a2 + hstep, voffA);
            PG8_WAIT_V(8); PG8_WAIT_L(0); PG8_BAR; PG8_MMA(0, 0, At, B0); PG8_MMA(0, 1, At, B1); PG8_BAR; PG8_SCHED;
            PG8_LDA(At, 1, 1); PG8_STAGE(PG8_SB(1, 0), b3, voffB); PG8_STAGE(PG8_SB(1, 1), b3 + hstep, voffB); PG8_STAGE(PG8_SA(1, 0), a3, voffA);
            PG8_WAIT_V(8); PG8_WAIT_L(0); PG8_BAR; PG8_MMA(1, 0, At, B0); PG8_MMA(1, 1, At, B1); PG8_BAR; PG8_SCHED;
            } else {
            PG8_LDB(B0, 0, 0); PG8_SCHED; PG8_LDA(At, 0, 0); PG8_STAGE(PG8_SA(1, 1), a1 + hstep, voffA);
            PG8_WAIT_L(8); PG8_BAR; PG8_WAIT_L(0); PG8_MMA(0, 0, At, B0); PG8_BAR; PG8_SCHED;
            PG8_LDB(B1, 0, 1); PG8_STAGE(PG8_SB(0, 0), b2, voffB);
            PG8_BAR; PG8_WAIT_L(0); PG8_MMA(0, 1, At, B1); PG8_BAR;
            PG8_LDA(At, 0, 1); PG8_STAGE(PG8_SA(0, 0), a2, voffA);
            PG8_BAR; PG8_WAIT_L(0); PG8_MMA(1, 0, At, B0); PG8_BAR; PG8_SCHED;
            PG8_STAGE(PG8_SB(0, 1), b2 + hstep, voffB);
            PG8_WAIT_V(6); PG8_BAR; PG8_MMA(1, 1, At, B1); PG8_BAR;
            PG8_LDB(B0, 1, 0); PG8_SCHED; PG8_LDA(At, 1, 0); PG8_STAGE(PG8_SA(0, 1), a2 + hstep, voffA);
            PG8_WAIT_L(8); PG8_BAR; PG8_WAIT_L(0); PG8_MMA(0, 0, At, B0); PG8_BAR; PG8_SCHED;
            PG8_LDB(B1, 1, 1); PG8_STAGE(PG8_SB(1, 0), b3, voffB);
            PG8_BAR; PG8_WAIT_L(0); PG8_MMA(0, 1, At, B1); PG8_BAR;
            PG8_LDA(At, 1, 1); PG8_STAGE(PG8_SA(1, 0), a3, voffA);
            PG8_BAR; PG8_WAIT_L(0); PG8_MMA(1, 0, At, B0); PG8_BAR; PG8_SCHED;
            PG8_STAGE(PG8_SB(1, 1), b3 + hstep, voffB);
            PG8_WAIT_V(6); PG8_BAR; PG8_MMA(1, 1, At, B1); PG8_BAR;
            }
        }
        if constexpr (ALIGN_EPI) { if (wr == 0) PG8_BAR; }
        if constexpr (!Epi::AFTER_DRAIN) { E(acc, cur, wr, wc, fr, fq); S.done(cur); }
        if (!has_next) break;
#pragma unroll
        for (int a = 0; a < 2; ++a)
#pragma unroll
            for (int b = 0; b < 2; ++b)
#pragma unroll
                for (int m = 0; m < 4; ++m)
#pragma unroll
                    for (int n = 0; n < 2; ++n) acc[a][b][m][n] = (f32x4){0.f, 0.f, 0.f, 0.f};
        cur = nxt; cA = nA; cB = nB; ++ui;
        if constexpr (ALIGN_EPI) { if (wr == 1) PG8_BAR; }
    }
    PG8_WAIT_V(0);
    if constexpr (!ALIGN_EPI) { if (wr == 0) PG8_BAR; }
    PG8_BAR;
    if constexpr (Epi::AFTER_DRAIN) { E.fused(acc, cur, wr, wc, fr, fq, lds, wid, lane); S.done(cur); }
#undef PG8_SA
#undef PG8_SB
#undef PG8_STAGE
#undef PG8_LDA
#undef PG8_LDB
#undef PG8_MMA
#undef PG8_WAIT_V
#undef PG8_WAIT_L
#undef PG8_BAR
#undef PG8_SCHED
}
}

constexpr int NWAVES = 8, NTHR = NWAVES * 64;
constexpr int D = 1024, M = 16384, MCTX = 8192, INC = 6144, FF = 4096;
constexpr float EPS = 1e-6f, LOG2E = 1.4426950408889634f;
constexpr size_t MiB = 1u << 20;
constexpr size_t WS_CTL = 0, CTL_ZERO_BYTES = 1 * MiB;
constexpr size_t CTL_VSS = 64 * 1024, CTL_OSS = 128 * 1024, CTL_FSS = 192 * 1024, CTL_MOD = 256 * 1024, CTL_XSS = 384 * 1024;
constexpr size_t CTL_CNT = 16 * 1024;
constexpr size_t WS_GC = 1 * MiB;
constexpr size_t WS_AGG = 2 * MiB;
constexpr size_t WS_CAR = 4 * MiB;
constexpr size_t WS_WG = 5 * MiB;
constexpr size_t WS_WSP = 5 * MiB + 512 * 1024;
constexpr size_t WS_WFF2 = 6 * MiB, WS_WFF1 = 14 * MiB, WS_WIN = 22 * MiB, WS_WBG = 34 * MiB, WS_WBR = 36 * MiB, WS_WOUT = 38 * MiB;
constexpr size_t WS_H = 40 * MiB;
constexpr size_t WS_F = 64 * MiB;
constexpr size_t WS_GU = 128 * MiB, WS_GGR = 160 * MiB, WS_SGA = 192 * MiB, WS_SGB = 224 * MiB;
constexpr size_t WS_F1 = 128 * MiB;
constexpr size_t WS_END = 256 * MiB;
constexpr int LDS_BYTES = 147456, LDS_BAR_OFF = 139264;
#ifndef WG_IN
#define WG_IN 4
#endif
#ifndef WG_FF1
#define WG_FF1 2
#endif
#ifndef DUP
#define DUP 0
#endif

#define GAS __attribute__((address_space(1)))
#define LAS __attribute__((address_space(3)))
typedef unsigned short bf16;
typedef unsigned v4u __attribute__((ext_vector_type(4)));
typedef unsigned v2u __attribute__((ext_vector_type(2)));
typedef float f32x4 __attribute__((ext_vector_type(4)));
typedef float f32x2 __attribute__((ext_vector_type(2)));
typedef short bf16x8 __attribute__((ext_vector_type(8)));
#define LDS_WAIT() asm volatile("s_waitcnt lgkmcnt(0)" ::: "memory")
__device__ __forceinline__ unsigned f2bf(float f) { unsigned u = __builtin_bit_cast(unsigned, f); return (u + 0x7fffu + ((u >> 16) & 1u)) >> 16; }
__device__ __forceinline__ unsigned pk2(float lo, float hi) { return pg8::cvt_pk_bf16(lo, hi); }
__device__ __forceinline__ float bf2f(bf16 b) { return __builtin_bit_cast(float, (unsigned)b << 16); }
using pg8::bflo; using pg8::bfhi;

struct Args { const float* in[27]; float* out; unsigned char* ws; int ph_lo, ph_hi; };
enum { I_XP = 0, I_XS, I_STATE, I_C, I_CCTX, I_WADA, I_BADA, I_GPREMIX, I_GPOSTMIX, I_GPREMLP, I_GPOSTMLP, I_WIN, I_GSGU, I_WSP, I_BSP, I_CONVW, I_CONVB,
       I_WRA, I_BRA, I_WRI, I_BRI, I_LAM, I_WBRG, I_WBRR, I_WOUT, I_WFF1, I_WFF2 };

__device__ __forceinline__ float wave_sum(float v) {
#pragma unroll
    for (int o = 1; o < 64; o <<= 1) v += __shfl_xor(v, o);
    return v;
}
__device__ __forceinline__ void p0_transpose_item(const float* W, int K, int N, bf16* WT, LAS float* scr, int item, int lane, int ldk = 0, int koff = 0) {
    if (ldk == 0) ldk = K;
    const int nblk = N / 32, kb = item / nblk, nb = item % nblk, k0 = 64 * kb, n0 = 32 * nb;
#pragma unroll
    for (int i = 0; i < 8; ++i) { const int kk = 8 * i + (lane >> 3);
        const f32x4 v = *(const f32x4*)(W + (size_t)(k0 + kk) * N + n0 + (lane & 7) * 4);
        LAS float* dd = scr + kk * 33 + (lane & 7) * 4; dd[0] = v[0]; dd[1] = v[1]; dd[2] = v[2]; dd[3] = v[3]; }
    LDS_WAIT(); asm volatile("" ::: "memory");
    const int c = lane & 7;
#pragma unroll
    for (int j = 0; j < 4; ++j) { const int n = (lane >> 3) + 8 * j; const LAS float* s = scr + (8 * c) * 33 + n;
        v4u o; o.x = pk2(s[0 * 33], s[1 * 33]); o.y = pk2(s[2 * 33], s[3 * 33]); o.z = pk2(s[4 * 33], s[5 * 33]); o.w = pk2(s[6 * 33], s[7 * 33]);
        *(v4u*)(WT + (size_t)(n0 + n) * ldk + koff + k0 + 8 * c) = o; }
    LDS_WAIT(); asm volatile("" ::: "memory");
}

__device__ __forceinline__ void phase_prep(const Args& a, LAS unsigned char* lds, int gw, int NGW, int wave, int lane, float* MOD) {
    unsigned char* ws = a.ws;
    LAS float* scr = (LAS float*)(lds + wave * 16384);
    if ((int)blockIdx.x < 192) {
        const float* wada = a.in[I_WADA]; const float* cctx = a.in[I_CCTX]; const float* cc = a.in[I_C];
        const int nb = blockIdx.x % 24, ksl = blockIdx.x / 24, n = nb * 256 + lane * 4, kbase = ksl * 128 + wave * 16;
        f32x4 a0 = {0.f, 0.f, 0.f, 0.f}, a1 = a0, a2 = a0;
#pragma unroll
        for (int kk = 0; kk < 16; ++kk) {
            const int k = kbase + kk;
            const f32x4 w = *(const f32x4*)(wada + (size_t)k * INC + n);
            const float c0 = cctx[k], c1 = cc[k], c2 = cc[D + k];
            const float s0 = c0 * pg8::sigmoid_f(c0), s1 = c1 * pg8::sigmoid_f(c1), s2 = c2 * pg8::sigmoid_f(c2);
            a0 += w * s0; a1 += w * s1; a2 += w * s2;
        }
        LAS float* red = (LAS float*)lds;
        *(LAS f32x4*)(red + (wave * 3 + 0) * 256 + lane * 4) = a0; *(LAS f32x4*)(red + (wave * 3 + 1) * 256 + lane * 4) = a1; *(LAS f32x4*)(red + (wave * 3 + 2) * 256 + lane * 4) = a2;
        __syncthreads();
        const int tid = wave * 64 + lane;
        if (tid < 192) {
            const int v = tid >> 6, c4 = (tid & 63) * 4;
            f32x4 sum = {0.f, 0.f, 0.f, 0.f};
#pragma unroll
            for (int w2 = 0; w2 < 8; ++w2) sum += *(const LAS f32x4*)(red + (w2 * 3 + v) * 256 + c4);
#pragma unroll
            for (int j = 0; j < 4; ++j) atomicAdd(MOD + v * INC + nb * 256 + c4 + j, sum[j]);
        }
        __syncthreads();
    }
    constexpr int I_IN = 16 * (INC / 32), I_SQ = 16 * (D / 32), I_F1 = 16 * (FF / 32), I_F2 = (FF / 64) * (D / 32);
    constexpr int NT = I_IN + 3 * I_SQ + I_F1 + I_F2;
    for (int it = gw; it < NT; it += NGW) {
        int r = it;
        if (r < I_IN) { p0_transpose_item(a.in[I_WIN], D, INC, (bf16*)(ws + WS_WIN), scr, r, lane); continue; } r -= I_IN;
        if (r < I_SQ) { p0_transpose_item(a.in[I_WBRG], D, D, (bf16*)(ws + WS_WBG), scr, r, lane, 2 * D, 0); continue; } r -= I_SQ;
        if (r < I_SQ) { p0_transpose_item(a.in[I_WBRR], D, D, (bf16*)(ws + WS_WBG), scr, r, lane, 2 * D, D); continue; } r -= I_SQ;
        if (r < I_SQ) { p0_transpose_item(a.in[I_WOUT], D, D, (bf16*)(ws + WS_WOUT), scr, r, lane); continue; } r -= I_SQ;
        if (r < I_F1) { p0_transpose_item(a.in[I_WFF1], D, FF, (bf16*)(ws + WS_WFF1), scr, r, lane); continue; } r -= I_F1;
        p0_transpose_item(a.in[I_WFF2], FF, D, (bf16*)(ws + WS_WFF2), scr, r, lane);
    }
    {
        const bool few = gridDim.x > 192;
        if (few && blockIdx.x < 192) return;
        const int gt = few ? ((int)blockIdx.x - 192) * NTHR + wave * 64 + lane : gw * 64 + lane, NGT = few ? ((int)gridDim.x - 192) * NTHR : NGW * 64;
        bf16* WG = (bf16*)(ws + WS_WG);
        for (int it = gt; it < 16 * 16 * 2 * 64; it += NGT) {
            const int ln = it & 63, ks = (it >> 6) & 1, cbi = (it >> 7) & 15, h = it >> 11;
            const int fr = ln & 15, fq = ln >> 4, type = cbi >> 3, d = (cbi >> 2) & 1, cb = cbi & 3;
            const float* W = type ? a.in[I_WRI] : a.in[I_WRA];
            const float* src = W + ((size_t)(d * 16 + h) * 64 + ks * 32 + fq * 8) * 64 + cb * 16 + fr;
            v4u o; o.x = pk2(-LOG2E * src[0], -LOG2E * src[64]); o.y = pk2(-LOG2E * src[128], -LOG2E * src[192]);
            o.z = pk2(-LOG2E * src[256], -LOG2E * src[320]); o.w = pk2(-LOG2E * src[384], -LOG2E * src[448]);
            *(v4u*)(WG + (size_t)it * 8) = o;
        }
        bf16* WSP = (bf16*)(ws + WS_WSP); const float* wsp = a.in[I_WSP];
        for (int it = gt; it < 8 * 128 * 128 / 8; it += NGT) {
            const f32x4 x0 = *(const f32x4*)(wsp + (size_t)it * 8), x1 = *(const f32x4*)(wsp + (size_t)it * 8 + 4);
            v4u o; o.x = pk2(x0[0], x0[1]); o.y = pk2(x0[2], x0[3]); o.z = pk2(x1[0], x1[1]); o.w = pk2(x1[2], x1[3]);
            *(v4u*)(WSP + (size_t)it * 8) = o;
        }
        float* GC = (float*)(ws + WS_GC);
        for (int it = gt; it < 2048; it += NGT) {
            const float lamv = a.in[I_LAM][it]; const float sp = log1pf(expf(-lamv));
            f32x4 o; o[0] = exp2f(-LOG2E * a.in[I_BRA][it]); o[1] = exp2f(-LOG2E * a.in[I_BRI][it]); o[2] = -8.f * sp * LOG2E; o[3] = 0.f;
            *(f32x4*)(GC + (size_t)it * 4) = o;
        }
    }
}

__device__ __forceinline__ f32x4 modv(const float* MOD, const float* bada, int cv, int part, int c) {
    return *(const f32x4*)(MOD + cv * INC + part * D + c) + *(const f32x4*)(bada + part * D + c);
}
__device__ __forceinline__ int cv_of(int m) { return m < MCTX ? 0 : (m < MCTX + 4096 ? 1 : 2); }
__device__ __forceinline__ const float* xrow_of(const Args& a, int m) { return m < MCTX ? a.in[I_XP] + (size_t)m * D : a.in[I_XS] + (size_t)(m - MCTX) * D; }
__device__ __forceinline__ void store_bf4(bf16* p, f32x4 v) { v2u o; o.x = pk2(v[0], v[1]); o.y = pk2(v[2], v[3]); *(v2u*)p = o; }

__device__ __forceinline__ void phase_norm1(const Args& a, int gw, int NGW, int lane) {
    const float* MOD = (const float*)(a.ws + CTL_MOD); const float* bada = a.in[I_BADA]; const float* g = a.in[I_GPREMIX];
    bf16* H = (bf16*)(a.ws + WS_H);
    const int RPW = M / NGW;
    if (RPW * NGW == M && (MCTX % RPW) == 0 && (4096 % RPW) == 0) {
        const int m0 = gw * RPW, cv = cv_of(m0);
        f32x4 cc[4], sh[4];
#pragma unroll
        for (int j = 0; j < 4; ++j) { const int c = 4 * lane + 256 * j; cc[j] = *(const f32x4*)(g + c) * (modv(MOD, bada, cv, 1, c) + 1.f); sh[j] = modv(MOD, bada, cv, 0, c); }
        for (int m = m0; m < m0 + RPW; ++m) {
            const float* xr = xrow_of(a, m);
            f32x4 v[4]; float s = 0.f;
#pragma unroll
            for (int j = 0; j < 4; ++j) { v[j] = *(const f32x4*)(xr + 4 * lane + 256 * j); s += (v[j][0] * v[j][0] + v[j][1] * v[j][1]) + (v[j][2] * v[j][2] + v[j][3] * v[j][3]); }
            const float rstd = rsqrtf(wave_sum(s) * (1.f / D) + EPS);
#pragma unroll
            for (int j = 0; j < 4; ++j) store_bf4(H + (size_t)m * D + 4 * lane + 256 * j, v[j] * rstd * cc[j] + sh[j]);
        }
        return;
    }
    for (int m = gw; m < M; m += NGW) {
        const float* xr = xrow_of(a, m); const int cv = cv_of(m);
        f32x4 v[4]; float s = 0.f;
#pragma unroll
        for (int j = 0; j < 4; ++j) { v[j] = *(const f32x4*)(xr + 4 * lane + 256 * j); s += (v[j][0] * v[j][0] + v[j][1] * v[j][1]) + (v[j][2] * v[j][2] + v[j][3] * v[j][3]); }
        const float rstd = rsqrtf(wave_sum(s) * (1.f / D) + EPS);
#pragma unroll
        for (int j = 0; j < 4; ++j) { const int c = 4 * lane + 256 * j;
            const f32x4 gg = *(const f32x4*)(g + c), sh = modv(MOD, bada, cv, 0, c), sc = modv(MOD, bada, cv, 1, c);
            store_bf4(H + (size_t)m * D + c, v[j] * rstd * gg * (sc + 1.f) + sh); }
    }
}
__device__ __forceinline__ void phase_mid(const Args& a, int gw, int NGW, int lane, float* xout, bf16* H) {
    const float* MOD = (const float*)(a.ws + CTL_MOD); const float* bada = a.in[I_BADA];
    const float* gpm = a.in[I_GPOSTMIX]; const float* gpl = a.in[I_GPREMLP]; const float* OSS = (const float*)(a.ws + CTL_OSS);
    const float* out = a.out;
    for (int m = gw; m < M; m += NGW) {
        const float* xr = xrow_of(a, m); const int cv = cv_of(m);
        const float rstd_o = rsqrtf(OSS[m] * (1.f / D) + EPS);
        f32x4 v[4]; float s = 0.f;
#pragma unroll
        for (int j = 0; j < 4; ++j) { const int c = 4 * lane + 256 * j;
            const f32x4 o = *(const f32x4*)(out + (size_t)m * D + c), x = *(const f32x4*)(xr + c);
            const f32x4 g1 = modv(MOD, bada, cv, 2, c), gg = *(const f32x4*)(gpm + c);
            v[j] = x + g1 * (o * rstd_o * gg);
            *(f32x4*)(xout + (size_t)m * D + c) = v[j];
            s += (v[j][0] * v[j][0] + v[j][1] * v[j][1]) + (v[j][2] * v[j][2] + v[j][3] * v[j][3]); }
        const float rstd = rsqrtf(wave_sum(s) * (1.f / D) + EPS);
#pragma unroll
        for (int j = 0; j < 4; ++j) { const int c = 4 * lane + 256 * j;
            const f32x4 gg = *(const f32x4*)(gpl + c), sh = modv(MOD, bada, cv, 3, c), sc = modv(MOD, bada, cv, 4, c);
            store_bf4(H + (size_t)m * D + c, v[j] * rstd * gg * (sc + 1.f) + sh); }
    }
}
__device__ __forceinline__ void phase_final(const Args& a, int gw, int NGW, int lane, float* yout) {
    const float* MOD = (const float*)(a.ws + CTL_MOD); const float* bada = a.in[I_BADA];
    const float* gpm = a.in[I_GPOSTMLP]; const float* FSS = (const float*)(a.ws + CTL_FSS); const float* F = (const float*)(a.ws + WS_F); const float* out = a.out;
    for (int m = gw; m < M; m += NGW) {
        const int cv = cv_of(m); const float rstd_f = rsqrtf(FSS[m] * (1.f / D) + EPS);
#pragma unroll
        for (int j = 0; j < 4; ++j) { const int c = 4 * lane + 256 * j;
            const f32x4 f = *(const f32x4*)(F + (size_t)m * D + c), x1 = *(const f32x4*)(out + (size_t)m * D + c);
            const f32x4 g2 = modv(MOD, bada, cv, 5, c), gg = *(const f32x4*)(gpm + c);
            *(f32x4*)(yout + (size_t)m * D + c) = x1 + g2 * (f * rstd_f * gg); }
    }
}

__device__ __forceinline__ void panel_sync(unsigned* cnt) {
    asm volatile("s_waitcnt vmcnt(0)" ::: "memory");
    __syncthreads();
    if (threadIdx.x == 0) {
        __hip_atomic_fetch_add(cnt, 1u, __ATOMIC_RELAXED, __HIP_MEMORY_SCOPE_AGENT);
        unsigned sp = 0;
        while (__hip_atomic_load(cnt, __ATOMIC_RELAXED, __HIP_MEMORY_SCOPE_AGENT) < 4u) { __builtin_amdgcn_s_sleep(1); if (++sp > (1u << 22)) break; }
    }
    __syncthreads();
}
__device__ __forceinline__ float ld_agent(const float* p) { return __builtin_bit_cast(float, __hip_atomic_load((const unsigned*)p, __ATOMIC_RELAXED, __HIP_MEMORY_SCOPE_AGENT)); }
__device__ __forceinline__ float sumsq4(f32x4 v) { return (v[0] * v[0] + v[1] * v[1]) + (v[2] * v[2] + v[3] * v[3]); }
template <int MODE> struct EpiFused {
    static constexpr bool PERM = true, AFTER_DRAIN = true, HOOK = false;
    float* out; const float* xp; const float* xs; bf16* H; float* SS1; float* SS2; unsigned* cnt1; unsigned* cnt2;
    const float* MOD; const float* bada; const float* gpost; const float* gpre;
    __device__ __forceinline__ void fused(f32x4 (&acc)[2][2][4][2], const pg8::Unit& u, int wr, int wc, int fr, int fq, LAS unsigned char*, int, int) const {
        const int row0 = u.pm * 256 + wr * 64 + fr, col0 = u.pn * 256 + wc * 32 + 8 * fq;
        const int cv = u.pm < 32 ? 0 : (u.pm < 48 ? 1 : 2);
#pragma unroll
        for (int ai = 0; ai < 2; ++ai)
#pragma unroll
            for (int m = 0; m < 4; ++m) {
                float ss = (sumsq4(acc[ai][0][m][0]) + sumsq4(acc[ai][0][m][1])) + (sumsq4(acc[ai][1][m][0]) + sumsq4(acc[ai][1][m][1]));
                ss += __shfl_xor(ss, 16); ss += __shfl_xor(ss, 32);
                if (fq == 0) atomicAdd(SS1 + row0 + ai * 128 + m * 16, ss);
            }
        panel_sync(cnt1 + 64 * u.pm);
        f32x4 ga[2][2];
#pragma unroll
        for (int bj = 0; bj < 2; ++bj)
#pragma unroll
            for (int n = 0; n < 2; ++n) { const int c = col0 + bj * 128 + 4 * n; ga[bj][n] = modv(MOD, bada, cv, MODE == 6 ? 2 : 5, c) * *(const f32x4*)(gpost + c); }
        float rs1[2][4];
#pragma unroll
        for (int ai = 0; ai < 2; ++ai)
#pragma unroll
            for (int m = 0; m < 4; ++m) rs1[ai][m] = ld_agent(SS1 + row0 + ai * 128 + m * 16);
#pragma unroll
        for (int ai = 0; ai < 2; ++ai)
#pragma unroll
            for (int m = 0; m < 4; ++m) {
                const int row = row0 + ai * 128 + m * 16;
                const float rstd = rsqrtf(rs1[ai][m] * (1.f / D) + EPS);
                const float* xrow = MODE == 6 ? (row < MCTX ? xp + (size_t)row * D : xs + (size_t)(row - MCTX) * D) : out + (size_t)row * D;
                float ss = 0.f;
#pragma unroll
                for (int bj = 0; bj < 2; ++bj)
#pragma unroll
                    for (int n = 0; n < 2; ++n) { const int c = col0 + bj * 128 + 4 * n;
                        const f32x4 v = *(const f32x4*)(xrow + c) + ga[bj][n] * (acc[ai][bj][m][n] * rstd);
                        *(f32x4*)(out + (size_t)row * D + c) = v; acc[ai][bj][m][n] = v; ss += sumsq4(v); }
                if constexpr (MODE == 6) { ss += __shfl_xor(ss, 16); ss += __shfl_xor(ss, 32); if (fq == 0) atomicAdd(SS2 + row, ss); }
            }
        if constexpr (MODE == 6) {
            panel_sync(cnt2 + 64 * u.pm);
            f32x4 cc[2][2], sh[2][2];
#pragma unroll
            for (int bj = 0; bj < 2; ++bj)
#pragma unroll
                for (int n = 0; n < 2; ++n) { const int c = col0 + bj * 128 + 4 * n; cc[bj][n] = *(const f32x4*)(gpre + c) * (modv(MOD, bada, cv, 4, c) + 1.f); sh[bj][n] = modv(MOD, bada, cv, 3, c); }
            float rs2[2][4];
#pragma unroll
            for (int ai = 0; ai < 2; ++ai)
#pragma unroll
                for (int m = 0; m < 4; ++m) rs2[ai][m] = ld_agent(SS2 + row0 + ai * 128 + m * 16);
#pragma unroll
            for (int ai = 0; ai < 2; ++ai)
#pragma unroll
                for (int m = 0; m < 4; ++m) {
                    const int row = row0 + ai * 128 + m * 16;
                    const float rstd = rsqrtf(rs2[ai][m] * (1.f / D) + EPS);
#pragma unroll
                    for (int bj = 0; bj < 2; ++bj) {
                        const f32x4 h0 = acc[ai][bj][m][0] * rstd * cc[bj][0] + sh[bj][0], h1 = acc[ai][bj][m][1] * rstd * cc[bj][1] + sh[bj][1];
                        v4u w; w.x = pg8::cvt_pk_bf16(h0[0], h0[1]); w.y = pg8::cvt_pk_bf16(h0[2], h0[3]); w.z = pg8::cvt_pk_bf16(h1[0], h1[1]); w.w = pg8::cvt_pk_bf16(h1[2], h1[3]);
                        *(v4u*)(H + (size_t)row * D + col0 + bj * 128) = w; }
                }
        }
    }
};

constexpr int YLD = 2048;
constexpr int SG_W = 0, SG_V = 34816, SG_U = 69632, SG_ST = 272;
__device__ __forceinline__ void sgu_load(const bf16* GV, const bf16* GU, const float* VSS, int item, int tid, v4u (&rv)[4], v4u (&ru)[4], float (&rss)[4]) {
    const int g = item & 7, t0 = (item >> 3) * 128;
#pragma unroll
    for (int i = 0; i < 4; ++i) { const int idx = tid + i * NTHR, p = idx >> 4, c8 = (idx & 15) * 8;
        rv[i] = *(const v4u*)(GV + (size_t)(t0 + p) * D + g * 128 + c8); ru[i] = *(const v4u*)(GU + (size_t)(t0 + p) * YLD + g * 128 + c8); rss[i] = VSS[t0 + p]; }
}
__device__ __forceinline__ void phase_sgu(const Args& a, LAS unsigned char* lds, int tid, int wave, int lane, bf16* YG) {
    const bf16* GV = (const bf16*)a.out; const bf16* GU = (const bf16*)(a.ws + WS_GU); const bf16* WSP = (const bf16*)(a.ws + WS_WSP);
    const float* VSS = (const float*)(a.ws + CTL_VSS); const float* gsgu = a.in[I_GSGU]; const float* bsp = a.in[I_BSP];
    const int fr = lane & 15, fq = lane >> 4;
    int last_g = -1;
    v4u rv[4], ru[4]; float rss[4];
    for (int item = blockIdx.x; item < 128 * 8; item += gridDim.x) {
        const int g = item & 7, n = item >> 3, t0 = n * 128;
        if (g != last_g) {
#pragma unroll
            for (int i = 0; i < 4; ++i) { const int idx = tid + i * NTHR, row = idx >> 4, c16 = idx & 15;
                *(LAS v4u*)(lds + SG_W + row * SG_ST + c16 * 16) = *(const v4u*)(WSP + (size_t)(g * 128 + row) * 128 + c16 * 8); }
            last_g = g;
        }
        if (item == (int)blockIdx.x) sgu_load(GV, GU, VSS, item, tid, rv, ru, rss);
#pragma unroll
        for (int i = 0; i < 4; ++i) {
            const int idx = tid + i * NTHR, p = idx >> 4, c8 = (idx & 15) * 8;
            const v4u r = rv[i]; const v4u uu = ru[i];
            const float rs = rsqrtf(rss[i] * (1.f / D) + EPS);
            const f32x4 g0 = *(const f32x4*)(gsgu + g * 128 + c8) * rs, g1 = *(const f32x4*)(gsgu + g * 128 + c8 + 4) * rs;
            v4u o; o.x = pk2(bflo(r.x) * g0[0], bfhi(r.x) * g0[1]); o.y = pk2(bflo(r.y) * g0[2], bfhi(r.y) * g0[3]);
            o.z = pk2(bflo(r.z) * g1[0], bfhi(r.z) * g1[1]); o.w = pk2(bflo(r.w) * g1[2], bfhi(r.w) * g1[3]);
            *(LAS v4u*)(lds + SG_V + p * SG_ST + c8 * 2) = o;
            *(LAS v4u*)(lds + SG_U + p * SG_ST + c8 * 2) = uu;
        }
        if (item + (int)gridDim.x < 128 * 8) sgu_load(GV, GU, VSS, item + gridDim.x, tid, rv, ru, rss);
        float bias8[8];
#pragma unroll
        for (int qb = 0; qb < 8; ++qb) bias8[qb] = bsp[g * 128 + qb * 16 + fr];
        __syncthreads();
        bf16x8 af[4];
#pragma unroll
        for (int ks = 0; ks < 4; ++ks) {
            unsigned short e[8];
#pragma unroll
            for (int j = 0; j < 8; ++j) e[j] = *(const LAS unsigned short*)(lds + SG_V + (ks * 32 + fq * 8 + j) * SG_ST + (wave * 16 + fr) * 2);
            v4u o; o.x = e[0] | ((unsigned)e[1] << 16); o.y = e[2] | ((unsigned)e[3] << 16); o.z = e[4] | ((unsigned)e[5] << 16); o.w = e[6] | ((unsigned)e[7] << 16);
            af[ks] = __builtin_bit_cast(bf16x8, o);
        }
#pragma unroll
        for (int qb = 0; qb < 8; ++qb) {
            const int q = qb * 16 + fr;
            f32x4 acc = {0.f, 0.f, 0.f, 0.f};
#pragma unroll
            for (int ks = 0; ks < 4; ++ks) { const bf16x8 b = *(const LAS bf16x8*)(lds + SG_W + q * SG_ST + (ks * 32 + fq * 8) * 2);
                acc = __builtin_amdgcn_mfma_f32_16x16x32_bf16(af[ks], b, acc, 0, 0, 0); }
            const float bias = bias8[qb];
            LAS v2u* up = (LAS v2u*)(lds + SG_U + q * SG_ST + (wave * 16 + fq * 4) * 2);
            const v2u gu = *up;
            v2u y; y.x = pk2(bflo(gu.x) * (acc[0] + bias), bfhi(gu.x) * (acc[1] + bias)); y.y = pk2(bflo(gu.y) * (acc[2] + bias), bfhi(gu.y) * (acc[3] + bias));
            *up = y;
        }
        __syncthreads();
#pragma unroll
        for (int i = 0; i < 4; ++i) { const int idx = tid + i * NTHR, p = idx >> 4, c8 = (idx & 15) * 8;
            *(v4u*)(YG + (size_t)(t0 + p) * YLD + g * 128 + c8) = *(const LAS v4u*)(lds + SG_U + p * SG_ST + c8 * 2); }
        __syncthreads();
    }
}

constexpr int RG_WB = 0, RG_XA = 32768, RG_XF = 51200, RG_AGL = 86016, RG_GCL = 94208, RG_CWL = 96256, RG_CARL = 97536;
__device__ __forceinline__ void rg_load_raw(const bf16* XR, int item, int tid, v4u (&xr)[2][4]) {
    const int h = item & 15, t0 = (item >> 4) * 128;
    const int seq_lo = t0 < MCTX ? (t0 & ~255) : MCTX + ((t0 - MCTX) & ~4095), seq_hi = seq_lo + (t0 < MCTX ? 256 : 4096);
#pragma unroll
    for (int i = 0; i < 2; ++i) {
        const int idx = tid + i * NTHR, tk = idx >> 3, chb = h * 64 + (idx & 7) * 8;
#pragma unroll
        for (int tap = 0; tap < 4; ++tap) {
            const int t = t0 + tk + tap - 2; const bool ok = (t >= seq_lo) && (t < seq_hi); const int tc = ok ? t : t0;
            xr[i][tap] = *(const v4u*)(XR + (size_t)tc * D + chb);
        }
    }
}
template <int MODE> __device__ __forceinline__ int rg_item(int k) {
    const int h = blockIdx.x & 15, q = blockIdx.x >> 4;
    int tt;
    if (MODE == 1) tt = k < 4 ? 2 * (q + 16 * (k >> 1)) + (k & 1) : 64 + q + 16 * (k - 4);
    else tt = k < 2 ? 2 * (q + 16 * k) + 1 : 64 + q + 16 * (k - 2);
    return tt * 16 + h;
}
template <int MODE>
__device__ __forceinline__ void phase_rg(const Args& a, LAS unsigned char* lds, int tid, int wave, int lane, bf16* YR) {
    const bf16* XR = (const bf16*)((const unsigned char*)a.out + 32 * MiB); const bf16* GGR = (const bf16*)(a.ws + WS_GU) + D;
    const float* GC = (const float*)(a.ws + WS_GC); const bf16* WG = (const bf16*)(a.ws + WS_WG);
    f32x2* AGG = (f32x2*)(a.ws + WS_AGG); const float* CAR = (const float*)(a.ws + WS_CAR); float* nstate = a.out + (size_t)M * D;
    const float* convw = a.in[I_CONVW]; const float* convb = a.in[I_CONVB];
    const int fr = lane & 15, fq = lane >> 4;
    int last_h = -1;
    v4u xr[2][4];
    constexpr int NK = MODE == 1 ? 8 : 6;
    rg_load_raw(XR, rg_item<MODE>(0), tid, xr);
    if constexpr (MODE == 1) {
        const float* st0 = a.in[I_STATE];
#pragma unroll 1
        for (int kk = tid >> 7; kk < 8; kk += 4) {
            const int it = rg_item<1>(kk);
            {
                const int d = (tid >> 6) & 1, cl = tid & 63, h = it & 15, tt = it >> 4;
                float hc;
                if (tt < 64) {
                    const f32x2 g = AGG[((size_t)((tt | 1) * 16 + h) * 2 + 1) * 64 + cl];
                    hc = ((tt & 1) == 0 && d == 1) ? g[1] : 0.f;
                } else {
                    const int b = (tt - 64) >> 5, j = (tt - 64) & 31, tt0 = 64 + b * 32;
                    f32x2 ag[31];
#pragma unroll
                    for (int sI = 0; sI < 31; ++sI) { const int ti = d ? 31 - sI : sI; ag[sI] = AGG[((size_t)((tt0 + ti) * 16 + h) * 2 + d) * 64 + cl]; }
                    hc = st0[(size_t)b * 2048 + d * 1024 + h * 64 + cl];
#pragma unroll
                    for (int sI = 0; sI < 31; ++sI) { const int ti = d ? 31 - sI : sI; if (d ? (ti > j) : (ti < j)) hc = ag[sI][0] * hc + ag[sI][1]; }
                }
                *(LAS float*)(lds + RG_CARL + ((kk * 2 + d) * 64 + cl) * 4) = hc;
            }
        }
        __syncthreads();
    }
    for (int kitem = 0; kitem < NK; ++kitem) {
        const int item = rg_item<MODE>(kitem);
        const int h = item & 15, tt = item >> 4, t0 = tt * 128;
        if (h != last_h) {
#pragma unroll
            for (int i = 0; i < 4; ++i) { const int o = (tid + i * NTHR) * 16; *(LAS v4u*)(lds + RG_WB + o) = *(const v4u*)((const unsigned char*)WG + (size_t)h * 32768 + o); }
            if (tid < 128) *(LAS f32x4*)(lds + RG_GCL + tid * 16) = *(const f32x4*)(GC + (size_t)((tid >> 6) * D + h * 64 + (tid & 63)) * 4);
            if (tid < 80) { const int row = tid >> 4, c4 = (tid & 15) * 4;
                *(LAS f32x4*)(lds + RG_CWL + (row * 64 + c4) * 4) = *(const f32x4*)((row < 4 ? convw + row * D : convb) + h * 64 + c4); }
            last_h = h;
            __syncthreads();
        }
        const int seq_lo = t0 < MCTX ? (t0 & ~255) : MCTX + ((t0 - MCTX) & ~4095), seq_hi = seq_lo + (t0 < MCTX ? 256 : 4096);
        float car[2][4]; v4u ggr[2];
        if constexpr (MODE == 1) {
#pragma unroll
            for (int d = 0; d < 2; ++d)
#pragma unroll
                for (int cb = 0; cb < 4; ++cb) car[d][cb] = *(const LAS float*)(lds + RG_CARL + ((kitem * 2 + d) * 64 + cb * 16 + fr) * 4);
#pragma unroll
            for (int i = 0; i < 2; ++i) { const int idx = tid + i * NTHR; ggr[i] = *(const v4u*)(GGR + (size_t)(t0 + (idx >> 3)) * YLD + h * 64 + (idx & 7) * 8); }
        }
        {
            const int c8 = (tid & 7) * 8;
            f32x4 w0[4], w1[4];
#pragma unroll
            for (int tap = 0; tap < 4; ++tap) { w0[tap] = *(const LAS f32x4*)(lds + RG_CWL + (tap * 64 + c8) * 4); w1[tap] = *(const LAS f32x4*)(lds + RG_CWL + (tap * 64 + c8 + 4) * 4); }
            const f32x4 b0 = *(const LAS f32x4*)(lds + RG_CWL + (4 * 64 + c8) * 4), b1 = *(const LAS f32x4*)(lds + RG_CWL + (4 * 64 + c8 + 4) * 4);
#pragma unroll
            for (int i = 0; i < 2; ++i) {
                const int idx = tid + i * NTHR, tk = idx >> 3, cg8 = idx & 7;
                f32x4 x0 = b0, x1 = b1;
#pragma unroll
                for (int tap = 0; tap < 4; ++tap) { const int t = t0 + tk + tap - 2; const bool ok = (t >= seq_lo) && (t < seq_hi);
                    v4u r = xr[i][tap]; r.x = ok ? r.x : 0u; r.y = ok ? r.y : 0u; r.z = ok ? r.z : 0u; r.w = ok ? r.w : 0u;
                    x0[0] += w0[tap][0] * bflo(r.x); x0[1] += w0[tap][1] * bfhi(r.x); x0[2] += w0[tap][2] * bflo(r.y); x0[3] += w0[tap][3] * bfhi(r.y);
                    x1[0] += w1[tap][0] * bflo(r.z); x1[1] += w1[tap][1] * bfhi(r.z); x1[2] += w1[tap][2] * bflo(r.w); x1[3] += w1[tap][3] * bfhi(r.w); }
                v4u o; o.x = pk2(x0[0], x0[1]); o.y = pk2(x0[2], x0[3]); o.z = pk2(x1[0], x1[1]); o.w = pk2(x1[2], x1[3]);
                *(LAS v4u*)(lds + RG_XA + tk * 144 + cg8 * 16) = o;
                *(LAS f32x4*)(lds + RG_XF + (tk * 68 + cg8 * 8) * 4) = x0; *(LAS f32x4*)(lds + RG_XF + (tk * 68 + cg8 * 8 + 4) * 4) = x1;
            }
        }
        if (kitem + 1 < NK) rg_load_raw(XR, rg_item<MODE>(kitem + 1), tid, xr);
        __syncthreads();
        const int tokb = wave * 16;
        bf16x8 afr[2];
#pragma unroll
        for (int ks = 0; ks < 2; ++ks) afr[ks] = *(const LAS bf16x8*)(lds + RG_XA + (tokb + fr) * 144 + (ks * 32 + fq * 8) * 2);
        f32x4 gcv[2][4];
#pragma unroll
        for (int d = 0; d < 2; ++d)
#pragma unroll
            for (int cb = 0; cb < 4; ++cb) gcv[d][cb] = *(const LAS f32x4*)(lds + RG_GCL + (d * 64 + cb * 16 + fr) * 16);
        float av[2][4][4], bv[2][4][4], Ap[2][4], Hp[2][4];
        const bool ctx = t0 < MCTX;
#pragma unroll
        for (int d = 0; d < 2; ++d) {
            if (MODE == 0 && ctx && d != (tt & 1)) continue;
#pragma unroll
            for (int cb = 0; cb < 4; ++cb) {
                const f32x4 gc = gcv[d][cb];
                f32x4 ar = {0.f, 0.f, 0.f, 0.f}, ai = {0.f, 0.f, 0.f, 0.f};
#pragma unroll
                for (int ks = 0; ks < 2; ++ks) {
                    const bf16x8 b0 = *(const LAS bf16x8*)(lds + RG_WB + (((0 * 8 + d * 4 + cb) * 2 + ks) * 64 + lane) * 16);
                    const bf16x8 b1 = *(const LAS bf16x8*)(lds + RG_WB + (((1 * 8 + d * 4 + cb) * 2 + ks) * 64 + lane) * 16);
                    ar = __builtin_amdgcn_mfma_f32_16x16x32_bf16(afr[ks], b0, ar, 0, 0, 0);
                    ai = __builtin_amdgcn_mfma_f32_16x16x32_bf16(afr[ks], b1, ai, 0, 0, 0);
                }
#pragma unroll
                for (int r = 0; r < 4; ++r) {
                    const float xcv = *(const LAS float*)(lds + RG_XF + ((tokb + fq * 4 + r) * 68 + cb * 16 + fr) * 4);
                    const float rr = __builtin_amdgcn_rcpf(__builtin_fmaf(__builtin_amdgcn_exp2f(ar[r]), gc[0], 1.f)), ii = __builtin_amdgcn_rcpf(__builtin_fmaf(__builtin_amdgcn_exp2f(ai[r]), gc[1], 1.f));
                    const float aa = __builtin_amdgcn_exp2f(rr * gc[2]);
                    const float om = fmaxf(1.f - aa * aa, 1e-12f);
                    av[d][cb][r] = aa; bv[d][cb][r] = __builtin_amdgcn_sqrtf(om) * ii * xcv;
                }
                float A = 1.f, Hh = 0.f;
#pragma unroll
                for (int rr = 0; rr < 4; ++rr) { const int r = d ? 3 - rr : rr; Hh = av[d][cb][r] * Hh + bv[d][cb][r]; A *= av[d][cb][r]; }
                float Aw = 1.f, Hw = 0.f, Apl = 1.f, Hpl = 0.f;
#pragma unroll
                for (int gg = 0; gg < 4; ++gg) { const int g = d ? 3 - gg : gg;
                    const float Ag = __shfl(A, g * 16 + fr), Hg = __shfl(Hh, g * 16 + fr);
                    if (g == fq) { Apl = Aw; Hpl = Hw; }
                    Hw = Ag * Hw + Hg; Aw *= Ag; }
                Ap[d][cb] = Apl; Hp[d][cb] = Hpl;
                if (fq == 0) *(LAS f32x2*)(lds + RG_AGL + ((wave * 2 + d) * 64 + cb * 16 + fr) * 8) = (f32x2){Aw, Hw};
            }
        }
        __syncthreads();
        if constexpr (MODE == 0) {
            if (tid < 128 && !(ctx && (tid >> 6) != (tt & 1))) {
                const int d = tid >> 6, cl = tid & 63; float A = 1.f, Hh = 0.f;
#pragma unroll
                for (int ww = 0; ww < 8; ++ww) { const int w2 = d ? 7 - ww : ww; const f32x2 sg = *(const LAS f32x2*)(lds + RG_AGL + ((w2 * 2 + d) * 64 + cl) * 8); Hh = sg[0] * Hh + sg[1]; A *= sg[0]; }
                AGG[((size_t)(tt * 16 + h) * 2 + d) * 64 + cl] = (f32x2){A, Hh};
            }
        } else {
            if (ctx && (tt & 1) == 0 && tid < 64) {
                float Hh = 0.f;
#pragma unroll
                for (int w2 = 0; w2 < 8; ++w2) { const f32x2 sg = *(const LAS f32x2*)(lds + RG_AGL + ((w2 * 2 + 0) * 64 + tid) * 8); Hh = sg[0] * Hh + sg[1]; }
                *(LAS float*)(lds + RG_CARL + (((kitem + 1) * 2 + 0) * 64 + tid) * 4) = Hh;
            }
            float hs[4][4];
#pragma unroll
            for (int cb = 0; cb < 4; ++cb)
#pragma unroll
                for (int r = 0; r < 4; ++r) hs[cb][r] = 0.f;
#pragma unroll
            for (int d = 0; d < 2; ++d)
#pragma unroll
                for (int cb = 0; cb < 4; ++cb) {
                    const int cl = cb * 16 + fr;
                    float hin = car[d][cb];
                    f32x2 sg[8];
#pragma unroll
                    for (int w2 = 0; w2 < 8; ++w2) sg[w2] = *(const LAS f32x2*)(lds + RG_AGL + ((w2 * 2 + d) * 64 + cl) * 8);
#pragma unroll
                    for (int ww = 0; ww < 8; ++ww) { const int w2 = d ? 7 - ww : ww; if (d ? (w2 > wave) : (w2 < wave)) hin = sg[w2][0] * hin + sg[w2][1]; }
                    float hh = Ap[d][cb] * hin + Hp[d][cb];
#pragma unroll
                    for (int rr = 0; rr < 4; ++rr) { const int r = d ? 3 - rr : rr; hh = av[d][cb][r] * hh + bv[d][cb][r]; hs[cb][r] += hh; }
                    if (ctx && (tt & 1) == (d ? 0 : 1) && wave == (d ? 0 : 7) && fq == (d ? 0 : 3)) nstate[(size_t)(tt >> 1) * 2048 + d * 1024 + h * 64 + cl] = hh;
                }
#pragma unroll
            for (int cb = 0; cb < 4; ++cb)
#pragma unroll
                for (int r = 0; r < 4; ++r) *(LAS float*)(lds + RG_XF + ((tokb + fq * 4 + r) * 68 + cb * 16 + fr) * 4) = hs[cb][r];
            __syncthreads();
#pragma unroll
            for (int i = 0; i < 2; ++i) {
                const int idx = tid + i * NTHR, tk = idx >> 3, cg8 = idx & 7;
                const f32x4 y0 = *(const LAS f32x4*)(lds + RG_XF + (tk * 68 + cg8 * 8) * 4), y1 = *(const LAS f32x4*)(lds + RG_XF + (tk * 68 + cg8 * 8 + 4) * 4);
                const v4u g = ggr[i];
                v4u o; o.x = pk2(y0[0] * bflo(g.x), y0[1] * bfhi(g.x)); o.y = pk2(y0[2] * bflo(g.y), y0[3] * bfhi(g.y));
                o.z = pk2(y1[0] * bflo(g.z), y1[1] * bfhi(g.z)); o.w = pk2(y1[2] * bflo(g.w), y1[3] * bfhi(g.w));
                *(v4u*)(YR + (size_t)(t0 + tk) * YLD + h * 64 + cg8 * 8) = o;
            }
        }
        __syncthreads();
    }
}

template <int NT>
__device__ __forceinline__ float carry_chain(const f32x2* AGG, float* CAR, int tt0, int h, int d, int cl, float h0) {
    f32x2 ag[NT];
#pragma unroll
    for (int i = 0; i < NT; ++i) ag[i] = AGG[((size_t)((tt0 + i) * 16 + h) * 2 + d) * 64 + cl];
    float hc = h0;
#pragma unroll
    for (int ii = 0; ii < NT; ++ii) { const int i = d ? NT - 1 - ii : ii;
        CAR[((size_t)((tt0 + i) * 16 + h) * 2 + d) * 64 + cl] = hc; hc = ag[i][0] * hc + ag[i][1]; }
    return hc;
}
__device__ __forceinline__ void phase_carry(const Args& a, int gw, int NGW, int lane) {
    const f32x2* AGG = (const f32x2*)(a.ws + WS_AGG); float* CAR = (float*)(a.ws + WS_CAR);
    for (int wi = gw; wi < 34 * 2 * 16; wi += NGW) {
        const int s = wi >> 5, d = (wi >> 4) & 1, h = wi & 15, ch = h * 64 + lane;
        if (s < 32) {
            const size_t i0 = ((size_t)((2 * s) * 16 + h) * 2 + d) * 64 + lane, i1 = ((size_t)((2 * s + 1) * 16 + h) * 2 + d) * 64 + lane;
            if (d == 0) { CAR[i0] = 0.f; CAR[i1] = AGG[i0][1]; }
            else { CAR[i1] = 0.f; CAR[i0] = AGG[i1][1]; }
        } else {
            const int b = s - 32; const float h0 = a.in[I_STATE][(size_t)b * 2048 + d * 1024 + ch];
            if (d == 0) (void)carry_chain<32>(AGG, CAR, 64 + b * 32, h, 0, lane, h0);
            else (void)carry_chain<32>(AGG, CAR, 64 + b * 32, h, 1, lane, h0);
        }
    }
}

#define RLX_AGENT __ATOMIC_RELAXED, __HIP_MEMORY_SCOPE_AGENT
#define XB_TMO      128
#define XB_XCNT(j)  (256  + 64 * (j))
#define XB_XSUB(j)  (1280 + 64 * (j))
#define XB_XGEN(j)  (2304 + 64 * (j))
#define XB_TOP      3328
#define XB_TOPGEN   3392
#define XCD_BAR_WORDS 3456
#define XB_SPIN_CAP (1u << 18)

__device__ __forceinline__ unsigned xb_ld(unsigned* p)              { return __hip_atomic_load(p, __ATOMIC_RELAXED, __HIP_MEMORY_SCOPE_AGENT); }
__device__ __forceinline__ unsigned xb_add(unsigned* p, unsigned v) { return __hip_atomic_fetch_add(p, v, __ATOMIC_RELAXED, __HIP_MEMORY_SCOPE_AGENT); }
__device__ __forceinline__ unsigned xb_xcc_id() { return (unsigned)__builtin_amdgcn_s_getreg((3 << 11) | 20) & 0xFu; }
#define XB_SPIN(cond, bar) do { unsigned _sp = 0; while (cond) { __builtin_amdgcn_s_sleep(1); \
    if ((++_sp & 255u) == 0u) { if (xb_ld(&(bar)[XB_TMO])) break; if (_sp > XB_SPIN_CAP) { atomicAdd(&(bar)[XB_TMO], 1u); break; } } } } while (0)

struct XcdBarrier {
    unsigned* bar; unsigned x;
    volatile LAS unsigned* st;
};

__device__ __forceinline__ XcdBarrier xcd_barrier_post(unsigned* bar, volatile LAS unsigned* st) {
    XcdBarrier b; b.bar = bar; b.x = xb_xcc_id(); b.st = st;
    if (threadIdx.x == 0) (void)xb_add(&bar[XB_XCNT(b.x)], 1u);
    return b;
}
__device__ __forceinline__ void xcd_barrier_complete(unsigned* bar, unsigned x, unsigned& nloc, unsigned& nx) {
    const unsigned G = gridDim.x * gridDim.y * gridDim.z;
    unsigned sum, cnt, mine, sp = 0u;
    for (;;) {
        sum = 0u; cnt = 0u; mine = 0u;
#pragma unroll
        for (unsigned j = 0; j < 16; ++j) { const unsigned c = xb_ld(&bar[XB_XCNT(j)]); sum += c; cnt += (c > 0u) ? 1u : 0u; mine = (j == x) ? c : mine; }
        if (sum == G) break;
        __builtin_amdgcn_s_sleep(1);
        if ((++sp & 255u) == 0u) { if (xb_ld(&bar[XB_TMO])) break; if (sp > XB_SPIN_CAP) { atomicAdd(&bar[XB_TMO], 1u); break; } }
    }
    nloc = mine > 0u ? mine : 1u; nx = cnt > 0u ? cnt : 1u;
}

__device__ __forceinline__ void xcd_barrier(const XcdBarrier& b) {
    asm volatile("s_waitcnt vmcnt(0)" ::: "memory");
    __syncthreads();
    if (threadIdx.x == 0) {
        unsigned* bar = b.bar;
        __builtin_amdgcn_s_waitcnt(0);
        unsigned nloc = b.st[0], nx = b.st[1];
        if (nloc == 0u) { xcd_barrier_complete(bar, b.x, nloc, nx); b.st[0] = nloc; b.st[1] = nx; }
        const unsigned old = xb_add(&bar[XB_XSUB(b.x)], 1u);
        const unsigned gen = old / nloc;
        if (old + 1u == (gen + 1u) * nloc) {
            __builtin_amdgcn_fence(__ATOMIC_RELEASE, "agent");
            asm volatile("s_waitcnt vmcnt(0)" ::: "memory");
            const unsigned og = xb_add(&bar[XB_TOP], 1u);
            const unsigned tg = og / nx;
            if (og + 1u == (tg + 1u) * nx) xb_add(&bar[XB_TOPGEN], 1u);
            else XB_SPIN(xb_ld(&bar[XB_TOPGEN]) == tg, bar);
            __builtin_amdgcn_fence(__ATOMIC_ACQUIRE, "agent");
            xb_add(&bar[XB_XGEN(b.x)], 1u);
            asm volatile("s_waitcnt vmcnt(0)" ::: "memory");
        } else {
            XB_SPIN(xb_ld(&bar[XB_XGEN(b.x)]) == gen, bar);
            __builtin_amdgcn_fence(__ATOMIC_ACQUIRE, "agent");
            asm volatile("s_waitcnt vmcnt(0)" ::: "memory");
        }
    }
    __syncthreads();
}

__global__ void __launch_bounds__(NTHR, 2) fwd_megakernel(Args a) {
    extern __shared__ __attribute__((aligned(16))) unsigned char lds_raw[];
    LAS unsigned char* lds = (LAS unsigned char*)lds_raw;
    const int tid = threadIdx.x, lane = tid & 63, wave = __builtin_amdgcn_readfirstlane(tid >> 6);
    const int G = gridDim.x, gw = blockIdx.x * NWAVES + wave, NGW = G * NWAVES;
    unsigned char* ws = a.ws;
    const int lo = a.ph_lo, hi = a.ph_hi;
    volatile LAS unsigned* bst = (volatile LAS unsigned*)(lds + LDS_BAR_OFF);
    if (tid < 2) bst[tid] = 0u;
    __syncthreads();
    XcdBarrier bar = xcd_barrier_post((unsigned*)(ws + WS_CTL), bst);
#define IN(k) (lo <= (k) && (k) < hi)
#define SEAM(k) do { if (IN(k) && IN((k) + 1)) { xcd_barrier(bar); if (DUP >> 12 & 1) xcd_barrier(bar); } } while (0)
    float* const DUMSS = (float*)(ws + 1 * MiB + 512 * 1024);
#define REP(k) for (int rep_ = ((DUP >> (k)) & 1); rep_ >= 0; --rep_)
#define ISDUP (rep_ > 0)
    if (IN(0)) REP(0) phase_prep(a, lds, gw, NGW, wave, lane, ISDUP ? (float*)(ws + 1 * MiB + 256 * 1024) : (float*)(ws + CTL_MOD));
    SEAM(0);
    if (IN(1)) REP(1) phase_norm1(a, gw, NGW, lane);
    SEAM(1);
    if (IN(2)) REP(2) {
        pg8::Gemm g{(const pg8::bf16_t*)(ws + WS_H), (const pg8::bf16_t*)(ws + WS_WIN), M, INC, D}; pg8::StaticOrder S; S.init(M, INC, G, (int)blockIdx.x, WG_IN);
        pg8::Epi<1> E{nullptr, nullptr, nullptr, ISDUP ? DUMSS : (float*)(ws + CTL_VSS), D, (bf16*)(ws + WS_GU), (bf16*)a.out, (bf16*)((unsigned char*)a.out + 32 * MiB), (bf16*)(ws + WS_GU) + D, (bf16*)(ws + WS_SGA), (bf16*)(ws + WS_SGB)};
        pg8::gemm_phase<pg8::Epi<1>, pg8::StaticOrder, true, true>(lds, g, S, E);
    }
    SEAM(2);
    if (IN(3)) REP(3) { phase_rg<0>(a, lds, tid, wave, lane, nullptr); phase_sgu(a, lds, tid, wave, lane, ISDUP ? (bf16*)(ws + WS_F) : (bf16*)(ws + WS_GU)); }
    SEAM(3);
    if (IN(5)) REP(5) phase_rg<1>(a, lds, tid, wave, lane, ISDUP ? (bf16*)(ws + WS_F) + D : (bf16*)(ws + WS_GU) + D);
    SEAM(5);
    if (IN(6)) REP(6) {
        pg8::Gemm g{(const pg8::bf16_t*)(ws + WS_GU), (const pg8::bf16_t*)(ws + WS_WBG), M, D, 2 * D}; pg8::StaticOrder S; S.init(M, D, G, (int)blockIdx.x);
        pg8::EpiMerge E{(bf16*)(ws + WS_H), (const bf16*)(ws + WS_SGA), (const bf16*)(ws + WS_SGB)};
        pg8::gemm_phase<pg8::EpiMerge, pg8::StaticOrder, false, true>(lds, g, S, E);
    }
    SEAM(6);
    if (IN(7)) {
        pg8::Gemm g{(const pg8::bf16_t*)(ws + WS_H), (const pg8::bf16_t*)(ws + WS_WOUT), M, D, D}; pg8::StaticOrder S; S.init(M, D, G, (int)blockIdx.x);
        EpiFused<6> E{a.out, a.in[I_XP], a.in[I_XS], (bf16*)(ws + WS_H), (float*)(ws + CTL_OSS), (float*)(ws + CTL_XSS), (unsigned*)(ws + CTL_CNT), (unsigned*)(ws + CTL_CNT + 16384),
                      (const float*)(ws + CTL_MOD), a.in[I_BADA], a.in[I_GPOSTMIX], a.in[I_GPREMLP]};
        pg8::gemm_phase<EpiFused<6>, pg8::StaticOrder, false, true>(lds, g, S, E);
    }
    SEAM(7);
    if (IN(8)) REP(8) {
        pg8::Gemm g{(const pg8::bf16_t*)(ws + WS_H), (const pg8::bf16_t*)(ws + WS_WFF1), M, FF, D}; pg8::StaticOrder S; S.init(M, FF, G, (int)blockIdx.x, WG_FF1);
        pg8::Epi<5> E{(bf16*)(ws + WS_F1), nullptr, nullptr, nullptr, FF, nullptr, nullptr, nullptr, nullptr, nullptr, nullptr};
        pg8::gemm_phase<pg8::Epi<5>, pg8::StaticOrder, true, true>(lds, g, S, E);
    }
    SEAM(8);
    if (IN(9)) {
        pg8::Gemm g{(const pg8::bf16_t*)(ws + WS_F1), (const pg8::bf16_t*)(ws + WS_WFF2), M, D, FF}; pg8::StaticOrder S; S.init(M, D, G, (int)blockIdx.x);
        EpiFused<7> E{a.out, nullptr, nullptr, nullptr, (float*)(ws + CTL_FSS), nullptr, (unsigned*)(ws + CTL_CNT + 32768), nullptr,
                      (const float*)(ws + CTL_MOD), a.in[I_BADA], a.in[I_GPOSTMLP], nullptr};
        pg8::gemm_phase<EpiFused<7>, pg8::StaticOrder, false, true>(lds, g, S, E);
    }
#undef IN
#undef SEAM
}

constexpr int N_PHASES = 10;
extern "C" void kernel_launch(void* const* d_in, const int* in_sizes, int n_in, void* d_out, int out_size, void* d_ws, size_t ws_size, hipStream_t stream) {
    static int grid = 0;
    if (grid == 0) {
        if (n_in != 27 || ws_size < WS_END) { fprintf(stderr, "kernel_launch: need 27 inputs and >= %zu B of workspace; got %d, %zu\n", (size_t)WS_END, n_in, ws_size); grid = -1; return; }
        int dev = 0, cus = 0, per_cu = 0;
        if (hipGetDevice(&dev) != hipSuccess || hipDeviceGetAttribute(&cus, hipDeviceAttributeMultiprocessorCount, dev) != hipSuccess) { grid = -1; return; }
        if (hipFuncSetAttribute((const void*)fwd_megakernel, hipFuncAttributeMaxDynamicSharedMemorySize, LDS_BYTES) != hipSuccess) { fprintf(stderr, "kernel_launch: hipFuncSetAttribute failed\n"); grid = -1; return; }
        if (hipOccupancyMaxActiveBlocksPerMultiprocessor(&per_cu, (const void*)fwd_megakernel, NTHR, LDS_BYTES) != hipSuccess || per_cu < 1) { fprintf(stderr, "kernel_launch: occupancy query says %d\n", per_cu); per_cu = 1; }
        (void)hipGetLastError();
        grid = cus * per_cu;
        if (grid < 256) { fprintf(stderr, "kernel_launch: this kernel's work split needs 256 co-resident workgroups; the device offers %d\n", grid); grid = -1; return; }
        grid = 256;
    }
    if (grid < 0) return;
    (void)hipMemsetAsync((char*)d_ws + WS_CTL, 0, CTL_ZERO_BYTES, stream);
    Args a{};
    for (int i = 0; i < 27; ++i) a.in[i] = (const float*)d_in[i];
    a.out = (float*)d_out; a.ws = (unsigned char*)d_ws; a.ph_lo = 0; a.ph_hi = N_PHASES;
    void* args[] = {&a};
    hipError_t e = hipLaunchCooperativeKernel((const void*)fwd_megakernel, dim3(grid), dim3(NTHR), args, LDS_BYTES, stream);
    if (e != hipSuccess) fprintf(stderr, "kernel_launch: cooperative launch failed: %s (grid %d)\n", hipGetErrorString(e), grid);
}
```

```cpp
#include <hip/hip_runtime.h>
#include <hip/hip_cooperative_groups.h>
#include <cstdio>
#include <cstdint>
namespace cg = cooperative_groups;
namespace pg8 {
#define PG8_LAS __attribute__((address_space(3)))
typedef unsigned short bf16_t;
typedef short bf16x8 __attribute__((ext_vector_type(8)));
typedef float f32x4 __attribute__((ext_vector_type(4)));
typedef unsigned u32x4 __attribute__((ext_vector_type(4)));
constexpr int BM = 256, BK = 64, HALF = 128, HTB = HALF * BK * 2  , STAGE_BYTES = 8 * HTB, NXCD = 8, WGM = 8;

__host__ __device__ __forceinline__ int lds_byte(int r, int c) { const int st = (r >> 4) * 2 + (c >> 5), rr = r & 15, cc = c & 31, ob = rr * 64 + cc * 2; return st * 1024 + (ob ^ (((ob >> 9) & 1) << 5)); }
__host__ __device__ __forceinline__ void stage_rc(int b, int& R, int& C) { const int st = b / 1024, sb = b % 1024, swz = sb ^ (((sb >> 9) & 1) << 5); R = (st >> 1) * 16 + swz / 64; C = (st & 1) * 32 + (swz % 64) / 2; }
__host__ __device__ __forceinline__ int perm32(int rho) { const int n = rho >> 4, i = rho & 15; return 8 * (i >> 2) + 4 * n + (i & 3); }

struct Unit { int pm, pn; };
struct Gemm { const bf16_t* A; const bf16_t* Bt; int M, N, K; };

struct StaticOrder {
    int nM, nN, nwg, G, c, wgm;
    __host__ __device__ void init(int M, int N, int G_, int c_, int wgm_ = 8) { nM = M / BM; nN = N / BM; nwg = nM * nN; G = G_; c = c_; wgm = wgm_; }
    __host__ __device__ bool next(int i, Unit& u) const {
        const long L = (long)i * G + c; if (L >= nwg) return false;
        int wgid = (int)L; { const int q = nwg / NXCD, r = nwg % NXCD, xcd = wgid % NXCD, off = wgid / NXCD; wgid = (xcd < r ? xcd * (q + 1) : r * (q + 1) + (xcd - r) * q) + off; }
        const int nig = wgm * nN, gid = wgid / nig, fm = gid * wgm, gsz = (nM - fm) < wgm ? (nM - fm) : wgm;
        u.pm = fm + ((wgid % nig) % gsz); u.pn = (wgid % nig) / gsz; return true;
    }
    __device__ __forceinline__ void a_ready(const Unit&) const {}
    __device__ __forceinline__ void done(const Unit&) const {}
};

typedef __bf16 bf16x2_cvt __attribute__((ext_vector_type(2)));
typedef float f32x2_cvt __attribute__((ext_vector_type(2)));
__device__ __forceinline__ unsigned cvt_pk_bf16(float lo, float hi) { const f32x2_cvt v = {lo, hi}; const bf16x2_cvt b = __builtin_convertvector(v, bf16x2_cvt); return __builtin_bit_cast(unsigned, b); }
__device__ __forceinline__ float sigmoid_f(float x) { return __builtin_amdgcn_rcpf(1.f + __builtin_amdgcn_exp2f(-1.4426950409f * x)); }
__device__ __forceinline__ float gelu_tanh_f(float x) { const float u = x * (-2.3022081985f - 0.10294324f * (x * x)); return x * __builtin_amdgcn_rcpf(1.f + __builtin_amdgcn_exp2f(u)); }
__device__ __forceinline__ float bflo(unsigned w) { return __builtin_bit_cast(float, w << 16); }
__device__ __forceinline__ float bfhi(unsigned w) { return __builtin_bit_cast(float, w & 0xffff0000u); }
template <int MODE> struct Epi {
    static constexpr bool PERM = true, AFTER_DRAIN = false, HOOK = false;
    bf16_t* Ob; float* Of; const bf16_t* G; float* SS; int ldc;
    bf16_t *s0, *s1, *s2, *s3, *s4, *s5;
    template <int ACT> __device__ __forceinline__ void act_store(const f32x4 (&acc)[2][2][4][2], bf16_t* base, int ld, int row0, int col0, int fq) const {
#pragma unroll
        for (int ai = 0; ai < 2; ++ai)
#pragma unroll
            for (int m = 0; m < 4; ++m) {
                const int row = row0 + ai * HALF + m * 16; bf16_t* rowp = base + (size_t)row * ld + col0; float ss = 0.f;
#pragma unroll
                for (int bj = 0; bj < 2; ++bj) {
                    f32x4 v0 = acc[ai][bj][m][0], v1 = acc[ai][bj][m][1];
                    if constexpr (ACT == 2) {
#pragma unroll
                        for (int j = 0; j < 4; ++j) { v0[j] = sigmoid_f(v0[j]); v1[j] = sigmoid_f(v1[j]); }
                    } else if constexpr (ACT == 1 || ACT == 3) {
#pragma unroll
                        for (int j = 0; j < 4; ++j) { v0[j] = gelu_tanh_f(v0[j]); v1[j] = gelu_tanh_f(v1[j]); }
                    }
                    if constexpr (ACT == 3) {
#pragma unroll
                        for (int j = 0; j < 4; ++j) ss += v0[j] * v0[j] + v1[j] * v1[j];
                    }
                    u32x4 w; w.x = cvt_pk_bf16(v0[0], v0[1]); w.y = cvt_pk_bf16(v0[2], v0[3]); w.z = cvt_pk_bf16(v1[0], v1[1]); w.w = cvt_pk_bf16(v1[2], v1[3]);
                    *(u32x4*)(rowp + bj * HALF) = w;
                }
                if constexpr (ACT == 3) { ss += __shfl_xor(ss, 16); ss += __shfl_xor(ss, 32); if (fq == 0) atomicAdd(SS + row, ss); }
            }
    }
    __device__ __forceinline__ void operator()(const f32x4 (&acc)[2][2][4][2], const Unit& u, int wr, int wc, int fr, int fq) const {
        const int row0 = u.pm * BM + wr * 64 + fr;
        if constexpr (MODE == 1) {
            const int t = u.pn >> 2;
            bf16_t* base = t == 0 ? s0 : t == 1 ? s1 : t == 2 ? s2 : t == 3 ? s3 : t == 4 ? s4 : s5;
            const int ld = (t == 0 || t == 3) ? 2048 : 1024;
            const int col0 = (u.pn & 3) * BM + wc * 32 + 8 * fq;
            if (t >= 4) act_store<2>(acc, base, ld, row0, col0, fq);
            else if (t == 2) act_store<0>(acc, base, ld, row0, col0, fq);
            else if (t == 1) act_store<3>(acc, base, ld, row0, col0, fq);
            else act_store<1>(acc, base, ld, row0, col0, fq);
        } else {
            const int col0 = u.pn * BM + wc * 32 + 8 * fq;
#pragma unroll
            for (int ai = 0; ai < 2; ++ai)
#pragma unroll
                for (int m = 0; m < 4; ++m) {
                    const int row = row0 + ai * HALF + m * 16; float ss = 0.f;
#pragma unroll
                    for (int bj = 0; bj < 2; ++bj) {
                        f32x4 v0 = acc[ai][bj][m][0], v1 = acc[ai][bj][m][1];
                        const size_t off = (size_t)row * ldc + col0 + bj * HALF;
                        if constexpr (MODE == 2 || MODE == 3) {
                            const u32x4 g = *(const u32x4*)(G + off);
                            v0[0] *= bflo(g.x); v0[1] *= bfhi(g.x); v0[2] *= bflo(g.y); v0[3] *= bfhi(g.y);
                            v1[0] *= bflo(g.z); v1[1] *= bfhi(g.z); v1[2] *= bflo(g.w); v1[3] *= bfhi(g.w);
                        }
                        if constexpr (MODE == 3) { v0 = v0 + *(const f32x4*)(Of + off); v1 = v1 + *(const f32x4*)(Of + off + 4); }
                        if constexpr (MODE == 5) {
#pragma unroll
                            for (int j = 0; j < 4; ++j) { const float a = fmaxf(v0[j], 0.f), b = fmaxf(v1[j], 0.f); v0[j] = a * a; v1[j] = b * b; }
                        }
                        if constexpr (MODE == 4) {
#pragma unroll
                            for (int j = 0; j < 4; ++j) ss += v0[j] * v0[j] + v1[j] * v1[j];
                        }
                        if constexpr (MODE == 2 || MODE == 4) { *(f32x4*)(Of + off) = v0; *(f32x4*)(Of + off + 4) = v1; }
                        else { u32x4 w; w.x = cvt_pk_bf16(v0[0], v0[1]); w.y = cvt_pk_bf16(v0[2], v0[3]); w.z = cvt_pk_bf16(v1[0], v1[1]); w.w = cvt_pk_bf16(v1[2], v1[3]);
                            *(u32x4*)(Ob + off) = w; }
                    }
                    if constexpr (MODE == 4) { ss += __shfl_xor(ss, 16); ss += __shfl_xor(ss, 32); if (fq == 0) atomicAdd(SS + row, ss); }
                }
        }
    }
};

struct EpiMerge {
    static constexpr bool PERM = true, AFTER_DRAIN = false, HOOK = true;
    bf16_t* Ob; const bf16_t* GA; const bf16_t* GB;
    __device__ __forceinline__ void mid(f32x4 (&acc)[2][2][4][2], const Unit& u, int wr, int wc, int fr, int fq) const {
        int row0 = u.pm * BM + wr * 64 + fr, col0 = u.pn * BM + wc * 32 + 8 * fq;
        asm volatile("" : "+v"(row0), "+v"(col0));
#pragma unroll
        for (int ai = 0; ai < 2; ++ai)
#pragma unroll
            for (int m = 0; m < 4; ++m) {
                if ((m & 1) == 0) asm volatile("" ::: "memory");
#pragma unroll
                for (int bj = 0; bj < 2; ++bj) {
                    const size_t off = (size_t)(row0 + ai * HALF + m * 16) * 1024 + col0 + bj * HALF;
                    const u32x4 a = *(const u32x4*)(GA + off), b = *(const u32x4*)(GB + off);
                    f32x4 r0, r1;
                    r0[0] = bflo(a.x) * __builtin_amdgcn_rcpf(fmaxf(bflo(b.x), 1e-30f)); r0[1] = bfhi(a.x) * __builtin_amdgcn_rcpf(fmaxf(bfhi(b.x), 1e-30f));
                    r0[2] = bflo(a.y) * __builtin_amdgcn_rcpf(fmaxf(bflo(b.y), 1e-30f)); r0[3] = bfhi(a.y) * __builtin_amdgcn_rcpf(fmaxf(bfhi(b.y), 1e-30f));
                    r1[0] = bflo(a.z) * __builtin_amdgcn_rcpf(fmaxf(bflo(b.z), 1e-30f)); r1[1] = bfhi(a.z) * __builtin_amdgcn_rcpf(fmaxf(bfhi(b.z), 1e-30f));
                    r1[2] = bflo(a.w) * __builtin_amdgcn_rcpf(fmaxf(bflo(b.w), 1e-30f)); r1[3] = bfhi(a.w) * __builtin_amdgcn_rcpf(fmaxf(bfhi(b.w), 1e-30f));
                    acc[ai][bj][m][0] = acc[ai][bj][m][0] * r0; acc[ai][bj][m][1] = acc[ai][bj][m][1] * r1;
                }
            }
    }
    __device__ __forceinline__ void operator()(const f32x4 (&acc)[2][2][4][2], const Unit& u, int wr, int wc, int fr, int fq) const {
        const int row0 = u.pm * BM + wr * 64 + fr, col0 = u.pn * BM + wc * 32 + 8 * fq;
#pragma unroll
        for (int ai = 0; ai < 2; ++ai)
#pragma unroll
            for (int m = 0; m < 4; ++m)
#pragma unroll
                for (int bj = 0; bj < 2; ++bj) {
                    const size_t off = (size_t)(row0 + ai * HALF + m * 16) * 1024 + col0 + bj * HALF;
                    const u32x4 b = *(const u32x4*)(GB + off);
                    const f32x4 v0 = acc[ai][bj][m][0], v1 = acc[ai][bj][m][1];
                    u32x4 w; w.x = cvt_pk_bf16(v0[0] * bflo(b.x), v0[1] * bfhi(b.x)); w.y = cvt_pk_bf16(v0[2] * bflo(b.y), v0[3] * bfhi(b.y));
                    w.z = cvt_pk_bf16(v1[0] * bflo(b.z), v1[1] * bfhi(b.z)); w.w = cvt_pk_bf16(v1[2] * bflo(b.w), v1[3] * bfhi(b.w));
                    *(u32x4*)(Ob + off) = w;
                }
    }
};

template <class Epi, class Sched, bool ALIGN_EPI = false, bool SP2 = false>
__device__ __forceinline__ void gemm_phase(PG8_LAS unsigned char* lds, const Gemm g, const Sched& S, const Epi& E) {
    const int tid = threadIdx.x, wid = __builtin_amdgcn_readfirstlane(tid >> 6), lane = tid & 63, wr = wid >> 2, wc = wid & 3, fr = lane & 15, fq = lane >> 4;
    const int K = g.K, nt = K / BK;
    unsigned voffA[2], voffB[2];
#pragma unroll
    for (int i = 0; i < 2; ++i) { int R, C; stage_rc(tid * 16 + i * 8192, R, C); const int Rb = Epi::PERM ? ((R & ~31) + perm32(R & 31)) : R;
        voffA[i] = (unsigned)(R * K + C) * 2u; voffB[i] = (unsigned)(Rb * K + C) * 2u; }
    const size_t kstep = (size_t)(BK * 2);
    const size_t hstep = (size_t)HALF * K * 2;
    const size_t tstep = 2 * hstep;
    const unsigned ldsw = (unsigned)wid * 1024u;
    const int aoff = lds_byte(wr * 64 + fr, fq * 8), boff = lds_byte(wc * 32 + fr, fq * 8);
#define PG8_SA(b, h) (((b) * 2 + (h)) * HTB)
#define PG8_SB(b, h) ((4 + (b) * 2 + (h)) * HTB)
#define PG8_STAGE(bufoff, gbase, voff) do { _Pragma("unroll") for (int _i = 0; _i < 2; ++_i) \
        __builtin_amdgcn_global_load_lds((const unsigned*)((const char*)(gbase) + (voff)[_i]), (PG8_LAS unsigned*)(lds + (bufoff) + ldsw + _i * 8192), 16, 0, 0); } while (0)
#define PG8_LDA(dst, b, h) do { _Pragma("unroll") for (int m = 0; m < 4; ++m) _Pragma("unroll") for (int k = 0; k < 2; ++k) dst[m][k] = *(const PG8_LAS bf16x8*)(lds + PG8_SA(b, h) + aoff + m * 2048 + k * 1024); } while (0)
#define PG8_LDB(dst, b, h) do { _Pragma("unroll") for (int n = 0; n < 2; ++n) _Pragma("unroll") for (int k = 0; k < 2; ++k) dst[n][k] = *(const PG8_LAS bf16x8*)(lds + PG8_SB(b, h) + boff + n * 2048 + k * 1024); } while (0)
#define PG8_MMA(ai, bj, At, Bt) do { __builtin_amdgcn_s_setprio(1); _Pragma("unroll") for (int m = 0; m < 4; ++m) _Pragma("unroll") for (int n = 0; n < 2; ++n) _Pragma("unroll") for (int k = 0; k < 2; ++k) \
        acc[ai][bj][m][n] = __builtin_amdgcn_mfma_f32_16x16x32_bf16(Bt[n][k], At[m][k], acc[ai][bj][m][n], 0, 0, 0); __builtin_amdgcn_s_setprio(0); } while (0)
#define PG8_WAIT_V(n) asm volatile("s_waitcnt vmcnt(" #n ")" ::: "memory")
#define PG8_WAIT_L(n) asm volatile("s_waitcnt lgkmcnt(" #n ")" ::: "memory")
#define PG8_BAR __builtin_amdgcn_s_barrier()
#define PG8_SCHED __builtin_amdgcn_sched_barrier(0)
    Unit cur, nxt; int ui = 0;
    if (!S.next(0, cur)) return;
    f32x4 acc[2][2][4][2];
#pragma unroll
    for (int a = 0; a < 2; ++a)
#pragma unroll
        for (int b = 0; b < 2; ++b)
#pragma unroll
            for (int m = 0; m < 4; ++m)
#pragma unroll
                for (int n = 0; n < 2; ++n) acc[a][b][m][n] = (f32x4){0.f, 0.f, 0.f, 0.f};
    bf16x8 At[4][2], B0[2][2], B1[2][2];
    const char* cA = (const char*)g.A + (size_t)cur.pm * tstep; const char* cB = (const char*)g.Bt + (size_t)cur.pn * tstep;
    S.a_ready(cur);
    if constexpr (SP2) {
        PG8_STAGE(PG8_SB(0, 0), cB, voffB); PG8_STAGE(PG8_SB(0, 1), cB + hstep, voffB); PG8_STAGE(PG8_SA(0, 0), cA, voffA); PG8_STAGE(PG8_SA(0, 1), cA + hstep, voffA);
        if (wr == 1) PG8_BAR;
        PG8_WAIT_V(2); PG8_BAR;
        PG8_STAGE(PG8_SB(1, 0), cB + kstep, voffB); PG8_STAGE(PG8_SA(1, 0), cA + kstep, voffA); PG8_STAGE(PG8_SB(1, 1), cB + hstep + kstep, voffB);
        PG8_WAIT_V(6); PG8_BAR;
    } else {
        PG8_STAGE(PG8_SB(0, 0), cB, voffB); PG8_STAGE(PG8_SA(0, 0), cA, voffA); PG8_STAGE(PG8_SB(0, 1), cB + hstep, voffB); PG8_STAGE(PG8_SA(0, 1), cA + hstep, voffA);
        if (wr == 1) PG8_BAR;
        PG8_WAIT_V(4); PG8_BAR;
        PG8_STAGE(PG8_SB(1, 0), cB + kstep, voffB); PG8_STAGE(PG8_SA(1, 0), cA + kstep, voffA); PG8_STAGE(PG8_SB(1, 1), cB + hstep + kstep, voffB);
        PG8_WAIT_V(6); PG8_BAR;
    }
    for (;;) {
        const bool has_next = S.next(ui + 1, nxt);
        const char* nA = has_next ? (const char*)g.A + (size_t)nxt.pm * tstep : cA; const char* nB = has_next ? (const char*)g.Bt + (size_t)nxt.pn * tstep : cB;
        for (int t = 0; t < nt; t += 2) {
            if constexpr (Epi::HOOK) { if (t == (nt >> 1)) E.mid(acc, cur, wr, wc, fr, fq); }
            const bool last = (t == nt - 2);
            const char* a1 = cA + (size_t)(t + 1) * kstep;
            const char* a2 = last ? nA : cA + (size_t)(t + 2) * kstep; const char* b2 = last ? nB : cB + (size_t)(t + 2) * kstep;
            const char* a3 = a2 + kstep; const char* b3 = b2 + kstep;
            if (last && has_next) S.a_ready(nxt);
            if constexpr (SP2) {
            PG8_LDB(B0, 0, 0); PG8_LDB(B1, 0, 1); PG8_SCHED; PG8_LDA(At, 0, 0); PG8_STAGE(PG8_SA(1, 1), a1 + hstep, voffA);
            PG8_WAIT_V(8); PG8_WAIT_L(0); PG8_BAR; PG8_MMA(0, 0, At, B0); PG8_MMA(0, 1, At, B1); PG8_BAR; PG8_SCHED;
            PG8_LDA(At, 0, 1); PG8_STAGE(PG8_SB(0, 0), b2, voffB); PG8_STAGE(PG8_SB(0, 1), b2 + hstep, voffB); PG8_STAGE(PG8_SA(0, 0), a2, voffA);
            PG8_WAIT_V(8); PG8_WAIT_L(0); PG8_BAR; PG8_MMA(1, 0, At, B0); PG8_MMA(1, 1, At, B1); PG8_BAR; PG8_SCHED;
            PG8_LDB(B0, 1, 0); PG8_LDB(B1, 1, 1); PG8_SCHED; PG8_LDA(At, 1, 0); PG8_STAGE(PG8_SA(0, 1), a2 + hstep, voffA);
            PG8_WAIT_V(8); PG8_WAIT_L(0); PG8_BAR; PG8_MMA(0, 0, At, B0); PG8_MMA(0, 1, At, B1); PG8_BAR; PG8_SCHED;
            PG8_LDA(At, 1, 1); PG8_STAGE(PG8_SB(1, 0), b3, voffB); PG8_STAGE(PG8_SB(1, 1), b3 + hstep, voffB); PG8_STAGE(PG8_SA(1, 0), a3, voffA);
            PG8_WAIT_V(8); PG8_WAIT_L(0); PG8_BAR; PG8_MMA(1, 0, At, B0); PG8_MMA(1, 1, At, B1); PG8_BAR; PG8_SCHED;
            } else {
            PG8_LDB(B0, 0, 0); PG8_SCHED; PG8_LDA(At, 0, 0); PG8_STAGE(PG8_SA(1, 1), a1 + hstep, voffA);
            PG8_WAIT_L(8); PG8_BAR; PG8_WAIT_L(0); PG8_MMA(0, 0, At, B0); PG8_BAR; PG8_SCHED;
            PG8_LDB(B1, 0, 1); PG8_STAGE(PG8_SB(0, 0), b2, voffB);
            PG8_BAR; PG8_WAIT_L(0); PG8_MMA(0, 1, At, B1); PG8_BAR;
            PG8_LDA(At, 0, 1); PG8_STAGE(PG8_SA(0, 0), a2, voffA);
            PG8_BAR; PG8_WAIT_L(0); PG8_MMA(1, 0, At, B0); PG8_BAR; PG8_SCHED;
            PG8_STAGE(PG8_SB(0, 1), b2 + hstep, voffB);
            PG8_WAIT_V(6); PG8_BAR; PG8_MMA(1, 1, At, B1); PG8_BAR;
            PG8_LDB(B0, 1, 0); PG8_SCHED; PG8_LDA(At, 1, 0); PG8_STAGE(PG8_SA(0, 1), a2 + hstep, voffA);
            PG8_WAIT_L(8); PG8_BAR; PG8_WAIT_L(0); PG8_MMA(0, 0, At, B0); PG8_BAR; PG8_SCHED;
            PG8_LDB(B1, 1, 1); PG8_STAGE(PG8_SB(1, 0), b3, voffB);
            PG8_BAR; PG8_WAIT_L(0); PG8_MMA(0, 1, At, B1); PG8_BAR;
            PG8_LDA(At, 1, 1); PG8_STAGE(PG8_SA(1, 0), a3, voffA);
            PG8_BAR; PG8_WAIT_L(0); PG8_MMA(1, 0, At, B0); PG8_BAR; PG8_SCHED;
            PG8_STAGE(PG8_SB(1, 1), b3 + hstep, voffB);
            PG8_WAIT_V(6); PG8_BAR; PG8_MMA(1, 1, At, B1); PG8_BAR;
            }
        }
        if constexpr (ALIGN_EPI) { if (wr == 0) PG8_BAR; }
        if constexpr (!Epi::AFTER_DRAIN) { E(acc, cur, wr, wc, fr, fq); S.done(cur); }
        if (!has_next) break;
#pragma unroll
        for (int a = 0; a < 2; ++a)
#pragma unroll
            for (int b = 0; b < 2; ++b)
#pragma unroll
                for (int m = 0; m < 4; ++m)
#pragma unroll
                    for (int n = 0; n < 2; ++n) acc[a][b][m][n] = (f32x4){0.f, 0.f, 0.f, 0.f};
        cur = nxt; cA = nA; cB = nB; ++ui;
        if constexpr (ALIGN_EPI) { if (wr == 1) PG8_BAR; }
    }
    PG8_WAIT_V(0);
    if constexpr (!ALIGN_EPI) { if (wr == 0) PG8_BAR; }
    PG8_BAR;
    if constexpr (Epi::AFTER_DRAIN) { E.fused(acc, cur, wr, wc, fr, fq, lds, wid, lane); S.done(cur); }
#undef PG8_SA
#undef PG8_SB
#undef PG8_STAGE
#undef PG8_LDA
#undef PG8_LDB
#undef PG8_MMA
#undef PG8_WAIT_V
#undef PG8_WAIT_L
#undef PG8_BAR
#undef PG8_SCHED
}
}

constexpr int NWAVES = 8, NTHR = NWAVES * 64;
constexpr int D = 1024, M = 16384, MCTX = 8192, INC = 6144, FF = 4096;
constexpr float EPS = 1e-6f, LOG2E = 1.4426950408889634f;
constexpr size_t MiB = 1u << 20;
constexpr size_t WS_CTL = 0, CTL_ZERO_BYTES = 1 * MiB;
constexpr size_t CTL_VSS = 64 * 1024, CTL_OSS = 128 * 1024, CTL_FSS = 192 * 1024, CTL_MOD = 256 * 1024, CTL_XSS = 384 * 1024;
constexpr size_t CTL_CNT = 16 * 1024;
constexpr size_t WS_GC = 1 * MiB;
constexpr size_t WS_AGG = 2 * MiB;
constexpr size_t WS_CAR = 4 * MiB;
constexpr size_t WS_WG = 5 * MiB;
constexpr size_t WS_WSP = 5 * MiB + 512 * 1024;
constexpr size_t WS_WFF2 = 6 * MiB, WS_WFF1 = 14 * MiB, WS_WIN = 22 * MiB, WS_WBG = 34 * MiB, WS_WBR = 36 * MiB, WS_WOUT = 38 * MiB;
constexpr size_t WS_H = 40 * MiB;
constexpr size_t WS_F = 64 * MiB;
constexpr size_t WS_GU = 128 * MiB, WS_GGR = 160 * MiB, WS_SGA = 192 * MiB, WS_SGB = 224 * MiB;
constexpr size_t WS_F1 = 128 * MiB;
constexpr size_t WS_END = 256 * MiB;
constexpr int LDS_BYTES = 147456, LDS_BAR_OFF = 139264;
#ifndef WG_IN
#define WG_IN 4
#endif
#ifndef WG_FF1
#define WG_FF1 2
#endif
#ifndef DUP
#define DUP 0
#endif

#define GAS __attribute__((address_space(1)))
#define LAS __attribute__((address_space(3)))
typedef unsigned short bf16;
typedef unsigned v4u __attribute__((ext_vector_type(4)));
typedef unsigned v2u __attribute__((ext_vector_type(2)));
typedef float f32x4 __attribute__((ext_vector_type(4)));
typedef float f32x2 __attribute__((ext_vector_type(2)));
typedef short bf16x8 __attribute__((ext_vector_type(8)));
#define LDS_WAIT() asm volatile("s_waitcnt lgkmcnt(0)" ::: "memory")
__device__ __forceinline__ unsigned f2bf(float f) { unsigned u = __builtin_bit_cast(unsigned, f); return (u + 0x7fffu + ((u >> 16) & 1u)) >> 16; }
__device__ __forceinline__ unsigned pk2(float lo, float hi) { return pg8::cvt_pk_bf16(lo, hi); }
__device__ __forceinline__ float bf2f(bf16 b) { return __builtin_bit_cast(float, (unsigned)b << 16); }
using pg8::bflo; using pg8::bfhi;

struct Args { const float* in[27]; float* out; unsigned char* ws; int ph_lo, ph_hi; };
enum { I_XP = 0, I_XS, I_STATE, I_C, I_CCTX, I_WADA, I_BADA, I_GPREMIX, I_GPOSTMIX, I_GPREMLP, I_GPOSTMLP, I_WIN, I_GSGU, I_WSP, I_BSP, I_CONVW, I_CONVB,
       I_WRA, I_BRA, I_WRI, I_BRI, I_LAM, I_WBRG, I_WBRR, I_WOUT, I_WFF1, I_WFF2 };

__device__ __forceinline__ float wave_sum(float v) {
#pragma unroll
    for (int o = 1; o < 64; o <<= 1) v += __shfl_xor(v, o);
    return v;
}
__device__ __forceinline__ void p0_transpose_item(const float* W, int K, int N, bf16* WT, LAS float* scr, int item, int lane, int ldk = 0, int koff = 0) {
    if (ldk == 0) ldk = K;
    const int nblk = N / 32, kb = item / nblk, nb = item % nblk, k0 = 64 * kb, n0 = 32 * nb;
#pragma unroll
    for (int i = 0; i < 8; ++i) { const int kk = 8 * i + (lane >> 3);
        const f32x4 v = *(const f32x4*)(W + (size_t)(k0 + kk) * N + n0 + (lane & 7) * 4);
        LAS float* dd = scr + kk * 33 + (lane & 7) * 4; dd[0] = v[0]; dd[1] = v[1]; dd[2] = v[2]; dd[3] = v[3]; }
    LDS_WAIT(); asm volatile("" ::: "memory");
    const int c = lane & 7;
#pragma unroll
    for (int j = 0; j < 4; ++j) { const int n = (lane >> 3) + 8 * j; const LAS float* s = scr + (8 * c) * 33 + n;
        v4u o; o.x = pk2(s[0 * 33], s[1 * 33]); o.y = pk2(s[2 * 33], s[3 * 33]); o.z = pk2(s[4 * 33], s[5 * 33]); o.w = pk2(s[6 * 33], s[7 * 33]);
        *(v4u*)(WT + (size_t)(n0 + n) * ldk + koff + k0 + 8 * c) = o; }
    LDS_WAIT(); asm volatile("" ::: "memory");
}

__device__ __forceinline__ void phase_prep(const Args& a, LAS unsigned char* lds, int gw, int NGW, int wave, int lane, float* MOD) {
    unsigned char* ws = a.ws;
    LAS float* scr = (LAS float*)(lds + wave * 16384);
    if ((int)blockIdx.x < 192) {
        const float* wada = a.in[I_WADA]; const float* cctx = a.in[I_CCTX]; const float* cc = a.in[I_C];
        const int nb = blockIdx.x % 24, ksl = blockIdx.x / 24, n = nb * 256 + lane * 4, kbase = ksl * 128 + wave * 16;
        f32x4 a0 = {0.f, 0.f, 0.f, 0.f}, a1 = a0, a2 = a0;
#pragma unroll
        for (int kk = 0; kk < 16; ++kk) {
            const int k = kbase + kk;
            const f32x4 w = *(const f32x4*)(wada + (size_t)k * INC + n);
            const float c0 = cctx[k], c1 = cc[k], c2 = cc[D + k];
            const float s0 = c0 * pg8::sigmoid_f(c0), s1 = c1 * pg8::sigmoid_f(c1), s2 = c2 * pg8::sigmoid_f(c2);
            a0 += w * s0; a1 += w * s1; a2 += w * s2;
        }
        LAS float* red = (LAS float*)lds;
        *(LAS f32x4*)(red + (wave * 3 + 0) * 256 + lane * 4) = a0; *(LAS f32x4*)(red + (wave * 3 + 1) * 256 + lane * 4) = a1; *(LAS f32x4*)(red + (wave * 3 + 2) * 256 + lane * 4) = a2;
        __syncthreads();
        const int tid = wave * 64 + lane;
        if (tid < 192) {
            const int v = tid >> 6, c4 = (tid & 63) * 4;
            f32x4 sum = {0.f, 0.f, 0.f, 0.f};
#pragma unroll
            for (int w2 = 0; w2 < 8; ++w2) sum += *(const LAS f32x4*)(red + (w2 * 3 + v) * 256 + c4);
#pragma unroll
            for (int j = 0; j < 4; ++j) atomicAdd(MOD + v * INC + nb * 256 + c4 + j, sum[j]);
        }
        __syncthreads();
    }
    constexpr int I_IN = 16 * (INC / 32), I_SQ = 16 * (D / 32), I_F1 = 16 * (FF / 32), I_F2 = (FF / 64) * (D / 32);
    constexpr int NT = I_IN + 3 * I_SQ + I_F1 + I_F2;
    for (int it = gw; it < NT; it += NGW) {
        int r = it;
        if (r < I_IN) { p0_transpose_item(a.in[I_WIN], D, INC, (bf16*)(ws + WS_WIN), scr, r, lane); continue; } r -= I_IN;
        if (r < I_SQ) { p0_transpose_item(a.in[I_WBRG], D, D, (bf16*)(ws + WS_WBG), scr, r, lane, 2 * D, 0); continue; } r -= I_SQ;
        if (r < I_SQ) { p0_transpose_item(a.in[I_WBRR], D, D, (bf16*)(ws + WS_WBG), scr, r, lane, 2 * D, D); continue; } r -= I_SQ;
        if (r < I_SQ) { p0_transpose_item(a.in[I_WOUT], D, D, (bf16*)(ws + WS_WOUT), scr, r, lane); continue; } r -= I_SQ;
        if (r < I_F1) { p0_transpose_item(a.in[I_WFF1], D, FF, (bf16*)(ws + WS_WFF1), scr, r, lane); continue; } r -= I_F1;
        p0_transpose_item(a.in[I_WFF2], FF, D, (bf16*)(ws + WS_WFF2), scr, r, lane);
    }
    {
        const bool few = gridDim.x > 192;
        if (few && blockIdx.x < 192) return;
        const int gt = few ? ((int)blockIdx.x - 192) * NTHR + wave * 64 + lane : gw * 64 + lane, NGT = few ? ((int)gridDim.x - 192) * NTHR : NGW * 64;
        bf16* WG = (bf16*)(ws + WS_WG);
        for (int it = gt; it < 16 * 16 * 2 * 64; it += NGT) {
            const int ln = it & 63, ks = (it >> 6) & 1, cbi = (it >> 7) & 15, h = it >> 11;
            const int fr = ln & 15, fq = ln >> 4, type = cbi >> 3, d = (cbi >> 2) & 1, cb = cbi & 3;
            const float* W = type ? a.in[I_WRI] : a.in[I_WRA];
            const float* src = W + ((size_t)(d * 16 + h) * 64 + ks * 32 + fq * 8) * 64 + cb * 16 + fr;
            v4u o; o.x = pk2(-LOG2E * src[0], -LOG2E * src[64]); o.y = pk2(-LOG2E * src[128], -LOG2E * src[192]);
            o.z = pk2(-LOG2E * src[256], -LOG2E * src[320]); o.w = pk2(-LOG2E * src[384], -LOG2E * src[448]);
            *(v4u*)(WG + (size_t)it * 8) = o;
        }
        bf16* WSP = (bf16*)(ws + WS_WSP); const float* wsp = a.in[I_WSP];
        for (int it = gt; it < 8 * 128 * 128 / 8; it += NGT) {
            const f32x4 x0 = *(const f32x4*)(wsp + (size_t)it * 8), x1 = *(const f32x4*)(wsp + (size_t)it * 8 + 4);
            v4u o; o.x = pk2(x0[0], x0[1]); o.y = pk2(x0[2], x0[3]); o.z = pk2(x1[0], x1[1]); o.w = pk2(x1[2], x1[3]);
            *(v4u*)(WSP + (size_t)it * 8) = o;
        }
        float* GC = (float*)(ws + WS_GC);
        for (int it = gt; it < 2048; it += NGT) {
            const float lamv = a.in[I_LAM][it]; const float sp = log1pf(expf(-lamv));
            f32x4 o; o[0] = exp2f(-LOG2E * a.in[I_BRA][it]); o[1] = exp2f(-LOG2E * a.in[I_BRI][it]); o[2] = -8.f * sp * LOG2E; o[3] = 0.f;
            *(f32x4*)(GC + (size_t)it * 4) = o;
        }
    }
}

__device__ __forceinline__ f32x4 modv(const float* MOD, const float* bada, int cv, int part, int c) {
    return *(const f32x4*)(MOD + cv * INC + part * D + c) + *(const f32x4*)(bada + part * D + c);
}
__device__ __forceinline__ int cv_of(int m) { return m < MCTX ? 0 : (m < MCTX + 4096 ? 1 : 2); }
__device__ __forceinline__ const float* xrow_of(const Args& a, int m) { return m < MCTX ? a.in[I_XP] + (size_t)m * D : a.in[I_XS] + (size_t)(m - MCTX) * D; }
__device__ __forceinline__ void store_bf4(bf16* p, f32x4 v) { v2u o; o.x = pk2(v[0], v[1]); o.y = pk2(v[2], v[3]); *(v2u*)p = o; }

__device__ __forceinline__ void phase_norm1(const Args& a, int gw, int NGW, int lane) {
    const float* MOD = (const float*)(a.ws + CTL_MOD); const float* bada = a.in[I_BADA]; const float* g = a.in[I_GPREMIX];
    bf16* H = (bf16*)(a.ws + WS_H);
    const int RPW = M / NGW;
    if (RPW * NGW == M && (MCTX % RPW) == 0 && (4096 % RPW) == 0) {
        const int m0 = gw * RPW, cv = cv_of(m0);
        f32x4 cc[4], sh[4];
#pragma unroll
        for (int j = 0; j < 4; ++j) { const int c = 4 * lane + 256 * j; cc[j] = *(const f32x4*)(g + c) * (modv(MOD, bada, cv, 1, c) + 1.f); sh[j] = modv(MOD, bada, cv, 0, c); }
        for (int m = m0; m < m0 + RPW; ++m) {
            const float* xr = xrow_of(a, m);
            f32x4 v[4]; float s = 0.f;
#pragma unroll
            for (int j = 0; j < 4; ++j) { v[j] = *(const f32x4*)(xr + 4 * lane + 256 * j); s += (v[j][0] * v[j][0] + v[j][1] * v[j][1]) + (v[j][2] * v[j][2] + v[j][3] * v[j][3]); }
            const float rstd = rsqrtf(wave_sum(s) * (1.f / D) + EPS);
#pragma unroll
            for (int j = 0; j < 4; ++j) store_bf4(H + (size_t)m * D + 4 * lane + 256 * j, v[j] * rstd * cc[j] + sh[j]);
        }
        return;
    }
    for (int m = gw; m < M; m += NGW) {
        const float* xr = xrow_of(a, m); const int cv = cv_of(m);
        f32x4 v[4]; float s = 0.f;
#pragma unroll
        for (int j = 0; j < 4; ++j) { v[j] = *(const f32x4*)(xr + 4 * lane + 256 * j); s += (v[j][0] * v[j][0] + v[j][1] * v[j][1]) + (v[j][2] * v[j][2] + v[j][3] * v[j][3]); }
        const float rstd = rsqrtf(wave_sum(s) * (1.f / D) + EPS);
#pragma unroll
        for (int j = 0; j < 4; ++j) { const int c = 4 * lane + 256 * j;
            const f32x4 gg = *(const f32x4*)(g + c), sh = modv(MOD, bada, cv, 0, c), sc = modv(MOD, bada, cv, 1, c);
            store_bf4(H + (size_t)m * D + c, v[j] * rstd * gg * (sc + 1.f) + sh); }
    }
}
__device__ __forceinline__ void phase_mid(const Args& a, int gw, int NGW, int lane, float* xout, bf16* H) {
    const float* MOD = (const float*)(a.ws + CTL_MOD); const float* bada = a.in[I_BADA];
    const float* gpm = a.in[I_GPOSTMIX]; const float* gpl = a.in[I_GPREMLP]; const float* OSS = (const float*)(a.ws + CTL_OSS);
    const float* out = a.out;
    for (int m = gw; m < M; m += NGW) {
        const float* xr = xrow_of(a, m); const int cv = cv_of(m);
        const float rstd_o = rsqrtf(OSS[m] * (1.f / D) + EPS);
        f32x4 v[4]; float s = 0.f;
#pragma unroll
        for (int j = 0; j < 4; ++j) { const int c = 4 * lane + 256 * j;
            const f32x4 o = *(const f32x4*)(out + (size_t)m * D + c), x = *(const f32x4*)(xr + c);
            const f32x4 g1 = modv(MOD, bada, cv, 2, c), gg = *(const f32x4*)(gpm + c);
            v[j] = x + g1 * (o * rstd_o * gg);
            *(f32x4*)(xout + (size_t)m * D + c) = v[j];
            s += (v[j][0] * v[j][0] + v[j][1] * v[j][1]) + (v[j][2] * v[j][2] + v[j][3] * v[j][3]); }
        const float rstd = rsqrtf(wave_sum(s) * (1.f / D) + EPS);
#pragma unroll
        for (int j = 0; j < 4; ++j) { const int c = 4 * lane + 256 * j;
            const f32x4 gg = *(const f32x4*)(gpl + c), sh = modv(MOD, bada, cv, 3, c), sc = modv(MOD, bada, cv, 4, c);
            store_bf4(H + (size_t)m * D + c, v[j] * rstd * gg * (sc + 1.f) + sh); }
    }
}
__device__ __forceinline__ void phase_final(const Args& a, int gw, int NGW, int lane, float* yout) {
    const float* MOD = (const float*)(a.ws + CTL_MOD); const float* bada = a.in[I_BADA];
    const float* gpm = a.in[I_GPOSTMLP]; const float* FSS = (const float*)(a.ws + CTL_FSS); const float* F = (const float*)(a.ws + WS_F); const float* out = a.out;
    for (int m = gw; m < M; m += NGW) {
        const int cv = cv_of(m); const float rstd_f = rsqrtf(FSS[m] * (1.f / D) + EPS);
#pragma unroll
        for (int j = 0; j < 4; ++j) { const int c = 4 * lane + 256 * j;
            const f32x4 f = *(const f32x4*)(F + (size_t)m * D + c), x1 = *(const f32x4*)(out + (size_t)m * D + c);
            const f32x4 g2 = modv(MOD, bada, cv, 5, c), gg = *(const f32x4*)(gpm + c);
            *(f32x4*)(yout + (size_t)m * D + c) = x1 + g2 * (f * rstd_f * gg); }
    }
}

__device__ __forceinline__ void panel_sync(unsigned* cnt) {
    asm volatile("s_waitcnt vmcnt(0)" ::: "memory");
    __syncthreads();
    if (threadIdx.x == 0) {
        __hip_atomic_fetch_add(cnt, 1u, __ATOMIC_RELAXED, __HIP_MEMORY_SCOPE_AGENT);
        unsigned sp = 0;
        while (__hip_atomic_load(cnt, __ATOMIC_RELAXED, __HIP_MEMORY_SCOPE_AGENT) < 4u) { __builtin_amdgcn_s_sleep(1); if (++sp > (1u << 22)) break; }
    }
    __syncthreads();
}
__device__ __forceinline__ float ld_agent(const float* p) { return __builtin_bit_cast(float, __hip_atomic_load((const unsigned*)p, __ATOMIC_RELAXED, __HIP_MEMORY_SCOPE_AGENT)); }
__device__ __forceinline__ float sumsq4(f32x4 v) { return (v[0] * v[0] + v[1] * v[1]) + (v[2] * v[2] + v[3] * v[3]); }
template <int MODE> struct EpiFused {
    static constexpr bool PERM = true, AFTER_DRAIN = true, HOOK = false;
    float* out; const float* xp; const float* xs; bf16* H; float* SS1; float* SS2; unsigned* cnt1; unsigned* cnt2;
    const float* MOD; const float* bada; const float* gpost; const float* gpre;
    __device__ __forceinline__ void fused(f32x4 (&acc)[2][2][4][2], const pg8::Unit& u, int wr, int wc, int fr, int fq, LAS unsigned char*, int, int) const {
        const int row0 = u.pm * 256 + wr * 64 + fr, col0 = u.pn * 256 + wc * 32 + 8 * fq;
        const int cv = u.pm < 32 ? 0 : (u.pm < 48 ? 1 : 2);
#pragma unroll
        for (int ai = 0; ai < 2; ++ai)
#pragma unroll
            for (int m = 0; m < 4; ++m) {
                float ss = (sumsq4(acc[ai][0][m][0]) + sumsq4(acc[ai][0][m][1])) + (sumsq4(acc[ai][1][m][0]) + sumsq4(acc[ai][1][m][1]));
                ss += __shfl_xor(ss, 16); ss += __shfl_xor(ss, 32);
                if (fq == 0) atomicAdd(SS1 + row0 + ai * 128 + m * 16, ss);
            }
        panel_sync(cnt1 + 64 * u.pm);
        f32x4 ga[2][2];
#pragma unroll
        for (int bj = 0; bj < 2; ++bj)
#pragma unroll
            for (int n = 0; n < 2; ++n) { const int c = col0 + bj * 128 + 4 * n; ga[bj][n] = modv(MOD, bada, cv, MODE == 6 ? 2 : 5, c) * *(const f32x4*)(gpost + c); }
        float rs1[2][4];
#pragma unroll
        for (int ai = 0; ai < 2; ++ai)
#pragma unroll
            for (int m = 0; m < 4; ++m) rs1[ai][m] = ld_agent(SS1 + row0 + ai * 128 + m * 16);
#pragma unroll
        for (int ai = 0; ai < 2; ++ai)
#pragma unroll
            for (int m = 0; m < 4; ++m) {
                const int row = row0 + ai * 128 + m * 16;
                const float rstd = rsqrtf(rs1[ai][m] * (1.f / D) + EPS);
                const float* xrow = MODE == 6 ? (row < MCTX ? xp + (size_t)row * D : xs + (size_t)(row - MCTX) * D) : out + (size_t)row * D;
                float ss = 0.f;
#pragma unroll
                for (int bj = 0; bj < 2; ++bj)
#pragma unroll
                    for (int n = 0; n < 2; ++n) { const int c = col0 + bj * 128 + 4 * n;
                        const f32x4 v = *(const f32x4*)(xrow + c) + ga[bj][n] * (acc[ai][bj][m][n] * rstd);
                        *(f32x4*)(out + (size_t)row * D + c) = v; acc[ai][bj][m][n] = v; ss += sumsq4(v); }
                if constexpr (MODE == 6) { ss += __shfl_xor(ss, 16); ss += __shfl_xor(ss, 32); if (fq == 0) atomicAdd(SS2 + row, ss); }
            }
        if constexpr (MODE == 6) {
            panel_sync(cnt2 + 64 * u.pm);
            f32x4 cc[2][2], sh[2][2];
#pragma unroll
            for (int bj = 0; bj < 2; ++bj)
#pragma unroll
                for (int n = 0; n < 2; ++n) { const int c = col0 + bj * 128 + 4 * n; cc[bj][n] = *(const f32x4*)(gpre + c) * (modv(MOD, bada, cv, 4, c) + 1.f); sh[bj][n] = modv(MOD, bada, cv, 3, c); }
            float rs2[2][4];
#pragma unroll
            for (int ai = 0; ai < 2; ++ai)
#pragma unroll
                for (int m = 0; m < 4; ++m) rs2[ai][m] = ld_agent(SS2 + row0 + ai * 128 + m * 16);
#pragma unroll
            for (int ai = 0; ai < 2; ++ai)
#pragma unroll
                for (int m = 0; m < 4; ++m) {
                    const int row = row0 + ai * 128 + m * 16;
                    const float rstd = rsqrtf(rs2[ai][m] * (1.f / D) + EPS);
#pragma unroll
                    for (int bj = 0; bj < 2; ++bj) {
                        const f32x4 h0 = acc[ai][bj][m][0] * rstd * cc[bj][0] + sh[bj][0], h1 = acc[ai][bj][m][1] * rstd * cc[bj][1] + sh[bj][1];
                        v4u w; w.x = pg8::cvt_pk_bf16(h0[0], h0[1]); w.y = pg8::cvt_pk_bf16(h0[2], h0[3]); w.z = pg8::cvt_pk_bf16(h1[0], h1[1]); w.w = pg8::cvt_pk_bf16(h1[2], h1[3]);
                        *(v4u*)(H + (size_t)row * D + col0 + bj * 128) = w; }
                }
        }
    }
};

constexpr int YLD = 2048;
constexpr int SG_W = 0, SG_V = 34816, SG_U = 69632, SG_ST = 272;
__device__ __forceinline__ void sgu_load(const bf16* GV, const bf16* GU, const float* VSS, int item, int tid, v4u (&rv)[4], v4u (&ru)[4], float (&rss)[4]) {
    const int g = item & 7, t0 = (item >> 3) * 128;
#pragma unroll
    for (int i = 0; i < 4; ++i) { const int idx = tid + i * NTHR, p = idx >> 4, c8 = (idx & 15) * 8;
        rv[i] = *(const v4u*)(GV + (size_t)(t0 + p) * D + g * 128 + c8); ru[i] = *(const v4u*)(GU + (size_t)(t0 + p) * YLD + g * 128 + c8); rss[i] = VSS[t0 + p]; }
}
__device__ __forceinline__ void phase_sgu(const Args& a, LAS unsigned char* lds, int tid, int wave, int lane, bf16* YG) {
    const bf16* GV = (const bf16*)a.out; const bf16* GU = (const bf16*)(a.ws + WS_GU); const bf16* WSP = (const bf16*)(a.ws + WS_WSP);
    const float* VSS = (const float*)(a.ws + CTL_VSS); const float* gsgu = a.in[I_GSGU]; const float* bsp = a.in[I_BSP];
    const int fr = lane & 15, fq = lane >> 4;
    int last_g = -1;
    v4u rv[4], ru[4]; float rss[4];
    for (int item = blockIdx.x; item < 128 * 8; item += gridDim.x) {
        const int g = item & 7, n = item >> 3, t0 = n * 128;
        if (g != last_g) {
#pragma unroll
            for (int i = 0; i < 4; ++i) { const int idx = tid + i * NTHR, row = idx >> 4, c16 = idx & 15;
                *(LAS v4u*)(lds + SG_W + row * SG_ST + c16 * 16) = *(const v4u*)(WSP + (size_t)(g * 128 + row) * 128 + c16 * 8); }
            last_g = g;
        }
        if (item == (int)blockIdx.x) sgu_load(GV, GU, VSS, item, tid, rv, ru, rss);
#pragma unroll
        for (int i = 0; i < 4; ++i) {
            const int idx = tid + i * NTHR, p = idx >> 4, c8 = (idx & 15) * 8;
            const v4u r = rv[i]; const v4u uu = ru[i];
            const float rs = rsqrtf(rss[i] * (1.f / D) + EPS);
            const f32x4 g0 = *(const f32x4*)(gsgu + g * 128 + c8) * rs, g1 = *(const f32x4*)(gsgu + g * 128 + c8 + 4) * rs;
            v4u o; o.x = pk2(bflo(r.x) * g0[0], bfhi(r.x) * g0[1]); o.y = pk2(bflo(r.y) * g0[2], bfhi(r.y) * g0[3]);
            o.z = pk2(bflo(r.z) * g1[0], bfhi(r.z) * g1[1]); o.w = pk2(bflo(r.w) * g1[2], bfhi(r.w) * g1[3]);
            *(LAS v4u*)(lds + SG_V + p * SG_ST + c8 * 2) = o;
            *(LAS v4u*)(lds + SG_U + p * SG_ST + c8 * 2) = uu;
        }
        if (item + (int)gridDim.x < 128 * 8) sgu_load(GV, GU, VSS, item + gridDim.x, tid, rv, ru, rss);
        float bias8[8];
#pragma unroll
        for (int qb = 0; qb < 8; ++qb) bias8[qb] = bsp[g * 128 + qb * 16 + fr];
        __syncthreads();
        bf16x8 af[4];
#pragma unroll
        for (int ks = 0; ks < 4; ++ks) {
            unsigned short e[8];
#pragma unroll
            for (int j = 0; j < 8; ++j) e[j] = *(const LAS unsigned short*)(lds + SG_V + (ks * 32 + fq * 8 + j) * SG_ST + (wave * 16 + fr) * 2);
            v4u o; o.x = e[0] | ((unsigned)e[1] << 16); o.y = e[2] | ((unsigned)e[3] << 16); o.z = e[4] | ((unsigned)e[5] << 16); o.w = e[6] | ((unsigned)e[7] << 16);
            af[ks] = __builtin_bit_cast(bf16x8, o);
        }
#pragma unroll
        for (int qb = 0; qb < 8; ++qb) {
            const int q = qb * 16 + fr;
            f32x4 acc = {0.f, 0.f, 0.f, 0.f};
#pragma unroll
            for (int ks = 0; ks < 4; ++ks) { const bf16x8 b = *(const LAS bf16x8*)(lds + SG_W + q * SG_ST + (ks * 32 + fq * 8) * 2);
                acc = __builtin_amdgcn_mfma_f32_16x16x32_bf16(af[ks], b, acc, 0, 0, 0); }
            const float bias = bias8[qb];
            LAS v2u* up = (LAS v2u*)(lds + SG_U + q * SG_ST + (wave * 16 + fq * 4) * 2);
            const v2u gu = *up;
            v2u y; y.x = pk2(bflo(gu.x) * (acc[0] + bias), bfhi(gu.x) * (acc[1] + bias)); y.y = pk2(bflo(gu.y) * (acc[2] + bias), bfhi(gu.y) * (acc[3] + bias));
            *up = y;
        }
        __syncthreads();
#pragma unroll
        for (int i = 0; i < 4; ++i) { const int idx = tid + i * NTHR, p = idx >> 4, c8 = (idx & 15) * 8;
            *(v4u*)(YG + (size_t)(t0 + p) * YLD + g * 128 + c8) = *(const LAS v4u*)(lds + SG_U + p * SG_ST + c8 * 2); }
    }
}

constexpr int RG_WB = 0, RG_XA = 32768, RG_XF = 51200, RG_AGL = 86016, RG_GCL = 94208, RG_CWL = 96256, RG_CARL = 97536;
__device__ __forceinline__ void rg_load_raw(const bf16* XR, int item, int tid, v4u (&xr)[2][4]) {
    const int h = item & 15, t0 = (item >> 4) * 128;
    const int seq_lo = t0 < MCTX ? (t0 & ~255) : MCTX + ((t0 - MCTX) & ~4095), seq_hi = seq_lo + (t0 < MCTX ? 256 : 4096);
#pragma unroll
    for (int i = 0; i < 2; ++i) {
        const int idx = tid + i * NTHR, tk = idx >> 3, chb = h * 64 + (idx & 7) * 8;
#pragma unroll
        for (int tap = 0; tap < 4; ++tap) {
            const int t = t0 + tk + tap - 2; const bool ok = (t >= seq_lo) && (t < seq_hi); const int tc = ok ? t : t0;
            xr[i][tap] = *(const v4u*)(XR + (size_t)tc * D + chb);
        }
    }
}
template <int MODE> __device__ __forceinline__ int rg_item(int k) {
    const int h = blockIdx.x & 15, q = blockIdx.x >> 4;
    int tt;
    if (MODE == 1) tt = k < 4 ? 2 * (q + 16 * (k >> 1)) + (k & 1) : 64 + q + 16 * (k - 4);
    else tt = k < 2 ? 2 * (q + 16 * k) + 1 : 64 + q + 16 * (k - 2);
    return tt * 16 + h;
}
template <int MODE>
__device__ __forceinline__ void phase_rg(const Args& a, LAS unsigned char* lds, int tid, int wave, int lane, bf16* YR) {
    const bf16* XR = (const bf16*)((const unsigned char*)a.out + 32 * MiB); const bf16* GGR = (const bf16*)(a.ws + WS_GU) + D;
    const float* GC = (const float*)(a.ws + WS_GC); const bf16* WG = (const bf16*)(a.ws + WS_WG);
    f32x2* AGG = (f32x2*)(a.ws + WS_AGG); const float* CAR = (const float*)(a.ws + WS_CAR); float* nstate = a.out + (size_t)M * D;
    const float* convw = a.in[I_CONVW]; const float* convb = a.in[I_CONVB];
    const int fr = lane & 15, fq = lane >> 4;
    int last_h = -1;
    v4u xr[2][4];
    constexpr int NK = MODE == 1 ? 8 : 6;
    rg_load_raw(XR, rg_item<MODE>(0), tid, xr);
    if constexpr (MODE == 1) {
        const float* st0 = a.in[I_STATE];
#pragma unroll 1
        for (int kk = tid >> 7; kk < 8; kk += 4) {
            const int it = rg_item<1>(kk);
            {
                const int d = (tid >> 6) & 1, cl = tid & 63, h = it & 15, tt = it >> 4;
                float hc;
                if (tt < 64) {
                    const f32x2 g = AGG[((size_t)((tt | 1) * 16 + h) * 2 + 1) * 64 + cl];
                    hc = ((tt & 1) == 0 && d == 1) ? g[1] : 0.f;
                } else {
                    const int b = (tt - 64) >> 5, j = (tt - 64) & 31, tt0 = 64 + b * 32;
                    f32x2 ag[31];
#pragma unroll
                    for (int sI = 0; sI < 31; ++sI) { const int ti = d ? 31 - sI : sI; ag[sI] = AGG[((size_t)((tt0 + ti) * 16 + h) * 2 + d) * 64 + cl]; }
                    hc = st0[(size_t)b * 2048 + d * 1024 + h * 64 + cl];
#pragma unroll
                    for (int sI = 0; sI < 31; ++sI) { const int ti = d ? 31 - sI : sI; if (d ? (ti > j) : (ti < j)) hc = ag[sI][0] * hc + ag[sI][1]; }
                }
                *(LAS float*)(lds + RG_CARL + ((kk * 2 + d) * 64 + cl) * 4) = hc;
            }
        }
        __syncthreads();
    }
    for (int kitem = 0; kitem < NK; ++kitem) {
        const int item = rg_item<MODE>(kitem);
        const int h = item & 15, tt = item >> 4, t0 = tt * 128;
        if (h != last_h) {
#pragma unroll
            for (int i = 0; i < 4; ++i) { const int o = (tid + i * NTHR) * 16; *(LAS v4u*)(lds + RG_WB + o) = *(const v4u*)((const unsigned char*)WG + (size_t)h * 32768 + o); }
            if (tid < 128) *(LAS f32x4*)(lds + RG_GCL + tid * 16) = *(const f32x4*)(GC + (size_t)((tid >> 6) * D + h * 64 + (tid & 63)) * 4);
            if (tid < 80) { const int row = tid >> 4, c4 = (tid & 15) * 4;
                *(LAS f32x4*)(lds + RG_CWL + (row * 64 + c4) * 4) = *(const f32x4*)((row < 4 ? convw + row * D : convb) + h * 64 + c4); }
            last_h = h;
            __syncthreads();
        }
        const int seq_lo = t0 < MCTX ? (t0 & ~255) : MCTX + ((t0 - MCTX) & ~4095), seq_hi = seq_lo + (t0 < MCTX ? 256 : 4096);
        float car[2][4]; v4u ggr[2];
        if constexpr (MODE == 1) {
#pragma unroll
            for (int d = 0; d < 2; ++d)
#pragma unroll
                for (int cb = 0; cb < 4; ++cb) car[d][cb] = *(const LAS float*)(lds + RG_CARL + ((kitem * 2 + d) * 64 + cb * 16 + fr) * 4);
#pragma unroll
            for (int i = 0; i < 2; ++i) { const int idx = tid + i * NTHR; ggr[i] = *(const v4u*)(GGR + (size_t)(t0 + (idx >> 3)) * YLD + h * 64 + (idx & 7) * 8); }
        }
        {
            const int c8 = (tid & 7) * 8;
            f32x4 w0[4], w1[4];
#pragma unroll
            for (int tap = 0; tap < 4; ++tap) { w0[tap] = *(const LAS f32x4*)(lds + RG_CWL + (tap * 64 + c8) * 4); w1[tap] = *(const LAS f32x4*)(lds + RG_CWL + (tap * 64 + c8 + 4) * 4); }
            const f32x4 b0 = *(const LAS f32x4*)(lds + RG_CWL + (4 * 64 + c8) * 4), b1 = *(const LAS f32x4*)(lds + RG_CWL + (4 * 64 + c8 + 4) * 4);
#pragma unroll
            for (int i = 0; i < 2; ++i) {
                const int idx = tid + i * NTHR, tk = idx >> 3, cg8 = idx & 7;
                f32x4 x0 = b0, x1 = b1;
#pragma unroll
                for (int tap = 0; tap < 4; ++tap) { const int t = t0 + tk + tap - 2; const bool ok = (t >= seq_lo) && (t < seq_hi);
                    v4u r = xr[i][tap]; r.x = ok ? r.x : 0u; r.y = ok ? r.y : 0u; r.z = ok ? r.z : 0u; r.w = ok ? r.w : 0u;
                    x0[0] += w0[tap][0] * bflo(r.x); x0[1] += w0[tap][1] * bfhi(r.x); x0[2] += w0[tap][2] * bflo(r.y); x0[3] += w0[tap][3] * bfhi(r.y);
                    x1[0] += w1[tap][0] * bflo(r.z); x1[1] += w1[tap][1] * bfhi(r.z); x1[2] += w1[tap][2] * bflo(r.w); x1[3] += w1[tap][3] * bfhi(r.w); }
                v4u o; o.x = pk2(x0[0], x0[1]); o.y = pk2(x0[2], x0[3]); o.z = pk2(x1[0], x1[1]); o.w = pk2(x1[2], x1[3]);
                *(LAS v4u*)(lds + RG_XA + tk * 144 + cg8 * 16) = o;
                *(LAS f32x4*)(lds + RG_XF + (tk * 68 + cg8 * 8) * 4) = x0; *(LAS f32x4*)(lds + RG_XF + (tk * 68 + cg8 * 8 + 4) * 4) = x1;
            }
        }
        if (kitem + 1 < NK) rg_load_raw(XR, rg_item<MODE>(kitem + 1), tid, xr);
        __syncthreads();
        const int tokb = wave * 16;
        bf16x8 afr[2];
#pragma unroll
        for (int ks = 0; ks < 2; ++ks) afr[ks] = *(const LAS bf16x8*)(lds + RG_XA + (tokb + fr) * 144 + (ks * 32 + fq * 8) * 2);
        f32x4 gcv[2][4];
#pragma unroll
        for (int d = 0; d < 2; ++d)
#pragma unroll
            for (int cb = 0; cb < 4; ++cb) gcv[d][cb] = *(const LAS f32x4*)(lds + RG_GCL + (d * 64 + cb * 16 + fr) * 16);
        float av[2][4][4], bv[2][4][4], Ap[2][4], Hp[2][4];
        const bool ctx = t0 < MCTX;
#pragma unroll
        for (int d = 0; d < 2; ++d) {
            if (MODE == 0 && ctx && d != (tt & 1)) continue;
#pragma unroll
            for (int cb = 0; cb < 4; ++cb) {
                const f32x4 gc = gcv[d][cb];
                f32x4 ar = {0.f, 0.f, 0.f, 0.f}, ai = {0.f, 0.f, 0.f, 0.f};
#pragma unroll
                for (int ks = 0; ks < 2; ++ks) {
                    const bf16x8 b0 = *(const LAS bf16x8*)(lds + RG_WB + (((0 * 8 + d * 4 + cb) * 2 + ks) * 64 + lane) * 16);
                    const bf16x8 b1 = *(const LAS bf16x8*)(lds + RG_WB + (((1 * 8 + d * 4 + cb) * 2 + ks) * 64 + lane) * 16);
                    ar = __builtin_amdgcn_mfma_f32_16x16x32_bf16(afr[ks], b0, ar, 0, 0, 0);
                    ai = __builtin_amdgcn_mfma_f32_16x16x32_bf16(afr[ks], b1, ai, 0, 0, 0);
                }
#pragma unroll
                for (int r = 0; r < 4; ++r) {
                    const float xcv = *(const LAS float*)(lds + RG_XF + ((tokb + fq * 4 + r) * 68 + cb * 16 + fr) * 4);
                    const float rr = __builtin_amdgcn_rcpf(__builtin_fmaf(__builtin_amdgcn_exp2f(ar[r]), gc[0], 1.f)), ii = __builtin_amdgcn_rcpf(__builtin_fmaf(__builtin_amdgcn_exp2f(ai[r]), gc[1], 1.f));
                    const float aa = __builtin_amdgcn_exp2f(rr * gc[2]);
                    const float om = fmaxf(1.f - aa * aa, 1e-12f);
                    av[d][cb][r] = aa; bv[d][cb][r] = __builtin_amdgcn_sqrtf(om) * ii * xcv;
                }
                float A = 1.f, Hh = 0.f;
#pragma unroll
                for (int rr = 0; rr < 4; ++rr) { const int r = d ? 3 - rr : rr; Hh = av[d][cb][r] * Hh + bv[d][cb][r]; A *= av[d][cb][r]; }
                float Aw = 1.f, Hw = 0.f, Apl = 1.f, Hpl = 0.f;
#pragma unroll
                for (int gg = 0; gg < 4; ++gg) { const int g = d ? 3 - gg : gg;
                    const float Ag = __shfl(A, g * 16 + fr), Hg = __shfl(Hh, g * 16 + fr);
                    if (g == fq) { Apl = Aw; Hpl = Hw; }
                    Hw = Ag * Hw + Hg; Aw *= Ag; }
                Ap[d][cb] = Apl; Hp[d][cb] = Hpl;
                if (fq == 0) *(LAS f32x2*)(lds + RG_AGL + ((wave * 2 + d) * 64 + cb * 16 + fr) * 8) = (f32x2){Aw, Hw};
            }
        }
        __syncthreads();
        if constexpr (MODE == 0) {
            if (tid < 128 && !(ctx && (tid >> 6) != (tt & 1))) {
                const int d = tid >> 6, cl = tid & 63; float A = 1.f, Hh = 0.f;
#pragma unroll
                for (int ww = 0; ww < 8; ++ww) { const int w2 = d ? 7 - ww : ww; const f32x2 sg = *(const LAS f32x2*)(lds + RG_AGL + ((w2 * 2 + d) * 64 + cl) * 8); Hh = sg[0] * Hh + sg[1]; A *= sg[0]; }
                AGG[((size_t)(tt * 16 + h) * 2 + d) * 64 + cl] = (f32x2){A, Hh};
            }
        } else {
            if (ctx && (tt & 1) == 0 && tid < 64) {
                float Hh = 0.f;
#pragma unroll
                for (int w2 = 0; w2 < 8; ++w2) { const f32x2 sg = *(const LAS f32x2*)(lds + RG_AGL + ((w2 * 2 + 0) * 64 + tid) * 8); Hh = sg[0] * Hh + sg[1]; }
                *(LAS float*)(lds + RG_CARL + (((kitem + 1) * 2 + 0) * 64 + tid) * 4) = Hh;
            }
            float hs[4][4];
#pragma unroll
            for (int cb = 0; cb < 4; ++cb)
#pragma unroll
                for (int r = 0; r < 4; ++r) hs[cb][r] = 0.f;
#pragma unroll
            for (int d = 0; d < 2; ++d)
#pragma unroll
                for (int cb = 0; cb < 4; ++cb) {
                    const int cl = cb * 16 + fr;
                    float hin = car[d][cb];
                    f32x2 sg[8];
#pragma unroll
                    for (int w2 = 0; w2 < 8; ++w2) sg[w2] = *(const LAS f32x2*)(lds + RG_AGL + ((w2 * 2 + d) * 64 + cl) * 8);
#pragma unroll
                    for (int ww = 0; ww < 8; ++ww) { const int w2 = d ? 7 - ww : ww; if (d ? (w2 > wave) : (w2 < wave)) hin = sg[w2][0] * hin + sg[w2][1]; }
                    float hh = Ap[d][cb] * hin + Hp[d][cb];
#pragma unroll
                    for (int rr = 0; rr < 4; ++rr) { const int r = d ? 3 - rr : rr; hh = av[d][cb][r] * hh + bv[d][cb][r]; hs[cb][r] += hh; }
                    if (ctx && (tt & 1) == (d ? 0 : 1) && wave == (d ? 0 : 7) && fq == (d ? 0 : 3)) nstate[(size_t)(tt >> 1) * 2048 + d * 1024 + h * 64 + cl] = hh;
                }
#pragma unroll
            for (int cb = 0; cb < 4; ++cb)
#pragma unroll
                for (int r = 0; r < 4; ++r) *(LAS float*)(lds + RG_XF + ((tokb + fq * 4 + r) * 68 + cb * 16 + fr) * 4) = hs[cb][r];
            __syncthreads();
#pragma unroll
            for (int i = 0; i < 2; ++i) {
                const int idx = tid + i * NTHR, tk = idx >> 3, cg8 = idx & 7;
                const f32x4 y0 = *(const LAS f32x4*)(lds + RG_XF + (tk * 68 + cg8 * 8) * 4), y1 = *(const LAS f32x4*)(lds + RG_XF + (tk * 68 + cg8 * 8 + 4) * 4);
                const v4u g = ggr[i];
                v4u o; o.x = pk2(y0[0] * bflo(g.x), y0[1] * bfhi(g.x)); o.y = pk2(y0[2] * bflo(g.y), y0[3] * bfhi(g.y));
                o.z = pk2(y1[0] * bflo(g.z), y1[1] * bfhi(g.z)); o.w = pk2(y1[2] * bflo(g.w), y1[3] * bfhi(g.w));
                *(v4u*)(YR + (size_t)(t0 + tk) * YLD + h * 64 + cg8 * 8) = o;
            }
        }
        if constexpr (MODE == 1) __syncthreads();
    }
}

template <int NT>
__device__ __forceinline__ float carry_chain(const f32x2* AGG, float* CAR, int tt0, int h, int d, int cl, float h0) {
    f32x2 ag[NT];
#pragma unroll
    for (int i = 0; i < NT; ++i) ag[i] = AGG[((size_t)((tt0 + i) * 16 + h) * 2 + d) * 64 + cl];
    float hc = h0;
#pragma unroll
    for (int ii = 0; ii < NT; ++ii) { const int i = d ? NT - 1 - ii : ii;
        CAR[((size_t)((tt0 + i) * 16 + h) * 2 + d) * 64 + cl] = hc; hc = ag[i][0] * hc + ag[i][1]; }
    return hc;
}
__device__ __forceinline__ void phase_carry(const Args& a, int gw, int NGW, int lane) {
    const f32x2* AGG = (const f32x2*)(a.ws + WS_AGG); float* CAR = (float*)(a.ws + WS_CAR);
    for (int wi = gw; wi < 34 * 2 * 16; wi += NGW) {
        const int s = wi >> 5, d = (wi >> 4) & 1, h = wi & 15, ch = h * 64 + lane;
        if (s < 32) {
            const size_t i0 = ((size_t)((2 * s) * 16 + h) * 2 + d) * 64 + lane, i1 = ((size_t)((2 * s + 1) * 16 + h) * 2 + d) * 64 + lane;
            if (d == 0) { CAR[i0] = 0.f; CAR[i1] = AGG[i0][1]; }
            else { CAR[i1] = 0.f; CAR[i0] = AGG[i1][1]; }
        } else {
            const int b = s - 32; const float h0 = a.in[I_STATE][(size_t)b * 2048 + d * 1024 + ch];
            if (d == 0) (void)carry_chain<32>(AGG, CAR, 64 + b * 32, h, 0, lane, h0);
            else (void)carry_chain<32>(AGG, CAR, 64 + b * 32, h, 1, lane, h0);
        }
    }
}

#define RLX_AGENT __ATOMIC_RELAXED, __HIP_MEMORY_SCOPE_AGENT
#define XB_TMO      128
#define XB_XCNT(j)  (256  + 64 * (j))
#define XB_XSUB(j)  (1280 + 64 * (j))
#define XB_XGEN(j)  (2304 + 64 * (j))
#define XB_TOP      3328
#define XB_TOPGEN   3392
#define XCD_BAR_WORDS 3456
#define XB_SPIN_CAP (1u << 18)

__device__ __forceinline__ unsigned xb_ld(unsigned* p)              { return __hip_atomic_load(p, __ATOMIC_RELAXED, __HIP_MEMORY_SCOPE_AGENT); }
__device__ __forceinline__ unsigned xb_add(unsigned* p, unsigned v) { return __hip_atomic_fetch_add(p, v, __ATOMIC_RELAXED, __HIP_MEMORY_SCOPE_AGENT); }
__device__ __forceinline__ unsigned xb_xcc_id() { return (unsigned)__builtin_amdgcn_s_getreg((3 << 11) | 20) & 0xFu; }
#define XB_SPIN(cond, bar) do { unsigned _sp = 0; while (cond) { __builtin_amdgcn_s_sleep(1); \
    if ((++_sp & 255u) == 0u) { if (xb_ld(&(bar)[XB_TMO])) break; if (_sp > XB_SPIN_CAP) { atomicAdd(&(bar)[XB_TMO], 1u); break; } } } } while (0)

struct XcdBarrier {
    unsigned* bar; unsigned x;
    volatile LAS unsigned* st;
};

__device__ __forceinline__ XcdBarrier xcd_barrier_post(unsigned* bar, volatile LAS unsigned* st) {
    XcdBarrier b; b.bar = bar; b.x = xb_xcc_id(); b.st = st;
    if (threadIdx.x == 0) (void)xb_add(&bar[XB_XCNT(b.x)], 1u);
    return b;
}
__device__ __forceinline__ void xcd_barrier_complete(unsigned* bar, unsigned x, unsigned& nloc, unsigned& nx) {
    const unsigned G = gridDim.x * gridDim.y * gridDim.z;
    unsigned sum, cnt, mine, sp = 0u;
    for (;;) {
        sum = 0u; cnt = 0u; mine = 0u;
#pragma unroll
        for (unsigned j = 0; j < 16; ++j) { const unsigned c = xb_ld(&bar[XB_XCNT(j)]); sum += c; cnt += (c > 0u) ? 1u : 0u; mine = (j == x) ? c : mine; }
        if (sum == G) break;
        __builtin_amdgcn_s_sleep(1);
        if ((++sp & 255u) == 0u) { if (xb_ld(&bar[XB_TMO])) break; if (sp > XB_SPIN_CAP) { atomicAdd(&bar[XB_TMO], 1u); break; } }
    }
    nloc = mine > 0u ? mine : 1u; nx = cnt > 0u ? cnt : 1u;
}

__device__ __forceinline__ void xcd_barrier(const XcdBarrier& b) {
    asm volatile("s_waitcnt vmcnt(0)" ::: "memory");
    __syncthreads();
    if (threadIdx.x == 0) {
        unsigned* bar = b.bar;
        __builtin_amdgcn_s_waitcnt(0);
        unsigned nloc = b.st[0], nx = b.st[1];
        if (nloc == 0u) { xcd_barrier_complete(bar, b.x, nloc, nx); b.st[0] = nloc; b.st[1] = nx; }
        const unsigned old = xb_add(&bar[XB_XSUB(b.x)], 1u);
        const unsigned gen = old / nloc;
        if (old + 1u == (gen + 1u) * nloc) {
            __builtin_amdgcn_fence(__ATOMIC_RELEASE, "agent");
            asm volatile("s_waitcnt vmcnt(0)" ::: "memory");
            const unsigned og = xb_add(&bar[XB_TOP], 1u);
            const unsigned tg = og / nx;
            if (og + 1u == (tg + 1u) * nx) xb_add(&bar[XB_TOPGEN], 1u);
            else XB_SPIN(xb_ld(&bar[XB_TOPGEN]) == tg, bar);
            __builtin_amdgcn_fence(__ATOMIC_ACQUIRE, "agent");
            xb_add(&bar[XB_XGEN(b.x)], 1u);
            asm volatile("s_waitcnt vmcnt(0)" ::: "memory");
        } else {
            XB_SPIN(xb_ld(&bar[XB_XGEN(b.x)]) == gen, bar);
            __builtin_amdgcn_fence(__ATOMIC_ACQUIRE, "agent");
            asm volatile("s_waitcnt vmcnt(0)" ::: "memory");
        }
    }
    __syncthreads();
}

__global__ void __launch_bounds__(NTHR, 2) fwd_megakernel(Args a) {
    extern __shared__ __attribute__((aligned(16))) unsigned char lds_raw[];
    LAS unsigned char* lds = (LAS unsigned char*)lds_raw;
    const int tid = threadIdx.x, lane = tid & 63, wave = __builtin_amdgcn_readfirstlane(tid >> 6);
    const int G = gridDim.x, gw = blockIdx.x * NWAVES + wave, NGW = G * NWAVES;
    unsigned char* ws = a.ws;
    const int lo = a.ph_lo, hi = a.ph_hi;
    volatile LAS unsigned* bst = (volatile LAS unsigned*)(lds + LDS_BAR_OFF);
    if (tid < 2) bst[tid] = 0u;
    __syncthreads();
    XcdBarrier bar = xcd_barrier_post((unsigned*)(ws + WS_CTL), bst);
#define IN(k) (lo <= (k) && (k) < hi)
#define SEAM(k) do { if (IN(k) && IN((k) + 1)) { xcd_barrier(bar); if (DUP >> 12 & 1) xcd_barrier(bar); } } while (0)
    float* const DUMSS = (float*)(ws + 1 * MiB + 512 * 1024);
#define REP(k) for (int rep_ = ((DUP >> (k)) & 1); rep_ >= 0; --rep_)
#define ISDUP (rep_ > 0)
    if (IN(0)) REP(0) phase_prep(a, lds, gw, NGW, wave, lane, ISDUP ? (float*)(ws + 1 * MiB + 256 * 1024) : (float*)(ws + CTL_MOD));
    SEAM(0);
    if (IN(1)) REP(1) phase_norm1(a, gw, NGW, lane);
    SEAM(1);
    if (IN(2)) REP(2) {
        pg8::Gemm g{(const pg8::bf16_t*)(ws + WS_H), (const pg8::bf16_t*)(ws + WS_WIN), M, INC, D}; pg8::StaticOrder S; S.init(M, INC, G, (int)blockIdx.x, WG_IN);
        pg8::Epi<1> E{nullptr, nullptr, nullptr, ISDUP ? DUMSS : (float*)(ws + CTL_VSS), D, (bf16*)(ws + WS_GU), (bf16*)a.out, (bf16*)((unsigned char*)a.out + 32 * MiB), (bf16*)(ws + WS_GU) + D, (bf16*)(ws + WS_SGA), (bf16*)(ws + WS_SGB)};
        pg8::gemm_phase<pg8::Epi<1>, pg8::StaticOrder, true, true>(lds, g, S, E);
    }
    SEAM(2);
    if (IN(3)) REP(3) { phase_rg<0>(a, lds, tid, wave, lane, nullptr); phase_sgu(a, lds, tid, wave, lane, ISDUP ? (bf16*)(ws + WS_F) : (bf16*)(ws + WS_GU)); }
    SEAM(3);
    if (IN(5)) REP(5) phase_rg<1>(a, lds, tid, wave, lane, ISDUP ? (bf16*)(ws + WS_F) + D : (bf16*)(ws + WS_GU) + D);
    SEAM(5);
    if (IN(6)) REP(6) {
        pg8::Gemm g{(const pg8::bf16_t*)(ws + WS_GU), (const pg8::bf16_t*)(ws + WS_WBG), M, D, 2 * D}; pg8::StaticOrder S; S.init(M, D, G, (int)blockIdx.x);
        pg8::EpiMerge E{(bf16*)(ws + WS_H), (const bf16*)(ws + WS_SGA), (const bf16*)(ws + WS_SGB)};
        pg8::gemm_phase<pg8::EpiMerge, pg8::StaticOrder, false, true>(lds, g, S, E);
    }
    SEAM(6);
    if (IN(7)) {
        pg8::Gemm g{(const pg8::bf16_t*)(ws + WS_H), (const pg8::bf16_t*)(ws + WS_WOUT), M, D, D}; pg8::StaticOrder S; S.init(M, D, G, (int)blockIdx.x);
        EpiFused<6> E{a.out, a.in[I_XP], a.in[I_XS], (bf16*)(ws + WS_H), (float*)(ws + CTL_OSS), (float*)(ws + CTL_XSS), (unsigned*)(ws + CTL_CNT), (unsigned*)(ws + CTL_CNT + 16384),
                      (const float*)(ws + CTL_MOD), a.in[I_BADA], a.in[I_GPOSTMIX], a.in[I_GPREMLP]};
        pg8::gemm_phase<EpiFused<6>, pg8::StaticOrder, false, true>(lds, g, S, E);
    }
    SEAM(7);
    if (IN(8)) REP(8) {
        pg8::Gemm g{(const pg8::bf16_t*)(ws + WS_H), (const pg8::bf16_t*)(ws + WS_WFF1), M, FF, D}; pg8::StaticOrder S; S.init(M, FF, G, (int)blockIdx.x, WG_FF1);
        pg8::Epi<5> E{(bf16*)(ws + WS_F1), nullptr, nullptr, nullptr, FF, nullptr, nullptr, nullptr, nullptr, nullptr, nullptr};
        pg8::gemm_phase<pg8::Epi<5>, pg8::StaticOrder, true, true>(lds, g, S, E);
    }
    SEAM(8);
    if (IN(9)) {
        pg8::Gemm g{(const pg8::bf16_t*)(ws + WS_F1), (const pg8::bf16_t*)(ws + WS_WFF2), M, D, FF}; pg8::StaticOrder S; S.init(M, D, G, (int)blockIdx.x);
        EpiFused<7> E{a.out, nullptr, nullptr, nullptr, (float*)(ws + CTL_FSS), nullptr, (unsigned*)(ws + CTL_CNT + 32768), nullptr,
                      (const float*)(ws + CTL_MOD), a.in[I_BADA], a.in[I_GPOSTMLP], nullptr};
        pg8::gemm_phase<EpiFused<7>, pg8::StaticOrder, false, true>(lds, g, S, E);
    }
#undef IN
#undef SEAM
}

constexpr int N_PHASES = 10;
extern "C" void kernel_launch(void* const* d_in, const int* in_sizes, int n_in, void* d_out, int out_size, void* d_ws, size_t ws_size, hipStream_t stream) {
    static int grid = 0;
    if (grid == 0) {
        if (n_in != 27 || ws_size < WS_END) { fprintf(stderr, "kernel_launch: need 27 inputs and >= %zu B of workspace; got %d, %zu\n", (size_t)WS_END, n_in, ws_size); grid = -1; return; }
        int dev = 0, cus = 0, per_cu = 0;
        if (hipGetDevice(&dev) != hipSuccess || hipDeviceGetAttribute(&cus, hipDeviceAttributeMultiprocessorCount, dev) != hipSuccess) { grid = -1; return; }
        if (hipFuncSetAttribute((const void*)fwd_megakernel, hipFuncAttributeMaxDynamicSharedMemorySize, LDS_BYTES) != hipSuccess) { fprintf(stderr, "kernel_launch: hipFuncSetAttribute failed\n"); grid = -1; return; }
        if (hipOccupancyMaxActiveBlocksPerMultiprocessor(&per_cu, (const void*)fwd_megakernel, NTHR, LDS_BYTES) != hipSuccess || per_cu < 1) { fprintf(stderr, "kernel_launch: occupancy query says %d\n", per_cu); per_cu = 1; }
        (void)hipGetLastError();
        grid = cus * per_cu;
        if (grid < 256) { fprintf(stderr, "kernel_launch: this kernel's work split needs 256 co-resident workgroups; the device offers %d\n", grid); grid = -1; return; }
        grid = 256;
    }
    if (grid < 0) return;
    (void)hipMemsetAsync((char*)d_ws + WS_CTL, 0, CTL_ZERO_BYTES, stream);
    Args a{};
    for (int i = 0; i < 27; ++i) a.in[i] = (const float*)d_in[i];
    a.out = (float*)d_out; a.ws = (unsigned char*)d_ws; a.ph_lo = 0; a.ph_hi = N_PHASES;
    void* args[] = {&a};
    hipError_t e = hipLaunchCooperativeKernel((const void*)fwd_megakernel, dim3(grid), dim3(NTHR), args, LDS_BYTES, stream);
    if (e != hipSuccess) fprintf(stderr, "kernel_launch: cooperative launch failed: %s (grid %d)\n", hipGetErrorString(e), grid);
}
```

```cpp
#include <hip/hip_runtime.h>
#include <hip/hip_cooperative_groups.h>
#include <cstdio>
#include <cstdint>
namespace cg = cooperative_groups;
namespace pg8 {
#define PG8_LAS __attribute__((address_space(3)))
typedef unsigned short bf16_t;
typedef short bf16x8 __attribute__((ext_vector_type(8)));
typedef float f32x4 __attribute__((ext_vector_type(4)));
typedef unsigned u32x4 __attribute__((ext_vector_type(4)));
constexpr int BM = 256, BK = 64, HALF = 128, HTB = HALF * BK * 2  , STAGE_BYTES = 8 * HTB, NXCD = 8, WGM = 8;

__host__ __device__ __forceinline__ int lds_byte(int r, int c) { const int st = (r >> 4) * 2 + (c >> 5), rr = r & 15, cc = c & 31, ob = rr * 64 + cc * 2; return st * 1024 + (ob ^ (((ob >> 9) & 1) << 5)); }
__host__ __device__ __forceinline__ void stage_rc(int b, int& R, int& C) { const int st = b / 1024, sb = b % 1024, swz = sb ^ (((sb >> 9) & 1) << 5); R = (st >> 1) * 16 + swz / 64; C = (st & 1) * 32 + (swz % 64) / 2; }
__host__ __device__ __forceinline__ int perm32(int rho) { const int n = rho >> 4, i = rho & 15; return 8 * (i >> 2) + 4 * n + (i & 3); }

struct Unit { int pm, pn; };
struct Gemm { const bf16_t* A; const bf16_t* Bt; int M, N, K; };

struct StaticOrder {
    int nM, nN, nwg, G, c, wgm;
    __host__ __device__ void init(int M, int N, int G_, int c_, int wgm_ = 8) { nM = M / BM; nN = N / BM; nwg = nM * nN; G = G_; c = c_; wgm = wgm_; }
    __host__ __device__ bool next(int i, Unit& u) const {
        const long L = (long)i * G + c; if (L >= nwg) return false;
        int wgid = (int)L; { const int q = nwg / NXCD, r = nwg % NXCD, xcd = wgid % NXCD, off = wgid / NXCD; wgid = (xcd < r ? xcd * (q + 1) : r * (q + 1) + (xcd - r) * q) + off; }
        const int nig = wgm * nN, gid = wgid / nig, fm = gid * wgm, gsz = (nM - fm) < wgm ? (nM - fm) : wgm;
        u.pm = fm + ((wgid % nig) % gsz); u.pn = (wgid % nig) / gsz; return true;
    }
    __device__ __forceinline__ void a_ready(const Unit&) const {}
    __device__ __forceinline__ void done(const Unit&) const {}
};

typedef __bf16 bf16x2_cvt __attribute__((ext_vector_type(2)));
typedef float f32x2_cvt __attribute__((ext_vector_type(2)));
__device__ __forceinline__ unsigned cvt_pk_bf16(float lo, float hi) { const f32x2_cvt v = {lo, hi}; const bf16x2_cvt b = __builtin_convertvector(v, bf16x2_cvt); return __builtin_bit_cast(unsigned, b); }
__device__ __forceinline__ float sigmoid_f(float x) { return __builtin_amdgcn_rcpf(1.f + __builtin_amdgcn_exp2f(-1.4426950409f * x)); }
__device__ __forceinline__ float gelu_tanh_f(float x) { const float u = x * (-2.3022081985f - 0.10294324f * (x * x)); return x * __builtin_amdgcn_rcpf(1.f + __builtin_amdgcn_exp2f(u)); }
__device__ __forceinline__ float bflo(unsigned w) { return __builtin_bit_cast(float, w << 16); }
__device__ __forceinline__ float bfhi(unsigned w) { return __builtin_bit_cast(float, w & 0xffff0000u); }
template <int MODE> struct Epi {
    static constexpr bool PERM = true, AFTER_DRAIN = false, HOOK = false;
    bf16_t* Ob; float* Of; const bf16_t* G; float* SS; int ldc;
    bf16_t *s0, *s1, *s2, *s3, *s4, *s5;
    template <int ACT> __device__ __forceinline__ void act_store(const f32x4 (&acc)[2][2][4][2], bf16_t* base, int ld, int row0, int col0, int fq) const {
#pragma unroll
        for (int ai = 0; ai < 2; ++ai)
#pragma unroll
            for (int m = 0; m < 4; ++m) {
                const int row = row0 + ai * HALF + m * 16; bf16_t* rowp = base + (size_t)row * ld + col0; float ss = 0.f;
#pragma unroll
                for (int bj = 0; bj < 2; ++bj) {
                    f32x4 v0 = acc[ai][bj][m][0], v1 = acc[ai][bj][m][1];
                    if constexpr (ACT == 2) {
#pragma unroll
                        for (int j = 0; j < 4; ++j) { v0[j] = sigmoid_f(v0[j]); v1[j] = sigmoid_f(v1[j]); }
                    } else if constexpr (ACT == 1 || ACT == 3) {
#pragma unroll
                        for (int j = 0; j < 4; ++j) { v0[j] = gelu_tanh_f(v0[j]); v1[j] = gelu_tanh_f(v1[j]); }
                    }
                    if constexpr (ACT == 3) {
#pragma unroll
                        for (int j = 0; j < 4; ++j) ss += v0[j] * v0[j] + v1[j] * v1[j];
                    }
                    u32x4 w; w.x = cvt_pk_bf16(v0[0], v0[1]); w.y = cvt_pk_bf16(v0[2], v0[3]); w.z = cvt_pk_bf16(v1[0], v1[1]); w.w = cvt_pk_bf16(v1[2], v1[3]);
                    *(u32x4*)(rowp + bj * HALF) = w;
                }
                if constexpr (ACT == 3) { ss += __shfl_xor(ss, 16); ss += __shfl_xor(ss, 32); if (fq == 0) atomicAdd(SS + row, ss); }
            }
    }
    __device__ __forceinline__ void operator()(const f32x4 (&acc)[2][2][4][2], const Unit& u, int wr, int wc, int fr, int fq) const {
        const int row0 = u.pm * BM + wr * 64 + fr;
        if constexpr (MODE == 1) {
            const int t = u.pn >> 2;
            bf16_t* base = t == 0 ? s0 : t == 1 ? s1 : t == 2 ? s2 : t == 3 ? s3 : t == 4 ? s4 : s5;
            const int ld = (t == 0 || t == 3) ? 2048 : 1024;
            const int col0 = (u.pn & 3) * BM + wc * 32 + 8 * fq;
            if (t >= 4) act_store<2>(acc, base, ld, row0, col0, fq);
            else if (t == 2) act_store<0>(acc, base, ld, row0, col0, fq);
            else if (t == 1) act_store<3>(acc, base, ld, row0, col0, fq);
            else act_store<1>(acc, base, ld, row0, col0, fq);
        } else {
            const int col0 = u.pn * BM + wc * 32 + 8 * fq;
#pragma unroll
            for (int ai = 0; ai < 2; ++ai)
#pragma unroll
                for (int m = 0; m < 4; ++m) {
                    const int row = row0 + ai * HALF + m * 16; float ss = 0.f;
#pragma unroll
                    for (int bj = 0; bj < 2; ++bj) {
                        f32x4 v0 = acc[ai][bj][m][0], v1 = acc[ai][bj][m][1];
                        const size_t off = (size_t)row * ldc + col0 + bj * HALF;
                        if constexpr (MODE == 2 || MODE == 3) {
                            const u32x4 g = *(const u32x4*)(G + off);
                            v0[0] *= bflo(g.x); v0[1] *= bfhi(g.x); v0[2] *= bflo(g.y); v0[3] *= bfhi(g.y);
                            v1[0] *= bflo(g.z); v1[1] *= bfhi(g.z); v1[2] *= bflo(g.w); v1[3] *= bfhi(g.w);
                        }
                        if constexpr (MODE == 3) { v0 = v0 + *(const f32x4*)(Of + off); v1 = v1 + *(const f32x4*)(Of + off + 4); }
                        if constexpr (MODE == 5) {
#pragma unroll
                            for (int j = 0; j < 4; ++j) { const float a = fmaxf(v0[j], 0.f), b = fmaxf(v1[j], 0.f); v0[j] = a * a; v1[j] = b * b; }
                        }
                        if constexpr (MODE == 4) {
#pragma unroll
                            for (int j = 0; j < 4; ++j) ss += v0[j] * v0[j] + v1[j] * v1[j];
                        }
                        if constexpr (MODE == 2 || MODE == 4) { *(f32x4*)(Of + off) = v0; *(f32x4*)(Of + off + 4) = v1; }
                        else { u32x4 w; w.x = cvt_pk_bf16(v0[0], v0[1]); w.y = cvt_pk_bf16(v0[2], v0[3]); w.z = cvt_pk_bf16(v1[0], v1[1]); w.w = cvt_pk_bf16(v1[2], v1[3]);
                            *(u32x4*)(Ob + off) = w; }
                    }
                    if constexpr (MODE == 4) { ss += __shfl_xor(ss, 16); ss += __shfl_xor(ss, 32); if (fq == 0) atomicAdd(SS + row, ss); }
                }
        }
    }
};

struct EpiMerge {
    static constexpr bool PERM = true, AFTER_DRAIN = false, HOOK = true;
    bf16_t* Ob; const bf16_t* GA; const bf16_t* GB;
    __device__ __forceinline__ void mid(f32x4 (&acc)[2][2][4][2], const Unit& u, int wr, int wc, int fr, int fq) const {
        int row0 = u.pm * BM + wr * 64 + fr, col0 = u.pn * BM + wc * 32 + 8 * fq;
        asm volatile("" : "+v"(row0), "+v"(col0));
#pragma unroll
        for (int ai = 0; ai < 2; ++ai)
#pragma unroll
            for (int m = 0; m < 4; ++m) {
                if ((m & 1) == 0) asm volatile("" ::: "memory");
#pragma unroll
                for (int bj = 0; bj < 2; ++bj) {
                    const size_t off = (size_t)(row0 + ai * HALF + m * 16) * 1024 + col0 + bj * HALF;
                    const u32x4 a = *(const u32x4*)(GA + off), b = *(const u32x4*)(GB + off);
                    f32x4 r0, r1;
                    r0[0] = bflo(a.x) * __builtin_amdgcn_rcpf(fmaxf(bflo(b.x), 1e-30f)); r0[1] = bfhi(a.x) * __builtin_amdgcn_rcpf(fmaxf(bfhi(b.x), 1e-30f));
                    r0[2] = bflo(a.y) * __builtin_amdgcn_rcpf(fmaxf(bflo(b.y), 1e-30f)); r0[3] = bfhi(a.y) * __builtin_amdgcn_rcpf(fmaxf(bfhi(b.y), 1e-30f));
                    r1[0] = bflo(a.z) * __builtin_amdgcn_rcpf(fmaxf(bflo(b.z), 1e-30f)); r1[1] = bfhi(a.z) * __builtin_amdgcn_rcpf(fmaxf(bfhi(b.z), 1e-30f));
                    r1[2] = bflo(a.w) * __builtin_amdgcn_rcpf(fmaxf(bflo(b.w), 1e-30f)); r1[3] = bfhi(a.w) * __builtin_amdgcn_rcpf(fmaxf(bfhi(b.w), 1e-30f));
                    acc[ai][bj][m][0] = acc[ai][bj][m][0] * r0; acc[ai][bj][m][1] = acc[ai][bj][m][1] * r1;
                }
            }
    }
    __device__ __forceinline__ void operator()(const f32x4 (&acc)[2][2][4][2], const Unit& u, int wr, int wc, int fr, int fq) const {
        const int row0 = u.pm * BM + wr * 64 + fr, col0 = u.pn * BM + wc * 32 + 8 * fq;
#pragma unroll
        for (int ai = 0; ai < 2; ++ai)
#pragma unroll
            for (int m = 0; m < 4; ++m)
#pragma unroll
                for (int bj = 0; bj < 2; ++bj) {
                    const size_t off = (size_t)(row0 + ai * HALF + m * 16) * 1024 + col0 + bj * HALF;
                    const u32x4 b = *(const u32x4*)(GB + off);
                    const f32x4 v0 = acc[ai][bj][m][0], v1 = acc[ai][bj][m][1];
                    u32x4 w; w.x = cvt_pk_bf16(v0[0] * bflo(b.x), v0[1] * bfhi(b.x)); w.y = cvt_pk_bf16(v0[2] * bflo(b.y), v0[3] * bfhi(b.y));
                    w.z = cvt_pk_bf16(v1[0] * bflo(b.z), v1[1] * bfhi(b.z)); w.w = cvt_pk_bf16(v1[2] * bflo(b.w), v1[3] * bfhi(b.w));
                    *(u32x4*)(Ob + off) = w;
                }
    }
};

template <class Epi, class Sched, bool ALIGN_EPI = false, bool SP2 = false>
__device__ __forceinline__ void gemm_phase(PG8_LAS unsigned char* lds, const Gemm g, const Sched& S, const Epi& E) {
    const int tid = threadIdx.x, wid = __builtin_amdgcn_readfirstlane(tid >> 6), lane = tid & 63, wr = wid >> 2, wc = wid & 3, fr = lane & 15, fq = lane >> 4;
    const int K = g.K, nt = K / BK;
    unsigned voffA[2], voffB[2];
#pragma unroll
    for (int i = 0; i < 2; ++i) { int R, C; stage_rc(tid * 16 + i * 8192, R, C); const int Rb = Epi::PERM ? ((R & ~31) + perm32(R & 31)) : R;
        voffA[i] = (unsigned)(R * K + C) * 2u; voffB[i] = (unsigned)(Rb * K + C) * 2u; }
    const size_t kstep = (size_t)(BK * 2);
    const size_t hstep = (size_t)HALF * K * 2;
    const size_t tstep = 2 * hstep;
    const unsigned ldsw = (unsigned)wid * 1024u;
    const int aoff = lds_byte(wr * 64 + fr, fq * 8), boff = lds_byte(wc * 32 + fr, fq * 8);
#define PG8_SA(b, h) (((b) * 2 + (h)) * HTB)
#define PG8_SB(b, h) ((4 + (b) * 2 + (h)) * HTB)
#define PG8_STAGE(bufoff, gbase, voff) do { _Pragma("unroll") for (int _i = 0; _i < 2; ++_i) \
        __builtin_amdgcn_global_load_lds((const unsigned*)((const char*)(gbase) + (voff)[_i]), (PG8_LAS unsigned*)(lds + (bufoff) + ldsw + _i * 8192), 16, 0, 0); } while (0)
#define PG8_LDA(dst, b, h) do { _Pragma("unroll") for (int m = 0; m < 4; ++m) _Pragma("unroll") for (int k = 0; k < 2; ++k) dst[m][k] = *(const PG8_LAS bf16x8*)(lds + PG8_SA(b, h) + aoff + m * 2048 + k * 1024); } while (0)
#define PG8_LDB(dst, b, h) do { _Pragma("unroll") for (int n = 0; n < 2; ++n) _Pragma("unroll") for (int k = 0; k < 2; ++k) dst[n][k] = *(const PG8_LAS bf16x8*)(lds + PG8_SB(b, h) + boff + n * 2048 + k * 1024); } while (0)
#define PG8_MMA(ai, bj, At, Bt) do { __builtin_amdgcn_s_setprio(1); _Pragma("unroll") for (int m = 0; m < 4; ++m) _Pragma("unroll") for (int n = 0; n < 2; ++n) _Pragma("unroll") for (int k = 0; k < 2; ++k) \
        acc[ai][bj][m][n] = __builtin_amdgcn_mfma_f32_16x16x32_bf16(Bt[n][k], At[m][k], acc[ai][bj][m][n], 0, 0, 0); __builtin_amdgcn_s_setprio(0); } while (0)
#define PG8_WAIT_V(n) asm volatile("s_waitcnt vmcnt(" #n ")" ::: "memory")
#define PG8_WAIT_L(n) asm volatile("s_waitcnt lgkmcnt(" #n ")" ::: "memory")
#define PG8_BAR __builtin_amdgcn_s_barrier()
#define PG8_SCHED __builtin_amdgcn_sched_barrier(0)
    Unit cur, nxt; int ui = 0;
    if (!S.next(0, cur)) return;
    f32x4 acc[2][2][4][2];
#pragma unroll
    for (int a = 0; a < 2; ++a)
#pragma unroll
        for (int b = 0; b < 2; ++b)
#pragma unroll
            for (int m = 0; m < 4; ++m)
#pragma unroll
                for (int n = 0; n < 2; ++n) acc[a][b][m][n] = (f32x4){0.f, 0.f, 0.f, 0.f};
    bf16x8 At[4][2], B0[2][2], B1[2][2];
    const char* cA = (const char*)g.A + (size_t)cur.pm * tstep; const char* cB = (const char*)g.Bt + (size_t)cur.pn * tstep;
    S.a_ready(cur);
    if constexpr (SP2) {
        PG8_STAGE(PG8_SB(0, 0), cB, voffB); PG8_STAGE(PG8_SB(0, 1), cB + hstep, voffB); PG8_STAGE(PG8_SA(0, 0), cA, voffA); PG8_STAGE(PG8_SA(0, 1), cA + hstep, voffA);
        if (wr == 1) PG8_BAR;
        PG8_WAIT_V(2); PG8_BAR;
        PG8_STAGE(PG8_SB(1, 0), cB + kstep, voffB); PG8_STAGE(PG8_SA(1, 0), cA + kstep, voffA); PG8_STAGE(PG8_SB(1, 1), cB + hstep + kstep, voffB);
        PG8_WAIT_V(6); PG8_BAR;
    } else {
        PG8_STAGE(PG8_SB(0, 0), cB, voffB); PG8_STAGE(PG8_SA(0, 0), cA, voffA); PG8_STAGE(PG8_SB(0, 1), cB + hstep, voffB); PG8_STAGE(PG8_SA(0, 1), cA + hstep, voffA);
        if (wr == 1) PG8_BAR;
        PG8_WAIT_V(4); PG8_BAR;
        PG8_STAGE(PG8_SB(1, 0), cB + kstep, voffB); PG8_STAGE(PG8_SA(1, 0), cA + kstep, voffA); PG8_STAGE(PG8_SB(1, 1), cB + hstep + kstep, voffB);
        PG8_WAIT_V(6); PG8_BAR;
    }
    for (;;) {
        const bool has_next = S.next(ui + 1, nxt);
        const char* nA = has_next ? (const char*)g.A + (size_t)nxt.pm * tstep : cA; const char* nB = has_next ? (const char*)g.Bt + (size_t)nxt.pn * tstep : cB;
        for (int t = 0; t < nt; t += 2) {
            if constexpr (Epi::HOOK) { if (t == (nt >> 1)) E.mid(acc, cur, wr, wc, fr, fq); }
            const bool last = (t == nt - 2);
            const char* a1 = cA + (size_t)(t + 1) * kstep;
            const char* a2 = last ? nA : cA + (size_t)(t + 2) * kstep; const char* b2 = last ? nB : cB + (size_t)(t + 2) * kstep;
            const char* a3 = a2 + kstep; const char* b3 = b2 + kstep;
            if (last && has_next) S.a_ready(nxt);
            if constexpr (SP2) {
            PG8_LDB(B0, 0, 0); PG8_LDB(B1, 0, 1); PG8_SCHED; PG8_LDA(At, 0, 0); PG8_STAGE(PG8_SA(1, 1), a1 + hstep, voffA);
            PG8_WAIT_V(8); PG8_WAIT_L(0); PG8_BAR; PG8_MMA(0, 0, At, B0); PG8_MMA(0, 1, At, B1); PG8_BAR; PG8_SCHED;
            PG8_LDA(At, 0, 1); PG8_STAGE(PG8_SB(0, 0), b2, voffB); PG8_STAGE(PG8_SB(0, 1), b2 + hstep, voffB); PG8_STAGE(PG8_SA(0, 0), a2, voffA);
            PG8_WAIT_V(8); PG8_WAIT_L(0); PG8_BAR; PG8_MMA(1, 0, At, B0); PG8_MMA(1, 1, At, B1); PG8_BAR; PG8_SCHED;
            PG8_LDB(B0, 1, 0); PG8_LDB(B1, 1, 1); PG8_SCHED; PG8_LDA(At, 1, 0); PG8_STAGE(PG8_SA(0, 1), a2 + hstep, voffA);
            PG8_WAIT_V(8); PG8_WAIT_L(0); PG8_BAR; PG8_MMA(0, 0, At, B0); PG8_MMA(0, 1, At, B1); PG8_BAR; PG8_SCHED;
            PG8_LDA(At, 1, 1); PG8_STAGE(PG8_SB(1, 0), b3, voffB); PG8_STAGE(PG8_SB(1, 1), b3 + hstep, voffB); PG8_STAGE(PG8_SA(1, 0), a3, voffA);
            PG8_WAIT_V(8); PG8_WAIT_L(0); PG8_BAR; PG8_MMA(1, 0, At, B0); PG8_MMA(1, 1, At, B1); PG8_BAR; PG8_SCHED;
            } else {
            PG8_LDB(B0, 0, 0); PG8_SCHED; PG8_LDA(At, 0, 0); PG8_STAGE(PG8_SA(1, 1), a1 + hstep, voffA);
            PG8_WAIT_L(8); PG8_BAR; PG8_WAIT_L(0); PG8_MMA(0, 0, At, B0); PG8_BAR; PG8_SCHED;
            PG8_LDB(B1, 0, 1); PG8_STAGE(PG8_SB(0, 0), b2, voffB);
            PG8_BAR; PG8_WAIT_L(0); PG8_MMA(0, 1, At, B1); PG8_BAR;
            PG8_LDA(At, 0, 1); PG8_STAGE(PG8_SA(0, 0), a2, voffA);
            PG8_BAR; PG8_WAIT_L(0); PG8_MMA(1, 0, At, B0); PG8_BAR; PG8_SCHED;
            PG8_STAGE(PG8_SB(0, 1), b2 + hstep, voffB);
            PG8_WAIT_V(6); PG8_BAR; PG8_MMA(1, 1, At, B1); PG8_BAR;
            PG8_LDB(B0, 1, 0); PG8_SCHED; PG8_LDA(At, 1, 0); PG8_STAGE(PG8_SA(0, 1), a2 + hstep, voffA);
            PG8_WAIT_L(8); PG8_BAR; PG8_WAIT_L(0); PG8_MMA(0, 0, At, B0); PG8_BAR; PG8_SCHED;
            PG8_LDB(B1, 1, 1); PG8_STAGE(PG8_SB(1, 0), b3, voffB);
            PG8_BAR; PG8_WAIT_L(0); PG8_MMA(0, 1, At, B1); PG8_BAR;
            PG8_LDA(At, 1, 1); PG8_STAGE(PG8_SA(1, 0), a3, voffA);
            PG8_BAR; PG8_WAIT_L(0); PG8_MMA(1, 0, At, B0); PG8_BAR; PG8_SCHED;
            PG8_STAGE(PG8_SB(1, 1), b3 + hstep, voffB);
            PG8_WAIT_V(6); PG8_BAR; PG8_MMA(1, 1, At, B1); PG8_BAR;
            }
        }
        if constexpr (ALIGN_EPI) { if (wr == 0) PG8_BAR; }
        if constexpr (!Epi::AFTER_DRAIN) { E(acc, cur, wr, wc, fr, fq); S.done(cur); }
        if (!has_next) break;
#pragma unroll
        for (int a = 0; a < 2; ++a)
#pragma unroll
            for (int b = 0; b < 2; ++b)
#pragma unroll
                for (int m = 0; m < 4; ++m)
#pragma unroll
                    for (int n = 0; n < 2; ++n) acc[a][b][m][n] = (f32x4){0.f, 0.f, 0.f, 0.f};
        cur = nxt; cA = nA; cB = nB; ++ui;
        if constexpr (ALIGN_EPI) { if (wr == 1) PG8_BAR; }
    }
    PG8_WAIT_V(0);
    if constexpr (!ALIGN_EPI) { if (wr == 0) PG8_BAR; }
    PG8_BAR;
    if constexpr (Epi::AFTER_DRAIN) { E.fused(acc, cur, wr, wc, fr, fq, lds, wid, lane); S.done(cur); }
#undef PG8_SA
#undef PG8_SB
#undef PG8_STAGE
#undef PG8_LDA
#undef PG8_LDB
#undef PG8_MMA
#undef PG8_WAIT_V
#undef PG8_WAIT_L
#undef PG8_BAR
#undef PG8_SCHED
}
}

constexpr int NWAVES = 8, NTHR = NWAVES * 64;
constexpr int D = 1024, M = 16384, MCTX = 8192, INC = 6144, FF = 4096;
constexpr float EPS = 1e-6f, LOG2E = 1.4426950408889634f;
constexpr size_t MiB = 1u << 20;
constexpr size_t WS_CTL = 0, CTL_ZERO_BYTES = 1 * MiB;
constexpr size_t CTL_VSS = 64 * 1024, CTL_OSS = 128 * 1024, CTL_FSS = 192 * 1024, CTL_MOD = 256 * 1024, CTL_XSS = 384 * 1024;
constexpr size_t CTL_MODCNT = 14 * 1024;
constexpr size_t CTL_CNT = 16 * 1024;
constexpr size_t WS_GC = 1 * MiB;
constexpr size_t WS_AGG = 2 * MiB;
constexpr size_t WS_CAR = 4 * MiB;
constexpr size_t WS_WG = 5 * MiB;
constexpr size_t WS_WSP = 5 * MiB + 512 * 1024;
constexpr size_t WS_WFF2 = 6 * MiB, WS_WFF1 = 14 * MiB, WS_WIN = 22 * MiB, WS_WBG = 34 * MiB, WS_WBR = 36 * MiB, WS_WOUT = 38 * MiB;
constexpr size_t WS_H = 40 * MiB;
constexpr size_t WS_F = 64 * MiB;
constexpr size_t WS_GU = 128 * MiB, WS_GGR = 160 * MiB, WS_SGA = 192 * MiB, WS_SGB = 224 * MiB;
constexpr size_t WS_F1 = 128 * MiB;
constexpr size_t WS_END = 256 * MiB;
constexpr int LDS_BYTES = 147456, LDS_BAR_OFF = 139264;
#ifndef WG_IN
#define WG_IN 4
#endif
#ifndef WG_FF1
#define WG_FF1 2
#endif
#ifndef DUP
#define DUP 0
#endif

#define GAS __attribute__((address_space(1)))
#define LAS __attribute__((address_space(3)))
typedef unsigned short bf16;
typedef unsigned v4u __attribute__((ext_vector_type(4)));
typedef unsigned v2u __attribute__((ext_vector_type(2)));
typedef float f32x4 __attribute__((ext_vector_type(4)));
typedef float f32x2 __attribute__((ext_vector_type(2)));
typedef short bf16x8 __attribute__((ext_vector_type(8)));
#define LDS_WAIT() asm volatile("s_waitcnt lgkmcnt(0)" ::: "memory")
__device__ __forceinline__ unsigned f2bf(float f) { unsigned u = __builtin_bit_cast(unsigned, f); return (u + 0x7fffu + ((u >> 16) & 1u)) >> 16; }
__device__ __forceinline__ unsigned pk2(float lo, float hi) { return pg8::cvt_pk_bf16(lo, hi); }
__device__ __forceinline__ float bf2f(bf16 b) { return __builtin_bit_cast(float, (unsigned)b << 16); }
using pg8::bflo; using pg8::bfhi;

struct Args { const float* in[27]; float* out; unsigned char* ws; int ph_lo, ph_hi; };
enum { I_XP = 0, I_XS, I_STATE, I_C, I_CCTX, I_WADA, I_BADA, I_GPREMIX, I_GPOSTMIX, I_GPREMLP, I_GPOSTMLP, I_WIN, I_GSGU, I_WSP, I_BSP, I_CONVW, I_CONVB,
       I_WRA, I_BRA, I_WRI, I_BRI, I_LAM, I_WBRG, I_WBRR, I_WOUT, I_WFF1, I_WFF2 };

__device__ __forceinline__ float wave_sum(float v) {
#pragma unroll
    for (int o = 1; o < 64; o <<= 1) v += __shfl_xor(v, o);
    return v;
}
__device__ __forceinline__ void p0_transpose_item(const float* W, int K, int N, bf16* WT, LAS float* scr, int item, int lane, int ldk = 0, int koff = 0) {
    if (ldk == 0) ldk = K;
    const int nblk = N / 32, kb = item / nblk, nb = item % nblk, k0 = 64 * kb, n0 = 32 * nb;
#pragma unroll
    for (int i = 0; i < 8; ++i) { const int kk = 8 * i + (lane >> 3);
        const f32x4 v = *(const f32x4*)(W + (size_t)(k0 + kk) * N + n0 + (lane & 7) * 4);
        LAS float* dd = scr + kk * 33 + (lane & 7) * 4; dd[0] = v[0]; dd[1] = v[1]; dd[2] = v[2]; dd[3] = v[3]; }
    LDS_WAIT(); asm volatile("" ::: "memory");
    const int c = lane & 7;
#pragma unroll
    for (int j = 0; j < 4; ++j) { const int n = (lane >> 3) + 8 * j; const LAS float* s = scr + (8 * c) * 33 + n;
        v4u o; o.x = pk2(s[0 * 33], s[1 * 33]); o.y = pk2(s[2 * 33], s[3 * 33]); o.z = pk2(s[4 * 33], s[5 * 33]); o.w = pk2(s[6 * 33], s[7 * 33]);
        *(v4u*)(WT + (size_t)(n0 + n) * ldk + koff + k0 + 8 * c) = o; }
    LDS_WAIT(); asm volatile("" ::: "memory");
}

__device__ __forceinline__ void phase_prep(const Args& a, LAS unsigned char* lds, int gw, int NGW, int wave, int lane, float* MOD) {
    unsigned char* ws = a.ws;
    LAS float* scr = (LAS float*)(lds + wave * 16384);
    if ((int)blockIdx.x < 192) {
        const float* wada = a.in[I_WADA]; const float* cctx = a.in[I_CCTX]; const float* cc = a.in[I_C];
        const int nb = blockIdx.x % 24, ksl = blockIdx.x / 24, n = nb * 256 + lane * 4, kbase = ksl * 128 + wave * 16;
        f32x4 a0 = {0.f, 0.f, 0.f, 0.f}, a1 = a0, a2 = a0;
#pragma unroll
        for (int kk = 0; kk < 16; ++kk) {
            const int k = kbase + kk;
            const f32x4 w = *(const f32x4*)(wada + (size_t)k * INC + n);
            const float c0 = cctx[k], c1 = cc[k], c2 = cc[D + k];
            const float s0 = c0 * pg8::sigmoid_f(c0), s1 = c1 * pg8::sigmoid_f(c1), s2 = c2 * pg8::sigmoid_f(c2);
            a0 += w * s0; a1 += w * s1; a2 += w * s2;
        }
        LAS float* red = (LAS float*)lds;
        *(LAS f32x4*)(red + (wave * 3 + 0) * 256 + lane * 4) = a0; *(LAS f32x4*)(red + (wave * 3 + 1) * 256 + lane * 4) = a1; *(LAS f32x4*)(red + (wave * 3 + 2) * 256 + lane * 4) = a2;
        __syncthreads();
        const int tid = wave * 64 + lane;
        if (tid < 192) {
            const int v = tid >> 6, c4 = (tid & 63) * 4;
            f32x4 sum = {0.f, 0.f, 0.f, 0.f};
#pragma unroll
            for (int w2 = 0; w2 < 8; ++w2) sum += *(const LAS f32x4*)(red + (w2 * 3 + v) * 256 + c4);
#pragma unroll
            for (int j = 0; j < 4; ++j) atomicAdd(MOD + v * INC + nb * 256 + c4 + j, sum[j]);
        }
        asm volatile("s_waitcnt vmcnt(0)" ::: "memory");
        __syncthreads();
        if (threadIdx.x == 0) __hip_atomic_fetch_add((unsigned*)(ws + CTL_MODCNT), 1u, __ATOMIC_RELAXED, __HIP_MEMORY_SCOPE_AGENT);
    }
    constexpr int I_IN = 16 * (INC / 32), I_SQ = 16 * (D / 32), I_F1 = 16 * (FF / 32), I_F2 = (FF / 64) * (D / 32);
    constexpr int NT = I_IN + 3 * I_SQ + I_F1 + I_F2;
    for (int it = gw; it < NT; it += NGW) {
        int r = it;
        if (r < I_IN) { p0_transpose_item(a.in[I_WIN], D, INC, (bf16*)(ws + WS_WIN), scr, r, lane); continue; } r -= I_IN;
        if (r < I_SQ) { p0_transpose_item(a.in[I_WBRG], D, D, (bf16*)(ws + WS_WBG), scr, r, lane, 2 * D, 0); continue; } r -= I_SQ;
        if (r < I_SQ) { p0_transpose_item(a.in[I_WBRR], D, D, (bf16*)(ws + WS_WBG), scr, r, lane, 2 * D, D); continue; } r -= I_SQ;
        if (r < I_SQ) { p0_transpose_item(a.in[I_WOUT], D, D, (bf16*)(ws + WS_WOUT), scr, r, lane); continue; } r -= I_SQ;
        if (r < I_F1) { p0_transpose_item(a.in[I_WFF1], D, FF, (bf16*)(ws + WS_WFF1), scr, r, lane); continue; } r -= I_F1;
        p0_transpose_item(a.in[I_WFF2], FF, D, (bf16*)(ws + WS_WFF2), scr, r, lane);
    }
    {
        const bool few = gridDim.x > 192;
        if (few && blockIdx.x < 192) return;
        const int gt = few ? ((int)blockIdx.x - 192) * NTHR + wave * 64 + lane : gw * 64 + lane, NGT = few ? ((int)gridDim.x - 192) * NTHR : NGW * 64;
        bf16* WG = (bf16*)(ws + WS_WG);
        for (int it = gt; it < 16 * 16 * 2 * 64; it += NGT) {
            const int ln = it & 63, ks = (it >> 6) & 1, cbi = (it >> 7) & 15, h = it >> 11;
            const int fr = ln & 15, fq = ln >> 4, type = cbi >> 3, d = (cbi >> 2) & 1, cb = cbi & 3;
            const float* W = type ? a.in[I_WRI] : a.in[I_WRA];
            const float* src = W + ((size_t)(d * 16 + h) * 64 + ks * 32 + fq * 8) * 64 + cb * 16 + fr;
            v4u o; o.x = pk2(-LOG2E * src[0], -LOG2E * src[64]); o.y = pk2(-LOG2E * src[128], -LOG2E * src[192]);
            o.z = pk2(-LOG2E * src[256], -LOG2E * src[320]); o.w = pk2(-LOG2E * src[384], -LOG2E * src[448]);
            *(v4u*)(WG + (size_t)it * 8) = o;
        }
        bf16* WSP = (bf16*)(ws + WS_WSP); const float* wsp = a.in[I_WSP];
        for (int it = gt; it < 8 * 128 * 128 / 8; it += NGT) {
            const f32x4 x0 = *(const f32x4*)(wsp + (size_t)it * 8), x1 = *(const f32x4*)(wsp + (size_t)it * 8 + 4);
            v4u o; o.x = pk2(x0[0], x0[1]); o.y = pk2(x0[2], x0[3]); o.z = pk2(x1[0], x1[1]); o.w = pk2(x1[2], x1[3]);
            *(v4u*)(WSP + (size_t)it * 8) = o;
        }
        float* GC = (float*)(ws + WS_GC);
        for (int it = gt; it < 2048; it += NGT) {
            const float lamv = a.in[I_LAM][it]; const float sp = log1pf(expf(-lamv));
            f32x4 o; o[0] = exp2f(-LOG2E * a.in[I_BRA][it]); o[1] = exp2f(-LOG2E * a.in[I_BRI][it]); o[2] = -8.f * sp * LOG2E; o[3] = 0.f;
            *(f32x4*)(GC + (size_t)it * 4) = o;
        }
    }
}

__device__ __forceinline__ f32x4 modv(const float* MOD, const float* bada, int cv, int part, int c) {
    return *(const f32x4*)(MOD + cv * INC + part * D + c) + *(const f32x4*)(bada + part * D + c);
}
__device__ __forceinline__ int cv_of(int m) { return m < MCTX ? 0 : (m < MCTX + 4096 ? 1 : 2); }
__device__ __forceinline__ const float* xrow_of(const Args& a, int m) { return m < MCTX ? a.in[I_XP] + (size_t)m * D : a.in[I_XS] + (size_t)(m - MCTX) * D; }
__device__ __forceinline__ void store_bf4(bf16* p, f32x4 v) { v2u o; o.x = pk2(v[0], v[1]); o.y = pk2(v[2], v[3]); *(v2u*)p = o; }

__device__ __forceinline__ void phase_norm1(const Args& a, int gw, int NGW, int lane) {
    const float* MOD = (const float*)(a.ws + CTL_MOD); const float* bada = a.in[I_BADA]; const float* g = a.in[I_GPREMIX];
    bf16* H = (bf16*)(a.ws + WS_H);
    const int RPW = M / NGW;
    if (RPW * NGW == M && (MCTX % RPW) == 0 && (4096 % RPW) == 0) {
        const int m0 = gw * RPW, cv = cv_of(m0);
        f32x4 cc[4], sh[4];
#pragma unroll
        for (int j = 0; j < 4; ++j) { const int c = 4 * lane + 256 * j; cc[j] = *(const f32x4*)(g + c) * (modv(MOD, bada, cv, 1, c) + 1.f); sh[j] = modv(MOD, bada, cv, 0, c); }
        for (int m = m0; m < m0 + RPW; ++m) {
            const float* xr = xrow_of(a, m);
            f32x4 v[4]; float s = 0.f;
#pragma unroll
            for (int j = 0; j < 4; ++j) { v[j] = *(const f32x4*)(xr + 4 * lane + 256 * j); s += (v[j][0] * v[j][0] + v[j][1] * v[j][1]) + (v[j][2] * v[j][2] + v[j][3] * v[j][3]); }
            const float rstd = rsqrtf(wave_sum(s) * (1.f / D) + EPS);
#pragma unroll
            for (int j = 0; j < 4; ++j) store_bf4(H + (size_t)m * D + 4 * lane + 256 * j, v[j] * rstd * cc[j] + sh[j]);
        }
        return;
    }
    for (int m = gw; m < M; m += NGW) {
        const float* xr = xrow_of(a, m); const int cv = cv_of(m);
        f32x4 v[4]; float s = 0.f;
#pragma unroll
        for (int j = 0; j < 4; ++j) { v[j] = *(const f32x4*)(xr + 4 * lane + 256 * j); s += (v[j][0] * v[j][0] + v[j][1] * v[j][1]) + (v[j][2] * v[j][2] + v[j][3] * v[j][3]); }
        const float rstd = rsqrtf(wave_sum(s) * (1.f / D) + EPS);
#pragma unroll
        for (int j = 0; j < 4; ++j) { const int c = 4 * lane + 256 * j;
            const f32x4 gg = *(const f32x4*)(g + c), sh = modv(MOD, bada, cv, 0, c), sc = modv(MOD, bada, cv, 1, c);
            store_bf4(H + (size_t)m * D + c, v[j] * rstd * gg * (sc + 1.f) + sh); }
    }
}
__device__ __forceinline__ void phase_mid(const Args& a, int gw, int NGW, int lane, float* xout, bf16* H) {
    const float* MOD = (const float*)(a.ws + CTL_MOD); const float* bada = a.in[I_BADA];
    const float* gpm = a.in[I_GPOSTMIX]; const float* gpl = a.in[I_GPREMLP]; const float* OSS = (const float*)(a.ws + CTL_OSS);
    const float* out = a.out;
    for (int m = gw; m < M; m += NGW) {
        const float* xr = xrow_of(a, m); const int cv = cv_of(m);
        const float rstd_o = rsqrtf(OSS[m] * (1.f / D) + EPS);
        f32x4 v[4]; float s = 0.f;
#pragma unroll
        for (int j = 0; j < 4; ++j) { const int c = 4 * lane + 256 * j;
            const f32x4 o = *(const f32x4*)(out + (size_t)m * D + c), x = *(const f32x4*)(xr + c);
            const f32x4 g1 = modv(MOD, bada, cv, 2, c), gg = *(const f32x4*)(gpm + c);
            v[j] = x + g1 * (o * rstd_o * gg);
            *(f32x4*)(xout + (size_t)m * D + c) = v[j];
            s += (v[j][0] * v[j][0] + v[j][1] * v[j][1]) + (v[j][2] * v[j][2] + v[j][3] * v[j][3]); }
        const float rstd = rsqrtf(wave_sum(s) * (1.f / D) + EPS);
#pragma unroll
        for (int j = 0; j < 4; ++j) { const int c = 4 * lane + 256 * j;
            const f32x4 gg = *(const f32x4*)(gpl + c), sh = modv(MOD, bada, cv, 3, c), sc = modv(MOD, bada, cv, 4, c);
            store_bf4(H + (size_t)m * D + c, v[j] * rstd * gg * (sc + 1.f) + sh); }
    }
}
__device__ __forceinline__ void phase_final(const Args& a, int gw, int NGW, int lane, float* yout) {
    const float* MOD = (const float*)(a.ws + CTL_MOD); const float* bada = a.in[I_BADA];
    const float* gpm = a.in[I_GPOSTMLP]; const float* FSS = (const float*)(a.ws + CTL_FSS); const float* F = (const float*)(a.ws + WS_F); const float* out = a.out;
    for (int m = gw; m < M; m += NGW) {
        const int cv = cv_of(m); const float rstd_f = rsqrtf(FSS[m] * (1.f / D) + EPS);
#pragma unroll
        for (int j = 0; j < 4; ++j) { const int c = 4 * lane + 256 * j;
            const f32x4 f = *(const f32x4*)(F + (size_t)m * D + c), x1 = *(const f32x4*)(out + (size_t)m * D + c);
            const f32x4 g2 = modv(MOD, bada, cv, 5, c), gg = *(const f32x4*)(gpm + c);
            *(f32x4*)(yout + (size_t)m * D + c) = x1 + g2 * (f * rstd_f * gg); }
    }
}

__device__ __forceinline__ void panel_sync(unsigned* cnt) {
    asm volatile("s_waitcnt vmcnt(0)" ::: "memory");
    __syncthreads();
    if (threadIdx.x == 0) {
        __hip_atomic_fetch_add(cnt, 1u, __ATOMIC_RELAXED, __HIP_MEMORY_SCOPE_AGENT);
        unsigned sp = 0;
        while (__hip_atomic_load(cnt, __ATOMIC_RELAXED, __HIP_MEMORY_SCOPE_AGENT) < 4u) { __builtin_amdgcn_s_sleep(1); if (++sp > (1u << 22)) break; }
    }
    __syncthreads();
}
__device__ __forceinline__ float ld_agent(const float* p) { return __builtin_bit_cast(float, __hip_atomic_load((const unsigned*)p, __ATOMIC_RELAXED, __HIP_MEMORY_SCOPE_AGENT)); }
__device__ __forceinline__ float sumsq4(f32x4 v) { return (v[0] * v[0] + v[1] * v[1]) + (v[2] * v[2] + v[3] * v[3]); }
template <int MODE> struct EpiFused {
    static constexpr bool PERM = true, AFTER_DRAIN = true, HOOK = false;
    float* out; const float* xp; const float* xs; bf16* H; float* SS1; float* SS2; unsigned* cnt1; unsigned* cnt2;
    const float* MOD; const float* bada; const float* gpost; const float* gpre;
    __device__ __forceinline__ void fused(f32x4 (&acc)[2][2][4][2], const pg8::Unit& u, int wr, int wc, int fr, int fq, LAS unsigned char*, int, int) const {
        const int row0 = u.pm * 256 + wr * 64 + fr, col0 = u.pn * 256 + wc * 32 + 8 * fq;
        const int cv = u.pm < 32 ? 0 : (u.pm < 48 ? 1 : 2);
#pragma unroll
        for (int ai = 0; ai < 2; ++ai)
#pragma unroll
            for (int m = 0; m < 4; ++m) {
                float ss = (sumsq4(acc[ai][0][m][0]) + sumsq4(acc[ai][0][m][1])) + (sumsq4(acc[ai][1][m][0]) + sumsq4(acc[ai][1][m][1]));
                ss += __shfl_xor(ss, 16); ss += __shfl_xor(ss, 32);
                if (fq == 0) atomicAdd(SS1 + row0 + ai * 128 + m * 16, ss);
            }
        panel_sync(cnt1 + 64 * u.pm);
        f32x4 ga[2][2];
#pragma unroll
        for (int bj = 0; bj < 2; ++bj)
#pragma unroll
            for (int n = 0; n < 2; ++n) { const int c = col0 + bj * 128 + 4 * n; ga[bj][n] = modv(MOD, bada, cv, MODE == 6 ? 2 : 5, c) * *(const f32x4*)(gpost + c); }
        float rs1[2][4];
#pragma unroll
        for (int ai = 0; ai < 2; ++ai)
#pragma unroll
            for (int m = 0; m < 4; ++m) rs1[ai][m] = ld_agent(SS1 + row0 + ai * 128 + m * 16);
#pragma unroll
        for (int ai = 0; ai < 2; ++ai)
#pragma unroll
            for (int m = 0; m < 4; ++m) {
                const int row = row0 + ai * 128 + m * 16;
                const float rstd = rsqrtf(rs1[ai][m] * (1.f / D) + EPS);
                const float* xrow = MODE == 6 ? (row < MCTX ? xp + (size_t)row * D : xs + (size_t)(row - MCTX) * D) : out + (size_t)row * D;
                float ss = 0.f;
#pragma unroll
                for (int bj = 0; bj < 2; ++bj)
#pragma unroll
                    for (int n = 0; n < 2; ++n) { const int c = col0 + bj * 128 + 4 * n;
                        const f32x4 v = *(const f32x4*)(xrow + c) + ga[bj][n] * (acc[ai][bj][m][n] * rstd);
                        *(f32x4*)(out + (size_t)row * D + c) = v; acc[ai][bj][m][n] = v; ss += sumsq4(v); }
                if constexpr (MODE == 6) { ss += __shfl_xor(ss, 16); ss += __shfl_xor(ss, 32); if (fq == 0) atomicAdd(SS2 + row, ss); }
            }
        if constexpr (MODE == 6) {
            panel_sync(cnt2 + 64 * u.pm);
            f32x4 cc[2][2], sh[2][2];
#pragma unroll
            for (int bj = 0; bj < 2; ++bj)
#pragma unroll
                for (int n = 0; n < 2; ++n) { const int c = col0 + bj * 128 + 4 * n; cc[bj][n] = *(const f32x4*)(gpre + c) * (modv(MOD, bada, cv, 4, c) + 1.f); sh[bj][n] = modv(MOD, bada, cv, 3, c); }
            float rs2[2][4];
#pragma unroll
            for (int ai = 0; ai < 2; ++ai)
#pragma unroll
                for (int m = 0; m < 4; ++m) rs2[ai][m] = ld_agent(SS2 + row0 + ai * 128 + m * 16);
#pragma unroll
            for (int ai = 0; ai < 2; ++ai)
#pragma unroll
                for (int m = 0; m < 4; ++m) {
                    const int row = row0 + ai * 128 + m * 16;
                    const float rstd = rsqrtf(rs2[ai][m] * (1.f / D) + EPS);
#pragma unroll
                    for (int bj = 0; bj < 2; ++bj) {
                        const f32x4 h0 = acc[ai][bj][m][0] * rstd * cc[bj][0] + sh[bj][0], h1 = acc[ai][bj][m][1] * rstd * cc[bj][1] + sh[bj][1];
                        v4u w; w.x = pg8::cvt_pk_bf16(h0[0], h0[1]); w.y = pg8::cvt_pk_bf16(h0[2], h0[3]); w.z = pg8::cvt_pk_bf16(h1[0], h1[1]); w.w = pg8::cvt_pk_bf16(h1[2], h1[3]);
                        *(v4u*)(H + (size_t)row * D + col0 + bj * 128) = w; }
                }
        }
    }
};

constexpr int YLD = 2048;
constexpr int SG_W = 0, SG_V = 34816, SG_U = 69632, SG_ST = 272;
__device__ __forceinline__ void sgu_load(const bf16* GV, const bf16* GU, const float* VSS, int item, int tid, v4u (&rv)[4], v4u (&ru)[4], float (&rss)[4]) {
    const int g = item & 7, t0 = (item >> 3) * 128;
#pragma unroll
    for (int i = 0; i < 4; ++i) { const int idx = tid + i * NTHR, p = idx >> 4, c8 = (idx & 15) * 8;
        rv[i] = *(const v4u*)(GV + (size_t)(t0 + p) * D + g * 128 + c8); ru[i] = *(const v4u*)(GU + (size_t)(t0 + p) * YLD + g * 128 + c8); rss[i] = VSS[t0 + p]; }
}
__device__ __forceinline__ void phase_sgu(const Args& a, LAS unsigned char* lds, int tid, int wave, int lane, bf16* YG) {
    const bf16* GV = (const bf16*)a.out; const bf16* GU = (const bf16*)(a.ws + WS_GU); const bf16* WSP = (const bf16*)(a.ws + WS_WSP);
    const float* VSS = (const float*)(a.ws + CTL_VSS); const float* gsgu = a.in[I_GSGU]; const float* bsp = a.in[I_BSP];
    const int fr = lane & 15, fq = lane >> 4;
    int last_g = -1;
    v4u rv[4], ru[4]; float rss[4];
    for (int item = blockIdx.x; item < 128 * 8; item += gridDim.x) {
        const int g = item & 7, n = item >> 3, t0 = n * 128;
        if (g != last_g) {
#pragma unroll
            for (int i = 0; i < 4; ++i) { const int idx = tid + i * NTHR, row = idx >> 4, c16 = idx & 15;
                *(LAS v4u*)(lds + SG_W + row * SG_ST + c16 * 16) = *(const v4u*)(WSP + (size_t)(g * 128 + row) * 128 + c16 * 8); }
            last_g = g;
        }
        if (item == (int)blockIdx.x) sgu_load(GV, GU, VSS, item, tid, rv, ru, rss);
#pragma unroll
        for (int i = 0; i < 4; ++i) {
            const int idx = tid + i * NTHR, p = idx >> 4, c8 = (idx & 15) * 8;
            const v4u r = rv[i]; const v4u uu = ru[i];
            const float rs = rsqrtf(rss[i] * (1.f / D) + EPS);
            const f32x4 g0 = *(const f32x4*)(gsgu + g * 128 + c8) * rs, g1 = *(const f32x4*)(gsgu + g * 128 + c8 + 4) * rs;
            v4u o; o.x = pk2(bflo(r.x) * g0[0], bfhi(r.x) * g0[1]); o.y = pk2(bflo(r.y) * g0[2], bfhi(r.y) * g0[3]);
            o.z = pk2(bflo(r.z) * g1[0], bfhi(r.z) * g1[1]); o.w = pk2(bflo(r.w) * g1[2], bfhi(r.w) * g1[3]);
            *(LAS v4u*)(lds + SG_V + p * SG_ST + c8 * 2) = o;
            *(LAS v4u*)(lds + SG_U + p * SG_ST + c8 * 2) = uu;
        }
        if (item + (int)gridDim.x < 128 * 8) sgu_load(GV, GU, VSS, item + gridDim.x, tid, rv, ru, rss);
        float bias8[8];
#pragma unroll
        for (int qb = 0; qb < 8; ++qb) bias8[qb] = bsp[g * 128 + qb * 16 + fr];
        __syncthreads();
        bf16x8 af[4];
#pragma unroll
        for (int ks = 0; ks < 4; ++ks) {
            unsigned short e[8];
#pragma unroll
            for (int j = 0; j < 8; ++j) e[j] = *(const LAS unsigned short*)(lds + SG_V + (ks * 32 + fq * 8 + j) * SG_ST + (wave * 16 + fr) * 2);
            v4u o; o.x = e[0] | ((unsigned)e[1] << 16); o.y = e[2] | ((unsigned)e[3] << 16); o.z = e[4] | ((unsigned)e[5] << 16); o.w = e[6] | ((unsigned)e[7] << 16);
            af[ks] = __builtin_bit_cast(bf16x8, o);
        }
#pragma unroll
        for (int qb = 0; qb < 8; ++qb) {
            const int q = qb * 16 + fr;
            f32x4 acc = {0.f, 0.f, 0.f, 0.f};
#pragma unroll
            for (int ks = 0; ks < 4; ++ks) { const bf16x8 b = *(const LAS bf16x8*)(lds + SG_W + q * SG_ST + (ks * 32 + fq * 8) * 2);
                acc = __builtin_amdgcn_mfma_f32_16x16x32_bf16(af[ks], b, acc, 0, 0, 0); }
            const float bias = bias8[qb];
            LAS v2u* up = (LAS v2u*)(lds + SG_U + q * SG_ST + (wave * 16 + fq * 4) * 2);
            const v2u gu = *up;
            v2u y; y.x = pk2(bflo(gu.x) * (acc[0] + bias), bfhi(gu.x) * (acc[1] + bias)); y.y = pk2(bflo(gu.y) * (acc[2] + bias), bfhi(gu.y) * (acc[3] + bias));
            *up = y;
        }
        __syncthreads();
#pragma unroll
        for (int i = 0; i < 4; ++i) { const int idx = tid + i * NTHR, p = idx >> 4, c8 = (idx & 15) * 8;
            *(v4u*)(YG + (size_t)(t0 + p) * YLD + g * 128 + c8) = *(const LAS v4u*)(lds + SG_U + p * SG_ST + c8 * 2); }
    }
}

constexpr int RG_WB = 0, RG_XA = 32768, RG_XF = 51200, RG_AGL = 86016, RG_GCL = 94208, RG_CWL = 96256, RG_CARL = 97536;
__device__ __forceinline__ void rg_load_raw(const bf16* XR, int item, int tid, v4u (&xr)[2][4]) {
    const int h = item & 15, t0 = (item >> 4) * 128;
    const int seq_lo = t0 < MCTX ? (t0 & ~255) : MCTX + ((t0 - MCTX) & ~4095), seq_hi = seq_lo + (t0 < MCTX ? 256 : 4096);
#pragma unroll
    for (int i = 0; i < 2; ++i) {
        const int idx = tid + i * NTHR, tk = idx >> 3, chb = h * 64 + (idx & 7) * 8;
#pragma unroll
        for (int tap = 0; tap < 4; ++tap) {
            const int t = t0 + tk + tap - 2; const bool ok = (t >= seq_lo) && (t < seq_hi); const int tc = ok ? t : t0;
            xr[i][tap] = *(const v4u*)(XR + (size_t)tc * D + chb);
        }
    }
}
template <int MODE> __device__ __forceinline__ int rg_item(int k) {
    const int h = blockIdx.x & 15, q = blockIdx.x >> 4;
    int tt;
    if (MODE == 1) tt = k < 4 ? 2 * (q + 16 * (k >> 1)) + (k & 1) : 64 + q + 16 * (k - 4);
    else tt = k < 2 ? 2 * (q + 16 * k) + 1 : 64 + q + 16 * (k - 2);
    return tt * 16 + h;
}
template <int MODE>
__device__ __forceinline__ void phase_rg(const Args& a, LAS unsigned char* lds, int tid, int wave, int lane, bf16* YR) {
    const bf16* XR = (const bf16*)((const unsigned char*)a.out + 32 * MiB); const bf16* GGR = (const bf16*)(a.ws + WS_GU) + D;
    const float* GC = (const float*)(a.ws + WS_GC); const bf16* WG = (const bf16*)(a.ws + WS_WG);
    f32x2* AGG = (f32x2*)(a.ws + WS_AGG); const float* CAR = (const float*)(a.ws + WS_CAR); float* nstate = a.out + (size_t)M * D;
    const float* convw = a.in[I_CONVW]; const float* convb = a.in[I_CONVB];
    const int fr = lane & 15, fq = lane >> 4;
    int last_h = -1;
    v4u xr[2][4];
    constexpr int NK = MODE == 1 ? 8 : 6;
    rg_load_raw(XR, rg_item<MODE>(0), tid, xr);
    if constexpr (MODE == 1) {
        const float* st0 = a.in[I_STATE];
#pragma unroll 1
        for (int kk = tid >> 7; kk < 8; kk += 4) {
            const int it = rg_item<1>(kk);
            {
                const int d = (tid >> 6) & 1, cl = tid & 63, h = it & 15, tt = it >> 4;
                float hc;
                if (tt < 64) {
                    const f32x2 g = AGG[((size_t)((tt | 1) * 16 + h) * 2 + 1) * 64 + cl];
                    hc = ((tt & 1) == 0 && d == 1) ? g[1] : 0.f;
                } else {
                    const int b = (tt - 64) >> 5, j = (tt - 64) & 31, tt0 = 64 + b * 32;
                    f32x2 ag[31];
#pragma unroll
                    for (int sI = 0; sI < 31; ++sI) { const int ti = d ? 31 - sI : sI; ag[sI] = AGG[((size_t)((tt0 + ti) * 16 + h) * 2 + d) * 64 + cl]; }
                    hc = st0[(size_t)b * 2048 + d * 1024 + h * 64 + cl];
#pragma unroll
                    for (int sI = 0; sI < 31; ++sI) { const int ti = d ? 31 - sI : sI; if (d ? (ti > j) : (ti < j)) hc = ag[sI][0] * hc + ag[sI][1]; }
                }
                *(LAS float*)(lds + RG_CARL + ((kk * 2 + d) * 64 + cl) * 4) = hc;
            }
        }
        __syncthreads();
    }
    for (int kitem = 0; kitem < NK; ++kitem) {
        const int item = rg_item<MODE>(kitem);
        const int h = item & 15, tt = item >> 4, t0 = tt * 128;
        if (h != last_h) {
#pragma unroll
            for (int i = 0; i < 4; ++i) { const int o = (tid + i * NTHR) * 16; *(LAS v4u*)(lds + RG_WB + o) = *(const v4u*)((const unsigned char*)WG + (size_t)h * 32768 + o); }
            if (tid < 128) *(LAS f32x4*)(lds + RG_GCL + tid * 16) = *(const f32x4*)(GC + (size_t)((tid >> 6) * D + h * 64 + (tid & 63)) * 4);
            if (tid < 80) { const int row = tid >> 4, c4 = (tid & 15) * 4;
                *(LAS f32x4*)(lds + RG_CWL + (row * 64 + c4) * 4) = *(const f32x4*)((row < 4 ? convw + row * D : convb) + h * 64 + c4); }
            last_h = h;
            __syncthreads();
        }
        const int seq_lo = t0 < MCTX ? (t0 & ~255) : MCTX + ((t0 - MCTX) & ~4095), seq_hi = seq_lo + (t0 < MCTX ? 256 : 4096);
        float car[2][4]; v4u ggr[2];
        if constexpr (MODE == 1) {
#pragma unroll
            for (int d = 0; d < 2; ++d)
#pragma unroll
                for (int cb = 0; cb < 4; ++cb) car[d][cb] = *(const LAS float*)(lds + RG_CARL + ((kitem * 2 + d) * 64 + cb * 16 + fr) * 4);
#pragma unroll
            for (int i = 0; i < 2; ++i) { const int idx = tid + i * NTHR; ggr[i] = *(const v4u*)(GGR + (size_t)(t0 + (idx >> 3)) * YLD + h * 64 + (idx & 7) * 8); }
        }
        {
            const int c8 = (tid & 7) * 8;
            f32x4 w0[4], w1[4];
#pragma unroll
            for (int tap = 0; tap < 4; ++tap) { w0[tap] = *(const LAS f32x4*)(lds + RG_CWL + (tap * 64 + c8) * 4); w1[tap] = *(const LAS f32x4*)(lds + RG_CWL + (tap * 64 + c8 + 4) * 4); }
            const f32x4 b0 = *(const LAS f32x4*)(lds + RG_CWL + (4 * 64 + c8) * 4), b1 = *(const LAS f32x4*)(lds + RG_CWL + (4 * 64 + c8 + 4) * 4);
#pragma unroll
            for (int i = 0; i < 2; ++i) {
                const int idx = tid + i * NTHR, tk = idx >> 3, cg8 = idx & 7;
                f32x4 x0 = b0, x1 = b1;
#pragma unroll
                for (int tap = 0; tap < 4; ++tap) { const int t = t0 + tk + tap - 2; const bool ok = (t >= seq_lo) && (t < seq_hi);
                    v4u r = xr[i][tap]; r.x = ok ? r.x : 0u; r.y = ok ? r.y : 0u; r.z = ok ? r.z : 0u; r.w = ok ? r.w : 0u;
                    x0[0] += w0[tap][0] * bflo(r.x); x0[1] += w0[tap][1] * bfhi(r.x); x0[2] += w0[tap][2] * bflo(r.y); x0[3] += w0[tap][3] * bfhi(r.y);
                    x1[0] += w1[tap][0] * bflo(r.z); x1[1] += w1[tap][1] * bfhi(r.z); x1[2] += w1[tap][2] * bflo(r.w); x1[3] += w1[tap][3] * bfhi(r.w); }
                v4u o; o.x = pk2(x0[0], x0[1]); o.y = pk2(x0[2], x0[3]); o.z = pk2(x1[0], x1[1]); o.w = pk2(x1[2], x1[3]);
                *(LAS v4u*)(lds + RG_XA + tk * 144 + cg8 * 16) = o;
                *(LAS f32x4*)(lds + RG_XF + (tk * 68 + cg8 * 8) * 4) = x0; *(LAS f32x4*)(lds + RG_XF + (tk * 68 + cg8 * 8 + 4) * 4) = x1;
            }
        }
        if (kitem + 1 < NK) rg_load_raw(XR, rg_item<MODE>(kitem + 1), tid, xr);
        __syncthreads();
        const int tokb = wave * 16;
        bf16x8 afr[2];
#pragma unroll
        for (int ks = 0; ks < 2; ++ks) afr[ks] = *(const LAS bf16x8*)(lds + RG_XA + (tokb + fr) * 144 + (ks * 32 + fq * 8) * 2);
        f32x4 gcv[2][4];
#pragma unroll
        for (int d = 0; d < 2; ++d)
#pragma unroll
            for (int cb = 0; cb < 4; ++cb) gcv[d][cb] = *(const LAS f32x4*)(lds + RG_GCL + (d * 64 + cb * 16 + fr) * 16);
        float av[2][4][4], bv[2][4][4], Ap[2][4], Hp[2][4];
        const bool ctx = t0 < MCTX;
#pragma unroll
        for (int d = 0; d < 2; ++d) {
            if (MODE == 0 && ctx && d != (tt & 1)) continue;
#pragma unroll
            for (int cb = 0; cb < 4; ++cb) {
                const f32x4 gc = gcv[d][cb];
                f32x4 ar = {0.f, 0.f, 0.f, 0.f}, ai = {0.f, 0.f, 0.f, 0.f};
#pragma unroll
                for (int ks = 0; ks < 2; ++ks) {
                    const bf16x8 b0 = *(const LAS bf16x8*)(lds + RG_WB + (((0 * 8 + d * 4 + cb) * 2 + ks) * 64 + lane) * 16);
                    const bf16x8 b1 = *(const LAS bf16x8*)(lds + RG_WB + (((1 * 8 + d * 4 + cb) * 2 + ks) * 64 + lane) * 16);
                    ar = __builtin_amdgcn_mfma_f32_16x16x32_bf16(afr[ks], b0, ar, 0, 0, 0);
                    ai = __builtin_amdgcn_mfma_f32_16x16x32_bf16(afr[ks], b1, ai, 0, 0, 0);
                }
#pragma unroll
                for (int r = 0; r < 4; ++r) {
                    const float xcv = *(const LAS float*)(lds + RG_XF + ((tokb + fq * 4 + r) * 68 + cb * 16 + fr) * 4);
                    const float rr = __builtin_amdgcn_rcpf(__builtin_fmaf(__builtin_amdgcn_exp2f(ar[r]), gc[0], 1.f)), ii = __builtin_amdgcn_rcpf(__builtin_fmaf(__builtin_amdgcn_exp2f(ai[r]), gc[1], 1.f));
                    const float aa = __builtin_amdgcn_exp2f(rr * gc[2]);
                    const float om = fmaxf(1.f - aa * aa, 1e-12f);
                    av[d][cb][r] = aa; bv[d][cb][r] = __builtin_amdgcn_sqrtf(om) * ii * xcv;
                }
                float A = 1.f, Hh = 0.f;
#pragma unroll
                for (int rr = 0; rr < 4; ++rr) { const int r = d ? 3 - rr : rr; Hh = av[d][cb][r] * Hh + bv[d][cb][r]; A *= av[d][cb][r]; }
                float Aw = 1.f, Hw = 0.f, Apl = 1.f, Hpl = 0.f;
#pragma unroll
                for (int gg = 0; gg < 4; ++gg) { const int g = d ? 3 - gg : gg;
                    const float Ag = __shfl(A, g * 16 + fr), Hg = __shfl(Hh, g * 16 + fr);
                    if (g == fq) { Apl = Aw; Hpl = Hw; }
                    Hw = Ag * Hw + Hg; Aw *= Ag; }
                Ap[d][cb] = Apl; Hp[d][cb] = Hpl;
                if (fq == 0) *(LAS f32x2*)(lds + RG_AGL + ((wave * 2 + d) * 64 + cb * 16 + fr) * 8) = (f32x2){Aw, Hw};
            }
        }
        __syncthreads();
        if constexpr (MODE == 0) {
            if (tid < 128 && !(ctx && (tid >> 6) != (tt & 1))) {
                const int d = tid >> 6, cl = tid & 63; float A = 1.f, Hh = 0.f;
#pragma unroll
                for (int ww = 0; ww < 8; ++ww) { const int w2 = d ? 7 - ww : ww; const f32x2 sg = *(const LAS f32x2*)(lds + RG_AGL + ((w2 * 2 + d) * 64 + cl) * 8); Hh = sg[0] * Hh + sg[1]; A *= sg[0]; }
                AGG[((size_t)(tt * 16 + h) * 2 + d) * 64 + cl] = (f32x2){A, Hh};
            }
        } else {
            if (ctx && (tt & 1) == 0 && tid < 64) {
                float Hh = 0.f;
#pragma unroll
                for (int w2 = 0; w2 < 8; ++w2) { const f32x2 sg = *(const LAS f32x2*)(lds + RG_AGL + ((w2 * 2 + 0) * 64 + tid) * 8); Hh = sg[0] * Hh + sg[1]; }
                *(LAS float*)(lds + RG_CARL + (((kitem + 1) * 2 + 0) * 64 + tid) * 4) = Hh;
            }
            float hs[4][4];
#pragma unroll
            for (int cb = 0; cb < 4; ++cb)
#pragma unroll
                for (int r = 0; r < 4; ++r) hs[cb][r] = 0.f;
#pragma unroll
            for (int d = 0; d < 2; ++d)
#pragma unroll
                for (int cb = 0; cb < 4; ++cb) {
                    const int cl = cb * 16 + fr;
                    float hin = car[d][cb];
                    f32x2 sg[8];
#pragma unroll
                    for (int w2 = 0; w2 < 8; ++w2) sg[w2] = *(const LAS f32x2*)(lds + RG_AGL + ((w2 * 2 + d) * 64 + cl) * 8);
#pragma unroll
                    for (int ww = 0; ww < 8; ++ww) { const int w2 = d ? 7 - ww : ww; if (d ? (w2 > wave) : (w2 < wave)) hin = sg[w2][0] * hin + sg[w2][1]; }
                    float hh = Ap[d][cb] * hin + Hp[d][cb];
#pragma unroll
                    for (int rr = 0; rr < 4; ++rr) { const int r = d ? 3 - rr : rr; hh = av[d][cb][r] * hh + bv[d][cb][r]; hs[cb][r] += hh; }
                    if (ctx && (tt & 1) == (d ? 0 : 1) && wave == (d ? 0 : 7) && fq == (d ? 0 : 3)) nstate[(size_t)(tt >> 1) * 2048 + d * 1024 + h * 64 + cl] = hh;
                }
#pragma unroll
            for (int cb = 0; cb < 4; ++cb)
#pragma unroll
                for (int r = 0; r < 4; ++r) *(LAS float*)(lds + RG_XF + ((tokb + fq * 4 + r) * 68 + cb * 16 + fr) * 4) = hs[cb][r];
            __syncthreads();
#pragma unroll
            for (int i = 0; i < 2; ++i) {
                const int idx = tid + i * NTHR, tk = idx >> 3, cg8 = idx & 7;
                const f32x4 y0 = *(const LAS f32x4*)(lds + RG_XF + (tk * 68 + cg8 * 8) * 4), y1 = *(const LAS f32x4*)(lds + RG_XF + (tk * 68 + cg8 * 8 + 4) * 4);
                const v4u g = ggr[i];
                v4u o; o.x = pk2(y0[0] * bflo(g.x), y0[1] * bfhi(g.x)); o.y = pk2(y0[2] * bflo(g.y), y0[3] * bfhi(g.y));
                o.z = pk2(y1[0] * bflo(g.z), y1[1] * bfhi(g.z)); o.w = pk2(y1[2] * bflo(g.w), y1[3] * bfhi(g.w));
                *(v4u*)(YR + (size_t)(t0 + tk) * YLD + h * 64 + cg8 * 8) = o;
            }
        }
        if constexpr (MODE == 1) __syncthreads();
    }
}

template <int NT>
__device__ __forceinline__ float carry_chain(const f32x2* AGG, float* CAR, int tt0, int h, int d, int cl, float h0) {
    f32x2 ag[NT];
#pragma unroll
    for (int i = 0; i < NT; ++i) ag[i] = AGG[((size_t)((tt0 + i) * 16 + h) * 2 + d) * 64 + cl];
    float hc = h0;
#pragma unroll
    for (int ii = 0; ii < NT; ++ii) { const int i = d ? NT - 1 - ii : ii;
        CAR[((size_t)((tt0 + i) * 16 + h) * 2 + d) * 64 + cl] = hc; hc = ag[i][0] * hc + ag[i][1]; }
    return hc;
}
__device__ __forceinline__ void phase_carry(const Args& a, int gw, int NGW, int lane) {
    const f32x2* AGG = (const f32x2*)(a.ws + WS_AGG); float* CAR = (float*)(a.ws + WS_CAR);
    for (int wi = gw; wi < 34 * 2 * 16; wi += NGW) {
        const int s = wi >> 5, d = (wi >> 4) & 1, h = wi & 15, ch = h * 64 + lane;
        if (s < 32) {
            const size_t i0 = ((size_t)((2 * s) * 16 + h) * 2 + d) * 64 + lane, i1 = ((size_t)((2 * s + 1) * 16 + h) * 2 + d) * 64 + lane;
            if (d == 0) { CAR[i0] = 0.f; CAR[i1] = AGG[i0][1]; }
            else { CAR[i1] = 0.f; CAR[i0] = AGG[i1][1]; }
        } else {
            const int b = s - 32; const float h0 = a.in[I_STATE][(size_t)b * 2048 + d * 1024 + ch];
            if (d == 0) (void)carry_chain<32>(AGG, CAR, 64 + b * 32, h, 0, lane, h0);
            else (void)carry_chain<32>(AGG, CAR, 64 + b * 32, h, 1, lane, h0);
        }
    }
}

#define RLX_AGENT __ATOMIC_RELAXED, __HIP_MEMORY_SCOPE_AGENT
#define XB_TMO      128
#define XB_XCNT(j)  (256  + 64 * (j))
#define XB_XSUB(j)  (1280 + 64 * (j))
#define XB_XGEN(j)  (2304 + 64 * (j))
#define XB_TOP      3328
#define XB_TOPGEN   3392
#define XCD_BAR_WORDS 3456
#define XB_SPIN_CAP (1u << 18)

__device__ __forceinline__ unsigned xb_ld(unsigned* p)              { return __hip_atomic_load(p, __ATOMIC_RELAXED, __HIP_MEMORY_SCOPE_AGENT); }
__device__ __forceinline__ unsigned xb_add(unsigned* p, unsigned v) { return __hip_atomic_fetch_add(p, v, __ATOMIC_RELAXED, __HIP_MEMORY_SCOPE_AGENT); }
__device__ __forceinline__ unsigned xb_xcc_id() { return (unsigned)__builtin_amdgcn_s_getreg((3 << 11) | 20) & 0xFu; }
#define XB_SPIN(cond, bar) do { unsigned _sp = 0; while (cond) { __builtin_amdgcn_s_sleep(1); \
    if ((++_sp & 255u) == 0u) { if (xb_ld(&(bar)[XB_TMO])) break; if (_sp > XB_SPIN_CAP) { atomicAdd(&(bar)[XB_TMO], 1u); break; } } } } while (0)

struct XcdBarrier {
    unsigned* bar; unsigned x;
    volatile LAS unsigned* st;
};

__device__ __forceinline__ XcdBarrier xcd_barrier_post(unsigned* bar, volatile LAS unsigned* st) {
    XcdBarrier b; b.bar = bar; b.x = xb_xcc_id(); b.st = st;
    if (threadIdx.x == 0) (void)xb_add(&bar[XB_XCNT(b.x)], 1u);
    return b;
}
__device__ __forceinline__ void xcd_barrier_complete(unsigned* bar, unsigned x, unsigned& nloc, unsigned& nx) {
    const unsigned G = gridDim.x * gridDim.y * gridDim.z;
    unsigned sum, cnt, mine, sp = 0u;
    for (;;) {
        sum = 0u; cnt = 0u; mine = 0u;
#pragma unroll
        for (unsigned j = 0; j < 16; ++j) { const unsigned c = xb_ld(&bar[XB_XCNT(j)]); sum += c; cnt += (c > 0u) ? 1u : 0u; mine = (j == x) ? c : mine; }
        if (sum == G) break;
        __builtin_amdgcn_s_sleep(1);
        if ((++sp & 255u) == 0u) { if (xb_ld(&bar[XB_TMO])) break; if (sp > XB_SPIN_CAP) { atomicAdd(&bar[XB_TMO], 1u); break; } }
    }
    nloc = mine > 0u ? mine : 1u; nx = cnt > 0u ? cnt : 1u;
}

__device__ __forceinline__ void xcd_barrier(const XcdBarrier& b) {
    asm volatile("s_waitcnt vmcnt(0)" ::: "memory");
    __syncthreads();
    if (threadIdx.x == 0) {
        unsigned* bar = b.bar;
        __builtin_amdgcn_s_waitcnt(0);
        unsigned nloc = b.st[0], nx = b.st[1];
        if (nloc == 0u) { xcd_barrier_complete(bar, b.x, nloc, nx); b.st[0] = nloc; b.st[1] = nx; }
        const unsigned old = xb_add(&bar[XB_XSUB(b.x)], 1u);
        const unsigned gen = old / nloc;
        if (old + 1u == (gen + 1u) * nloc) {
            __builtin_amdgcn_fence(__ATOMIC_RELEASE, "agent");
            asm volatile("s_waitcnt vmcnt(0)" ::: "memory");
            const unsigned og = xb_add(&bar[XB_TOP], 1u);
            const unsigned tg = og / nx;
            if (og + 1u == (tg + 1u) * nx) xb_add(&bar[XB_TOPGEN], 1u);
            else XB_SPIN(xb_ld(&bar[XB_TOPGEN]) == tg, bar);
            __builtin_amdgcn_fence(__ATOMIC_ACQUIRE, "agent");
            xb_add(&bar[XB_XGEN(b.x)], 1u);
            asm volatile("s_waitcnt vmcnt(0)" ::: "memory");
        } else {
            XB_SPIN(xb_ld(&bar[XB_XGEN(b.x)]) == gen, bar);
            __builtin_amdgcn_fence(__ATOMIC_ACQUIRE, "agent");
            asm volatile("s_waitcnt vmcnt(0)" ::: "memory");
        }
    }
    __syncthreads();
}

__global__ void __launch_bounds__(NTHR, 2) fwd_megakernel(Args a) {
    extern __shared__ __attribute__((aligned(16))) unsigned char lds_raw[];
    LAS unsigned char* lds = (LAS unsigned char*)lds_raw;
    const int tid = threadIdx.x, lane = tid & 63, wave = __builtin_amdgcn_readfirstlane(tid >> 6);
    const int G = gridDim.x, gw = blockIdx.x * NWAVES + wave, NGW = G * NWAVES;
    unsigned char* ws = a.ws;
    const int lo = a.ph_lo, hi = a.ph_hi;
    volatile LAS unsigned* bst = (volatile LAS unsigned*)(lds + LDS_BAR_OFF);
    if (tid < 2) bst[tid] = 0u;
    __syncthreads();
    XcdBarrier bar = xcd_barrier_post((unsigned*)(ws + WS_CTL), bst);
#define IN(k) (lo <= (k) && (k) < hi)
#define SEAM(k) do { if (IN(k) && IN((k) + 1)) { xcd_barrier(bar); if (DUP >> 12 & 1) xcd_barrier(bar); } } while (0)
    float* const DUMSS = (float*)(ws + 1 * MiB + 512 * 1024);
#define REP(k) for (int rep_ = ((DUP >> (k)) & 1); rep_ >= 0; --rep_)
#define ISDUP (rep_ > 0)
    if (IN(0)) REP(0) phase_prep(a, lds, gw, NGW, wave, lane, ISDUP ? (float*)(ws + 1 * MiB + 256 * 1024) : (float*)(ws + CTL_MOD));
    if (IN(1)) {
        if (tid == 0) { unsigned sp = 0; const unsigned need = G > 192 ? 192u : (unsigned)G;
            while (__hip_atomic_load((unsigned*)(ws + CTL_MODCNT), __ATOMIC_RELAXED, __HIP_MEMORY_SCOPE_AGENT) < need) { __builtin_amdgcn_s_sleep(1); if (++sp > (1u << 22)) break; }
            __builtin_amdgcn_fence(__ATOMIC_ACQUIRE, "agent"); asm volatile("s_waitcnt vmcnt(0)" ::: "memory"); }
        __syncthreads();
        REP(1) phase_norm1(a, gw, NGW, lane);
    }
    SEAM(1);
    if (IN(2)) REP(2) {
        pg8::Gemm g{(const pg8::bf16_t*)(ws + WS_H), (const pg8::bf16_t*)(ws + WS_WIN), M, INC, D}; pg8::StaticOrder S; S.init(M, INC, G, (int)blockIdx.x, WG_IN);
        pg8::Epi<1> E{nullptr, nullptr, nullptr, ISDUP ? DUMSS : (float*)(ws + CTL_VSS), D, (bf16*)(ws + WS_GU), (bf16*)a.out, (bf16*)((unsigned char*)a.out + 32 * MiB), (bf16*)(ws + WS_GU) + D, (bf16*)(ws + WS_SGA), (bf16*)(ws + WS_SGB)};
        pg8::gemm_phase<pg8::Epi<1>, pg8::StaticOrder, true, true>(lds, g, S, E);
    }
    SEAM(2);
    if (IN(3)) REP(3) { phase_rg<0>(a, lds, tid, wave, lane, nullptr); phase_sgu(a, lds, tid, wave, lane, ISDUP ? (bf16*)(ws + WS_F) : (bf16*)(ws + WS_GU)); }
    SEAM(3);
    if (IN(5)) REP(5) phase_rg<1>(a, lds, tid, wave, lane, ISDUP ? (bf16*)(ws + WS_F) + D : (bf16*)(ws + WS_GU) + D);
    SEAM(5);
    if (IN(6)) REP(6) {
        pg8::Gemm g{(const pg8::bf16_t*)(ws + WS_GU), (const pg8::bf16_t*)(ws + WS_WBG), M, D, 2 * D}; pg8::StaticOrder S; S.init(M, D, G, (int)blockIdx.x);
        pg8::EpiMerge E{(bf16*)(ws + WS_H), (const bf16*)(ws + WS_SGA), (const bf16*)(ws + WS_SGB)};
        pg8::gemm_phase<pg8::EpiMerge, pg8::StaticOrder, false, true>(lds, g, S, E);
    }
    SEAM(6);
    if (IN(7)) {
        pg8::Gemm g{(const pg8::bf16_t*)(ws + WS_H), (const pg8::bf16_t*)(ws + WS_WOUT), M, D, D}; pg8::StaticOrder S; S.init(M, D, G, (int)blockIdx.x);
        EpiFused<6> E{a.out, a.in[I_XP], a.in[I_XS], (bf16*)(ws + WS_H), (float*)(ws + CTL_OSS), (float*)(ws + CTL_XSS), (unsigned*)(ws + CTL_CNT), (unsigned*)(ws + CTL_CNT + 16384),
                      (const float*)(ws + CTL_MOD), a.in[I_BADA], a.in[I_GPOSTMIX], a.in[I_GPREMLP]};
        pg8::gemm_phase<EpiFused<6>, pg8::StaticOrder, false, true>(lds, g, S, E);
    }
    SEAM(7);
    if (IN(8)) REP(8) {
        pg8::Gemm g{(const pg8::bf16_t*)(ws + WS_H), (const pg8::bf16_t*)(ws + WS_WFF1), M, FF, D}; pg8::StaticOrder S; S.init(M, FF, G, (int)blockIdx.x, WG_FF1);
        pg8::Epi<5> E{(bf16*)(ws + WS_F1), nullptr, nullptr, nullptr, FF, nullptr, nullptr, nullptr, nullptr, nullptr, nullptr};
        pg8::gemm_phase<pg8::Epi<5>, pg8::StaticOrder, true, true>(lds, g, S, E);
    }
    SEAM(8);
    if (IN(9)) {
        pg8::Gemm g{(const pg8::bf16_t*)(ws + WS_F1), (const pg8::bf16_t*)(ws + WS_WFF2), M, D, FF}; pg8::StaticOrder S; S.init(M, D, G, (int)blockIdx.x);
        EpiFused<7> E{a.out, nullptr, nullptr, nullptr, (float*)(ws + CTL_FSS), nullptr, (unsigned*)(ws + CTL_CNT + 32768), nullptr,
                      (const float*)(ws + CTL_MOD), a.in[I_BADA], a.in[I_GPOSTMLP], nullptr};
        pg8::gemm_phase<EpiFused<7>, pg8::StaticOrder, false, true>(lds, g, S, E);
    }
#undef IN
#undef SEAM
}

constexpr int N_PHASES = 10;
extern "C" void kernel_launch(void* const* d_in, const int* in_sizes, int n_in, void* d_out, int out_size, void* d_ws, size_t ws_size, hipStream_t stream) {
    static int grid = 0;
    if (grid == 0) {
        if (n_in != 27 || ws_size < WS_END) { fprintf(stderr, "kernel_launch: need 27 inputs and >= %zu B of workspace; got %d, %zu\n", (size_t)WS_END, n_in, ws_size); grid = -1; return; }
        int dev = 0, cus = 0, per_cu = 0;
        if (hipGetDevice(&dev) != hipSuccess || hipDeviceGetAttribute(&cus, hipDeviceAttributeMultiprocessorCount, dev) != hipSuccess) { grid = -1; return; }
        if (hipFuncSetAttribute((const void*)fwd_megakernel, hipFuncAttributeMaxDynamicSharedMemorySize, LDS_BYTES) != hipSuccess) { fprintf(stderr, "kernel_launch: hipFuncSetAttribute failed\n"); grid = -1; return; }
        if (hipOccupancyMaxActiveBlocksPerMultiprocessor(&per_cu, (const void*)fwd_megakernel, NTHR, LDS_BYTES) != hipSuccess || per_cu < 1) { fprintf(stderr, "kernel_launch: occupancy query says %d\n", per_cu); per_cu = 1; }
        (void)hipGetLastError();
        grid = cus * per_cu;
        if (grid < 256) { fprintf(stderr, "kernel_launch: this kernel's work split needs 256 co-resident workgroups; the device offers %d\n", grid); grid = -1; return; }
        grid = 256;
    }
    if (grid < 0) return;
    (void)hipMemsetAsync((char*)d_ws + WS_CTL, 0, CTL_ZERO_BYTES, stream);
    Args a{};
    for (int i = 0; i < 27; ++i) a.in[i] = (const float*)d_in[i];
    a.out = (float*)d_out; a.ws = (unsigned char*)d_ws; a.ph_lo = 0; a.ph_hi = N_PHASES;
    void* args[] = {&a};
    hipError_t e = hipLaunchCooperativeKernel((const void*)fwd_megakernel, dim3(grid), dim3(NTHR), args, LDS_BYTES, stream);
    if (e != hipSuccess) fprintf(stderr, "kernel_launch: cooperative launch failed: %s (grid %d)\n", hipGetErrorString(e), grid);
}
```

```cpp
#include <hip/hip_runtime.h>
#include <hip/hip_cooperative_groups.h>
#include <cstdio>
#include <cstdint>
namespace cg = cooperative_groups;
namespace pg8 {
#define PG8_LAS __attribute__((address_space(3)))
typedef unsigned short bf16_t;
typedef short bf16x8 __attribute__((ext_vector_type(8)));
typedef float f32x4 __attribute__((ext_vector_type(4)));
typedef unsigned u32x4 __attribute__((ext_vector_type(4)));
constexpr int BM = 256, BK = 64, HALF = 128, HTB = HALF * BK * 2  , STAGE_BYTES = 8 * HTB, NXCD = 8, WGM = 8;

__host__ __device__ __forceinline__ int lds_byte(int r, int c) { const int st = (r >> 4) * 2 + (c >> 5), rr = r & 15, cc = c & 31, ob = rr * 64 + cc * 2; return st * 1024 + (ob ^ (((ob >> 9) & 1) << 5)); }
__host__ __device__ __forceinline__ void stage_rc(int b, int& R, int& C) { const int st = b / 1024, sb = b % 1024, swz = sb ^ (((sb >> 9) & 1) << 5); R = (st >> 1) * 16 + swz / 64; C = (st & 1) * 32 + (swz % 64) / 2; }
__host__ __device__ __forceinline__ int perm32(int rho) { const int n = rho >> 4, i = rho & 15; return 8 * (i >> 2) + 4 * n + (i & 3); }

struct Unit { int pm, pn; };
struct Gemm { const bf16_t* A; const bf16_t* Bt; int M, N, K; };

struct StaticOrder {
    int nM, nN, nwg, G, c, wgm;
    __host__ __device__ void init(int M, int N, int G_, int c_, int wgm_ = 8) { nM = M / BM; nN = N / BM; nwg = nM * nN; G = G_; c = c_; wgm = wgm_; }
    __host__ __device__ bool next(int i, Unit& u) const {
        const long L = (long)i * G + c; if (L >= nwg) return false;
        int wgid = (int)L; { const int q = nwg / NXCD, r = nwg % NXCD, xcd = wgid % NXCD, off = wgid / NXCD; wgid = (xcd < r ? xcd * (q + 1) : r * (q + 1) + (xcd - r) * q) + off; }
        const int nig = wgm * nN, gid = wgid / nig, fm = gid * wgm, gsz = (nM - fm) < wgm ? (nM - fm) : wgm;
        u.pm = fm + ((wgid % nig) % gsz); u.pn = (wgid % nig) / gsz; return true;
    }
    __device__ __forceinline__ void a_ready(const Unit&) const {}
    __device__ __forceinline__ void done(const Unit&) const {}
};

typedef __bf16 bf16x2_cvt __attribute__((ext_vector_type(2)));
typedef float f32x2_cvt __attribute__((ext_vector_type(2)));
__device__ __forceinline__ unsigned cvt_pk_bf16(float lo, float hi) { const f32x2_cvt v = {lo, hi}; const bf16x2_cvt b = __builtin_convertvector(v, bf16x2_cvt); return __builtin_bit_cast(unsigned, b); }
__device__ __forceinline__ float sigmoid_f(float x) { return __builtin_amdgcn_rcpf(1.f + __builtin_amdgcn_exp2f(-1.4426950409f * x)); }
__device__ __forceinline__ float gelu_tanh_f(float x) { const float u = x * (-2.3022081985f - 0.10294324f * (x * x)); return x * __builtin_amdgcn_rcpf(1.f + __builtin_amdgcn_exp2f(u)); }
__device__ __forceinline__ float bflo(unsigned w) { return __builtin_bit_cast(float, w << 16); }
__device__ __forceinline__ float bfhi(unsigned w) { return __builtin_bit_cast(float, w & 0xffff0000u); }
template <int MODE> struct Epi {
    static constexpr bool PERM = true, AFTER_DRAIN = false, HOOK = false;
    bf16_t* Ob; float* Of; const bf16_t* G; float* SS; int ldc;
    bf16_t *s0, *s1, *s2, *s3, *s4, *s5;
    template <int ACT> __device__ __forceinline__ void act_store(const f32x4 (&acc)[2][2][4][2], bf16_t* base, int ld, int row0, int col0, int fq) const {
#pragma unroll
        for (int ai = 0; ai < 2; ++ai)
#pragma unroll
            for (int m = 0; m < 4; ++m) {
                const int row = row0 + ai * HALF + m * 16; bf16_t* rowp = base + (size_t)row * ld + col0; float ss = 0.f;
#pragma unroll
                for (int bj = 0; bj < 2; ++bj) {
                    f32x4 v0 = acc[ai][bj][m][0], v1 = acc[ai][bj][m][1];
                    if constexpr (ACT == 2) {
#pragma unroll
                        for (int j = 0; j < 4; ++j) { v0[j] = sigmoid_f(v0[j]); v1[j] = sigmoid_f(v1[j]); }
                    } else if constexpr (ACT == 1 || ACT == 3) {
#pragma unroll
                        for (int j = 0; j < 4; ++j) { v0[j] = gelu_tanh_f(v0[j]); v1[j] = gelu_tanh_f(v1[j]); }
                    }
                    if constexpr (ACT == 3) {
#pragma unroll
                        for (int j = 0; j < 4; ++j) ss += v0[j] * v0[j] + v1[j] * v1[j];
                    }
                    u32x4 w; w.x = cvt_pk_bf16(v0[0], v0[1]); w.y = cvt_pk_bf16(v0[2], v0[3]); w.z = cvt_pk_bf16(v1[0], v1[1]); w.w = cvt_pk_bf16(v1[2], v1[3]);
                    *(u32x4*)(rowp + bj * HALF) = w;
                }
                if constexpr (ACT == 3) { ss += __shfl_xor(ss, 16); ss += __shfl_xor(ss, 32); if (fq == 0) atomicAdd(SS + row, ss); }
            }
    }
    __device__ __forceinline__ void operator()(const f32x4 (&acc)[2][2][4][2], const Unit& u, int wr, int wc, int fr, int fq) const {
        const int row0 = u.pm * BM + wr * 64 + fr;
        if constexpr (MODE == 1) {
            const int t = u.pn >> 2;
            bf16_t* base = t == 0 ? s0 : t == 1 ? s1 : t == 2 ? s2 : t == 3 ? s3 : t == 4 ? s4 : s5;
            const int ld = (t == 0 || t == 3) ? 2048 : 1024;
            const int col0 = (u.pn & 3) * BM + wc * 32 + 8 * fq;
            if (t >= 4) act_store<2>(acc, base, ld, row0, col0, fq);
            else if (t == 2) act_store<0>(acc, base, ld, row0, col0, fq);
            else if (t == 1) act_store<3>(acc, base, ld, row0, col0, fq);
            else act_store<1>(acc, base, ld, row0, col0, fq);
        } else {
            const int col0 = u.pn * BM + wc * 32 + 8 * fq;
#pragma unroll
            for (int ai = 0; ai < 2; ++ai)
#pragma unroll
                for (int m = 0; m < 4; ++m) {
                    const int row = row0 + ai * HALF + m * 16; float ss = 0.f;
#pragma unroll
                    for (int bj = 0; bj < 2; ++bj) {
                        f32x4 v0 = acc[ai][bj][m][0], v1 = acc[ai][bj][m][1];
                        const size_t off = (size_t)row * ldc + col0 + bj * HALF;
                        if constexpr (MODE == 2 || MODE == 3) {
                            const u32x4 g = *(const u32x4*)(G + off);
                            v0[0] *= bflo(g.x); v0[1] *= bfhi(g.x); v0[2] *= bflo(g.y); v0[3] *= bfhi(g.y);
                            v1[0] *= bflo(g.z); v1[1] *= bfhi(g.z); v1[2] *= bflo(g.w); v1[3] *= bfhi(g.w);
                        }
                        if constexpr (MODE == 3) { v0 = v0 + *(const f32x4*)(Of + off); v1 = v1 + *(const f32x4*)(Of + off + 4); }
                        if constexpr (MODE == 5) {
#pragma unroll
                            for (int j = 0; j < 4; ++j) { const float a = fmaxf(v0[j], 0.f), b = fmaxf(v1[j], 0.f); v0[j] = a * a; v1[j] = b * b; }
                        }
                        if constexpr (MODE == 4) {
#pragma unroll
                            for (int j = 0; j < 4; ++j) ss += v0[j] * v0[j] + v1[j] * v1[j];
                        }
                        if constexpr (MODE == 2 || MODE == 4) { *(f32x4*)(Of + off) = v0; *(f32x4*)(Of + off + 4) = v1; }
                        else { u32x4 w; w.x = cvt_pk_bf16(v0[0], v0[1]); w.y = cvt_pk_bf16(v0[2], v0[3]); w.z = cvt_pk_bf16(v1[0], v1[1]); w.w = cvt_pk_bf16(v1[2], v1[3]);
                            *(u32x4*)(Ob + off) = w; }
                    }
                    if constexpr (MODE == 4) { ss += __shfl_xor(ss, 16); ss += __shfl_xor(ss, 32); if (fq == 0) atomicAdd(SS + row, ss); }
                }
        }
    }
};

struct EpiMerge {
    static constexpr bool PERM = true, AFTER_DRAIN = false, HOOK = true;
    bf16_t* Ob; const bf16_t* GA; const bf16_t* GB;
    __device__ __forceinline__ void mid(f32x4 (&acc)[2][2][4][2], const Unit& u, int wr, int wc, int fr, int fq) const {
        int row0 = u.pm * BM + wr * 64 + fr, col0 = u.pn * BM + wc * 32 + 8 * fq;
        asm volatile("" : "+v"(row0), "+v"(col0));
#pragma unroll
        for (int ai = 0; ai < 2; ++ai)
#pragma unroll
            for (int m = 0; m < 4; ++m) {
                if ((m & 1) == 0) asm volatile("" ::: "memory");
#pragma unroll
                for (int bj = 0; bj < 2; ++bj) {
                    const size_t off = (size_t)(row0 + ai * HALF + m * 16) * 1024 + col0 + bj * HALF;
                    const u32x4 a = *(const u32x4*)(GA + off), b = *(const u32x4*)(GB + off);
                    f32x4 r0, r1;
                    r0[0] = bflo(a.x) * __builtin_amdgcn_rcpf(fmaxf(bflo(b.x), 1e-30f)); r0[1] = bfhi(a.x) * __builtin_amdgcn_rcpf(fmaxf(bfhi(b.x), 1e-30f));
                    r0[2] = bflo(a.y) * __builtin_amdgcn_rcpf(fmaxf(bflo(b.y), 1e-30f)); r0[3] = bfhi(a.y) * __builtin_amdgcn_rcpf(fmaxf(bfhi(b.y), 1e-30f));
                    r1[0] = bflo(a.z) * __builtin_amdgcn_rcpf(fmaxf(bflo(b.z), 1e-30f)); r1[1] = bfhi(a.z) * __builtin_amdgcn_rcpf(fmaxf(bfhi(b.z), 1e-30f));
                    r1[2] = bflo(a.w) * __builtin_amdgcn_rcpf(fmaxf(bflo(b.w), 1e-30f)); r1[3] = bfhi(a.w) * __builtin_amdgcn_rcpf(fmaxf(bfhi(b.w), 1e-30f));
                    acc[ai][bj][m][0] = acc[ai][bj][m][0] * r0; acc[ai][bj][m][1] = acc[ai][bj][m][1] * r1;
                }
            }
    }
    __device__ __forceinline__ void operator()(const f32x4 (&acc)[2][2][4][2], const Unit& u, int wr, int wc, int fr, int fq) const {
        const int row0 = u.pm * BM + wr * 64 + fr, col0 = u.pn * BM + wc * 32 + 8 * fq;
#pragma unroll
        for (int ai = 0; ai < 2; ++ai)
#pragma unroll
            for (int m = 0; m < 4; ++m)
#pragma unroll
                for (int bj = 0; bj < 2; ++bj) {
                    const size_t off = (size_t)(row0 + ai * HALF + m * 16) * 1024 + col0 + bj * HALF;
                    const u32x4 b = *(const u32x4*)(GB + off);
                    const f32x4 v0 = acc[ai][bj][m][0], v1 = acc[ai][bj][m][1];
                    u32x4 w; w.x = cvt_pk_bf16(v0[0] * bflo(b.x), v0[1] * bfhi(b.x)); w.y = cvt_pk_bf16(v0[2] * bflo(b.y), v0[3] * bfhi(b.y));
                    w.z = cvt_pk_bf16(v1[0] * bflo(b.z), v1[1] * bfhi(b.z)); w.w = cvt_pk_bf16(v1[2] * bflo(b.w), v1[3] * bfhi(b.w));
                    *(u32x4*)(Ob + off) = w;
                }
    }
};

template <class Epi, class Sched, bool ALIGN_EPI = false, bool SP2 = false>
__device__ __forceinline__ void gemm_phase(PG8_LAS unsigned char* lds, const Gemm g, const Sched& S, const Epi& E) {
    const int tid = threadIdx.x, wid = __builtin_amdgcn_readfirstlane(tid >> 6), lane = tid & 63, wr = wid >> 2, wc = wid & 3, fr = lane & 15, fq = lane >> 4;
    const int K = g.K, nt = K / BK;
    unsigned voffA[2], voffB[2];
#pragma unroll
    for (int i = 0; i < 2; ++i) { int R, C; stage_rc(tid * 16 + i * 8192, R, C); const int Rb = Epi::PERM ? ((R & ~31) + perm32(R & 31)) : R;
        voffA[i] = (unsigned)(R * K + C) * 2u; voffB[i] = (unsigned)(Rb * K + C) * 2u; }
    const size_t kstep = (size_t)(BK * 2);
    const size_t hstep = (size_t)HALF * K * 2;
    const size_t tstep = 2 * hstep;
    const unsigned ldsw = (unsigned)wid * 1024u;
    const int aoff = lds_byte(wr * 64 + fr, fq * 8), boff = lds_byte(wc * 32 + fr, fq * 8);
#define PG8_SA(b, h) (((b) * 2 + (h)) * HTB)
#define PG8_SB(b, h) ((4 + (b) * 2 + (h)) * HTB)
#define PG8_STAGE(bufoff, gbase, voff) do { _Pragma("unroll") for (int _i = 0; _i < 2; ++_i) \
        __builtin_amdgcn_global_load_lds((const unsigned*)((const char*)(gbase) + (voff)[_i]), (PG8_LAS unsigned*)(lds + (bufoff) + ldsw + _i * 8192), 16, 0, 0); } while (0)
#define PG8_LDA(dst, b, h) do { _Pragma("unroll") for (int m = 0; m < 4; ++m) _Pragma("unroll") for (int k = 0; k < 2; ++k) dst[m][k] = *(const PG8_LAS bf16x8*)(lds + PG8_SA(b, h) + aoff + m * 2048 + k * 1024); } while (0)
#define PG8_LDB(dst, b, h) do { _Pragma("unroll") for (int n = 0; n < 2; ++n) _Pragma("unroll") for (int k = 0; k < 2; ++k) dst[n][k] = *(const PG8_LAS bf16x8*)(lds + PG8_SB(b, h) + boff + n * 2048 + k * 1024); } while (0)
#define PG8_MMA(ai, bj, At, Bt) do { __builtin_amdgcn_s_setprio(1); _Pragma("unroll") for (int m = 0; m < 4; ++m) _Pragma("unroll") for (int n = 0; n < 2; ++n) _Pragma("unroll") for (int k = 0; k < 2; ++k) \
        acc[ai][bj][m][n] = __builtin_amdgcn_mfma_f32_16x16x32_bf16(Bt[n][k], At[m][k], acc[ai][bj][m][n], 0, 0, 0); __builtin_amdgcn_s_setprio(0); } while (0)
#define PG8_WAIT_V(n) asm volatile("s_waitcnt vmcnt(" #n ")" ::: "memory")
#define PG8_WAIT_L(n) asm volatile("s_waitcnt lgkmcnt(" #n ")" ::: "memory")
#define PG8_BAR __builtin_amdgcn_s_barrier()
#define PG8_SCHED __builtin_amdgcn_sched_barrier(0)
    Unit cur, nxt; int ui = 0;
    if (!S.next(0, cur)) return;
    f32x4 acc[2][2][4][2];
#pragma unroll
    for (int a = 0; a < 2; ++a)
#pragma unroll
        for (int b = 0; b < 2; ++b)
#pragma unroll
            for (int m = 0; m < 4; ++m)
#pragma unroll
                for (int n = 0; n < 2; ++n) acc[a][b][m][n] = (f32x4){0.f, 0.f, 0.f, 0.f};
    bf16x8 At[4][2], B0[2][2], B1[2][2];
    const char* cA = (const char*)g.A + (size_t)cur.pm * tstep; const char* cB = (const char*)g.Bt + (size_t)cur.pn * tstep;
    S.a_ready(cur);
    if constexpr (SP2) {
        PG8_STAGE(PG8_SB(0, 0), cB, voffB); PG8_STAGE(PG8_SB(0, 1), cB + hstep, voffB); PG8_STAGE(PG8_SA(0, 0), cA, voffA); PG8_STAGE(PG8_SA(0, 1), cA + hstep, voffA);
        if (wr == 1) PG8_BAR;
        PG8_WAIT_V(2); PG8_BAR;
        PG8_STAGE(PG8_SB(1, 0), cB + kstep, voffB); PG8_STAGE(PG8_SA(1, 0), cA + kstep, voffA); PG8_STAGE(PG8_SB(1, 1), cB + hstep + kstep, voffB);
        PG8_WAIT_V(6); PG8_BAR;
    } else {
        PG8_STAGE(PG8_SB(0, 0), cB, voffB); PG8_STAGE(PG8_SA(0, 0), cA, voffA); PG8_STAGE(PG8_SB(0, 1), cB + hstep, voffB); PG8_STAGE(PG8_SA(0, 1), cA + hstep, voffA);
        if (wr == 1) PG8_BAR;
        PG8_WAIT_V(4); PG8_BAR;
        PG8_STAGE(PG8_SB(1, 0), cB + kstep, voffB); PG8_STAGE(PG8_SA(1, 0), cA + kstep, voffA); PG8_STAGE(PG8_SB(1, 1), cB + hstep + kstep, voffB);
        PG8_WAIT_V(6); PG8_BAR;
    }
    for (;;) {
        const bool has_next = S.next(ui + 1, nxt);
        const char* nA = has_next ? (const char*)g.A + (size_t)nxt.pm * tstep : cA; const char* nB = has_next ? (const char*)g.Bt + (size_t)nxt.pn * tstep : cB;
        for (int t = 0; t < nt; t += 2) {
            if constexpr (Epi::HOOK) { if (t == (nt >> 1)) E.mid(acc, cur, wr, wc, fr, fq); }
            const bool last = (t == nt - 2);
            const char* a1 = cA + (size_t)(t + 1) * kstep;
            const char* a2 = last ? nA : cA + (size_t)(t + 2) * kstep; const char* b2 = last ? nB : cB + (size_t)(t + 2) * kstep;
            const char* a3 = a2 + kstep; const char* b3 = b2 + kstep;
            if (last && has_next) S.a_ready(nxt);
            if constexpr (SP2) {
            PG8_LDB(B0, 0, 0); PG8_LDB(B1, 0, 1); PG8_SCHED; PG8_LDA(At, 0, 0); PG8_STAGE(PG8_SA(1, 1), a1 + hstep, voffA);
            PG8_WAIT_V(8); PG8_WAIT_L(0); PG8_BAR; PG8_MMA(0, 0, At, B0); PG8_MMA(0, 1, At, B1); PG8_BAR; PG8_SCHED;
            PG8_LDA(At, 0, 1); PG8_STAGE(PG8_SB(0, 0), b2, voffB); PG8_STAGE(PG8_SB(0, 1), b2 + hstep, voffB); PG8_STAGE(PG8_SA(0, 0), a2, voffA);
            PG8_WAIT_V(8); PG8_WAIT_L(0); PG8_BAR; PG8_MMA(1, 0, At, B0); PG8_MMA(1, 1, At, B1); PG8_BAR; PG8_SCHED;
            PG8_LDB(B0, 1, 0); PG8_LDB(B1, 1, 1); PG8_SCHED; PG8_LDA(At, 1, 0); PG8_STAGE(PG8_SA(0, 1), a2 + hstep, voffA);
            PG8_WAIT_V(8); PG8_WAIT_L(0); PG8_BAR; PG8_MMA(0, 0, At, B0); PG8_MMA(0, 1, At, B1); PG8_BAR; PG8_SCHED;
            PG8_LDA(At, 1, 1); PG8_STAGE(PG8_SB(1, 0), b3, voffB); PG8_STAGE(PG8_SB(1, 1), b3 + hstep, voffB); PG8_STAGE(PG8_SA(1, 0), a3, voffA);
            PG8_WAIT_V(8); PG8_WAIT_L(0); PG8_BAR; PG8_MMA(1, 0, At, B0); PG8_MMA(1, 1, At, B1); PG8_BAR; PG8_SCHED;
            } else {
            PG8_LDB(B0, 0, 0); PG8_SCHED; PG8_LDA(At, 0, 0); PG8_STAGE(PG8_SA(1, 1), a1 + hstep, voffA);
            PG8_WAIT_L(8); PG8_BAR; PG8_WAIT_L(0); PG8_MMA(0, 0, At, B0); PG8_BAR; PG8_SCHED;
            PG8_LDB(B1, 0, 1); PG8_STAGE(PG8_SB(0, 0), b2, voffB);
            PG8_BAR; PG8_WAIT_L(0); PG8_MMA(0, 1, At, B1); PG8_BAR;
            PG8_LDA(At, 0, 1); PG8_STAGE(PG8_SA(0, 0), a2, voffA);
            PG8_BAR; PG8_WAIT_L(0); PG8_MMA(1, 0, At, B0); PG8_BAR; PG8_SCHED;
            PG8_STAGE(PG8_SB(0, 1), b2 + hstep, voffB);
            PG8_WAIT_V(6); PG8_BAR; PG8_MMA(1, 1, At, B1); PG8_BAR;
            PG8_LDB(B0, 1, 0); PG8_SCHED; PG8_LDA(At, 1, 0); PG8_STAGE(PG8_SA(0, 1), a2 + hstep, voffA);
            PG8_WAIT_L(8); PG8_BAR; PG8_WAIT_L(0); PG8_MMA(0, 0, At, B0); PG8_BAR; PG8_SCHED;
            PG8_LDB(B1, 1, 1); PG8_STAGE(PG8_SB(1, 0), b3, voffB);
            PG8_BAR; PG8_WAIT_L(0); PG8_MMA(0, 1, At, B1); PG8_BAR;
            PG8_LDA(At, 1, 1); PG8_STAGE(PG8_SA(1, 0), a3, voffA);
            PG8_BAR; PG8_WAIT_L(0); PG8_MMA(1, 0, At, B0); PG8_BAR; PG8_SCHED;
            PG8_STAGE(PG8_SB(1, 1), b3 + hstep, voffB);
            PG8_WAIT_V(6); PG8_BAR; PG8_MMA(1, 1, At, B1); PG8_BAR;
            }
        }
        if constexpr (ALIGN_EPI) { if (wr == 0) PG8_BAR; }
        if constexpr (!Epi::AFTER_DRAIN) { E(acc, cur, wr, wc, fr, fq); S.done(cur); }
        if (!has_next) break;
#pragma unroll
        for (int a = 0; a < 2; ++a)
#pragma unroll
            for (int b = 0; b < 2; ++b)
#pragma unroll
                for (int m = 0; m < 4; ++m)
#pragma unroll
                    for (int n = 0; n < 2; ++n) acc[a][b][m][n] = (f32x4){0.f, 0.f, 0.f, 0.f};
        cur = nxt; cA = nA; cB = nB; ++ui;
        if constexpr (ALIGN_EPI) { if (wr == 1) PG8_BAR; }
    }
    PG8_WAIT_V(0);
    if constexpr (!ALIGN_EPI) { if (wr == 0) PG8_BAR; }
    PG8_BAR;
    if constexpr (Epi::AFTER_DRAIN) { E.fused(acc, cur, wr, wc, fr, fq, lds, wid, lane); S.done(cur); }
#undef PG8_SA
#undef PG8_SB
#undef PG8_STAGE
#undef PG8_LDA
#undef PG8_LDB
#undef PG8_MMA
#undef PG8_WAIT_V
#undef PG8_WAIT_L
#undef PG8_BAR
#undef PG8_SCHED
}
}

constexpr int NWAVES = 8, NTHR = NWAVES * 64;
constexpr int D = 1024, M = 16384, MCTX = 8192, INC = 6144, FF = 4096;
constexpr float EPS = 1e-6f, LOG2E = 1.4426950408889634f;
constexpr size_t MiB = 1u << 20;
constexpr size_t WS_CTL = 0, CTL_ZERO_BYTES = 1 * MiB;
constexpr size_t CTL_VSS = 64 * 1024, CTL_OSS = 128 * 1024, CTL_FSS = 192 * 1024, CTL_MOD = 256 * 1024, CTL_XSS = 384 * 1024;
constexpr size_t CTL_CNT = 16 * 1024;
constexpr size_t WS_GC = 1 * MiB;
constexpr size_t WS_AGG = 2 * MiB;
constexpr size_t WS_CAR = 4 * MiB;
constexpr size_t WS_WG = 5 * MiB;
constexpr size_t WS_WSP = 5 * MiB + 512 * 1024;
constexpr size_t WS_WFF2 = 6 * MiB, WS_WFF1 = 14 * MiB, WS_WIN = 22 * MiB, WS_WBG = 34 * MiB, WS_WBR = 36 * MiB, WS_WOUT = 38 * MiB;
constexpr size_t WS_H = 40 * MiB;
constexpr size_t WS_F = 64 * MiB;
constexpr size_t WS_GU = 128 * MiB, WS_GGR = 160 * MiB, WS_SGA = 192 * MiB, WS_SGB = 224 * MiB;
constexpr size_t WS_F1 = 128 * MiB;
constexpr size_t WS_END = 256 * MiB;
constexpr int LDS_BYTES = 147456, LDS_BAR_OFF = 139264;
#ifndef WG_IN
#define WG_IN 4
#endif
#ifndef WG_FF1
#define WG_FF1 2
#endif
#ifndef DUP
#define DUP 0
#endif

#define GAS __attribute__((address_space(1)))
#define LAS __attribute__((address_space(3)))
typedef unsigned short bf16;
typedef unsigned v4u __attribute__((ext_vector_type(4)));
typedef unsigned v2u __attribute__((ext_vector_type(2)));
typedef float f32x4 __attribute__((ext_vector_type(4)));
typedef float f32x2 __attribute__((ext_vector_type(2)));
typedef short bf16x8 __attribute__((ext_vector_type(8)));
#define LDS_WAIT() asm volatile("s_waitcnt lgkmcnt(0)" ::: "memory")
__device__ __forceinline__ unsigned f2bf(float f) { unsigned u = __builtin_bit_cast(unsigned, f); return (u + 0x7fffu + ((u >> 16) & 1u)) >> 16; }
__device__ __forceinline__ unsigned pk2(float lo, float hi) { return pg8::cvt_pk_bf16(lo, hi); }
__device__ __forceinline__ float bf2f(bf16 b) { return __builtin_bit_cast(float, (unsigned)b << 16); }
using pg8::bflo; using pg8::bfhi;

struct Args { const float* in[27]; float* out; unsigned char* ws; int ph_lo, ph_hi; };
enum { I_XP = 0, I_XS, I_STATE, I_C, I_CCTX, I_WADA, I_BADA, I_GPREMIX, I_GPOSTMIX, I_GPREMLP, I_GPOSTMLP, I_WIN, I_GSGU, I_WSP, I_BSP, I_CONVW, I_CONVB,
       I_WRA, I_BRA, I_WRI, I_BRI, I_LAM, I_WBRG, I_WBRR, I_WOUT, I_WFF1, I_WFF2 };

__device__ __forceinline__ float wave_sum(float v) {
#pragma unroll
    for (int o = 1; o < 64; o <<= 1) v += __shfl_xor(v, o);
    return v;
}
__device__ __forceinline__ void p0_transpose_item(const float* W, int K, int N, bf16* WT, LAS float* scr, int item, int lane, int ldk = 0, int koff = 0) {
    if (ldk == 0) ldk = K;
    const int nblk = N / 32, kb = item / nblk, nb = item % nblk, k0 = 64 * kb, n0 = 32 * nb;
#pragma unroll
    for (int i = 0; i < 8; ++i) { const int kk = 8 * i + (lane >> 3);
        const f32x4 v = *(const f32x4*)(W + (size_t)(k0 + kk) * N + n0 + (lane & 7) * 4);
        LAS float* dd = scr + kk * 33 + (lane & 7) * 4; dd[0] = v[0]; dd[1] = v[1]; dd[2] = v[2]; dd[3] = v[3]; }
    LDS_WAIT(); asm volatile("" ::: "memory");
    const int c = lane & 7;
#pragma unroll
    for (int j = 0; j < 4; ++j) { const int n = (lane >> 3) + 8 * j; const LAS float* s = scr + (8 * c) * 33 + n;
        v4u o; o.x = pk2(s[0 * 33], s[1 * 33]); o.y = pk2(s[2 * 33], s[3 * 33]); o.z = pk2(s[4 * 33], s[5 * 33]); o.w = pk2(s[6 * 33], s[7 * 33]);
        *(v4u*)(WT + (size_t)(n0 + n) * ldk + koff + k0 + 8 * c) = o; }
    LDS_WAIT(); asm volatile("" ::: "memory");
}

__device__ __forceinline__ void phase_prep(const Args& a, LAS unsigned char* lds, int gw, int NGW, int wave, int lane, float* MOD) {
    unsigned char* ws = a.ws;
    LAS float* scr = (LAS float*)(lds + wave * 16384);
    if ((int)blockIdx.x < 192) {
        const float* wada = a.in[I_WADA]; const float* cctx = a.in[I_CCTX]; const float* cc = a.in[I_C];
        const int nb = blockIdx.x % 24, ksl = blockIdx.x / 24, n = nb * 256 + lane * 4, kbase = ksl * 128 + wave * 16;
        f32x4 a0 = {0.f, 0.f, 0.f, 0.f}, a1 = a0, a2 = a0;
#pragma unroll
        for (int kk = 0; kk < 16; ++kk) {
            const int k = kbase + kk;
            const f32x4 w = *(const f32x4*)(wada + (size_t)k * INC + n);
            const float c0 = cctx[k], c1 = cc[k], c2 = cc[D + k];
            const float s0 = c0 * pg8::sigmoid_f(c0), s1 = c1 * pg8::sigmoid_f(c1), s2 = c2 * pg8::sigmoid_f(c2);
            a0 += w * s0; a1 += w * s1; a2 += w * s2;
        }
        LAS float* red = (LAS float*)lds;
        *(LAS f32x4*)(red + (wave * 3 + 0) * 256 + lane * 4) = a0; *(LAS f32x4*)(red + (wave * 3 + 1) * 256 + lane * 4) = a1; *(LAS f32x4*)(red + (wave * 3 + 2) * 256 + lane * 4) = a2;
        __syncthreads();
        const int tid = wave * 64 + lane;
        if (tid < 192) {
            const int v = tid >> 6, c4 = (tid & 63) * 4;
            f32x4 sum = {0.f, 0.f, 0.f, 0.f};
#pragma unroll
            for (int w2 = 0; w2 < 8; ++w2) sum += *(const LAS f32x4*)(red + (w2 * 3 + v) * 256 + c4);
#pragma unroll
            for (int j = 0; j < 4; ++j) atomicAdd(MOD + v * INC + nb * 256 + c4 + j, sum[j]);
        }
        __syncthreads();
    }
    constexpr int I_IN = 16 * (INC / 32), I_SQ = 16 * (D / 32), I_F1 = 16 * (FF / 32), I_F2 = (FF / 64) * (D / 32);
    constexpr int NT = I_IN + 3 * I_SQ + I_F1 + I_F2;
    for (int it = gw; it < NT; it += NGW) {
        int r = it;
        if (r < I_IN) { p0_transpose_item(a.in[I_WIN], D, INC, (bf16*)(ws + WS_WIN), scr, r, lane); continue; } r -= I_IN;
        if (r < I_SQ) { p0_transpose_item(a.in[I_WBRG], D, D, (bf16*)(ws + WS_WBG), scr, r, lane, 2 * D, 0); continue; } r -= I_SQ;
        if (r < I_SQ) { p0_transpose_item(a.in[I_WBRR], D, D, (bf16*)(ws + WS_WBG), scr, r, lane, 2 * D, D); continue; } r -= I_SQ;
        if (r < I_SQ) { p0_transpose_item(a.in[I_WOUT], D, D, (bf16*)(ws + WS_WOUT), scr, r, lane); continue; } r -= I_SQ;
        if (r < I_F1) { p0_transpose_item(a.in[I_WFF1], D, FF, (bf16*)(ws + WS_WFF1), scr, r, lane); continue; } r -= I_F1;
        p0_transpose_item(a.in[I_WFF2], FF, D, (bf16*)(ws + WS_WFF2), scr, r, lane);
    }
    {
        const bool few = gridDim.x > 192;
        if (few && blockIdx.x < 192) return;
        const int gt = few ? ((int)blockIdx.x - 192) * NTHR + wave * 64 + lane : gw * 64 + lane, NGT = few ? ((int)gridDim.x - 192) * NTHR : NGW * 64;
        bf16* WG = (bf16*)(ws + WS_WG);
        for (int it = gt; it < 16 * 16 * 2 * 64; it += NGT) {
            const int ln = it & 63, ks = (it >> 6) & 1, cbi = (it >> 7) & 15, h = it >> 11;
            const int fr = ln & 15, fq = ln >> 4, type = cbi >> 3, d = (cbi >> 2) & 1, cb = cbi & 3;
            const float* W = type ? a.in[I_WRI] : a.in[I_WRA];
            const float* src = W + ((size_t)(d * 16 + h) * 64 + ks * 32 + fq * 8) * 64 + cb * 16 + fr;
            v4u o; o.x = pk2(-LOG2E * src[0], -LOG2E * src[64]); o.y = pk2(-LOG2E * src[128], -LOG2E * src[192]);
            o.z = pk2(-LOG2E * src[256], -LOG2E * src[320]); o.w = pk2(-LOG2E * src[384], -LOG2E * src[448]);
            *(v4u*)(WG + (size_t)it * 8) = o;
        }
        bf16* WSP = (bf16*)(ws + WS_WSP); const float* wsp = a.in[I_WSP];
        for (int it = gt; it < 8 * 128 * 128 / 8; it += NGT) {
            const f32x4 x0 = *(const f32x4*)(wsp + (size_t)it * 8), x1 = *(const f32x4*)(wsp + (size_t)it * 8 + 4);
            v4u o; o.x = pk2(x0[0], x0[1]); o.y = pk2(x0[2], x0[3]); o.z = pk2(x1[0], x1[1]); o.w = pk2(x1[2], x1[3]);
            *(v4u*)(WSP + (size_t)it * 8) = o;
        }
        float* GC = (float*)(ws + WS_GC);
        for (int it = gt; it < 2048; it += NGT) {
            const float lamv = a.in[I_LAM][it]; const float sp = log1pf(expf(-lamv));
            f32x4 o; o[0] = exp2f(-LOG2E * a.in[I_BRA][it]); o[1] = exp2f(-LOG2E * a.in[I_BRI][it]); o[2] = -8.f * sp * LOG2E; o[3] = 0.f;
            *(f32x4*)(GC + (size_t)it * 4) = o;
        }
    }
}

__device__ __forceinline__ f32x4 modv(const float* MOD, const float* bada, int cv, int part, int c) {
    return *(const f32x4*)(MOD + cv * INC + part * D + c) + *(const f32x4*)(bada + part * D + c);
}
__device__ __forceinline__ int cv_of(int m) { return m < MCTX ? 0 : (m < MCTX + 4096 ? 1 : 2); }
__device__ __forceinline__ const float* xrow_of(const Args& a, int m) { return m < MCTX ? a.in[I_XP] + (size_t)m * D : a.in[I_XS] + (size_t)(m - MCTX) * D; }
__device__ __forceinline__ void store_bf4(bf16* p, f32x4 v) { v2u o; o.x = pk2(v[0], v[1]); o.y = pk2(v[2], v[3]); *(v2u*)p = o; }

__device__ __forceinline__ void phase_norm1(const Args& a, int gw, int NGW, int lane) {
    const float* MOD = (const float*)(a.ws + CTL_MOD); const float* bada = a.in[I_BADA]; const float* g = a.in[I_GPREMIX];
    bf16* H = (bf16*)(a.ws + WS_H);
    const int RPW = M / NGW;
    if (RPW * NGW == M && (MCTX % RPW) == 0 && (4096 % RPW) == 0) {
        const int m0 = gw * RPW, cv = cv_of(m0);
        f32x4 cc[4], sh[4];
#pragma unroll
        for (int j = 0; j < 4; ++j) { const int c = 4 * lane + 256 * j; cc[j] = *(const f32x4*)(g + c) * (modv(MOD, bada, cv, 1, c) + 1.f); sh[j] = modv(MOD, bada, cv, 0, c); }
        for (int m = m0; m < m0 + RPW; ++m) {
            const float* xr = xrow_of(a, m);
            f32x4 v[4]; float s = 0.f;
#pragma unroll
            for (int j = 0; j < 4; ++j) { v[j] = *(const f32x4*)(xr + 4 * lane + 256 * j); s += (v[j][0] * v[j][0] + v[j][1] * v[j][1]) + (v[j][2] * v[j][2] + v[j][3] * v[j][3]); }
            const float rstd = rsqrtf(wave_sum(s) * (1.f / D) + EPS);
#pragma unroll
            for (int j = 0; j < 4; ++j) store_bf4(H + (size_t)m * D + 4 * lane + 256 * j, v[j] * rstd * cc[j] + sh[j]);
        }
        return;
    }
    for (int m = gw; m < M; m += NGW) {
        const float* xr = xrow_of(a, m); const int cv = cv_of(m);
        f32x4 v[4]; float s = 0.f;
#pragma unroll
        for (int j = 0; j < 4; ++j) { v[j] = *(const f32x4*)(xr + 4 * lane + 256 * j); s += (v[j][0] * v[j][0] + v[j][1] * v[j][1]) + (v[j][2] * v[j][2] + v[j][3] * v[j][3]); }
        const float rstd = rsqrtf(wave_sum(s) * (1.f / D) + EPS);
#pragma unroll
        for (int j = 0; j < 4; ++j) { const int c = 4 * lane + 256 * j;
            const f32x4 gg = *(const f32x4*)(g + c), sh = modv(MOD, bada, cv, 0, c), sc = modv(MOD, bada, cv, 1, c);
            store_bf4(H + (size_t)m * D + c, v[j] * rstd * gg * (sc + 1.f) + sh); }
    }
}
__device__ __forceinline__ void phase_mid(const Args& a, int gw, int NGW, int lane, float* xout, bf16* H) {
    const float* MOD = (const float*)(a.ws + CTL_MOD); const float* bada = a.in[I_BADA];
    const float* gpm = a.in[I_GPOSTMIX]; const float* gpl = a.in[I_GPREMLP]; const float* OSS = (const float*)(a.ws + CTL_OSS);
    const float* out = a.out;
    for (int m = gw; m < M; m += NGW) {
        const float* xr = xrow_of(a, m); const int cv = cv_of(m);
        const float rstd_o = rsqrtf(OSS[m] * (1.f / D) + EPS);
        f32x4 v[4]; float s = 0.f;
#pragma unroll
        for (int j = 0; j < 4; ++j) { const int c = 4 * lane + 256 * j;
            const f32x4 o = *(const f32x4*)(out + (size_t)m * D + c), x = *(const f32x4*)(xr + c);
            const f32x4 g1 = modv(MOD, bada, cv, 2, c), gg = *(const f32x4*)(gpm + c);
            v[j] = x + g1 * (o * rstd_o * gg);
            *(f32x4*)(xout + (size_t)m * D + c) = v[j];
            s += (v[j][0] * v[j][0] + v[j][1] * v[j][1]) + (v[j][2] * v[j][2] + v[j][3] * v[j][3]); }
        const float rstd = rsqrtf(wave_sum(s) * (1.f / D) + EPS);
#pragma unroll
        for (int j = 0; j < 4; ++j) { const int c = 4 * lane + 256 * j;
            const f32x4 gg = *(const f32x4*)(gpl + c), sh = modv(MOD, bada, cv, 3, c), sc = modv(MOD, bada, cv, 4, c);
            store_bf4(H + (size_t)m * D + c, v[j] * rstd * gg * (sc + 1.f) + sh); }
    }
}
__device__ __forceinline__ void phase_final(const Args& a, int gw, int NGW, int lane, float* yout) {
    const float* MOD = (const float*)(a.ws + CTL_MOD); const float* bada = a.in[I_BADA];
    const float* gpm = a.in[I_GPOSTMLP]; const float* FSS = (const float*)(a.ws + CTL_FSS); const float* F = (const float*)(a.ws + WS_F); const float* out = a.out;
    for (int m = gw; m < M; m += NGW) {
        const int cv = cv_of(m); const float rstd_f = rsqrtf(FSS[m] * (1.f / D) + EPS);
#pragma unroll
        for (int j = 0; j < 4; ++j) { const int c = 4 * lane + 256 * j;
            const f32x4 f = *(const f32x4*)(F + (size_t)m * D + c), x1 = *(const f32x4*)(out + (size_t)m * D + c);
            const f32x4 g2 = modv(MOD, bada, cv, 5, c), gg = *(const f32x4*)(gpm + c);
            *(f32x4*)(yout + (size_t)m * D + c) = x1 + g2 * (f * rstd_f * gg); }
    }
}

__device__ __forceinline__ void panel_sync(unsigned* cnt) {
    asm volatile("s_waitcnt vmcnt(0)" ::: "memory");
    __syncthreads();
    if (threadIdx.x == 0) {
        __hip_atomic_fetch_add(cnt, 1u, __ATOMIC_RELAXED, __HIP_MEMORY_SCOPE_AGENT);
        unsigned sp = 0;
        while (__hip_atomic_load(cnt, __ATOMIC_RELAXED, __HIP_MEMORY_SCOPE_AGENT) < 4u) { __builtin_amdgcn_s_sleep(1); if (++sp > (1u << 22)) break; }
    }
    __syncthreads();
}
__device__ __forceinline__ float ld_agent(const float* p) { return __builtin_bit_cast(float, __hip_atomic_load((const unsigned*)p, __ATOMIC_RELAXED, __HIP_MEMORY_SCOPE_AGENT)); }
__device__ __forceinline__ float sumsq4(f32x4 v) { return (v[0] * v[0] + v[1] * v[1]) + (v[2] * v[2] + v[3] * v[3]); }
template <int MODE> struct EpiFused {
    static constexpr bool PERM = true, AFTER_DRAIN = true, HOOK = false;
    float* out; const float* xp; const float* xs; bf16* H; float* SS1; float* SS2; unsigned* cnt1; unsigned* cnt2;
    const float* MOD; const float* bada; const float* gpost; const float* gpre;
    __device__ __forceinline__ void fused(f32x4 (&acc)[2][2][4][2], const pg8::Unit& u, int wr, int wc, int fr, int fq, LAS unsigned char*, int, int) const {
        const int row0 = u.pm * 256 + wr * 64 + fr, col0 = u.pn * 256 + wc * 32 + 8 * fq;
        const int cv = u.pm < 32 ? 0 : (u.pm < 48 ? 1 : 2);
#pragma unroll
        for (int ai = 0; ai < 2; ++ai)
#pragma unroll
            for (int m = 0; m < 4; ++m) {
                float ss = (sumsq4(acc[ai][0][m][0]) + sumsq4(acc[ai][0][m][1])) + (sumsq4(acc[ai][1][m][0]) + sumsq4(acc[ai][1][m][1]));
                ss += __shfl_xor(ss, 16); ss += __shfl_xor(ss, 32);
                if (fq == 0) atomicAdd(SS1 + row0 + ai * 128 + m * 16, ss);
            }
        panel_sync(cnt1 + 64 * u.pm);
        f32x4 ga[2][2];
#pragma unroll
        for (int bj = 0; bj < 2; ++bj)
#pragma unroll
            for (int n = 0; n < 2; ++n) { const int c = col0 + bj * 128 + 4 * n; ga[bj][n] = modv(MOD, bada, cv, MODE == 6 ? 2 : 5, c) * *(const f32x4*)(gpost + c); }
        float rs1[2][4];
#pragma unroll
        for (int ai = 0; ai < 2; ++ai)
#pragma unroll
            for (int m = 0; m < 4; ++m) rs1[ai][m] = ld_agent(SS1 + row0 + ai * 128 + m * 16);
#pragma unroll
        for (int ai = 0; ai < 2; ++ai)
#pragma unroll
            for (int m = 0; m < 4; ++m) {
                const int row = row0 + ai * 128 + m * 16;
                const float rstd = rsqrtf(rs1[ai][m] * (1.f / D) + EPS);
                const float* xrow = MODE == 6 ? (row < MCTX ? xp + (size_t)row * D : xs + (size_t)(row - MCTX) * D) : out + (size_t)row * D;
                float ss = 0.f;
#pragma unroll
                for (int bj = 0; bj < 2; ++bj)
#pragma unroll
                    for (int n = 0; n < 2; ++n) { const int c = col0 + bj * 128 + 4 * n;
                        const f32x4 v = *(const f32x4*)(xrow + c) + ga[bj][n] * (acc[ai][bj][m][n] * rstd);
                        *(f32x4*)(out + (size_t)row * D + c) = v; acc[ai][bj][m][n] = v; ss += sumsq4(v); }
                if constexpr (MODE == 6) { ss += __shfl_xor(ss, 16); ss += __shfl_xor(ss, 32); if (fq == 0) atomicAdd(SS2 + row, ss); }
            }
        if constexpr (MODE == 6) {
            panel_sync(cnt2 + 64 * u.pm);
            f32x4 cc[2][2], sh[2][2];
#pragma unroll
            for (int bj = 0; bj < 2; ++bj)
#pragma unroll
                for (int n = 0; n < 2; ++n) { const int c = col0 + bj * 128 + 4 * n; cc[bj][n] = *(const f32x4*)(gpre + c) * (modv(MOD, bada, cv, 4, c) + 1.f); sh[bj][n] = modv(MOD, bada, cv, 3, c); }
            float rs2[2][4];
#pragma unroll
            for (int ai = 0; ai < 2; ++ai)
#pragma unroll
                for (int m = 0; m < 4; ++m) rs2[ai][m] = ld_agent(SS2 + row0 + ai * 128 + m * 16);
#pragma unroll
            for (int ai = 0; ai < 2; ++ai)
#pragma unroll
                for (int m = 0; m < 4; ++m) {
                    const int row = row0 + ai * 128 + m * 16;
                    const float rstd = rsqrtf(rs2[ai][m] * (1.f / D) + EPS);
#pragma unroll
                    for (int bj = 0; bj < 2; ++bj) {
                        const f32x4 h0 = acc[ai][bj][m][0] * rstd * cc[bj][0] + sh[bj][0], h1 = acc[ai][bj][m][1] * rstd * cc[bj][1] + sh[bj][1];
                        v4u w; w.x = pg8::cvt_pk_bf16(h0[0], h0[1]); w.y = pg8::cvt_pk_bf16(h0[2], h0[3]); w.z = pg8::cvt_pk_bf16(h1[0], h1[1]); w.w = pg8::cvt_pk_bf16(h1[2], h1[3]);
                        *(v4u*)(H + (size_t)row * D + col0 + bj * 128) = w; }
                }
        }
    }
};

constexpr int YLD = 2048;
constexpr int SG_W = 0, SG_V = 34816, SG_U = 69632, SG_ST = 272;
__device__ __forceinline__ void sgu_load(const bf16* GV, const bf16* GU, const float* VSS, int item, int tid, v4u (&rv)[4], v4u (&ru)[4], float (&rss)[4]) {
    const int g = item & 7, t0 = (item >> 3) * 128;
#pragma unroll
    for (int i = 0; i < 4; ++i) { const int idx = tid + i * NTHR, p = idx >> 4, c8 = (idx & 15) * 8;
        rv[i] = *(const v4u*)(GV + (size_t)(t0 + p) * D + g * 128 + c8); ru[i] = *(const v4u*)(GU + (size_t)(t0 + p) * YLD + g * 128 + c8); rss[i] = VSS[t0 + p]; }
}
__device__ __forceinline__ void phase_sgu(const Args& a, LAS unsigned char* lds, int tid, int wave, int lane, bf16* YG) {
    const bf16* GV = (const bf16*)a.out; const bf16* GU = (const bf16*)(a.ws + WS_GU); const bf16* WSP = (const bf16*)(a.ws + WS_WSP);
    const float* VSS = (const float*)(a.ws + CTL_VSS); const float* gsgu = a.in[I_GSGU]; const float* bsp = a.in[I_BSP];
    const int fr = lane & 15, fq = lane >> 4;
    int last_g = -1;
    v4u rv[4], ru[4]; float rss[4];
    for (int item = blockIdx.x; item < 128 * 8; item += gridDim.x) {
        const int g = item & 7, n = item >> 3, t0 = n * 128;
        if (g != last_g) {
#pragma unroll
            for (int i = 0; i < 4; ++i) { const int idx = tid + i * NTHR, row = idx >> 4, c16 = idx & 15;
                *(LAS v4u*)(lds + SG_W + row * SG_ST + c16 * 16) = *(const v4u*)(WSP + (size_t)(g * 128 + row) * 128 + c16 * 8); }
            last_g = g;
        }
        if (item == (int)blockIdx.x) sgu_load(GV, GU, VSS, item, tid, rv, ru, rss);
#pragma unroll
        for (int i = 0; i < 4; ++i) {
            const int idx = tid + i * NTHR, p = idx >> 4, c8 = (idx & 15) * 8;
            const v4u r = rv[i]; const v4u uu = ru[i];
            const float rs = rsqrtf(rss[i] * (1.f / D) + EPS);
            const f32x4 g0 = *(const f32x4*)(gsgu + g * 128 + c8) * rs, g1 = *(const f32x4*)(gsgu + g * 128 + c8 + 4) * rs;
            v4u o; o.x = pk2(bflo(r.x) * g0[0], bfhi(r.x) * g0[1]); o.y = pk2(bflo(r.y) * g0[2], bfhi(r.y) * g0[3]);
            o.z = pk2(bflo(r.z) * g1[0], bfhi(r.z) * g1[1]); o.w = pk2(bflo(r.w) * g1[2], bfhi(r.w) * g1[3]);
            *(LAS v4u*)(lds + SG_V + p * SG_ST + c8 * 2) = o;
            *(LAS v4u*)(lds + SG_U + p * SG_ST + c8 * 2) = uu;
        }
        if (item + (int)gridDim.x < 128 * 8) sgu_load(GV, GU, VSS, item + gridDim.x, tid, rv, ru, rss);
        float bias8[8];
#pragma unroll
        for (int qb = 0; qb < 8; ++qb) bias8[qb] = bsp[g * 128 + qb * 16 + fr];
        __syncthreads();
        bf16x8 af[4];
#pragma unroll
        for (int ks = 0; ks < 4; ++ks) {
            unsigned short e[8];
#pragma unroll
            for (int j = 0; j < 8; ++j) e[j] = *(const LAS unsigned short*)(lds + SG_V + (ks * 32 + fq * 8 + j) * SG_ST + (wave * 16 + fr) * 2);
            v4u o; o.x = e[0] | ((unsigned)e[1] << 16); o.y = e[2] | ((unsigned)e[3] << 16); o.z = e[4] | ((unsigned)e[5] << 16); o.w = e[6] | ((unsigned)e[7] << 16);
            af[ks] = __builtin_bit_cast(bf16x8, o);
        }
#pragma unroll
        for (int qb = 0; qb < 8; ++qb) {
            const int q = qb * 16 + fr;
            f32x4 acc = {0.f, 0.f, 0.f, 0.f};
#pragma unroll
            for (int ks = 0; ks < 4; ++ks) { const bf16x8 b = *(const LAS bf16x8*)(lds + SG_W + q * SG_ST + (ks * 32 + fq * 8) * 2);
                acc = __builtin_amdgcn_mfma_f32_16x16x32_bf16(af[ks], b, acc, 0, 0, 0); }
            const float bias = bias8[qb];
            LAS v2u* up = (LAS v2u*)(lds + SG_U + q * SG_ST + (wave * 16 + fq * 4) * 2);
            const v2u gu = *up;
            v2u y; y.x = pk2(bflo(gu.x) * (acc[0] + bias), bfhi(gu.x) * (acc[1] + bias)); y.y = pk2(bflo(gu.y) * (acc[2] + bias), bfhi(gu.y) * (acc[3] + bias));
            *up = y;
        }
        __syncthreads();
#pragma unroll
        for (int i = 0; i < 4; ++i) { const int idx = tid + i * NTHR, p = idx >> 4, c8 = (idx & 15) * 8;
            *(v4u*)(YG + (size_t)(t0 + p) * YLD + g * 128 + c8) = *(const LAS v4u*)(lds + SG_U + p * SG_ST + c8 * 2); }
    }
}

constexpr int RG_WB = 0, RG_XA = 32768, RG_XF = 51200, RG_AGL = 86016, RG_GCL = 94208, RG_CWL = 96256, RG_CARL = 97536, RG_AGL2 = 102400;
#define RGIDX(i) (((tid >> 6) << 7) + (tid & 63) + 64 * (i))
__device__ __forceinline__ void rg_load_raw(const bf16* XR, int item, int tid, v4u (&xr)[2][4]) {
    const int h = item & 15, t0 = (item >> 4) * 128;
    const int seq_lo = t0 < MCTX ? (t0 & ~255) : MCTX + ((t0 - MCTX) & ~4095), seq_hi = seq_lo + (t0 < MCTX ? 256 : 4096);
#pragma unroll
    for (int i = 0; i < 2; ++i) {
        const int idx = RGIDX(i), tk = idx >> 3, chb = h * 64 + (idx & 7) * 8;
#pragma unroll
        for (int tap = 0; tap < 4; ++tap) {
            const int t = t0 + tk + tap - 2; const bool ok = (t >= seq_lo) && (t < seq_hi); const int tc = ok ? t : t0;
            xr[i][tap] = *(const v4u*)(XR + (size_t)tc * D + chb);
        }
    }
}
template <int MODE> __device__ __forceinline__ int rg_item(int k) {
    const int h = blockIdx.x & 15, q = blockIdx.x >> 4;
    int tt;
    if (MODE == 1) tt = k < 4 ? 2 * (q + 16 * (k >> 1)) + (k & 1) : 64 + q + 16 * (k - 4);
    else tt = k < 2 ? 2 * (q + 16 * k) + 1 : 64 + q + 16 * (k - 2);
    return tt * 16 + h;
}
template <int MODE>
__device__ __forceinline__ void phase_rg(const Args& a, LAS unsigned char* lds, int tid, int wave, int lane, bf16* YR) {
    const bf16* XR = (const bf16*)((const unsigned char*)a.out + 32 * MiB); const bf16* GGR = (const bf16*)(a.ws + WS_GU) + D;
    const float* GC = (const float*)(a.ws + WS_GC); const bf16* WG = (const bf16*)(a.ws + WS_WG);
    f32x2* AGG = (f32x2*)(a.ws + WS_AGG); const float* CAR = (const float*)(a.ws + WS_CAR); float* nstate = a.out + (size_t)M * D;
    const float* convw = a.in[I_CONVW]; const float* convb = a.in[I_CONVB];
    const int fr = lane & 15, fq = lane >> 4;
    int last_h = -1;
    v4u xr[2][4];
    constexpr int NK = MODE == 1 ? 8 : 6;
    rg_load_raw(XR, rg_item<MODE>(0), tid, xr);
    if constexpr (MODE == 1) {
        const float* st0 = a.in[I_STATE];
#pragma unroll 1
        for (int kk = tid >> 7; kk < 8; kk += 4) {
            const int it = rg_item<1>(kk);
            {
                const int d = (tid >> 6) & 1, cl = tid & 63, h = it & 15, tt = it >> 4;
                float hc;
                if (tt < 64) {
                    const f32x2 g = AGG[((size_t)((tt | 1) * 16 + h) * 2 + 1) * 64 + cl];
                    hc = ((tt & 1) == 0 && d == 1) ? g[1] : 0.f;
                } else {
                    const int b = (tt - 64) >> 5, j = (tt - 64) & 31, tt0 = 64 + b * 32;
                    f32x2 ag[31];
#pragma unroll
                    for (int sI = 0; sI < 31; ++sI) { const int ti = d ? 31 - sI : sI; ag[sI] = AGG[((size_t)((tt0 + ti) * 16 + h) * 2 + d) * 64 + cl]; }
                    hc = st0[(size_t)b * 2048 + d * 1024 + h * 64 + cl];
#pragma unroll
                    for (int sI = 0; sI < 31; ++sI) { const int ti = d ? 31 - sI : sI; if (d ? (ti > j) : (ti < j)) hc = ag[sI][0] * hc + ag[sI][1]; }
                }
                *(LAS float*)(lds + RG_CARL + ((kk * 2 + d) * 64 + cl) * 4) = hc;
            }
        }
        __syncthreads();
    }
    for (int kitem = 0; kitem < NK; ++kitem) {
        const int item = rg_item<MODE>(kitem);
        const int h = item & 15, tt = item >> 4, t0 = tt * 128;
        const int AGLo = (kitem & 1) ? RG_AGL2 : RG_AGL;
        if (h != last_h) {
#pragma unroll
            for (int i = 0; i < 4; ++i) { const int o = (tid + i * NTHR) * 16; *(LAS v4u*)(lds + RG_WB + o) = *(const v4u*)((const unsigned char*)WG + (size_t)h * 32768 + o); }
            if (tid < 128) *(LAS f32x4*)(lds + RG_GCL + tid * 16) = *(const f32x4*)(GC + (size_t)((tid >> 6) * D + h * 64 + (tid & 63)) * 4);
            if (tid < 80) { const int row = tid >> 4, c4 = (tid & 15) * 4;
                *(LAS f32x4*)(lds + RG_CWL + (row * 64 + c4) * 4) = *(const f32x4*)((row < 4 ? convw + row * D : convb) + h * 64 + c4); }
            last_h = h;
            __syncthreads();
        }
        const int seq_lo = t0 < MCTX ? (t0 & ~255) : MCTX + ((t0 - MCTX) & ~4095), seq_hi = seq_lo + (t0 < MCTX ? 256 : 4096);
        float car[2][4]; v4u ggr[2];
        if constexpr (MODE == 1) {
#pragma unroll
            for (int i = 0; i < 2; ++i) { const int idx = RGIDX(i); ggr[i] = *(const v4u*)(GGR + (size_t)(t0 + (idx >> 3)) * YLD + h * 64 + (idx & 7) * 8); }
        }
        {
            const int c8 = (tid & 7) * 8;
            f32x4 w0[4], w1[4];
#pragma unroll
            for (int tap = 0; tap < 4; ++tap) { w0[tap] = *(const LAS f32x4*)(lds + RG_CWL + (tap * 64 + c8) * 4); w1[tap] = *(const LAS f32x4*)(lds + RG_CWL + (tap * 64 + c8 + 4) * 4); }
            const f32x4 b0 = *(const LAS f32x4*)(lds + RG_CWL + (4 * 64 + c8) * 4), b1 = *(const LAS f32x4*)(lds + RG_CWL + (4 * 64 + c8 + 4) * 4);
#pragma unroll
            for (int i = 0; i < 2; ++i) {
                const int idx = RGIDX(i), tk = idx >> 3, cg8 = idx & 7;
                f32x4 x0 = b0, x1 = b1;
#pragma unroll
                for (int tap = 0; tap < 4; ++tap) { const int t = t0 + tk + tap - 2; const bool ok = (t >= seq_lo) && (t < seq_hi);
                    v4u r = xr[i][tap]; r.x = ok ? r.x : 0u; r.y = ok ? r.y : 0u; r.z = ok ? r.z : 0u; r.w = ok ? r.w : 0u;
                    x0[0] += w0[tap][0] * bflo(r.x); x0[1] += w0[tap][1] * bfhi(r.x); x0[2] += w0[tap][2] * bflo(r.y); x0[3] += w0[tap][3] * bfhi(r.y);
                    x1[0] += w1[tap][0] * bflo(r.z); x1[1] += w1[tap][1] * bfhi(r.z); x1[2] += w1[tap][2] * bflo(r.w); x1[3] += w1[tap][3] * bfhi(r.w); }
                v4u o; o.x = pk2(x0[0], x0[1]); o.y = pk2(x0[2], x0[3]); o.z = pk2(x1[0], x1[1]); o.w = pk2(x1[2], x1[3]);
                *(LAS v4u*)(lds + RG_XA + tk * 144 + cg8 * 16) = o;
                *(LAS f32x4*)(lds + RG_XF + (tk * 68 + cg8 * 8) * 4) = x0; *(LAS f32x4*)(lds + RG_XF + (tk * 68 + cg8 * 8 + 4) * 4) = x1;
            }
        }
        if (kitem + 1 < NK) rg_load_raw(XR, rg_item<MODE>(kitem + 1), tid, xr);
        asm volatile("" ::: "memory");
        const int tokb = wave * 16;
        bf16x8 afr[2];
#pragma unroll
        for (int ks = 0; ks < 2; ++ks) afr[ks] = *(const LAS bf16x8*)(lds + RG_XA + (tokb + fr) * 144 + (ks * 32 + fq * 8) * 2);
        f32x4 gcv[2][4];
#pragma unroll
        for (int d = 0; d < 2; ++d)
#pragma unroll
            for (int cb = 0; cb < 4; ++cb) gcv[d][cb] = *(const LAS f32x4*)(lds + RG_GCL + (d * 64 + cb * 16 + fr) * 16);
        float av[2][4][4], bv[2][4][4], Ap[2][4], Hp[2][4];
        const bool ctx = t0 < MCTX;
#pragma unroll
        for (int d = 0; d < 2; ++d) {
            if (MODE == 0 && ctx && d != (tt & 1)) continue;
#pragma unroll
            for (int cb = 0; cb < 4; ++cb) {
                const f32x4 gc = gcv[d][cb];
                f32x4 ar = {0.f, 0.f, 0.f, 0.f}, ai = {0.f, 0.f, 0.f, 0.f};
#pragma unroll
                for (int ks = 0; ks < 2; ++ks) {
                    const bf16x8 b0 = *(const LAS bf16x8*)(lds + RG_WB + (((0 * 8 + d * 4 + cb) * 2 + ks) * 64 + lane) * 16);
                    const bf16x8 b1 = *(const LAS bf16x8*)(lds + RG_WB + (((1 * 8 + d * 4 + cb) * 2 + ks) * 64 + lane) * 16);
                    ar = __builtin_amdgcn_mfma_f32_16x16x32_bf16(afr[ks], b0, ar, 0, 0, 0);
                    ai = __builtin_amdgcn_mfma_f32_16x16x32_bf16(afr[ks], b1, ai, 0, 0, 0);
                }
#pragma unroll
                for (int r = 0; r < 4; ++r) {
                    const float xcv = *(const LAS float*)(lds + RG_XF + ((tokb + fq * 4 + r) * 68 + cb * 16 + fr) * 4);
                    const float rr = __builtin_amdgcn_rcpf(__builtin_fmaf(__builtin_amdgcn_exp2f(ar[r]), gc[0], 1.f)), ii = __builtin_amdgcn_rcpf(__builtin_fmaf(__builtin_amdgcn_exp2f(ai[r]), gc[1], 1.f));
                    const float aa = __builtin_amdgcn_exp2f(rr * gc[2]);
                    const float om = fmaxf(1.f - aa * aa, 1e-12f);
                    av[d][cb][r] = aa; bv[d][cb][r] = __builtin_amdgcn_sqrtf(om) * ii * xcv;
                }
                float A = 1.f, Hh = 0.f;
#pragma unroll
                for (int rr = 0; rr < 4; ++rr) { const int r = d ? 3 - rr : rr; Hh = av[d][cb][r] * Hh + bv[d][cb][r]; A *= av[d][cb][r]; }
                float Aw = 1.f, Hw = 0.f, Apl = 1.f, Hpl = 0.f;
#pragma unroll
                for (int gg = 0; gg < 4; ++gg) { const int g = d ? 3 - gg : gg;
                    const float Ag = __shfl(A, g * 16 + fr), Hg = __shfl(Hh, g * 16 + fr);
                    if (g == fq) { Apl = Aw; Hpl = Hw; }
                    Hw = Ag * Hw + Hg; Aw *= Ag; }
                Ap[d][cb] = Apl; Hp[d][cb] = Hpl;
                if (fq == 0) *(LAS f32x2*)(lds + AGLo + ((wave * 2 + d) * 64 + cb * 16 + fr) * 8) = (f32x2){Aw, Hw};
            }
        }
        __syncthreads();
        if constexpr (MODE == 0) {
            if (tid < 128 && !(ctx && (tid >> 6) != (tt & 1))) {
                const int d = tid >> 6, cl = tid & 63; float A = 1.f, Hh = 0.f;
#pragma unroll
                for (int ww = 0; ww < 8; ++ww) { const int w2 = d ? 7 - ww : ww; const f32x2 sg = *(const LAS f32x2*)(lds + AGLo + ((w2 * 2 + d) * 64 + cl) * 8); Hh = sg[0] * Hh + sg[1]; A *= sg[0]; }
                AGG[((size_t)(tt * 16 + h) * 2 + d) * 64 + cl] = (f32x2){A, Hh};
            }
        } else {
            if (ctx && (tt & 1) == 0 && tid < 64) {
                float Hh = 0.f;
#pragma unroll
                for (int w2 = 0; w2 < 8; ++w2) { const f32x2 sg = *(const LAS f32x2*)(lds + AGLo + ((w2 * 2 + 0) * 64 + tid) * 8); Hh = sg[0] * Hh + sg[1]; }
                *(LAS float*)(lds + RG_CARL + (((kitem + 1) * 2 + 0) * 64 + tid) * 4) = Hh;
            }
#pragma unroll
            for (int d = 0; d < 2; ++d)
#pragma unroll
                for (int cb = 0; cb < 4; ++cb) car[d][cb] = *(const LAS float*)(lds + RG_CARL + ((kitem * 2 + d) * 64 + cb * 16 + fr) * 4);
            float hs[4][4];
#pragma unroll
            for (int cb = 0; cb < 4; ++cb)
#pragma unroll
                for (int r = 0; r < 4; ++r) hs[cb][r] = 0.f;
#pragma unroll
            for (int d = 0; d < 2; ++d)
#pragma unroll
                for (int cb = 0; cb < 4; ++cb) {
                    const int cl = cb * 16 + fr;
                    float hin = car[d][cb];
                    f32x2 sg[8];
#pragma unroll
                    for (int w2 = 0; w2 < 8; ++w2) sg[w2] = *(const LAS f32x2*)(lds + AGLo + ((w2 * 2 + d) * 64 + cl) * 8);
#pragma unroll
                    for (int ww = 0; ww < 8; ++ww) { const int w2 = d ? 7 - ww : ww; if (d ? (w2 > wave) : (w2 < wave)) hin = sg[w2][0] * hin + sg[w2][1]; }
                    float hh = Ap[d][cb] * hin + Hp[d][cb];
#pragma unroll
                    for (int rr = 0; rr < 4; ++rr) { const int r = d ? 3 - rr : rr; hh = av[d][cb][r] * hh + bv[d][cb][r]; hs[cb][r] += hh; }
                    if (ctx && (tt & 1) == (d ? 0 : 1) && wave == (d ? 0 : 7) && fq == (d ? 0 : 3)) nstate[(size_t)(tt >> 1) * 2048 + d * 1024 + h * 64 + cl] = hh;
                }
#pragma unroll
            for (int cb = 0; cb < 4; ++cb)
#pragma unroll
                for (int r = 0; r < 4; ++r) *(LAS float*)(lds + RG_XF + ((tokb + fq * 4 + r) * 68 + cb * 16 + fr) * 4) = hs[cb][r];
            asm volatile("" ::: "memory");
#pragma unroll
            for (int i = 0; i < 2; ++i) {
                const int idx = RGIDX(i), tk = idx >> 3, cg8 = idx & 7;
                const f32x4 y0 = *(const LAS f32x4*)(lds + RG_XF + (tk * 68 + cg8 * 8) * 4), y1 = *(const LAS f32x4*)(lds + RG_XF + (tk * 68 + cg8 * 8 + 4) * 4);
                const v4u g = ggr[i];
                v4u o; o.x = pk2(y0[0] * bflo(g.x), y0[1] * bfhi(g.x)); o.y = pk2(y0[2] * bflo(g.y), y0[3] * bfhi(g.y));
                o.z = pk2(y1[0] * bflo(g.z), y1[1] * bfhi(g.z)); o.w = pk2(y1[2] * bflo(g.w), y1[3] * bfhi(g.w));
                *(v4u*)(YR + (size_t)(t0 + tk) * YLD + h * 64 + cg8 * 8) = o;
            }
        }
    }
}

template <int NT>
__device__ __forceinline__ float carry_chain(const f32x2* AGG, float* CAR, int tt0, int h, int d, int cl, float h0) {
    f32x2 ag[NT];
#pragma unroll
    for (int i = 0; i < NT; ++i) ag[i] = AGG[((size_t)((tt0 + i) * 16 + h) * 2 + d) * 64 + cl];
    float hc = h0;
#pragma unroll
    for (int ii = 0; ii < NT; ++ii) { const int i = d ? NT - 1 - ii : ii;
        CAR[((size_t)((tt0 + i) * 16 + h) * 2 + d) * 64 + cl] = hc; hc = ag[i][0] * hc + ag[i][1]; }
    return hc;
}
__device__ __forceinline__ void phase_carry(const Args& a, int gw, int NGW, int lane) {
    const f32x2* AGG = (const f32x2*)(a.ws + WS_AGG); float* CAR = (float*)(a.ws + WS_CAR);
    for (int wi = gw; wi < 34 * 2 * 16; wi += NGW) {
        const int s = wi >> 5, d = (wi >> 4) & 1, h = wi & 15, ch = h * 64 + lane;
        if (s < 32) {
            const size_t i0 = ((size_t)((2 * s) * 16 + h) * 2 + d) * 64 + lane, i1 = ((size_t)((2 * s + 1) * 16 + h) * 2 + d) * 64 + lane;
            if (d == 0) { CAR[i0] = 0.f; CAR[i1] = AGG[i0][1]; }
            else { CAR[i1] = 0.f; CAR[i0] = AGG[i1][1]; }
        } else {
            const int b = s - 32; const float h0 = a.in[I_STATE][(size_t)b * 2048 + d * 1024 + ch];
            if (d == 0) (void)carry_chain<32>(AGG, CAR, 64 + b * 32, h, 0, lane, h0);
            else (void)carry_chain<32>(AGG, CAR, 64 + b * 32, h, 1, lane, h0);
        }
    }
}

#define RLX_AGENT __ATOMIC_RELAXED, __HIP_MEMORY_SCOPE_AGENT
#define XB_TMO      128
#define XB_XCNT(j)  (256  + 64 * (j))
#define XB_XSUB(j)  (1280 + 64 * (j))
#define XB_XGEN(j)  (2304 + 64 * (j))
#define XB_TOP      3328
#define XB_TOPGEN   3392
#define XCD_BAR_WORDS 3456
#define XB_SPIN_CAP (1u << 18)

__device__ __forceinline__ unsigned xb_ld(unsigned* p)              { return __hip_atomic_load(p, __ATOMIC_RELAXED, __HIP_MEMORY_SCOPE_AGENT); }
__device__ __forceinline__ unsigned xb_add(unsigned* p, unsigned v) { return __hip_atomic_fetch_add(p, v, __ATOMIC_RELAXED, __HIP_MEMORY_SCOPE_AGENT); }
__device__ __forceinline__ unsigned xb_xcc_id() { return (unsigned)__builtin_amdgcn_s_getreg((3 << 11) | 20) & 0xFu; }
#define XB_SPIN(cond, bar) do { unsigned _sp = 0; while (cond) { __builtin_amdgcn_s_sleep(1); \
    if ((++_sp & 255u) == 0u) { if (xb_ld(&(bar)[XB_TMO])) break; if (_sp > XB_SPIN_CAP) { atomicAdd(&(bar)[XB_TMO], 1u); break; } } } } while (0)

struct XcdBarrier {
    unsigned* bar; unsigned x;
    volatile LAS unsigned* st;
};

__device__ __forceinline__ XcdBarrier xcd_barrier_post(unsigned* bar, volatile LAS unsigned* st) {
    XcdBarrier b; b.bar = bar; b.x = xb_xcc_id(); b.st = st;
    if (threadIdx.x == 0) (void)xb_add(&bar[XB_XCNT(b.x)], 1u);
    return b;
}
__device__ __forceinline__ void xcd_barrier_complete(unsigned* bar, unsigned x, unsigned& nloc, unsigned& nx) {
    const unsigned G = gridDim.x * gridDim.y * gridDim.z;
    unsigned sum, cnt, mine, sp = 0u;
    for (;;) {
        sum = 0u; cnt = 0u; mine = 0u;
#pragma unroll
        for (unsigned j = 0; j < 16; ++j) { const unsigned c = xb_ld(&bar[XB_XCNT(j)]); sum += c; cnt += (c > 0u) ? 1u : 0u; mine = (j == x) ? c : mine; }
        if (sum == G) break;
        __builtin_amdgcn_s_sleep(1);
        if ((++sp & 255u) == 0u) { if (xb_ld(&bar[XB_TMO])) break; if (sp > XB_SPIN_CAP) { atomicAdd(&bar[XB_TMO], 1u); break; } }
    }
    nloc = mine > 0u ? mine : 1u; nx = cnt > 0u ? cnt : 1u;
}

__device__ __forceinline__ void xcd_barrier(const XcdBarrier& b) {
    asm volatile("s_waitcnt vmcnt(0)" ::: "memory");
    __syncthreads();
    if (threadIdx.x == 0) {
        unsigned* bar = b.bar;
        __builtin_amdgcn_s_waitcnt(0);
        unsigned nloc = b.st[0], nx = b.st[1];
        if (nloc == 0u) { xcd_barrier_complete(bar, b.x, nloc, nx); b.st[0] = nloc; b.st[1] = nx; }
        const unsigned old = xb_add(&bar[XB_XSUB(b.x)], 1u);
        const unsigned gen = old / nloc;
        if (old + 1u == (gen + 1u) * nloc) {
            __builtin_amdgcn_fence(__ATOMIC_RELEASE, "agent");
            asm volatile("s_waitcnt vmcnt(0)" ::: "memory");
            const unsigned og = xb_add(&bar[XB_TOP], 1u);
            const unsigned tg = og / nx;
            if (og + 1u == (tg + 1u) * nx) xb_add(&bar[XB_TOPGEN], 1u);
            else XB_SPIN(xb_ld(&bar[XB_TOPGEN]) == tg, bar);
            __builtin_amdgcn_fence(__ATOMIC_ACQUIRE, "agent");
            xb_add(&bar[XB_XGEN(b.x)], 1u);
            asm volatile("s_waitcnt vmcnt(0)" ::: "memory");
        } else {
            XB_SPIN(xb_ld(&bar[XB_XGEN(b.x)]) == gen, bar);
            __builtin_amdgcn_fence(__ATOMIC_ACQUIRE, "agent");
            asm volatile("s_waitcnt vmcnt(0)" ::: "memory");
        }
    }
    __syncthreads();
}

__global__ void __launch_bounds__(NTHR, 2) fwd_megakernel(Args a) {
    extern __shared__ __attribute__((aligned(16))) unsigned char lds_raw[];
    LAS unsigned char* lds = (LAS unsigned char*)lds_raw;
    const int tid = threadIdx.x, lane = tid & 63, wave = __builtin_amdgcn_readfirstlane(tid >> 6);
    const int G = gridDim.x, gw = blockIdx.x * NWAVES + wave, NGW = G * NWAVES;
    unsigned char* ws = a.ws;
    const int lo = a.ph_lo, hi = a.ph_hi;
    volatile LAS unsigned* bst = (volatile LAS unsigned*)(lds + LDS_BAR_OFF);
    if (tid < 2) bst[tid] = 0u;
    __syncthreads();
    XcdBarrier bar = xcd_barrier_post((unsigned*)(ws + WS_CTL), bst);
#define IN(k) (lo <= (k) && (k) < hi)
#define SEAM(k) do { if (IN(k) && IN((k) + 1)) { xcd_barrier(bar); if (DUP >> 12 & 1) xcd_barrier(bar); } } while (0)
    float* const DUMSS = (float*)(ws + 1 * MiB + 512 * 1024);
#define REP(k) for (int rep_ = ((DUP >> (k)) & 1); rep_ >= 0; --rep_)
#define ISDUP (rep_ > 0)
    if (IN(0)) REP(0) phase_prep(a, lds, gw, NGW, wave, lane, ISDUP ? (float*)(ws + 1 * MiB + 256 * 1024) : (float*)(ws + CTL_MOD));
    SEAM(0);
    if (IN(1)) REP(1) phase_norm1(a, gw, NGW, lane);
    SEAM(1);
    if (IN(2)) REP(2) {
        pg8::Gemm g{(const pg8::bf16_t*)(ws + WS_H), (const pg8::bf16_t*)(ws + WS_WIN), M, INC, D}; pg8::StaticOrder S; S.init(M, INC, G, (int)blockIdx.x, WG_IN);
        pg8::Epi<1> E{nullptr, nullptr, nullptr, ISDUP ? DUMSS : (float*)(ws + CTL_VSS), D, (bf16*)(ws + WS_GU), (bf16*)a.out, (bf16*)((unsigned char*)a.out + 32 * MiB), (bf16*)(ws + WS_GU) + D, (bf16*)(ws + WS_SGA), (bf16*)(ws + WS_SGB)};
        pg8::gemm_phase<pg8::Epi<1>, pg8::StaticOrder, true, true>(lds, g, S, E);
    }
    SEAM(2);
    if (IN(3)) REP(3) { phase_rg<0>(a, lds, tid, wave, lane, nullptr); phase_sgu(a, lds, tid, wave, lane, ISDUP ? (bf16*)(ws + WS_F) : (bf16*)(ws + WS_GU)); }
    SEAM(3);
    if (IN(5)) REP(5) phase_rg<1>(a, lds, tid, wave, lane, ISDUP ? (bf16*)(ws + WS_F) + D : (bf16*)(ws + WS_GU) + D);
    SEAM(5);
    if (IN(6)) REP(6) {
        pg8::Gemm g{(const pg8::bf16_t*)(ws + WS_GU), (const pg8::bf16_t*)(ws + WS_WBG), M, D, 2 * D}; pg8::StaticOrder S; S.init(M, D, G, (int)blockIdx.x);
        pg8::EpiMerge E{(bf16*)(ws + WS_H), (const bf16*)(ws + WS_SGA), (const bf16*)(ws + WS_SGB)};
        pg8::gemm_phase<pg8::EpiMerge, pg8::StaticOrder, false, true>(lds, g, S, E);
    }
    SEAM(6);
    if (IN(7)) {
        pg8::Gemm g{(const pg8::bf16_t*)(ws + WS_H), (const pg8::bf16_t*)(ws + WS_WOUT), M, D, D}; pg8::StaticOrder S; S.init(M, D, G, (int)blockIdx.x);
        EpiFused<6> E{a.out, a.in[I_XP], a.in[I_XS], (bf16*)(ws + WS_H), (float*)(ws + CTL_OSS), (float*)(ws + CTL_XSS), (unsigned*)(ws + CTL_CNT), (unsigned*)(ws + CTL_CNT + 16384),
                      (const float*)(ws + CTL_MOD), a.in[I_BADA], a.in[I_GPOSTMIX], a.in[I_GPREMLP]};
        pg8::gemm_phase<EpiFused<6>, pg8::StaticOrder, false, true>(lds, g, S, E);
    }
    SEAM(7);
    if (IN(8)) REP(8) {
        pg8::Gemm g{(const pg8::bf16_t*)(ws + WS_H), (const pg8::bf16_t*)(ws + WS_WFF1), M, FF, D}; pg8::StaticOrder S; S.init(M, FF, G, (int)blockIdx.x, WG_FF1);
        pg8::Epi<5> E{(bf16*)(ws + WS_F1), nullptr, nullptr, nullptr, FF, nullptr, nullptr, nullptr, nullptr, nullptr, nullptr};
        pg8::gemm_phase<pg8::Epi<5>, pg8::StaticOrder, true, true>(lds, g, S, E);
    }
    SEAM(8);
    if (IN(9)) {
        pg8::Gemm g{(const pg8::bf16_t*)(ws + WS_F1), (const pg8::bf16_t*)(ws + WS_WFF2), M, D, FF}; pg8::StaticOrder S; S.init(M, D, G, (int)blockIdx.x);
        EpiFused<7> E{a.out, nullptr, nullptr, nullptr, (float*)(ws + CTL_FSS), nullptr, (unsigned*)(ws + CTL_CNT + 32768), nullptr,
                      (const float*)(ws + CTL_MOD), a.in[I_BADA], a.in[I_GPOSTMLP], nullptr};
        pg8::gemm_phase<EpiFused<7>, pg8::StaticOrder, false, true>(lds, g, S, E);
    }
#undef IN
#undef SEAM
}

constexpr int N_PHASES = 10;
extern "C" void kernel_launch(void* const* d_in, const int* in_sizes, int n_in, void* d_out, int out_size, void* d_ws, size_t ws_size, hipStream_t stream) {
    static int grid = 0;
    if (grid == 0) {
        if (n_in != 27 || ws_size < WS_END) { fprintf(stderr, "kernel_launch: need 27 inputs and >= %zu B of workspace; got %d, %zu\n", (size_t)WS_END, n_in, ws_size); grid = -1; return; }
        int dev = 0, cus = 0, per_cu = 0;
        if (hipGetDevice(&dev) != hipSuccess || hipDeviceGetAttribute(&cus, hipDeviceAttributeMultiprocessorCount, dev) != hipSuccess) { grid = -1; return; }
        if (hipFuncSetAttribute((const void*)fwd_megakernel, hipFuncAttributeMaxDynamicSharedMemorySize, LDS_BYTES) != hipSuccess) { fprintf(stderr, "kernel_launch: hipFuncSetAttribute failed\n"); grid = -1; return; }
        if (hipOccupancyMaxActiveBlocksPerMultiprocessor(&per_cu, (const void*)fwd_megakernel, NTHR, LDS_BYTES) != hipSuccess || per_cu < 1) { fprintf(stderr, "kernel_launch: occupancy query says %d\n", per_cu); per_cu = 1; }
        (void)hipGetLastError();
        grid = cus * per_cu;
        if (grid < 256) { fprintf(stderr, "kernel_launch: this kernel's work split needs 256 co-resident workgroups; the device offers %d\n", grid); grid = -1; return; }
        grid = 256;
    }
    if (grid < 0) return;
    (void)hipMemsetAsync((char*)d_ws + WS_CTL, 0, CTL_ZERO_BYTES, stream);
    Args a{};
    for (int i = 0; i < 27; ++i) a.in[i] = (const float*)d_in[i];
    a.out = (float*)d_out; a.ws = (unsigned char*)d_ws; a.ph_lo = 0; a.ph_hi = N_PHASES;
    void* args[] = {&a};
    hipError_t e = hipLaunchCooperativeKernel((const void*)fwd_megakernel, dim3(grid), dim3(NTHR), args, LDS_BYTES, stream);
    if (e != hipSuccess) fprintf(stderr, "kernel_launch: cooperative launch failed: %s (grid %d)\n", hipGetErrorString(e), grid);
}
```

```cpp
#include <hip/hip_runtime.h>
#include <hip/hip_cooperative_groups.h>
#include <cstdio>
#include <cstdint>
namespace cg = cooperative_groups;
namespace pg8 {
#define PG8_LAS __attribute__((address_space(3)))
typedef unsigned short bf16_t;
typedef short bf16x8 __attribute__((ext_vector_type(8)));
typedef float f32x4 __attribute__((ext_vector_type(4)));
typedef unsigned u32x4 __attribute__((ext_vector_type(4)));
constexpr int BM = 256, BK = 64, HALF = 128, HTB = HALF * BK * 2  , STAGE_BYTES = 8 * HTB, NXCD = 8, WGM = 8;

__host__ __device__ __forceinline__ int lds_byte(int r, int c) { const int st = (r >> 4) * 2 + (c >> 5), rr = r & 15, cc = c & 31, ob = rr * 64 + cc * 2; return st * 1024 + (ob ^ (((ob >> 9) & 1) << 5)); }
__host__ __device__ __forceinline__ void stage_rc(int b, int& R, int& C) { const int st = b / 1024, sb = b % 1024, swz = sb ^ (((sb >> 9) & 1) << 5); R = (st >> 1) * 16 + swz / 64; C = (st & 1) * 32 + (swz % 64) / 2; }
__host__ __device__ __forceinline__ int perm32(int rho) { const int n = rho >> 4, i = rho & 15; return 8 * (i >> 2) + 4 * n + (i & 3); }

struct Unit { int pm, pn; };
struct Gemm { const bf16_t* A; const bf16_t* Bt; int M, N, K; };

struct StaticOrder {
    int nM, nN, nwg, G, c, wgm;
    __host__ __device__ void init(int M, int N, int G_, int c_, int wgm_ = 8) { nM = M / BM; nN = N / BM; nwg = nM * nN; G = G_; c = c_; wgm = wgm_; }
    __host__ __device__ bool next(int i, Unit& u) const {
        const long L = (long)i * G + c; if (L >= nwg) return false;
        int wgid = (int)L; { const int q = nwg / NXCD, r = nwg % NXCD, xcd = wgid % NXCD, off = wgid / NXCD; wgid = (xcd < r ? xcd * (q + 1) : r * (q + 1) + (xcd - r) * q) + off; }
        const int nig = wgm * nN, gid = wgid / nig, fm = gid * wgm, gsz = (nM - fm) < wgm ? (nM - fm) : wgm;
        u.pm = fm + ((wgid % nig) % gsz); u.pn = (wgid % nig) / gsz; return true;
    }
    __device__ __forceinline__ void a_ready(const Unit&) const {}
    __device__ __forceinline__ void done(const Unit&) const {}
};

typedef __bf16 bf16x2_cvt __attribute__((ext_vector_type(2)));
typedef float f32x2_cvt __attribute__((ext_vector_type(2)));
__device__ __forceinline__ unsigned cvt_pk_bf16(float lo, float hi) { const f32x2_cvt v = {lo, hi}; const bf16x2_cvt b = __builtin_convertvector(v, bf16x2_cvt); return __builtin_bit_cast(unsigned, b); }
__device__ __forceinline__ float sigmoid_f(float x) { return __builtin_amdgcn_rcpf(1.f + __builtin_amdgcn_exp2f(-1.4426950409f * x)); }
__device__ __forceinline__ float gelu_tanh_f(float x) { const float u = x * (-2.3022081985f - 0.10294324f * (x * x)); return x * __builtin_amdgcn_rcpf(1.f + __builtin_amdgcn_exp2f(u)); }
__device__ __forceinline__ float bflo(unsigned w) { return __builtin_bit_cast(float, w << 16); }
__device__ __forceinline__ float bfhi(unsigned w) { return __builtin_bit_cast(float, w & 0xffff0000u); }
template <int MODE> struct Epi {
    static constexpr bool PERM = true, AFTER_DRAIN = false, HOOK = false;
    bf16_t* Ob; float* Of; const bf16_t* G; float* SS; int ldc;
    bf16_t *s0, *s1, *s2, *s3, *s4, *s5;
    template <int ACT> __device__ __forceinline__ void act_store(const f32x4 (&acc)[2][2][4][2], bf16_t* base, int ld, int row0, int col0, int fq) const {
#pragma unroll
        for (int ai = 0; ai < 2; ++ai)
#pragma unroll
            for (int m = 0; m < 4; ++m) {
                const int row = row0 + ai * HALF + m * 16; bf16_t* rowp = base + (size_t)row * ld + col0; float ss = 0.f;
#pragma unroll
                for (int bj = 0; bj < 2; ++bj) {
                    f32x4 v0 = acc[ai][bj][m][0], v1 = acc[ai][bj][m][1];
                    if constexpr (ACT == 2) {
#pragma unroll
                        for (int j = 0; j < 4; ++j) { v0[j] = sigmoid_f(v0[j]); v1[j] = sigmoid_f(v1[j]); }
                    } else if constexpr (ACT == 1 || ACT == 3) {
#pragma unroll
                        for (int j = 0; j < 4; ++j) { v0[j] = gelu_tanh_f(v0[j]); v1[j] = gelu_tanh_f(v1[j]); }
                    }
                    if constexpr (ACT == 3) {
#pragma unroll
                        for (int j = 0; j < 4; ++j) ss += v0[j] * v0[j] + v1[j] * v1[j];
                    }
                    u32x4 w; w.x = cvt_pk_bf16(v0[0], v0[1]); w.y = cvt_pk_bf16(v0[2], v0[3]); w.z = cvt_pk_bf16(v1[0], v1[1]); w.w = cvt_pk_bf16(v1[2], v1[3]);
                    *(u32x4*)(rowp + bj * HALF) = w;
                }
                if constexpr (ACT == 3) { ss += __shfl_xor(ss, 16); ss += __shfl_xor(ss, 32); if (fq == 0) atomicAdd(SS + row, ss); }
            }
    }
    __device__ __forceinline__ void operator()(const f32x4 (&acc)[2][2][4][2], const Unit& u, int wr, int wc, int fr, int fq) const {
        const int row0 = u.pm * BM + wr * 64 + fr;
        if constexpr (MODE == 1) {
            const int t = u.pn >> 2;
            bf16_t* base = t == 0 ? s0 : t == 1 ? s1 : t == 2 ? s2 : t == 3 ? s3 : t == 4 ? s4 : s5;
            const int ld = (t == 0 || t == 3) ? 2048 : 1024;
            const int col0 = (u.pn & 3) * BM + wc * 32 + 8 * fq;
            if (t >= 4) act_store<2>(acc, base, ld, row0, col0, fq);
            else if (t == 2) act_store<0>(acc, base, ld, row0, col0, fq);
            else if (t == 1) act_store<3>(acc, base, ld, row0, col0, fq);
            else act_store<1>(acc, base, ld, row0, col0, fq);
        } else {
            const int col0 = u.pn * BM + wc * 32 + 8 * fq;
#pragma unroll
            for (int ai = 0; ai < 2; ++ai)
#pragma unroll
                for (int m = 0; m < 4; ++m) {
                    const int row = row0 + ai * HALF + m * 16; float ss = 0.f;
#pragma unroll
                    for (int bj = 0; bj < 2; ++bj) {
                        f32x4 v0 = acc[ai][bj][m][0], v1 = acc[ai][bj][m][1];
                        const size_t off = (size_t)row * ldc + col0 + bj * HALF;
                        if constexpr (MODE == 2 || MODE == 3) {
                            const u32x4 g = *(const u32x4*)(G + off);
                            v0[0] *= bflo(g.x); v0[1] *= bfhi(g.x); v0[2] *= bflo(g.y); v0[3] *= bfhi(g.y);
                            v1[0] *= bflo(g.z); v1[1] *= bfhi(g.z); v1[2] *= bflo(g.w); v1[3] *= bfhi(g.w);
                        }
                        if constexpr (MODE == 3) { v0 = v0 + *(const f32x4*)(Of + off); v1 = v1 + *(const f32x4*)(Of + off + 4); }
                        if constexpr (MODE == 5) {
#pragma unroll
                            for (int j = 0; j < 4; ++j) { const float a = fmaxf(v0[j], 0.f), b = fmaxf(v1[j], 0.f); v0[j] = a * a; v1[j] = b * b; }
                        }
                        if constexpr (MODE == 4) {
#pragma unroll
                            for (int j = 0; j < 4; ++j) ss += v0[j] * v0[j] + v1[j] * v1[j];
                        }
                        if constexpr (MODE == 2 || MODE == 4) { *(f32x4*)(Of + off) = v0; *(f32x4*)(Of + off + 4) = v1; }
                        else { u32x4 w; w.x = cvt_pk_bf16(v0[0], v0[1]); w.y = cvt_pk_bf16(v0[2], v0[3]); w.z = cvt_pk_bf16(v1[0], v1[1]); w.w = cvt_pk_bf16(v1[2], v1[3]);
                            *(u32x4*)(Ob + off) = w; }
                    }
                    if constexpr (MODE == 4) { ss += __shfl_xor(ss, 16); ss += __shfl_xor(ss, 32); if (fq == 0) atomicAdd(SS + row, ss); }
                }
        }
    }
};

struct EpiMerge {
    static constexpr bool PERM = true, AFTER_DRAIN = false, HOOK = true;
    bf16_t* Ob; const bf16_t* GA; const bf16_t* GB;
    __device__ __forceinline__ void mid(f32x4 (&acc)[2][2][4][2], const Unit& u, int wr, int wc, int fr, int fq) const {
        int row0 = u.pm * BM + wr * 64 + fr, col0 = u.pn * BM + wc * 32 + 8 * fq;
        asm volatile("" : "+v"(row0), "+v"(col0));
#pragma unroll
        for (int ai = 0; ai < 2; ++ai)
#pragma unroll
            for (int m = 0; m < 4; ++m) {
                if ((m & 1) == 0) asm volatile("" ::: "memory");
#pragma unroll
                for (int bj = 0; bj < 2; ++bj) {
                    const size_t off = (size_t)(row0 + ai * HALF + m * 16) * 1024 + col0 + bj * HALF;
                    const u32x4 a = *(const u32x4*)(GA + off), b = *(const u32x4*)(GB + off);
                    f32x4 r0, r1;
                    r0[0] = bflo(a.x) * __builtin_amdgcn_rcpf(fmaxf(bflo(b.x), 1e-30f)); r0[1] = bfhi(a.x) * __builtin_amdgcn_rcpf(fmaxf(bfhi(b.x), 1e-30f));
                    r0[2] = bflo(a.y) * __builtin_amdgcn_rcpf(fmaxf(bflo(b.y), 1e-30f)); r0[3] = bfhi(a.y) * __builtin_amdgcn_rcpf(fmaxf(bfhi(b.y), 1e-30f));
                    r1[0] = bflo(a.z) * __builtin_amdgcn_rcpf(fmaxf(bflo(b.z), 1e-30f)); r1[1] = bfhi(a.z) * __builtin_amdgcn_rcpf(fmaxf(bfhi(b.z), 1e-30f));
                    r1[2] = bflo(a.w) * __builtin_amdgcn_rcpf(fmaxf(bflo(b.w), 1e-30f)); r1[3] = bfhi(a.w) * __builtin_amdgcn_rcpf(fmaxf(bfhi(b.w), 1e-30f));
                    acc[ai][bj][m][0] = acc[ai][bj][m][0] * r0; acc[ai][bj][m][1] = acc[ai][bj][m][1] * r1;
                }
            }
    }
    __device__ __forceinline__ void operator()(const f32x4 (&acc)[2][2][4][2], const Unit& u, int wr, int wc, int fr, int fq) const {
        const int row0 = u.pm * BM + wr * 64 + fr, col0 = u.pn * BM + wc * 32 + 8 * fq;
#pragma unroll
        for (int ai = 0; ai < 2; ++ai)
#pragma unroll
            for (int m = 0; m < 4; ++m)
#pragma unroll
                for (int bj = 0; bj < 2; ++bj) {
                    const size_t off = (size_t)(row0 + ai * HALF + m * 16) * 1024 + col0 + bj * HALF;
                    const u32x4 b = *(const u32x4*)(GB + off);
                    const f32x4 v0 = acc[ai][bj][m][0], v1 = acc[ai][bj][m][1];
                    u32x4 w; w.x = cvt_pk_bf16(v0[0] * bflo(b.x), v0[1] * bfhi(b.x)); w.y = cvt_pk_bf16(v0[2] * bflo(b.y), v0[3] * bfhi(b.y));
                    w.z = cvt_pk_bf16(v1[0] * bflo(b.z), v1[1] * bfhi(b.z)); w.w = cvt_pk_bf16(v1[2] * bflo(b.w), v1[3] * bfhi(b.w));
                    *(u32x4*)(Ob + off) = w;
                }
    }
};

template <class Epi, class Sched, bool ALIGN_EPI = false, bool SP2 = false>
__device__ __forceinline__ void gemm_phase(PG8_LAS unsigned char* lds, const Gemm g, const Sched& S, const Epi& E) {
    const int tid = threadIdx.x, wid = __builtin_amdgcn_readfirstlane(tid >> 6), lane = tid & 63, wr = wid >> 2, wc = wid & 3, fr = lane & 15, fq = lane >> 4;
    const int K = g.K, nt = K / BK;
    unsigned voffA[2], voffB[2];
#pragma unroll
    for (int i = 0; i < 2; ++i) { int R, C; stage_rc(tid * 16 + i * 8192, R, C); const int Rb = Epi::PERM ? ((R & ~31) + perm32(R & 31)) : R;
        voffA[i] = (unsigned)(R * K + C) * 2u; voffB[i] = (unsigned)(Rb * K + C) * 2u; }
    const size_t kstep = (size_t)(BK * 2);
    const size_t hstep = (size_t)HALF * K * 2;
    const size_t tstep = 2 * hstep;
    const unsigned ldsw = (unsigned)wid * 1024u;
    const int aoff = lds_byte(wr * 64 + fr, fq * 8), boff = lds_byte(wc * 32 + fr, fq * 8);
#define PG8_SA(b, h) (((b) * 2 + (h)) * HTB)
#define PG8_SB(b, h) ((4 + (b) * 2 + (h)) * HTB)
#define PG8_STAGE(bufoff, gbase, voff) do { _Pragma("unroll") for (int _i = 0; _i < 2; ++_i) \
        __builtin_amdgcn_global_load_lds((const unsigned*)((const char*)(gbase) + (voff)[_i]), (PG8_LAS unsigned*)(lds + (bufoff) + ldsw + _i * 8192), 16, 0, 0); } while (0)
#define PG8_LDA(dst, b, h) do { _Pragma("unroll") for (int m = 0; m < 4; ++m) _Pragma("unroll") for (int k = 0; k < 2; ++k) dst[m][k] = *(const PG8_LAS bf16x8*)(lds + PG8_SA(b, h) + aoff + m * 2048 + k * 1024); } while (0)
#define PG8_LDB(dst, b, h) do { _Pragma("unroll") for (int n = 0; n < 2; ++n) _Pragma("unroll") for (int k = 0; k < 2; ++k) dst[n][k] = *(const PG8_LAS bf16x8*)(lds + PG8_SB(b, h) + boff + n * 2048 + k * 1024); } while (0)
#define PG8_MMA(ai, bj, At, Bt) do { __builtin_amdgcn_s_setprio(1); _Pragma("unroll") for (int m = 0; m < 4; ++m) _Pragma("unroll") for (int n = 0; n < 2; ++n) _Pragma("unroll") for (int k = 0; k < 2; ++k) \
        acc[ai][bj][m][n] = __builtin_amdgcn_mfma_f32_16x16x32_bf16(Bt[n][k], At[m][k], acc[ai][bj][m][n], 0, 0, 0); __builtin_amdgcn_s_setprio(0); } while (0)
#define PG8_WAIT_V(n) asm volatile("s_waitcnt vmcnt(" #n ")" ::: "memory")
#define PG8_WAIT_L(n) asm volatile("s_waitcnt lgkmcnt(" #n ")" ::: "memory")
#define PG8_BAR __builtin_amdgcn_s_barrier()
#define PG8_SCHED __builtin_amdgcn_sched_barrier(0)
    Unit cur, nxt; int ui = 0;
    if (!S.next(0, cur)) return;
    f32x4 acc[2][2][4][2];
#pragma unroll
    for (int a = 0; a < 2; ++a)
#pragma unroll
        for (int b = 0; b < 2; ++b)
#pragma unroll
            for (int m = 0; m < 4; ++m)
#pragma unroll
                for (int n = 0; n < 2; ++n) acc[a][b][m][n] = (f32x4){0.f, 0.f, 0.f, 0.f};
    bf16x8 At[4][2], B0[2][2], B1[2][2];
    const char* cA = (const char*)g.A + (size_t)cur.pm * tstep; const char* cB = (const char*)g.Bt + (size_t)cur.pn * tstep;
    S.a_ready(cur);
    if constexpr (SP2) {
        PG8_STAGE(PG8_SB(0, 0), cB, voffB); PG8_STAGE(PG8_SB(0, 1), cB + hstep, voffB); PG8_STAGE(PG8_SA(0, 0), cA, voffA); PG8_STAGE(PG8_SA(0, 1), cA + hstep, voffA);
        if (wr == 1) PG8_BAR;
        PG8_WAIT_V(2); PG8_BAR;
        PG8_STAGE(PG8_SB(1, 0), cB + kstep, voffB); PG8_STAGE(PG8_SA(1, 0), cA + kstep, voffA); PG8_STAGE(PG8_SB(1, 1), cB + hstep + kstep, voffB);
        PG8_WAIT_V(6); PG8_BAR;
    } else {
        PG8_STAGE(PG8_SB(0, 0), cB, voffB); PG8_STAGE(PG8_SA(0, 0), cA, voffA); PG8_STAGE(PG8_SB(0, 1), cB + hstep, voffB); PG8_STAGE(PG8_SA(0, 1), cA + hstep, voffA);
        if (wr == 1) PG8_BAR;
        PG8_WAIT_V(4); PG8_BAR;
        PG8_STAGE(PG8_SB(1, 0), cB + kstep, voffB); PG8_STAGE(PG8_SA(1, 0), cA + kstep, voffA); PG8_STAGE(PG8_SB(1, 1), cB + hstep + kstep, voffB);
        PG8_WAIT_V(6); PG8_BAR;
    }
    for (;;) {
        const bool has_next = S.next(ui + 1, nxt);
        const char* nA = has_next ? (const char*)g.A + (size_t)nxt.pm * tstep : cA; const char* nB = has_next ? (const char*)g.Bt + (size_t)nxt.pn * tstep : cB;
        for (int t = 0; t < nt; t += 2) {
            if constexpr (Epi::HOOK) { if (t == (nt >> 1)) E.mid(acc, cur, wr, wc, fr, fq); }
            const bool last = (t == nt - 2);
            const char* a1 = cA + (size_t)(t + 1) * kstep;
            const char* a2 = last ? nA : cA + (size_t)(t + 2) * kstep; const char* b2 = last ? nB : cB + (size_t)(t + 2) * kstep;
            const char* a3 = a2 + kstep; const char* b3 = b2 + kstep;
            if (last && has_next) S.a_ready(nxt);
            if constexpr (SP2) {
            PG8_LDB(B0, 0, 0); PG8_LDB(B1, 0, 1); PG8_SCHED; PG8_LDA(At, 0, 0); PG8_STAGE(PG8_SA(1, 1), a1 + hstep, voffA);
            PG8_WAIT_V(8); PG8_WAIT_L(0); PG8_BAR; PG8_MMA(0, 0, At, B0); PG8_MMA(0, 1, At, B1); PG8_BAR; PG8_SCHED;
            PG8_LDA(At, 0, 1); PG8_STAGE(PG8_SB(0, 0), b2, voffB); PG8_STAGE(PG8_SB(0, 1), b2 + hstep, voffB); PG8_STAGE(PG8_SA(0, 0), a2, voffA);
            PG8_WAIT_V(8); PG8_WAIT_L(0); PG8_BAR; PG8_MMA(1, 0, At, B0); PG8_MMA(1, 1, At, B1); PG8_BAR; PG8_SCHED;
            PG8_LDB(B0, 1, 0); PG8_LDB(B1, 1, 1); PG8_SCHED; PG8_LDA(At, 1, 0); PG8_STAGE(PG8_SA(0, 1), a2 + hstep, voffA);
            PG8_WAIT_V(8); PG8_WAIT_L(0); PG8_BAR; PG8_MMA(0, 0, At, B0); PG8_MMA(0, 1, At, B1); PG8_BAR; PG8_SCHED;
            PG8_LDA(At, 1, 1); PG8_STAGE(PG8_SB(1, 0), b3, voffB); PG8_STAGE(PG8_SB(1, 1), b3 + hstep, voffB); PG8_STAGE(PG8_SA(1, 0), a3, voffA);
            PG8_WAIT_V(8); PG8_WAIT_L(0); PG8_BAR; PG8_MMA(1, 0, At, B0); PG8_MMA(1, 1, At, B1); PG8_BAR; PG8_SCHED;
            } else {
            PG8_LDB(B0, 0, 0); PG8_SCHED; PG8_LDA(At, 0, 0); PG8_STAGE(PG8_SA(1, 1), a1 + hstep, voffA);
            PG8_WAIT_L(8); PG8_BAR; PG8_WAIT_L(0); PG8_MMA(0, 0, At, B0); PG8_BAR; PG8_SCHED;
            PG8_LDB(B1, 0, 1); PG8_STAGE(PG8_SB(0, 0), b2, voffB);
            PG8_BAR; PG8_WAIT_L(0); PG8_MMA(0, 1, At, B1); PG8_BAR;
            PG8_LDA(At, 0, 1); PG8_STAGE(PG8_SA(0, 0), a2, voffA);
            PG8_BAR; PG8_WAIT_L(0); PG8_MMA(1, 0, At, B0); PG8_BAR; PG8_SCHED;
            PG8_STAGE(PG8_SB(0, 1), b2 + hstep, voffB);
            PG8_WAIT_V(6); PG8_BAR; PG8_MMA(1, 1, At, B1); PG8_BAR;
            PG8_LDB(B0, 1, 0); PG8_SCHED; PG8_LDA(At, 1, 0); PG8_STAGE(PG8_SA(0, 1), a2 + hstep, voffA);
            PG8_WAIT_L(8); PG8_BAR; PG8_WAIT_L(0); PG8_MMA(0, 0, At, B0); PG8_BAR; PG8_SCHED;
            PG8_LDB(B1, 1, 1); PG8_STAGE(PG8_SB(1, 0), b3, voffB);
            PG8_BAR; PG8_WAIT_L(0); PG8_MMA(0, 1, At, B1); PG8_BAR;
            PG8_LDA(At, 1, 1); PG8_STAGE(PG8_SA(1, 0), a3, voffA);
            PG8_BAR; PG8_WAIT_L(0); PG8_MMA(1, 0, At, B0); PG8_BAR; PG8_SCHED;
            PG8_STAGE(PG8_SB(1, 1), b3 + hstep, voffB);
            PG8_WAIT_V(6); PG8_BAR; PG8_MMA(1, 1, At, B1); PG8_BAR;
            }
        }
        if constexpr (ALIGN_EPI) { if (wr == 0) PG8_BAR; }
        if constexpr (!Epi::AFTER_DRAIN) { E(acc, cur, wr, wc, fr, fq); S.done(cur); }
        if (!has_next) break;
#pragma unroll
        for (int a = 0; a < 2; ++a)
#pragma unroll
            for (int b = 0; b < 2; ++b)
#pragma unroll
                for (int m = 0; m < 4; ++m)
#pragma unroll
                    for (int n = 0; n < 2; ++n) acc[a][b][m][n] = (f32x4){0.f, 0.f, 0.f, 0.f};
        cur = nxt; cA = nA; cB = nB; ++ui;
        if constexpr (ALIGN_EPI) { if (wr == 1) PG8_BAR; }
    }
    PG8_WAIT_V(0);
    if constexpr (!ALIGN_EPI) { if (wr == 0) PG8_BAR; }
    PG8_BAR;
    if constexpr (Epi::AFTER_DRAIN) { E.fused(acc, cur, wr, wc, fr, fq, lds, wid, lane); S.done(cur); }
#undef PG8_SA
#undef PG8_SB
#undef PG8_STAGE
#undef PG8_LDA
#undef PG8_LDB
#undef PG8_MMA
#undef PG8_WAIT_V
#undef PG8_WAIT_L
#undef PG8_BAR
#undef PG8_SCHED
}
}

constexpr int NWAVES = 8, NTHR = NWAVES * 64;
constexpr int D = 1024, M = 16384, MCTX = 8192, INC = 6144, FF = 4096;
constexpr float EPS = 1e-6f, LOG2E = 1.4426950408889634f;
constexpr size_t MiB = 1u << 20;
constexpr size_t WS_CTL = 0, CTL_ZERO_BYTES = 1 * MiB;
constexpr size_t CTL_VSS = 64 * 1024, CTL_OSS = 128 * 1024, CTL_FSS = 192 * 1024, CTL_MOD = 256 * 1024, CTL_XSS = 384 * 1024;
constexpr size_t CTL_MODCNT = 14 * 1024;
constexpr size_t CTL_CNT = 16 * 1024;
constexpr size_t WS_GC = 1 * MiB;
constexpr size_t WS_AGG = 2 * MiB;
constexpr size_t WS_CAR = 4 * MiB;
constexpr size_t WS_WG = 5 * MiB;
constexpr size_t WS_WSP = 5 * MiB + 512 * 1024;
constexpr size_t WS_WFF2 = 6 * MiB, WS_WFF1 = 14 * MiB, WS_WIN = 22 * MiB, WS_WBG = 34 * MiB, WS_WBR = 36 * MiB, WS_WOUT = 38 * MiB;
constexpr size_t WS_H = 40 * MiB;
constexpr size_t WS_F = 64 * MiB;
constexpr size_t WS_GU = 128 * MiB, WS_GGR = 160 * MiB, WS_SGA = 192 * MiB, WS_SGB = 224 * MiB;
constexpr size_t WS_F1 = 128 * MiB;
constexpr size_t WS_END = 256 * MiB;
constexpr int LDS_BYTES = 147456, LDS_BAR_OFF = 139264;
#ifndef WG_IN
#define WG_IN 4
#endif
#ifndef WG_FF1
#define WG_FF1 2
#endif
#ifndef DUP
#define DUP 0
#endif

#define GAS __attribute__((address_space(1)))
#define LAS __attribute__((address_space(3)))
typedef unsigned short bf16;
typedef unsigned v4u __attribute__((ext_vector_type(4)));
typedef unsigned v2u __attribute__((ext_vector_type(2)));
typedef float f32x4 __attribute__((ext_vector_type(4)));
typedef float f32x2 __attribute__((ext_vector_type(2)));
typedef short bf16x8 __attribute__((ext_vector_type(8)));
#define LDS_WAIT() asm volatile("s_waitcnt lgkmcnt(0)" ::: "memory")
__device__ __forceinline__ unsigned f2bf(float f) { unsigned u = __builtin_bit_cast(unsigned, f); return (u + 0x7fffu + ((u >> 16) & 1u)) >> 16; }
__device__ __forceinline__ unsigned pk2(float lo, float hi) { return pg8::cvt_pk_bf16(lo, hi); }
__device__ __forceinline__ float bf2f(bf16 b) { return __builtin_bit_cast(float, (unsigned)b << 16); }
using pg8::bflo; using pg8::bfhi;

struct Args { const float* in[27]; float* out; unsigned char* ws; int ph_lo, ph_hi; };
enum { I_XP = 0, I_XS, I_STATE, I_C, I_CCTX, I_WADA, I_BADA, I_GPREMIX, I_GPOSTMIX, I_GPREMLP, I_GPOSTMLP, I_WIN, I_GSGU, I_WSP, I_BSP, I_CONVW, I_CONVB,
       I_WRA, I_BRA, I_WRI, I_BRI, I_LAM, I_WBRG, I_WBRR, I_WOUT, I_WFF1, I_WFF2 };

__device__ __forceinline__ float wave_sum(float v) {
#pragma unroll
    for (int o = 1; o < 64; o <<= 1) v += __shfl_xor(v, o);
    return v;
}
__device__ __forceinline__ void p0_transpose_item(const float* W, int K, int N, bf16* WT, LAS float* scr, int item, int lane, int ldk = 0, int koff = 0) {
    if (ldk == 0) ldk = K;
    const int nblk = N / 32, kb = item / nblk, nb = item % nblk, k0 = 64 * kb, n0 = 32 * nb;
#pragma unroll
    for (int i = 0; i < 8; ++i) { const int kk = 8 * i + (lane >> 3);
        const f32x4 v = *(const f32x4*)(W + (size_t)(k0 + kk) * N + n0 + (lane & 7) * 4);
        LAS float* dd = scr + kk * 33 + (lane & 7) * 4; dd[0] = v[0]; dd[1] = v[1]; dd[2] = v[2]; dd[3] = v[3]; }
    LDS_WAIT(); asm volatile("" ::: "memory");
    const int c = lane & 7;
#pragma unroll
    for (int j = 0; j < 4; ++j) { const int n = (lane >> 3) + 8 * j; const LAS float* s = scr + (8 * c) * 33 + n;
        v4u o; o.x = pk2(s[0 * 33], s[1 * 33]); o.y = pk2(s[2 * 33], s[3 * 33]); o.z = pk2(s[4 * 33], s[5 * 33]); o.w = pk2(s[6 * 33], s[7 * 33]);
        *(v4u*)(WT + (size_t)(n0 + n) * ldk + koff + k0 + 8 * c) = o; }
    LDS_WAIT(); asm volatile("" ::: "memory");
}

__device__ __forceinline__ void phase_prep(const Args& a, LAS unsigned char* lds, int gw, int NGW, int wave, int lane, float* MOD) {
    unsigned char* ws = a.ws;
    LAS float* scr = (LAS float*)(lds + wave * 16384);
    if ((int)blockIdx.x < 192) {
        const float* wada = a.in[I_WADA]; const float* cctx = a.in[I_CCTX]; const float* cc = a.in[I_C];
        const int nb = blockIdx.x % 24, ksl = blockIdx.x / 24, n = nb * 256 + lane * 4, kbase = ksl * 128 + wave * 16;
        f32x4 a0 = {0.f, 0.f, 0.f, 0.f}, a1 = a0, a2 = a0;
#pragma unroll
        for (int kk = 0; kk < 16; ++kk) {
            const int k = kbase + kk;
            const f32x4 w = *(const f32x4*)(wada + (size_t)k * INC + n);
            const float c0 = cctx[k], c1 = cc[k], c2 = cc[D + k];
            const float s0 = c0 * pg8::sigmoid_f(c0), s1 = c1 * pg8::sigmoid_f(c1), s2 = c2 * pg8::sigmoid_f(c2);
            a0 += w * s0; a1 += w * s1; a2 += w * s2;
        }
        LAS float* red = (LAS float*)lds;
        *(LAS f32x4*)(red + (wave * 3 + 0) * 256 + lane * 4) = a0; *(LAS f32x4*)(red + (wave * 3 + 1) * 256 + lane * 4) = a1; *(LAS f32x4*)(red + (wave * 3 + 2) * 256 + lane * 4) = a2;
        __syncthreads();
        const int tid = wave * 64 + lane;
        if (tid < 192) {
            const int v = tid >> 6, c4 = (tid & 63) * 4;
            f32x4 sum = {0.f, 0.f, 0.f, 0.f};
#pragma unroll
            for (int w2 = 0; w2 < 8; ++w2) sum += *(const LAS f32x4*)(red + (w2 * 3 + v) * 256 + c4);
#pragma unroll
            for (int j = 0; j < 4; ++j) atomicAdd(MOD + v * INC + nb * 256 + c4 + j, sum[j]);
        }
        asm volatile("s_waitcnt vmcnt(0)" ::: "memory");
        __syncthreads();
        if (threadIdx.x == 0) __hip_atomic_fetch_add((unsigned*)(ws + CTL_MODCNT), 1u, __ATOMIC_RELAXED, __HIP_MEMORY_SCOPE_AGENT);
    }
    constexpr int I_IN = 16 * (INC / 32), I_SQ = 16 * (D / 32), I_F1 = 16 * (FF / 32), I_F2 = (FF / 64) * (D / 32);
    constexpr int NT = I_IN + 3 * I_SQ + I_F1 + I_F2;
    for (int it = gw; it < NT; it += NGW) {
        int r = it;
        if (r < I_IN) { p0_transpose_item(a.in[I_WIN], D, INC, (bf16*)(ws + WS_WIN), scr, r, lane); continue; } r -= I_IN;
        if (r < I_SQ) { p0_transpose_item(a.in[I_WBRG], D, D, (bf16*)(ws + WS_WBG), scr, r, lane, 2 * D, 0); continue; } r -= I_SQ;
        if (r < I_SQ) { p0_transpose_item(a.in[I_WBRR], D, D, (bf16*)(ws + WS_WBG), scr, r, lane, 2 * D, D); continue; } r -= I_SQ;
        if (r < I_SQ) { p0_transpose_item(a.in[I_WOUT], D, D, (bf16*)(ws + WS_WOUT), scr, r, lane); continue; } r -= I_SQ;
        if (r < I_F1) { p0_transpose_item(a.in[I_WFF1], D, FF, (bf16*)(ws + WS_WFF1), scr, r, lane); continue; } r -= I_F1;
        p0_transpose_item(a.in[I_WFF2], FF, D, (bf16*)(ws + WS_WFF2), scr, r, lane);
    }
    {
        const bool few = gridDim.x > 192;
        if (few && blockIdx.x < 192) return;
        const int gt = few ? ((int)blockIdx.x - 192) * NTHR + wave * 64 + lane : gw * 64 + lane, NGT = few ? ((int)gridDim.x - 192) * NTHR : NGW * 64;
        bf16* WG = (bf16*)(ws + WS_WG);
        for (int it = gt; it < 16 * 16 * 2 * 64; it += NGT) {
            const int ln = it & 63, ks = (it >> 6) & 1, cbi = (it >> 7) & 15, h = it >> 11;
            const int fr = ln & 15, fq = ln >> 4, type = cbi >> 3, d = (cbi >> 2) & 1, cb = cbi & 3;
            const float* W = type ? a.in[I_WRI] : a.in[I_WRA];
            const float* src = W + ((size_t)(d * 16 + h) * 64 + ks * 32 + fq * 8) * 64 + cb * 16 + fr;
            v4u o; o.x = pk2(-LOG2E * src[0], -LOG2E * src[64]); o.y = pk2(-LOG2E * src[128], -LOG2E * src[192]);
            o.z = pk2(-LOG2E * src[256], -LOG2E * src[320]); o.w = pk2(-LOG2E * src[384], -LOG2E * src[448]);
            *(v4u*)(WG + (size_t)it * 8) = o;
        }
        bf16* WSP = (bf16*)(ws + WS_WSP); const float* wsp = a.in[I_WSP];
        for (int it = gt; it < 8 * 128 * 128 / 8; it += NGT) {
            const f32x4 x0 = *(const f32x4*)(wsp + (size_t)it * 8), x1 = *(const f32x4*)(wsp + (size_t)it * 8 + 4);
            v4u o; o.x = pk2(x0[0], x0[1]); o.y = pk2(x0[2], x0[3]); o.z = pk2(x1[0], x1[1]); o.w = pk2(x1[2], x1[3]);
            *(v4u*)(WSP + (size_t)it * 8) = o;
        }
        float* GC = (float*)(ws + WS_GC);
        for (int it = gt; it < 2048; it += NGT) {
            const float lamv = a.in[I_LAM][it]; const float sp = log1pf(expf(-lamv));
            f32x4 o; o[0] = exp2f(-LOG2E * a.in[I_BRA][it]); o[1] = exp2f(-LOG2E * a.in[I_BRI][it]); o[2] = -8.f * sp * LOG2E; o[3] = 0.f;
            *(f32x4*)(GC + (size_t)it * 4) = o;
        }
    }
}

__device__ __forceinline__ f32x4 modv(const float* MOD, const float* bada, int cv, int part, int c) {
    return *(const f32x4*)(MOD + cv * INC + part * D + c) + *(const f32x4*)(bada + part * D + c);
}
__device__ __forceinline__ int cv_of(int m) { return m < MCTX ? 0 : (m < MCTX + 4096 ? 1 : 2); }
__device__ __forceinline__ const float* xrow_of(const Args& a, int m) { return m < MCTX ? a.in[I_XP] + (size_t)m * D : a.in[I_XS] + (size_t)(m - MCTX) * D; }
__device__ __forceinline__ void store_bf4(bf16* p, f32x4 v) { v2u o; o.x = pk2(v[0], v[1]); o.y = pk2(v[2], v[3]); *(v2u*)p = o; }

__device__ __forceinline__ void phase_norm1(const Args& a, int gw, int NGW, int lane) {
    const float* MOD = (const float*)(a.ws + CTL_MOD); const float* bada = a.in[I_BADA]; const float* g = a.in[I_GPREMIX];
    bf16* H = (bf16*)(a.ws + WS_H);
    const int RPW = M / NGW;
    if (RPW * NGW == M && (MCTX % RPW) == 0 && (4096 % RPW) == 0) {
        const int m0 = gw * RPW, cv = cv_of(m0);
        f32x4 cc[4], sh[4];
#pragma unroll
        for (int j = 0; j < 4; ++j) { const int c = 4 * lane + 256 * j; cc[j] = *(const f32x4*)(g + c) * (modv(MOD, bada, cv, 1, c) + 1.f); sh[j] = modv(MOD, bada, cv, 0, c); }
        for (int m = m0; m < m0 + RPW; ++m) {
            const float* xr = xrow_of(a, m);
            f32x4 v[4]; float s = 0.f;
#pragma unroll
            for (int j = 0; j < 4; ++j) { v[j] = *(const f32x4*)(xr + 4 * lane + 256 * j); s += (v[j][0] * v[j][0] + v[j][1] * v[j][1]) + (v[j][2] * v[j][2] + v[j][3] * v[j][3]); }
            const float rstd = rsqrtf(wave_sum(s) * (1.f / D) + EPS);
#pragma unroll
            for (int j = 0; j < 4; ++j) store_bf4(H + (size_t)m * D + 4 * lane + 256 * j, v[j] * rstd * cc[j] + sh[j]);
        }
        return;
    }
    for (int m = gw; m < M; m += NGW) {
        const float* xr = xrow_of(a, m); const int cv = cv_of(m);
        f32x4 v[4]; float s = 0.f;
#pragma unroll
        for (int j = 0; j < 4; ++j) { v[j] = *(const f32x4*)(xr + 4 * lane + 256 * j); s += (v[j][0] * v[j][0] + v[j][1] * v[j][1]) + (v[j][2] * v[j][2] + v[j][3] * v[j][3]); }
        const float rstd = rsqrtf(wave_sum(s) * (1.f / D) + EPS);
#pragma unroll
        for (int j = 0; j < 4; ++j) { const int c = 4 * lane + 256 * j;
            const f32x4 gg = *(const f32x4*)(g + c), sh = modv(MOD, bada, cv, 0, c), sc = modv(MOD, bada, cv, 1, c);
            store_bf4(H + (size_t)m * D + c, v[j] * rstd * gg * (sc + 1.f) + sh); }
    }
}
__device__ __forceinline__ void phase_mid(const Args& a, int gw, int NGW, int lane, float* xout, bf16* H) {
    const float* MOD = (const float*)(a.ws + CTL_MOD); const float* bada = a.in[I_BADA];
    const float* gpm = a.in[I_GPOSTMIX]; const float* gpl = a.in[I_GPREMLP]; const float* OSS = (const float*)(a.ws + CTL_OSS);
    const float* out = a.out;
    for (int m = gw; m < M; m += NGW) {
        const float* xr = xrow_of(a, m); const int cv = cv_of(m);
        const float rstd_o = rsqrtf(OSS[m] * (1.f / D) + EPS);
        f32x4 v[4]; float s = 0.f;
#pragma unroll
        for (int j = 0; j < 4; ++j) { const int c = 4 * lane + 256 * j;
            const f32x4 o = *(const f32x4*)(out + (size_t)m * D + c), x = *(const f32x4*)(xr + c);
            const f32x4 g1 = modv(MOD, bada, cv, 2, c), gg = *(const f32x4*)(gpm + c);
            v[j] = x + g1 * (o * rstd_o * gg);
            *(f32x4*)(xout + (size_t)m * D + c) = v[j];
            s += (v[j][0] * v[j][0] + v[j][1] * v[j][1]) + (v[j][2] * v[j][2] + v[j][3] * v[j][3]); }
        const float rstd = rsqrtf(wave_sum(s) * (1.f / D) + EPS);
#pragma unroll
        for (int j = 0; j < 4; ++j) { const int c = 4 * lane + 256 * j;
            const f32x4 gg = *(const f32x4*)(gpl + c), sh = modv(MOD, bada, cv, 3, c), sc = modv(MOD, bada, cv, 4, c);
            store_bf4(H + (size_t)m * D + c, v[j] * rstd * gg * (sc + 1.f) + sh); }
    }
}
__device__ __forceinline__ void phase_final(const Args& a, int gw, int NGW, int lane, float* yout) {
    const float* MOD = (const float*)(a.ws + CTL_MOD); const float* bada = a.in[I_BADA];
    const float* gpm = a.in[I_GPOSTMLP]; const float* FSS = (const float*)(a.ws + CTL_FSS); const float* F = (const float*)(a.ws + WS_F); const float* out = a.out;
    for (int m = gw; m < M; m += NGW) {
        const int cv = cv_of(m); const float rstd_f = rsqrtf(FSS[m] * (1.f / D) + EPS);
#pragma unroll
        for (int j = 0; j < 4; ++j) { const int c = 4 * lane + 256 * j;
            const f32x4 f = *(const f32x4*)(F + (size_t)m * D + c), x1 = *(const f32x4*)(out + (size_t)m * D + c);
            const f32x4 g2 = modv(MOD, bada, cv, 5, c), gg = *(const f32x4*)(gpm + c);
            *(f32x4*)(yout + (size_t)m * D + c) = x1 + g2 * (f * rstd_f * gg); }
    }
}

__device__ __forceinline__ void panel_sync(unsigned* cnt) {
    asm volatile("s_waitcnt vmcnt(0)" ::: "memory");
    __syncthreads();
    if (threadIdx.x == 0) {
        __hip_atomic_fetch_add(cnt, 1u, __ATOMIC_RELAXED, __HIP_MEMORY_SCOPE_AGENT);
        unsigned sp = 0;
        while (__hip_atomic_load(cnt, __ATOMIC_RELAXED, __HIP_MEMORY_SCOPE_AGENT) < 4u) { __builtin_amdgcn_s_sleep(1); if (++sp > (1u << 22)) break; }
    }
    __syncthreads();
}
__device__ __forceinline__ float ld_agent(const float* p) { return __builtin_bit_cast(float, __hip_atomic_load((const unsigned*)p, __ATOMIC_RELAXED, __HIP_MEMORY_SCOPE_AGENT)); }
__device__ __forceinline__ float sumsq4(f32x4 v) { return (v[0] * v[0] + v[1] * v[1]) + (v[2] * v[2] + v[3] * v[3]); }
template <int MODE> struct EpiFused {
    static constexpr bool PERM = true, AFTER_DRAIN = true, HOOK = false;
    float* out; const float* xp; const float* xs; bf16* H; float* SS1; float* SS2; unsigned* cnt1; unsigned* cnt2;
    const float* MOD; const float* bada; const float* gpost; const float* gpre;
    __device__ __forceinline__ void fused(f32x4 (&acc)[2][2][4][2], const pg8::Unit& u, int wr, int wc, int fr, int fq, LAS unsigned char*, int, int) const {
        const int row0 = u.pm * 256 + wr * 64 + fr, col0 = u.pn * 256 + wc * 32 + 8 * fq;
        const int cv = u.pm < 32 ? 0 : (u.pm < 48 ? 1 : 2);
#pragma unroll
        for (int ai = 0; ai < 2; ++ai)
#pragma unroll
            for (int m = 0; m < 4; ++m) {
                float ss = (sumsq4(acc[ai][0][m][0]) + sumsq4(acc[ai][0][m][1])) + (sumsq4(acc[ai][1][m][0]) + sumsq4(acc[ai][1][m][1]));
                ss += __shfl_xor(ss, 16); ss += __shfl_xor(ss, 32);
                if (fq == 0) atomicAdd(SS1 + row0 + ai * 128 + m * 16, ss);
            }
        panel_sync(cnt1 + 64 * u.pm);
        f32x4 ga[2][2];
#pragma unroll
        for (int bj = 0; bj < 2; ++bj)
#pragma unroll
            for (int n = 0; n < 2; ++n) { const int c = col0 + bj * 128 + 4 * n; ga[bj][n] = modv(MOD, bada, cv, MODE == 6 ? 2 : 5, c) * *(const f32x4*)(gpost + c); }
        float rs1[2][4];
#pragma unroll
        for (int ai = 0; ai < 2; ++ai)
#pragma unroll
            for (int m = 0; m < 4; ++m) rs1[ai][m] = ld_agent(SS1 + row0 + ai * 128 + m * 16);
#pragma unroll
        for (int ai = 0; ai < 2; ++ai)
#pragma unroll
            for (int m = 0; m < 4; ++m) {
                const int row = row0 + ai * 128 + m * 16;
                const float rstd = rsqrtf(rs1[ai][m] * (1.f / D) + EPS);
                const float* xrow = MODE == 6 ? (row < MCTX ? xp + (size_t)row * D : xs + (size_t)(row - MCTX) * D) : out + (size_t)row * D;
                float ss = 0.f;
#pragma unroll
                for (int bj = 0; bj < 2; ++bj)
#pragma unroll
                    for (int n = 0; n < 2; ++n) { const int c = col0 + bj * 128 + 4 * n;
                        const f32x4 v = *(const f32x4*)(xrow + c) + ga[bj][n] * (acc[ai][bj][m][n] * rstd);
                        *(f32x4*)(out + (size_t)row * D + c) = v; acc[ai][bj][m][n] = v; ss += sumsq4(v); }
                if constexpr (MODE == 6) { ss += __shfl_xor(ss, 16); ss += __shfl_xor(ss, 32); if (fq == 0) atomicAdd(SS2 + row, ss); }
            }
        if constexpr (MODE == 6) {
            panel_sync(cnt2 + 64 * u.pm);
            f32x4 cc[2][2], sh[2][2];
#pragma unroll
            for (int bj = 0; bj < 2; ++bj)
#pragma unroll
                for (int n = 0; n < 2; ++n) { const int c = col0 + bj * 128 + 4 * n; cc[bj][n] = *(const f32x4*)(gpre + c) * (modv(MOD, bada, cv, 4, c) + 1.f); sh[bj][n] = modv(MOD, bada, cv, 3, c); }
            float rs2[2][4];
#pragma unroll
            for (int ai = 0; ai < 2; ++ai)
#pragma unroll
                for (int m = 0; m < 4; ++m) rs2[ai][m] = ld_agent(SS2 + row0 + ai * 128 + m * 16);
#pragma unroll
            for (int ai = 0; ai < 2; ++ai)
#pragma unroll
                for (int m = 0; m < 4; ++m) {
                    const int row = row0 + ai * 128 + m * 16;
                    const float rstd = rsqrtf(rs2[ai][m] * (1.f / D) + EPS);
#pragma unroll
                    for (int bj = 0; bj < 2; ++bj) {
                        const f32x4 h0 = acc[ai][bj][m][0] * rstd * cc[bj][0] + sh[bj][0], h1 = acc[ai][bj][m][1] * rstd * cc[bj][1] + sh[bj][1];
                        v4u w; w.x = pg8::cvt_pk_bf16(h0[0], h0[1]); w.y = pg8::cvt_pk_bf16(h0[2], h0[3]); w.z = pg8::cvt_pk_bf16(h1[0], h1[1]); w.w = pg8::cvt_pk_bf16(h1[2], h1[3]);
                        *(v4u*)(H + (size_t)row * D + col0 + bj * 128) = w; }
                }
        }
    }
};

constexpr int YLD = 2048;
constexpr int SG_W = 0, SG_V = 34816, SG_U = 69632, SG_ST = 272;
__device__ __forceinline__ void sgu_load(const bf16* GV, const bf16* GU, const float* VSS, int item, int tid, v4u (&rv)[4], v4u (&ru)[4], float (&rss)[4]) {
    const int g = item & 7, t0 = (item >> 3) * 128;
#pragma unroll
    for (int i = 0; i < 4; ++i) { const int idx = tid + i * NTHR, p = idx >> 4, c8 = (idx & 15) * 8;
        rv[i] = *(const v4u*)(GV + (size_t)(t0 + p) * D + g * 128 + c8); ru[i] = *(const v4u*)(GU + (size_t)(t0 + p) * YLD + g * 128 + c8); rss[i] = VSS[t0 + p]; }
}
__device__ __forceinline__ void phase_sgu(const Args& a, LAS unsigned char* lds, int tid, int wave, int lane, bf16* YG) {
    const bf16* GV = (const bf16*)a.out; const bf16* GU = (const bf16*)(a.ws + WS_GU); const bf16* WSP = (const bf16*)(a.ws + WS_WSP);
    const float* VSS = (const float*)(a.ws + CTL_VSS); const float* gsgu = a.in[I_GSGU]; const float* bsp = a.in[I_BSP];
    const int fr = lane & 15, fq = lane >> 4;
    int last_g = -1;
    v4u rv[4], ru[4]; float rss[4];
    for (int item = blockIdx.x; item < 128 * 8; item += gridDim.x) {
        const int g = item & 7, n = item >> 3, t0 = n * 128;
        if (g != last_g) {
#pragma unroll
            for (int i = 0; i < 4; ++i) { const int idx = tid + i * NTHR, row = idx >> 4, c16 = idx & 15;
                *(LAS v4u*)(lds + SG_W + row * SG_ST + c16 * 16) = *(const v4u*)(WSP + (size_t)(g * 128 + row) * 128 + c16 * 8); }
            last_g = g;
        }
        if (item == (int)blockIdx.x) sgu_load(GV, GU, VSS, item, tid, rv, ru, rss);
#pragma unroll
        for (int i = 0; i < 4; ++i) {
            const int idx = tid + i * NTHR, p = idx >> 4, c8 = (idx & 15) * 8;
            const v4u r = rv[i]; const v4u uu = ru[i];
            const float rs = rsqrtf(rss[i] * (1.f / D) + EPS);
            const f32x4 g0 = *(const f32x4*)(gsgu + g * 128 + c8) * rs, g1 = *(const f32x4*)(gsgu + g * 128 + c8 + 4) * rs;
            v4u o; o.x = pk2(bflo(r.x) * g0[0], bfhi(r.x) * g0[1]); o.y = pk2(bflo(r.y) * g0[2], bfhi(r.y) * g0[3]);
            o.z = pk2(bflo(r.z) * g1[0], bfhi(r.z) * g1[1]); o.w = pk2(bflo(r.w) * g1[2], bfhi(r.w) * g1[3]);
            *(LAS v4u*)(lds + SG_V + p * SG_ST + c8 * 2) = o;
            *(LAS v4u*)(lds + SG_U + p * SG_ST + c8 * 2) = uu;
        }
        if (item + (int)gridDim.x < 128 * 8) sgu_load(GV, GU, VSS, item + gridDim.x, tid, rv, ru, rss);
        float bias8[8];
#pragma unroll
        for (int qb = 0; qb < 8; ++qb) bias8[qb] = bsp[g * 128 + qb * 16 + fr];
        __syncthreads();
        bf16x8 af[4];
#pragma unroll
        for (int ks = 0; ks < 4; ++ks) {
            unsigned short e[8];
#pragma unroll
            for (int j = 0; j < 8; ++j) e[j] = *(const LAS unsigned short*)(lds + SG_V + (ks * 32 + fq * 8 + j) * SG_ST + (wave * 16 + fr) * 2);
            v4u o; o.x = e[0] | ((unsigned)e[1] << 16); o.y = e[2] | ((unsigned)e[3] << 16); o.z = e[4] | ((unsigned)e[5] << 16); o.w = e[6] | ((unsigned)e[7] << 16);
            af[ks] = __builtin_bit_cast(bf16x8, o);
        }
#pragma unroll
        for (int qb = 0; qb < 8; ++qb) {
            const int q = qb * 16 + fr;
            f32x4 acc = {0.f, 0.f, 0.f, 0.f};
#pragma unroll
            for (int ks = 0; ks < 4; ++ks) { const bf16x8 b = *(const LAS bf16x8*)(lds + SG_W + q * SG_ST + (ks * 32 + fq * 8) * 2);
                acc = __builtin_amdgcn_mfma_f32_16x16x32_bf16(af[ks], b, acc, 0, 0, 0); }
            const float bias = bias8[qb];
            LAS v2u* up = (LAS v2u*)(lds + SG_U + q * SG_ST + (wave * 16 + fq * 4) * 2);
            const v2u gu = *up;
            v2u y; y.x = pk2(bflo(gu.x) * (acc[0] + bias), bfhi(gu.x) * (acc[1] + bias)); y.y = pk2(bflo(gu.y) * (acc[2] + bias), bfhi(gu.y) * (acc[3] + bias));
            *up = y;
        }
        __syncthreads();
#pragma unroll
        for (int i = 0; i < 4; ++i) { const int idx = tid + i * NTHR, p = idx >> 4, c8 = (idx & 15) * 8;
            *(v4u*)(YG + (size_t)(t0 + p) * YLD + g * 128 + c8) = *(const LAS v4u*)(lds + SG_U + p * SG_ST + c8 * 2); }
    }
}

constexpr int RG_WB = 0, RG_XA = 32768, RG_XF = 51200, RG_AGL = 86016, RG_GCL = 94208, RG_CWL = 96256, RG_CARL = 97536, RG_AGL2 = 102400;
#define RGIDX(i) (((tid >> 6) << 7) + (tid & 63) + 64 * (i))
__device__ __forceinline__ void rg_load_raw(const bf16* XR, int item, int tid, v4u (&xr)[2][4]) {
    const int h = item & 15, t0 = (item >> 4) * 128;
    const int seq_lo = t0 < MCTX ? (t0 & ~255) : MCTX + ((t0 - MCTX) & ~4095), seq_hi = seq_lo + (t0 < MCTX ? 256 : 4096);
#pragma unroll
    for (int i = 0; i < 2; ++i) {
        const int idx = RGIDX(i), tk = idx >> 3, chb = h * 64 + (idx & 7) * 8;
#pragma unroll
        for (int tap = 0; tap < 4; ++tap) {
            const int t = t0 + tk + tap - 2; const bool ok = (t >= seq_lo) && (t < seq_hi); const int tc = ok ? t : t0;
            xr[i][tap] = *(const v4u*)(XR + (size_t)tc * D + chb);
        }
    }
}
template <int MODE> __device__ __forceinline__ int rg_item(int k) {
    const int h = blockIdx.x & 15, q = blockIdx.x >> 4;
    int tt;
    if (MODE == 1) tt = k < 4 ? 2 * (q + 16 * (k >> 1)) + (k & 1) : 64 + q + 16 * (k - 4);
    else tt = k < 2 ? 2 * (q + 16 * k) + 1 : 64 + q + 16 * (k - 2);
    return tt * 16 + h;
}
template <int MODE>
__device__ __forceinline__ void phase_rg(const Args& a, LAS unsigned char* lds, int tid, int wave, int lane, bf16* YR) {
    const bf16* XR = (const bf16*)((const unsigned char*)a.out + 32 * MiB); const bf16* GGR = (const bf16*)(a.ws + WS_GU) + D;
    const float* GC = (const float*)(a.ws + WS_GC); const bf16* WG = (const bf16*)(a.ws + WS_WG);
    f32x2* AGG = (f32x2*)(a.ws + WS_AGG); const float* CAR = (const float*)(a.ws + WS_CAR); float* nstate = a.out + (size_t)M * D;
    const float* convw = a.in[I_CONVW]; const float* convb = a.in[I_CONVB];
    const int fr = lane & 15, fq = lane >> 4;
    int last_h = -1;
    v4u xr[2][4];
    constexpr int NK = MODE == 1 ? 8 : 6;
    rg_load_raw(XR, rg_item<MODE>(0), tid, xr);
    if constexpr (MODE == 1) {
        const float* st0 = a.in[I_STATE];
#pragma unroll 1
        for (int kk = tid >> 7; kk < 8; kk += 4) {
            const int it = rg_item<1>(kk);
            {
                const int d = (tid >> 6) & 1, cl = tid & 63, h = it & 15, tt = it >> 4;
                float hc;
                if (tt < 64) {
                    const f32x2 g = AGG[((size_t)((tt | 1) * 16 + h) * 2 + 1) * 64 + cl];
                    hc = ((tt & 1) == 0 && d == 1) ? g[1] : 0.f;
                } else {
                    const int b = (tt - 64) >> 5, j = (tt - 64) & 31, tt0 = 64 + b * 32;
                    f32x2 ag[31];
#pragma unroll
                    for (int sI = 0; sI < 31; ++sI) { const int ti = d ? 31 - sI : sI; ag[sI] = AGG[((size_t)((tt0 + ti) * 16 + h) * 2 + d) * 64 + cl]; }
                    hc = st0[(size_t)b * 2048 + d * 1024 + h * 64 + cl];
#pragma unroll
                    for (int sI = 0; sI < 31; ++sI) { const int ti = d ? 31 - sI : sI; if (d ? (ti > j) : (ti < j)) hc = ag[sI][0] * hc + ag[sI][1]; }
                }
                *(LAS float*)(lds + RG_CARL + ((kk * 2 + d) * 64 + cl) * 4) = hc;
            }
        }
        __syncthreads();
    }
    for (int kitem = 0; kitem < NK; ++kitem) {
        const int item = rg_item<MODE>(kitem);
        const int h = item & 15, tt = item >> 4, t0 = tt * 128;
        const int AGLo = (kitem & 1) ? RG_AGL2 : RG_AGL;
        if (h != last_h) {
#pragma unroll
            for (int i = 0; i < 4; ++i) { const int o = (tid + i * NTHR) * 16; *(LAS v4u*)(lds + RG_WB + o) = *(const v4u*)((const unsigned char*)WG + (size_t)h * 32768 + o); }
            if (tid < 128) *(LAS f32x4*)(lds + RG_GCL + tid * 16) = *(const f32x4*)(GC + (size_t)((tid >> 6) * D + h * 64 + (tid & 63)) * 4);
            if (tid < 80) { const int row = tid >> 4, c4 = (tid & 15) * 4;
                *(LAS f32x4*)(lds + RG_CWL + (row * 64 + c4) * 4) = *(const f32x4*)((row < 4 ? convw + row * D : convb) + h * 64 + c4); }
            last_h = h;
            __syncthreads();
        }
        const int seq_lo = t0 < MCTX ? (t0 & ~255) : MCTX + ((t0 - MCTX) & ~4095), seq_hi = seq_lo + (t0 < MCTX ? 256 : 4096);
        float car[2][4]; v4u ggr[2];
        if constexpr (MODE == 1) {
#pragma unroll
            for (int i = 0; i < 2; ++i) { const int idx = RGIDX(i); ggr[i] = *(const v4u*)(GGR + (size_t)(t0 + (idx >> 3)) * YLD + h * 64 + (idx & 7) * 8); }
        }
        {
            const int c8 = (tid & 7) * 8;
            f32x4 w0[4], w1[4];
#pragma unroll
            for (int tap = 0; tap < 4; ++tap) { w0[tap] = *(const LAS f32x4*)(lds + RG_CWL + (tap * 64 + c8) * 4); w1[tap] = *(const LAS f32x4*)(lds + RG_CWL + (tap * 64 + c8 + 4) * 4); }
            const f32x4 b0 = *(const LAS f32x4*)(lds + RG_CWL + (4 * 64 + c8) * 4), b1 = *(const LAS f32x4*)(lds + RG_CWL + (4 * 64 + c8 + 4) * 4);
#pragma unroll
            for (int i = 0; i < 2; ++i) {
                const int idx = RGIDX(i), tk = idx >> 3, cg8 = idx & 7;
                f32x4 x0 = b0, x1 = b1;
#pragma unroll
                for (int tap = 0; tap < 4; ++tap) { const int t = t0 + tk + tap - 2; const bool ok = (t >= seq_lo) && (t < seq_hi);
                    v4u r = xr[i][tap]; r.x = ok ? r.x : 0u; r.y = ok ? r.y : 0u; r.z = ok ? r.z : 0u; r.w = ok ? r.w : 0u;
                    x0[0] += w0[tap][0] * bflo(r.x); x0[1] += w0[tap][1] * bfhi(r.x); x0[2] += w0[tap][2] * bflo(r.y); x0[3] += w0[tap][3] * bfhi(r.y);
                    x1[0] += w1[tap][0] * bflo(r.z); x1[1] += w1[tap][1] * bfhi(r.z); x1[2] += w1[tap][2] * bflo(r.w); x1[3] += w1[tap][3] * bfhi(r.w); }
                v4u o; o.x = pk2(x0[0], x0[1]); o.y = pk2(x0[2], x0[3]); o.z = pk2(x1[0], x1[1]); o.w = pk2(x1[2], x1[3]);
                *(LAS v4u*)(lds + RG_XA + tk * 144 + cg8 * 16) = o;
                *(LAS f32x4*)(lds + RG_XF + (tk * 68 + cg8 * 8) * 4) = x0; *(LAS f32x4*)(lds + RG_XF + (tk * 68 + cg8 * 8 + 4) * 4) = x1;
            }
        }
        if (kitem + 1 < NK) rg_load_raw(XR, rg_item<MODE>(kitem + 1), tid, xr);
        asm volatile("" ::: "memory");
        const int tokb = wave * 16;
        bf16x8 afr[2];
#pragma unroll
        for (int ks = 0; ks < 2; ++ks) afr[ks] = *(const LAS bf16x8*)(lds + RG_XA + (tokb + fr) * 144 + (ks * 32 + fq * 8) * 2);
        f32x4 gcv[2][4];
#pragma unroll
        for (int d = 0; d < 2; ++d)
#pragma unroll
            for (int cb = 0; cb < 4; ++cb) gcv[d][cb] = *(const LAS f32x4*)(lds + RG_GCL + (d * 64 + cb * 16 + fr) * 16);
        float av[2][4][4], bv[2][4][4], Ap[2][4], Hp[2][4];
        const bool ctx = t0 < MCTX;
#pragma unroll
        for (int d = 0; d < 2; ++d) {
            if (MODE == 0 && ctx && d != (tt & 1)) continue;
#pragma unroll
            for (int cb = 0; cb < 4; ++cb) {
                const f32x4 gc = gcv[d][cb];
                f32x4 ar = {0.f, 0.f, 0.f, 0.f}, ai = {0.f, 0.f, 0.f, 0.f};
#pragma unroll
                for (int ks = 0; ks < 2; ++ks) {
                    const bf16x8 b0 = *(const LAS bf16x8*)(lds + RG_WB + (((0 * 8 + d * 4 + cb) * 2 + ks) * 64 + lane) * 16);
                    const bf16x8 b1 = *(const LAS bf16x8*)(lds + RG_WB + (((1 * 8 + d * 4 + cb) * 2 + ks) * 64 + lane) * 16);
                    ar = __builtin_amdgcn_mfma_f32_16x16x32_bf16(afr[ks], b0, ar, 0, 0, 0);
                    ai = __builtin_amdgcn_mfma_f32_16x16x32_bf16(afr[ks], b1, ai, 0, 0, 0);
                }
#pragma unroll
                for (int r = 0; r < 4; ++r) {
                    const float xcv = *(const LAS float*)(lds + RG_XF + ((tokb + fq * 4 + r) * 68 + cb * 16 + fr) * 4);
                    const float rr = __builtin_amdgcn_rcpf(__builtin_fmaf(__builtin_amdgcn_exp2f(ar[r]), gc[0], 1.f)), ii = __builtin_amdgcn_rcpf(__builtin_fmaf(__builtin_amdgcn_exp2f(ai[r]), gc[1], 1.f));
                    const float aa = __builtin_amdgcn_exp2f(rr * gc[2]);
                    const float om = fmaxf(1.f - aa * aa, 1e-12f);
                    av[d][cb][r] = aa; bv[d][cb][r] = __builtin_amdgcn_sqrtf(om) * ii * xcv;
                }
                float A = 1.f, Hh = 0.f;
#pragma unroll
                for (int rr = 0; rr < 4; ++rr) { const int r = d ? 3 - rr : rr; Hh = av[d][cb][r] * Hh + bv[d][cb][r]; A *= av[d][cb][r]; }
                float Aw = 1.f, Hw = 0.f, Apl = 1.f, Hpl = 0.f;
#pragma unroll
                for (int gg = 0; gg < 4; ++gg) { const int g = d ? 3 - gg : gg;
                    const float Ag = __shfl(A, g * 16 + fr), Hg = __shfl(Hh, g * 16 + fr);
                    if (g == fq) { Apl = Aw; Hpl = Hw; }
                    Hw = Ag * Hw + Hg; Aw *= Ag; }
                Ap[d][cb] = Apl; Hp[d][cb] = Hpl;
                if (fq == 0) *(LAS f32x2*)(lds + AGLo + ((wave * 2 + d) * 64 + cb * 16 + fr) * 8) = (f32x2){Aw, Hw};
            }
        }
        __syncthreads();
        if constexpr (MODE == 0) {
            if (tid < 128 && !(ctx && (tid >> 6) != (tt & 1))) {
                const int d = tid >> 6, cl = tid & 63; float A = 1.f, Hh = 0.f;
#pragma unroll
                for (int ww = 0; ww < 8; ++ww) { const int w2 = d ? 7 - ww : ww; const f32x2 sg = *(const LAS f32x2*)(lds + AGLo + ((w2 * 2 + d) * 64 + cl) * 8); Hh = sg[0] * Hh + sg[1]; A *= sg[0]; }
                AGG[((size_t)(tt * 16 + h) * 2 + d) * 64 + cl] = (f32x2){A, Hh};
            }
        } else {
            if (ctx && (tt & 1) == 0 && tid < 64) {
                float Hh = 0.f;
#pragma unroll
                for (int w2 = 0; w2 < 8; ++w2) { const f32x2 sg = *(const LAS f32x2*)(lds + AGLo + ((w2 * 2 + 0) * 64 + tid) * 8); Hh = sg[0] * Hh + sg[1]; }
                *(LAS float*)(lds + RG_CARL + (((kitem + 1) * 2 + 0) * 64 + tid) * 4) = Hh;
            }
#pragma unroll
            for (int d = 0; d < 2; ++d)
#pragma unroll
                for (int cb = 0; cb < 4; ++cb) car[d][cb] = *(const LAS float*)(lds + RG_CARL + ((kitem * 2 + d) * 64 + cb * 16 + fr) * 4);
            float hs[4][4];
#pragma unroll
            for (int cb = 0; cb < 4; ++cb)
#pragma unroll
                for (int r = 0; r < 4; ++r) hs[cb][r] = 0.f;
#pragma unroll
            for (int d = 0; d < 2; ++d)
#pragma unroll
                for (int cb = 0; cb < 4; ++cb) {
                    const int cl = cb * 16 + fr;
                    float hin = car[d][cb];
                    f32x2 sg[8];
#pragma unroll
                    for (int w2 = 0; w2 < 8; ++w2) sg[w2] = *(const LAS f32x2*)(lds + AGLo + ((w2 * 2 + d) * 64 + cl) * 8);
#pragma unroll
                    for (int ww = 0; ww < 8; ++ww) { const int w2 = d ? 7 - ww : ww; if (d ? (w2 > wave) : (w2 < wave)) hin = sg[w2][0] * hin + sg[w2][1]; }
                    float hh = Ap[d][cb] * hin + Hp[d][cb];
#pragma unroll
                    for (int rr = 0; rr < 4; ++rr) { const int r = d ? 3 - rr : rr; hh = av[d][cb][r] * hh + bv[d][cb][r]; hs[cb][r] += hh; }
                    if (ctx && (tt & 1) == (d ? 0 : 1) && wave == (d ? 0 : 7) && fq == (d ? 0 : 3)) nstate[(size_t)(tt >> 1) * 2048 + d * 1024 + h * 64 + cl] = hh;
                }
#pragma unroll
            for (int cb = 0; cb < 4; ++cb)
#pragma unroll
                for (int r = 0; r < 4; ++r) *(LAS float*)(lds + RG_XF + ((tokb + fq * 4 + r) * 68 + cb * 16 + fr) * 4) = hs[cb][r];
            asm volatile("" ::: "memory");
#pragma unroll
            for (int i = 0; i < 2; ++i) {
                const int idx = RGIDX(i), tk = idx >> 3, cg8 = idx & 7;
                const f32x4 y0 = *(const LAS f32x4*)(lds + RG_XF + (tk * 68 + cg8 * 8) * 4), y1 = *(const LAS f32x4*)(lds + RG_XF + (tk * 68 + cg8 * 8 + 4) * 4);
                const v4u g = ggr[i];
                v4u o; o.x = pk2(y0[0] * bflo(g.x), y0[1] * bfhi(g.x)); o.y = pk2(y0[2] * bflo(g.y), y0[3] * bfhi(g.y));
                o.z = pk2(y1[0] * bflo(g.z), y1[1] * bfhi(g.z)); o.w = pk2(y1[2] * bflo(g.w), y1[3] * bfhi(g.w));
                *(v4u*)(YR + (size_t)(t0 + tk) * YLD + h * 64 + cg8 * 8) = o;
            }
        }
    }
}

template <int NT>
__device__ __forceinline__ float carry_chain(const f32x2* AGG, float* CAR, int tt0, int h, int d, int cl, float h0) {
    f32x2 ag[NT];
#pragma unroll
    for (int i = 0; i < NT; ++i) ag[i] = AGG[((size_t)((tt0 + i) * 16 + h) * 2 + d) * 64 + cl];
    float hc = h0;
#pragma unroll
    for (int ii = 0; ii < NT; ++ii) { const int i = d ? NT - 1 - ii : ii;
        CAR[((size_t)((tt0 + i) * 16 + h) * 2 + d) * 64 + cl] = hc; hc = ag[i][0] * hc + ag[i][1]; }
    return hc;
}
__device__ __forceinline__ void phase_carry(const Args& a, int gw, int NGW, int lane) {
    const f32x2* AGG = (const f32x2*)(a.ws + WS_AGG); float* CAR = (float*)(a.ws + WS_CAR);
    for (int wi = gw; wi < 34 * 2 * 16; wi += NGW) {
        const int s = wi >> 5, d = (wi >> 4) & 1, h = wi & 15, ch = h * 64 + lane;
        if (s < 32) {
            const size_t i0 = ((size_t)((2 * s) * 16 + h) * 2 + d) * 64 + lane, i1 = ((size_t)((2 * s + 1) * 16 + h) * 2 + d) * 64 + lane;
            if (d == 0) { CAR[i0] = 0.f; CAR[i1] = AGG[i0][1]; }
            else { CAR[i1] = 0.f; CAR[i0] = AGG[i1][1]; }
        } else {
            const int b = s - 32; const float h0 = a.in[I_STATE][(size_t)b * 2048 + d * 1024 + ch];
            if (d == 0) (void)carry_chain<32>(AGG, CAR, 64 + b * 32, h, 0, lane, h0);
            else (void)carry_chain<32>(AGG, CAR, 64 + b * 32, h, 1, lane, h0);
        }
    }
}

#define RLX_AGENT __ATOMIC_RELAXED, __HIP_MEMORY_SCOPE_AGENT
#define XB_TMO      128
#define XB_XCNT(j)  (256  + 64 * (j))
#define XB_XSUB(j)  (1280 + 64 * (j))
#define XB_XGEN(j)  (2304 + 64 * (j))
#define XB_TOP      3328
#define XB_TOPGEN   3392
#define XCD_BAR_WORDS 3456
#define XB_SPIN_CAP (1u << 18)

__device__ __forceinline__ unsigned xb_ld(unsigned* p)              { return __hip_atomic_load(p, __ATOMIC_RELAXED, __HIP_MEMORY_SCOPE_AGENT); }
__device__ __forceinline__ unsigned xb_add(unsigned* p, unsigned v) { return __hip_atomic_fetch_add(p, v, __ATOMIC_RELAXED, __HIP_MEMORY_SCOPE_AGENT); }
__device__ __forceinline__ unsigned xb_xcc_id() { return (unsigned)__builtin_amdgcn_s_getreg((3 << 11) | 20) & 0xFu; }
#define XB_SPIN(cond, bar) do { unsigned _sp = 0; while (cond) { __builtin_amdgcn_s_sleep(1); \
    if ((++_sp & 255u) == 0u) { if (xb_ld(&(bar)[XB_TMO])) break; if (_sp > XB_SPIN_CAP) { atomicAdd(&(bar)[XB_TMO], 1u); break; } } } } while (0)

struct XcdBarrier {
    unsigned* bar; unsigned x;
    volatile LAS unsigned* st;
};

__device__ __forceinline__ XcdBarrier xcd_barrier_post(unsigned* bar, volatile LAS unsigned* st) {
    XcdBarrier b; b.bar = bar; b.x = xb_xcc_id(); b.st = st;
    if (threadIdx.x == 0) (void)xb_add(&bar[XB_XCNT(b.x)], 1u);
    return b;
}
__device__ __forceinline__ void xcd_barrier_complete(unsigned* bar, unsigned x, unsigned& nloc, unsigned& nx) {
    const unsigned G = gridDim.x * gridDim.y * gridDim.z;
    unsigned sum, cnt, mine, sp = 0u;
    for (;;) {
        sum = 0u; cnt = 0u; mine = 0u;
#pragma unroll
        for (unsigned j = 0; j < 16; ++j) { const unsigned c = xb_ld(&bar[XB_XCNT(j)]); sum += c; cnt += (c > 0u) ? 1u : 0u; mine = (j == x) ? c : mine; }
        if (sum == G) break;
        __builtin_amdgcn_s_sleep(1);
        if ((++sp & 255u) == 0u) { if (xb_ld(&bar[XB_TMO])) break; if (sp > XB_SPIN_CAP) { atomicAdd(&bar[XB_TMO], 1u); break; } }
    }
    nloc = mine > 0u ? mine : 1u; nx = cnt > 0u ? cnt : 1u;
}

__device__ __forceinline__ void xcd_barrier(const XcdBarrier& b) {
    asm volatile("s_waitcnt vmcnt(0)" ::: "memory");
    __syncthreads();
    if (threadIdx.x == 0) {
        unsigned* bar = b.bar;
        __builtin_amdgcn_s_waitcnt(0);
        unsigned nloc = b.st[0], nx = b.st[1];
        if (nloc == 0u) { xcd_barrier_complete(bar, b.x, nloc, nx); b.st[0] = nloc; b.st[1] = nx; }
        const unsigned old = xb_add(&bar[XB_XSUB(b.x)], 1u);
        const unsigned gen = old / nloc;
        if (old + 1u == (gen + 1u) * nloc) {
            __builtin_amdgcn_fence(__ATOMIC_RELEASE, "agent");
            asm volatile("s_waitcnt vmcnt(0)" ::: "memory");
            const unsigned og = xb_add(&bar[XB_TOP], 1u);
            const unsigned tg = og / nx;
            if (og + 1u == (tg + 1u) * nx) xb_add(&bar[XB_TOPGEN], 1u);
            else XB_SPIN(xb_ld(&bar[XB_TOPGEN]) == tg, bar);
            __builtin_amdgcn_fence(__ATOMIC_ACQUIRE, "agent");
            xb_add(&bar[XB_XGEN(b.x)], 1u);
            asm volatile("s_waitcnt vmcnt(0)" ::: "memory");
        } else {
            XB_SPIN(xb_ld(&bar[XB_XGEN(b.x)]) == gen, bar);
            __builtin_amdgcn_fence(__ATOMIC_ACQUIRE, "agent");
            asm volatile("s_waitcnt vmcnt(0)" ::: "memory");
        }
    }
    __syncthreads();
}

__global__ void __launch_bounds__(NTHR, 2) fwd_megakernel(Args a) {
    extern __shared__ __attribute__((aligned(16))) unsigned char lds_raw[];
    LAS unsigned char* lds = (LAS unsigned char*)lds_raw;
    const int tid = threadIdx.x, lane = tid & 63, wave = __builtin_amdgcn_readfirstlane(tid >> 6);
    const int G = gridDim.x, gw = blockIdx.x * NWAVES + wave, NGW = G * NWAVES;
    unsigned char* ws = a.ws;
    const int lo = a.ph_lo, hi = a.ph_hi;
    volatile LAS unsigned* bst = (volatile LAS unsigned*)(lds + LDS_BAR_OFF);
    if (tid < 2) bst[tid] = 0u;
    __syncthreads();
    XcdBarrier bar = xcd_barrier_post((unsigned*)(ws + WS_CTL), bst);
#define IN(k) (lo <= (k) && (k) < hi)
#define SEAM(k) do { if (IN(k) && IN((k) + 1)) { xcd_barrier(bar); if (DUP >> 12 & 1) xcd_barrier(bar); } } while (0)
    float* const DUMSS = (float*)(ws + 1 * MiB + 512 * 1024);
#define REP(k) for (int rep_ = ((DUP >> (k)) & 1); rep_ >= 0; --rep_)
#define ISDUP (rep_ > 0)
    if (IN(0)) REP(0) phase_prep(a, lds, gw, NGW, wave, lane, ISDUP ? (float*)(ws + 1 * MiB + 256 * 1024) : (float*)(ws + CTL_MOD));
    if (IN(1)) {
        if (tid == 0) { unsigned sp = 0; const unsigned need = G > 192 ? 192u : (unsigned)G;
            while (__hip_atomic_load((unsigned*)(ws + CTL_MODCNT), __ATOMIC_RELAXED, __HIP_MEMORY_SCOPE_AGENT) < need) { __builtin_amdgcn_s_sleep(1); if (++sp > (1u << 22)) break; }
            __builtin_amdgcn_fence(__ATOMIC_ACQUIRE, "agent"); asm volatile("s_waitcnt vmcnt(0)" ::: "memory"); }
        __syncthreads();
        REP(1) phase_norm1(a, gw, NGW, lane);
    }
    SEAM(1);
    if (IN(2)) REP(2) {
        pg8::Gemm g{(const pg8::bf16_t*)(ws + WS_H), (const pg8::bf16_t*)(ws + WS_WIN), M, INC, D}; pg8::StaticOrder S; S.init(M, INC, G, (int)blockIdx.x, WG_IN);
        pg8::Epi<1> E{nullptr, nullptr, nullptr, ISDUP ? DUMSS : (float*)(ws + CTL_VSS), D, (bf16*)(ws + WS_GU), (bf16*)a.out, (bf16*)((unsigned char*)a.out + 32 * MiB), (bf16*)(ws + WS_GU) + D, (bf16*)(ws + WS_SGA), (bf16*)(ws + WS_SGB)};
        pg8::gemm_phase<pg8::Epi<1>, pg8::StaticOrder, true, true>(lds, g, S, E);
    }
    SEAM(2);
    if (IN(3)) REP(3) { phase_rg<0>(a, lds, tid, wave, lane, nullptr); phase_sgu(a, lds, tid, wave, lane, ISDUP ? (bf16*)(ws + WS_F) : (bf16*)(ws + WS_GU)); }
    SEAM(3);
    if (IN(5)) REP(5) phase_rg<1>(a, lds, tid, wave, lane, ISDUP ? (bf16*)(ws + WS_F) + D : (bf16*)(ws + WS_GU) + D);
    SEAM(5);
    if (IN(6)) REP(6) {
        pg8::Gemm g{(const pg8::bf16_t*)(ws + WS_GU), (const pg8::bf16_t*)(ws + WS_WBG), M, D, 2 * D}; pg8::StaticOrder S; S.init(M, D, G, (int)blockIdx.x);
        pg8::EpiMerge E{(bf16*)(ws + WS_H), (const bf16*)(ws + WS_SGA), (const bf16*)(ws + WS_SGB)};
        pg8::gemm_phase<pg8::EpiMerge, pg8::StaticOrder, false, true>(lds, g, S, E);
    }
    SEAM(6);
    if (IN(7)) {
        pg8::Gemm g{(const pg8::bf16_t*)(ws + WS_H), (const pg8::bf16_t*)(ws + WS_WOUT), M, D, D}; pg8::StaticOrder S; S.init(M, D, G, (int)blockIdx.x);
        EpiFused<6> E{a.out, a.in[I_XP], a.in[I_XS], (bf16*)(ws + WS_H), (float*)(ws + CTL_OSS), (float*)(ws + CTL_XSS), (unsigned*)(ws + CTL_CNT), (unsigned*)(ws + CTL_CNT + 16384),
                      (const float*)(ws + CTL_MOD), a.in[I_BADA], a.in[I_GPOSTMIX], a.in[I_GPREMLP]};
        pg8::gemm_phase<EpiFused<6>, pg8::StaticOrder, false, true>(lds, g, S, E);
    }
    SEAM(7);
    if (IN(8)) REP(8) {
        pg8::Gemm g{(const pg8::bf16_t*)(ws + WS_H), (const pg8::bf16_t*)(ws + WS_WFF1), M, FF, D}; pg8::StaticOrder S; S.init(M, FF, G, (int)blockIdx.x, WG_FF1);
        pg8::Epi<5> E{(bf16*)(ws + WS_F1), nullptr, nullptr, nullptr, FF, nullptr, nullptr, nullptr, nullptr, nullptr, nullptr};
        pg8::gemm_phase<pg8::Epi<5>, pg8::StaticOrder, true, true>(lds, g, S, E);
    }
    SEAM(8);
    if (IN(9)) {
        pg8::Gemm g{(const pg8::bf16_t*)(ws + WS_F1), (const pg8::bf16_t*)(ws + WS_WFF2), M, D, FF}; pg8::StaticOrder S; S.init(M, D, G, (int)blockIdx.x);
        EpiFused<7> E{a.out, nullptr, nullptr, nullptr, (float*)(ws + CTL_FSS), nullptr, (unsigned*)(ws + CTL_CNT + 32768), nullptr,
                      (const float*)(ws + CTL_MOD), a.in[I_BADA], a.in[I_GPOSTMLP], nullptr};
        pg8::gemm_phase<EpiFused<7>, pg8::StaticOrder, false, true>(lds, g, S, E);
    }
#undef IN
#undef SEAM
}

constexpr int N_PHASES = 10;
extern "C" void kernel_launch(void* const* d_in, const int* in_sizes, int n_in, void* d_out, int out_size, void* d_ws, size_t ws_size, hipStream_t stream) {
    static int grid = 0;
    if (grid == 0) {
        if (n_in != 27 || ws_size < WS_END) { fprintf(stderr, "kernel_launch: need 27 inputs and >= %zu B of workspace; got %d, %zu\n", (size_t)WS_END, n_in, ws_size); grid = -1; return; }
        int dev = 0, cus = 0, per_cu = 0;
        if (hipGetDevice(&dev) != hipSuccess || hipDeviceGetAttribute(&cus, hipDeviceAttributeMultiprocessorCount, dev) != hipSuccess) { grid = -1; return; }
        if (hipFuncSetAttribute((const void*)fwd_megakernel, hipFuncAttributeMaxDynamicSharedMemorySize, LDS_BYTES) != hipSuccess) { fprintf(stderr, "kernel_launch: hipFuncSetAttribute failed\n"); grid = -1; return; }
        if (hipOccupancyMaxActiveBlocksPerMultiprocessor(&per_cu, (const void*)fwd_megakernel, NTHR, LDS_BYTES) != hipSuccess || per_cu < 1) { fprintf(stderr, "kernel_launch: occupancy query says %d\n", per_cu); per_cu = 1; }
        (void)hipGetLastError();
        grid = cus * per_cu;
        if (grid < 256) { fprintf(stderr, "kernel_launch: this kernel's work split needs 256 co-resident workgroups; the device offers %d\n", grid); grid = -1; return; }
        grid = 256;
    }
    if (grid < 0) return;
    (void)hipMemsetAsync((char*)d_ws + WS_CTL, 0, CTL_ZERO_BYTES, stream);
    Args a{};
    for (int i = 0; i < 27; ++i) a.in[i] = (const float*)d_in[i];
    a.out = (float*)d_out; a.ws = (unsigned char*)d_ws; a.ph_lo = 0; a.ph_hi = N_PHASES;
    void* args[] = {&a};
    hipError_t e = hipLaunchCooperativeKernel((const void*)fwd_megakernel, dim3(grid), dim3(NTHR), args, LDS_BYTES, stream);
    if (e != hipSuccess) fprintf(stderr, "kernel_launch: cooperative launch failed: %s (grid %d)\n", hipGetErrorString(e), grid);
}
```

```cpp
#include <hip/hip_runtime.h>
#include <hip/hip_cooperative_groups.h>
#include <cstdio>
#include <cstdint>
namespace cg = cooperative_groups;
namespace pg8 {
#define PG8_LAS __attribute__((address_space(3)))
typedef unsigned short bf16_t;
typedef short bf16x8 __attribute__((ext_vector_type(8)));
typedef float f32x4 __attribute__((ext_vector_type(4)));
typedef unsigned u32x4 __attribute__((ext_vector_type(4)));
constexpr int BM = 256, BK = 64, HALF = 128, HTB = HALF * BK * 2  , STAGE_BYTES = 8 * HTB, NXCD = 8, WGM = 8;

__host__ __device__ __forceinline__ int lds_byte(int r, int c) { const int st = (r >> 4) * 2 + (c >> 5), rr = r & 15, cc = c & 31, ob = rr * 64 + cc * 2; return st * 1024 + (ob ^ (((ob >> 9) & 1) << 5)); }
__host__ __device__ __forceinline__ void stage_rc(int b, int& R, int& C) { const int st = b / 1024, sb = b % 1024, swz = sb ^ (((sb >> 9) & 1) << 5); R = (st >> 1) * 16 + swz / 64; C = (st & 1) * 32 + (swz % 64) / 2; }
__host__ __device__ __forceinline__ int perm32(int rho) { const int n = rho >> 4, i = rho & 15; return 8 * (i >> 2) + 4 * n + (i & 3); }

struct Unit { int pm, pn; };
struct Gemm { const bf16_t* A; const bf16_t* Bt; int M, N, K; };

struct StaticOrder {
    int nM, nN, nwg, G, c, wgm;
    __host__ __device__ void init(int M, int N, int G_, int c_, int wgm_ = 8) { nM = M / BM; nN = N / BM; nwg = nM * nN; G = G_; c = c_; wgm = wgm_; }
    __host__ __device__ bool next(int i, Unit& u) const {
        const long L = (long)i * G + c; if (L >= nwg) return false;
        int wgid = (int)L; { const int q = nwg / NXCD, r = nwg % NXCD, xcd = wgid % NXCD, off = wgid / NXCD; wgid = (xcd < r ? xcd * (q + 1) : r * (q + 1) + (xcd - r) * q) + off; }
        const int nig = wgm * nN, gid = wgid / nig, fm = gid * wgm, gsz = (nM - fm) < wgm ? (nM - fm) : wgm;
        u.pm = fm + ((wgid % nig) % gsz); u.pn = (wgid % nig) / gsz; return true;
    }
    __device__ __forceinline__ void a_ready(const Unit&) const {}
    __device__ __forceinline__ void done(const Unit&) const {}
};

typedef __bf16 bf16x2_cvt __attribute__((ext_vector_type(2)));
typedef float f32x2_cvt __attribute__((ext_vector_type(2)));
__device__ __forceinline__ unsigned cvt_pk_bf16(float lo, float hi) { const f32x2_cvt v = {lo, hi}; const bf16x2_cvt b = __builtin_convertvector(v, bf16x2_cvt); return __builtin_bit_cast(unsigned, b); }
__device__ __forceinline__ float sigmoid_f(float x) { return __builtin_amdgcn_rcpf(1.f + __builtin_amdgcn_exp2f(-1.4426950409f * x)); }
__device__ __forceinline__ float gelu_tanh_f(float x) { const float u = x * (-2.3022081985f - 0.10294324f * (x * x)); return x * __builtin_amdgcn_rcpf(1.f + __builtin_amdgcn_exp2f(u)); }
__device__ __forceinline__ float bflo(unsigned w) { return __builtin_bit_cast(float, w << 16); }
__device__ __forceinline__ float bfhi(unsigned w) { return __builtin_bit_cast(float, w & 0xffff0000u); }
template <int MODE> struct Epi {
    static constexpr bool PERM = true, AFTER_DRAIN = false, HOOK = false;
    bf16_t* Ob; float* Of; const bf16_t* G; float* SS; int ldc;
    bf16_t *s0, *s1, *s2, *s3, *s4, *s5;
    template <int ACT> __device__ __forceinline__ void act_store(const f32x4 (&acc)[2][2][4][2], bf16_t* base, int ld, int row0, int col0, int fq) const {
#pragma unroll
        for (int ai = 0; ai < 2; ++ai)
#pragma unroll
            for (int m = 0; m < 4; ++m) {
                const int row = row0 + ai * HALF + m * 16; bf16_t* rowp = base + (size_t)row * ld + col0; float ss = 0.f;
#pragma unroll
                for (int bj = 0; bj < 2; ++bj) {
                    f32x4 v0 = acc[ai][bj][m][0], v1 = acc[ai][bj][m][1];
                    if constexpr (ACT == 2) {
#pragma unroll
                        for (int j = 0; j < 4; ++j) { v0[j] = sigmoid_f(v0[j]); v1[j] = sigmoid_f(v1[j]); }
                    } else if constexpr (ACT == 1 || ACT == 3) {
#pragma unroll
                        for (int j = 0; j < 4; ++j) { v0[j] = gelu_tanh_f(v0[j]); v1[j] = gelu_tanh_f(v1[j]); }
                    }
                    if constexpr (ACT == 3) {
#pragma unroll
                        for (int j = 0; j < 4; ++j) ss += v0[j] * v0[j] + v1[j] * v1[j];
                    }
                    u32x4 w; w.x = cvt_pk_bf16(v0[0], v0[1]); w.y = cvt_pk_bf16(v0[2], v0[3]); w.z = cvt_pk_bf16(v1[0], v1[1]); w.w = cvt_pk_bf16(v1[2], v1[3]);
                    *(u32x4*)(rowp + bj * HALF) = w;
                }
                if constexpr (ACT == 3) { ss += __shfl_xor(ss, 16); ss += __shfl_xor(ss, 32); if (fq == 0) atomicAdd(SS + row, ss); }
            }
    }
    __device__ __forceinline__ void operator()(const f32x4 (&acc)[2][2][4][2], const Unit& u, int wr, int wc, int fr, int fq) const {
        const int row0 = u.pm * BM + wr * 64 + fr;
        if constexpr (MODE == 1) {
            const int t = u.pn >> 2;
            bf16_t* base = t == 0 ? s0 : t == 1 ? s1 : t == 2 ? s2 : t == 3 ? s3 : t == 4 ? s4 : s5;
            const int ld = (t == 0 || t == 3) ? 2048 : 1024;
            const int col0 = (u.pn & 3) * BM + wc * 32 + 8 * fq;
            if (t >= 4) act_store<2>(acc, base, ld, row0, col0, fq);
            else if (t == 2) act_store<0>(acc, base, ld, row0, col0, fq);
            else if (t == 1) act_store<3>(acc, base, ld, row0, col0, fq);
            else act_store<1>(acc, base, ld, row0, col0, fq);
        } else {
            const int col0 = u.pn * BM + wc * 32 + 8 * fq;
#pragma unroll
            for (int ai = 0; ai < 2; ++ai)
#pragma unroll
                for (int m = 0; m < 4; ++m) {
                    const int row = row0 + ai * HALF + m * 16; float ss = 0.f;
#pragma unroll
                    for (int bj = 0; bj < 2; ++bj) {
                        f32x4 v0 = acc[ai][bj][m][0], v1 = acc[ai][bj][m][1];
                        const size_t off = (size_t)row * ldc + col0 + bj * HALF;
                        if constexpr (MODE == 2 || MODE == 3) {
                            const u32x4 g = *(const u32x4*)(G + off);
                            v0[0] *= bflo(g.x); v0[1] *= bfhi(g.x); v0[2] *= bflo(g.y); v0[3] *= bfhi(g.y);
                            v1[0] *= bflo(g.z); v1[1] *= bfhi(g.z); v1[2] *= bflo(g.w); v1[3] *= bfhi(g.w);
                        }
                        if constexpr (MODE == 3) { v0 = v0 + *(const f32x4*)(Of + off); v1 = v1 + *(const f32x4*)(Of + off + 4); }
                        if constexpr (MODE == 5) {
#pragma unroll
                            for (int j = 0; j < 4; ++j) { const float a = fmaxf(v0[j], 0.f), b = fmaxf(v1[j], 0.f); v0[j] = a * a; v1[j] = b * b; }
                        }
                        if constexpr (MODE == 4) {
#pragma unroll
                            for (int j = 0; j < 4; ++j) ss += v0[j] * v0[j] + v1[j] * v1[j];
                        }
                        if constexpr (MODE == 2 || MODE == 4) { *(f32x4*)(Of + off) = v0; *(f32x4*)(Of + off + 4) = v1; }
                        else { u32x4 w; w.x = cvt_pk_bf16(v0[0], v0[1]); w.y = cvt_pk_bf16(v0[2], v0[3]); w.z = cvt_pk_bf16(v1[0], v1[1]); w.w = cvt_pk_bf16(v1[2], v1[3]);
                            *(u32x4*)(Ob + off) = w; }
                    }
                    if constexpr (MODE == 4) { ss += __shfl_xor(ss, 16); ss += __shfl_xor(ss, 32); if (fq == 0) atomicAdd(SS + row, ss); }
                }
        }
    }
};

struct EpiMerge {
    static constexpr bool PERM = true, AFTER_DRAIN = false, HOOK = true;
    bf16_t* Ob; const bf16_t* GA; const bf16_t* GB;
    __device__ __forceinline__ void mid(f32x4 (&acc)[2][2][4][2], const Unit& u, int wr, int wc, int fr, int fq) const {
        int row0 = u.pm * BM + wr * 64 + fr, col0 = u.pn * BM + wc * 32 + 8 * fq;
        asm volatile("" : "+v"(row0), "+v"(col0));
#pragma unroll
        for (int ai = 0; ai < 2; ++ai)
#pragma unroll
            for (int m = 0; m < 4; ++m) {
                if ((m & 1) == 0) asm volatile("" ::: "memory");
#pragma unroll
                for (int bj = 0; bj < 2; ++bj) {
                    const size_t off = (size_t)(row0 + ai * HALF + m * 16) * 1024 + col0 + bj * HALF;
                    const u32x4 a = *(const u32x4*)(GA + off), b = *(const u32x4*)(GB + off);
                    f32x4 r0, r1;
                    r0[0] = bflo(a.x) * __builtin_amdgcn_rcpf(fmaxf(bflo(b.x), 1e-30f)); r0[1] = bfhi(a.x) * __builtin_amdgcn_rcpf(fmaxf(bfhi(b.x), 1e-30f));
                    r0[2] = bflo(a.y) * __builtin_amdgcn_rcpf(fmaxf(bflo(b.y), 1e-30f)); r0[3] = bfhi(a.y) * __builtin_amdgcn_rcpf(fmaxf(bfhi(b.y), 1e-30f));
                    r1[0] = bflo(a.z) * __builtin_amdgcn_rcpf(fmaxf(bflo(b.z), 1e-30f)); r1[1] = bfhi(a.z) * __builtin_amdgcn_rcpf(fmaxf(bfhi(b.z), 1e-30f));
                    r1[2] = bflo(a.w) * __builtin_amdgcn_rcpf(fmaxf(bflo(b.w), 1e-30f)); r1[3] = bfhi(a.w) * __builtin_amdgcn_rcpf(fmaxf(bfhi(b.w), 1e-30f));
                    acc[ai][bj][m][0] = acc[ai][bj][m][0] * r0; acc[ai][bj][m][1] = acc[ai][bj][m][1] * r1;
                }
            }
    }
    __device__ __forceinline__ void operator()(const f32x4 (&acc)[2][2][4][2], const Unit& u, int wr, int wc, int fr, int fq) const {
        const int row0 = u.pm * BM + wr * 64 + fr, col0 = u.pn * BM + wc * 32 + 8 * fq;
#pragma unroll
        for (int ai = 0; ai < 2; ++ai)
#pragma unroll
            for (int m = 0; m < 4; ++m)
#pragma unroll
                for (int bj = 0; bj < 2; ++bj) {
                    const size_t off = (size_t)(row0 + ai * HALF + m * 16) * 1024 + col0 + bj * HALF;
                    const u32x4 b = *(const u32x4*)(GB + off);
                    const f32x4 v0 = acc[ai][bj][m][0], v1 = acc[ai][bj][m][1];
                    u32x4 w; w.x = cvt_pk_bf16(v0[0] * bflo(b.x), v0[1] * bfhi(b.x)); w.y = cvt_pk_bf16(v0[2] * bflo(b.y), v0[3] * bfhi(b.y));
                    w.z = cvt_pk_bf16(v1[0] * bflo(b.z), v1[1] * bfhi(b.z)); w.w = cvt_pk_bf16(v1[2] * bflo(b.w), v1[3] * bfhi(b.w));
                    *(u32x4*)(Ob + off) = w;
                }
    }
};

template <class Epi, class Sched, bool ALIGN_EPI = false, bool SP2 = false>
__device__ __forceinline__ void gemm_phase(PG8_LAS unsigned char* lds, const Gemm g, const Sched& S, const Epi& E) {
    const int tid = threadIdx.x, wid = __builtin_amdgcn_readfirstlane(tid >> 6), lane = tid & 63, wr = wid >> 2, wc = wid & 3, fr = lane & 15, fq = lane >> 4;
    const int K = g.K, nt = K / BK;
    unsigned voffA[2], voffB[2];
#pragma unroll
    for (int i = 0; i < 2; ++i) { int R, C; stage_rc(tid * 16 + i * 8192, R, C); const int Rb = Epi::PERM ? ((R & ~31) + perm32(R & 31)) : R;
        voffA[i] = (unsigned)(R * K + C) * 2u; voffB[i] = (unsigned)(Rb * K + C) * 2u; }
    const size_t kstep = (size_t)(BK * 2);
    const size_t hstep = (size_t)HALF * K * 2;
    const size_t tstep = 2 * hstep;
    const unsigned ldsw = (unsigned)wid * 1024u;
    const int aoff = lds_byte(wr * 64 + fr, fq * 8), boff = lds_byte(wc * 32 + fr, fq * 8);
#define PG8_SA(b, h) (((b) * 2 + (h)) * HTB)
#define PG8_SB(b, h) ((4 + (b) * 2 + (h)) * HTB)
#define PG8_STAGE(bufoff, gbase, voff) do { _Pragma("unroll") for (int _i = 0; _i < 2; ++_i) \
        __builtin_amdgcn_global_load_lds((const unsigned*)((const char*)(gbase) + (voff)[_i]), (PG8_LAS unsigned*)(lds + (bufoff) + ldsw + _i * 8192), 16, 0, 0); } while (0)
#define PG8_LDA(dst, b, h) do { _Pragma("unroll") for (int m = 0; m < 4; ++m) _Pragma("unroll") for (int k = 0; k < 2; ++k) dst[m][k] = *(const PG8_LAS bf16x8*)(lds + PG8_SA(b, h) + aoff + m * 2048 + k * 1024); } while (0)
#define PG8_LDB(dst, b, h) do { _Pragma("unroll") for (int n = 0; n < 2; ++n) _Pragma("unroll") for (int k = 0; k < 2; ++k) dst[n][k] = *(const PG8_LAS bf16x8*)(lds + PG8_SB(b, h) + boff + n * 2048 + k * 1024); } while (0)
#define PG8_MMA(ai, bj, At, Bt) do { __builtin_amdgcn_s_setprio(1); _Pragma("unroll") for (int m = 0; m < 4; ++m) _Pragma("unroll") for (int n = 0; n < 2; ++n) _Pragma("unroll") for (int k = 0; k < 2; ++k) \
        acc[ai][bj][m][n] = __builtin_amdgcn_mfma_f32_16x16x32_bf16(Bt[n][k], At[m][k], acc[ai][bj][m][n], 0, 0, 0); __builtin_amdgcn_s_setprio(0); } while (0)
#define PG8_WAIT_V(n) asm volatile("s_waitcnt vmcnt(" #n ")" ::: "memory")
#define PG8_WAIT_L(n) asm volatile("s_waitcnt lgkmcnt(" #n ")" ::: "memory")
#define PG8_BAR __builtin_amdgcn_s_barrier()
#define PG8_SCHED __builtin_amdgcn_sched_barrier(0)
    Unit cur, nxt; int ui = 0;
    if (!S.next(0, cur)) return;
    f32x4 acc[2][2][4][2];
#pragma unroll
    for (int a = 0; a < 2; ++a)
#pragma unroll
        for (int b = 0; b < 2; ++b)
#pragma unroll
            for (int m = 0; m < 4; ++m)
#pragma unroll
                for (int n = 0; n < 2; ++n) acc[a][b][m][n] = (f32x4){0.f, 0.f, 0.f, 0.f};
    bf16x8 At[4][2], B0[2][2], B1[2][2];
    const char* cA = (const char*)g.A + (size_t)cur.pm * tstep; const char* cB = (const char*)g.Bt + (size_t)cur.pn * tstep;
    S.a_ready(cur);
    if constexpr (SP2) {
        PG8_STAGE(PG8_SB(0, 0), cB, voffB); PG8_STAGE(PG8_SB(0, 1), cB + hstep, voffB); PG8_STAGE(PG8_SA(0, 0), cA, voffA); PG8_STAGE(PG8_SA(0, 1), cA + hstep, voffA);
        if (wr == 1) PG8_BAR;
        PG8_WAIT_V(2); PG8_BAR;
        PG8_STAGE(PG8_SB(1, 0), cB + kstep, voffB); PG8_STAGE(PG8_SA(1, 0), cA + kstep, voffA); PG8_STAGE(PG8_SB(1, 1), cB + hstep + kstep, voffB);
        PG8_WAIT_V(6); PG8_BAR;
    } else {
        PG8_STAGE(PG8_SB(0, 0), cB, voffB); PG8_STAGE(PG8_SA(0, 0), cA, voffA); PG8_STAGE(PG8_SB(0, 1), cB + hstep, voffB); PG8_STAGE(PG8_SA(0, 1), cA + hstep, voffA);
        if (wr == 1) PG8_BAR;
        PG8_WAIT_V(4); PG8_BAR;
        PG8_STAGE(PG8_SB(1, 0), cB + kstep, voffB); PG8_STAGE(PG8_SA(1, 0), cA + kstep, voffA); PG8_STAGE(PG8_SB(1, 1), cB + hstep + kstep, voffB);
        PG8_WAIT_V(6); PG8_BAR;
    }
    for (;;) {
        const bool has_next = S.next(ui + 1, nxt);
        const char* nA = has_next ? (const char*)g.A + (size_t)nxt.pm * tstep : cA; const char* nB = has_next ? (const char*)g.Bt + (size_t)nxt.pn * tstep : cB;
        for (int t = 0; t < nt; t += 2) {
            if constexpr (Epi::HOOK) { if (t == (nt >> 1)) E.mid(acc, cur, wr, wc, fr, fq); }
            const bool last = (t == nt - 2);
            const char* a1 = cA + (size_t)(t + 1) * kstep;
            const char* a2 = last ? nA : cA + (size_t)(t + 2) * kstep; const char* b2 = last ? nB : cB + (size_t)(t + 2) * kstep;
            const char* a3 = a2 + kstep; const char* b3 = b2 + kstep;
            if (last && has_next) S.a_ready(nxt);
            if constexpr (SP2) {
            PG8_LDB(B0, 0, 0); PG8_LDB(B1, 0, 1); PG8_SCHED; PG8_LDA(At, 0, 0); PG8_STAGE(PG8_SA(1, 1), a1 + hstep, voffA);
            PG8_WAIT_V(8); PG8_WAIT_L(0); PG8_BAR; PG8_MMA(0, 0, At, B0); PG8_MMA(0, 1, At, B1); PG8_BAR; PG8_SCHED;
            PG8_LDA(At, 0, 1); PG8_STAGE(PG8_SB(0, 0), b2, voffB); PG8_STAGE(PG8_SB(0, 1), b2 + hstep, voffB); PG8_STAGE(PG8_SA(0, 0), a2, voffA);
            PG8_WAIT_V(8); PG8_WAIT_L(0); PG8_BAR; PG8_MMA(1, 0, At, B0); PG8_MMA(1, 1, At, B1); PG8_BAR; PG8_SCHED;
            PG8_LDB(B0, 1, 0); PG8_LDB(B1, 1, 1); PG8_SCHED; PG8_LDA(At, 1, 0); PG8_STAGE(PG8_SA(0, 1), a2 + hstep, voffA);
            PG8_WAIT_V(8); PG8_WAIT_L(0); PG8_BAR; PG8_MMA(0, 0, At, B0); PG8_MMA(0, 1, At, B1); PG8_BAR; PG8_SCHED;
            PG8_LDA(At, 1, 1); PG8_STAGE(PG8_SB(1, 0), b3, voffB); PG8_STAGE(PG8_SB(1, 1), b3 + hstep, voffB); PG8_STAGE(PG8_SA(1, 0), a3, voffA);
            PG8_WAIT_V(8); PG8_WAIT_L(0); PG8_BAR; PG8_MMA(1, 0, At, B0); PG8_MMA(1, 1, At, B1); PG8_BAR; PG8_SCHED;
            } else {
            PG8_LDB(B0, 0, 0); PG8_SCHED; PG8_LDA(At, 0, 0); PG8_STAGE(PG8_SA(1, 1), a1 + hstep, voffA);
            PG8_WAIT_L(8); PG8_BAR; PG8_WAIT_L(0); PG8_MMA(0, 0, At, B0); PG8_BAR; PG8_SCHED;
            PG8_LDB(B1, 0, 1); PG8_STAGE(PG8_SB(0, 0), b2, voffB);
            PG8_BAR; PG8_WAIT_L(0); PG8_MMA(0, 1, At, B1); PG8_BAR;
            PG8_LDA(At, 0, 1); PG8_STAGE(PG8_SA(0, 0), a2, voffA);
            PG8_BAR; PG8_WAIT_L(0); PG8_MMA(1, 0, At, B0); PG8_BAR; PG8_SCHED;
            PG8_STAGE(PG8_SB(0, 1), b2 + hstep, voffB);
            PG8_WAIT_V(6); PG8_BAR; PG8_MMA(1, 1, At, B1); PG8_BAR;
            PG8_LDB(B0, 1, 0); PG8_SCHED; PG8_LDA(At, 1, 0); PG8_STAGE(PG8_SA(0, 1), a2 + hstep, voffA);
            PG8_WAIT_L(8); PG8_BAR; PG8_WAIT_L(0); PG8_MMA(0, 0, At, B0); PG8_BAR; PG8_SCHED;
            PG8_LDB(B1, 1, 1); PG8_STAGE(PG8_SB(1, 0), b3, voffB);
            PG8_BAR; PG8_WAIT_L(0); PG8_MMA(0, 1, At, B1); PG8_BAR;
            PG8_LDA(At, 1, 1); PG8_STAGE(PG8_SA(1, 0), a3, voffA);
            PG8_BAR; PG8_WAIT_L(0); PG8_MMA(1, 0, At, B0); PG8_BAR; PG8_SCHED;
            PG8_STAGE(PG8_SB(1, 1), b3 + hstep, voffB);
            PG8_WAIT_V(6); PG8_BAR; PG8_MMA(1, 1, At, B1); PG8_BAR;
            }
        }
        if constexpr (ALIGN_EPI) { if (wr == 0) PG8_BAR; }
        if constexpr (!Epi::AFTER_DRAIN) { E(acc, cur, wr, wc, fr, fq); S.done(cur); }
        if (!has_next) break;
#pragma unroll
        for (int a = 0; a < 2; ++a)
#pragma unroll
            for (int b = 0; b < 2; ++b)
#pragma unroll
                for (int m = 0; m < 4; ++m)
#pragma unroll
                    for (int n = 0; n < 2; ++n) acc[a][b][m][n] = (f32x4){0.f, 0.f, 0.f, 0.f};
        cur = nxt; cA = nA; cB = nB; ++ui;
        if constexpr (ALIGN_EPI) { if (wr == 1) PG8_BAR; }
    }
    PG8_WAIT_V(0);
    if constexpr (!ALIGN_EPI) { if (wr == 0) PG8_BAR; }
    PG8_BAR;
    if constexpr (Epi::AFTER_DRAIN) { E.fused(acc, cur, wr, wc, fr, fq, lds, wid, lane); S.done(cur); }
#undef PG8_SA
#undef PG8_SB
#undef PG8_STAGE
#undef PG8_LDA
#undef PG8_LDB
#undef PG8_MMA
#undef PG8_WAIT_V
#undef PG8_WAIT_L
#undef PG8_BAR
#undef PG8_SCHED
}
}

constexpr int NWAVES = 8, NTHR = NWAVES * 64;
constexpr int D = 1024, M = 16384, MCTX = 8192, INC = 6144, FF = 4096;
constexpr float EPS = 1e-6f, LOG2E = 1.4426950408889634f;
constexpr size_t MiB = 1u << 20;
constexpr size_t WS_CTL = 0, CTL_ZERO_BYTES = 1 * MiB;
constexpr size_t CTL_VSS = 64 * 1024, CTL_OSS = 128 * 1024, CTL_FSS = 192 * 1024, CTL_MOD = 256 * 1024, CTL_XSS = 384 * 1024;
constexpr size_t CTL_MODCNT = 14 * 1024;
constexpr size_t CTL_AGGCNT = 14 * 1024 + 256;
constexpr size_t CTL_CNT = 16 * 1024;
constexpr size_t WS_GC = 1 * MiB;
constexpr size_t WS_AGG = 2 * MiB;
constexpr size_t WS_CAR = 4 * MiB;
constexpr size_t WS_WG = 5 * MiB;
constexpr size_t WS_WSP = 5 * MiB + 512 * 1024;
constexpr size_t WS_WFF2 = 6 * MiB, WS_WFF1 = 14 * MiB, WS_WIN = 22 * MiB, WS_WBG = 34 * MiB, WS_WBR = 36 * MiB, WS_WOUT = 38 * MiB;
constexpr size_t WS_H = 40 * MiB;
constexpr size_t WS_F = 64 * MiB;
constexpr size_t WS_GU = 128 * MiB, WS_GGR = 160 * MiB, WS_SGA = 192 * MiB, WS_SGB = 224 * MiB;
constexpr size_t WS_F1 = 128 * MiB;
constexpr size_t WS_END = 256 * MiB;
constexpr int LDS_BYTES = 147456, LDS_BAR_OFF = 139264;
#ifndef WG_IN
#define WG_IN 4
#endif
#ifndef WG_FF1
#define WG_FF1 2
#endif
#ifndef DUP
#define DUP 0
#endif

#define GAS __attribute__((address_space(1)))
#define LAS __attribute__((address_space(3)))
typedef unsigned short bf16;
typedef unsigned v4u __attribute__((ext_vector_type(4)));
typedef unsigned v2u __attribute__((ext_vector_type(2)));
typedef float f32x4 __attribute__((ext_vector_type(4)));
typedef float f32x2 __attribute__((ext_vector_type(2)));
typedef short bf16x8 __attribute__((ext_vector_type(8)));
#define LDS_WAIT() asm volatile("s_waitcnt lgkmcnt(0)" ::: "memory")
__device__ __forceinline__ unsigned f2bf(float f) { unsigned u = __builtin_bit_cast(unsigned, f); return (u + 0x7fffu + ((u >> 16) & 1u)) >> 16; }
__device__ __forceinline__ unsigned pk2(float lo, float hi) { return pg8::cvt_pk_bf16(lo, hi); }
__device__ __forceinline__ float bf2f(bf16 b) { return __builtin_bit_cast(float, (unsigned)b << 16); }
using pg8::bflo; using pg8::bfhi;

struct Args { const float* in[27]; float* out; unsigned char* ws; int ph_lo, ph_hi; };
enum { I_XP = 0, I_XS, I_STATE, I_C, I_CCTX, I_WADA, I_BADA, I_GPREMIX, I_GPOSTMIX, I_GPREMLP, I_GPOSTMLP, I_WIN, I_GSGU, I_WSP, I_BSP, I_CONVW, I_CONVB,
       I_WRA, I_BRA, I_WRI, I_BRI, I_LAM, I_WBRG, I_WBRR, I_WOUT, I_WFF1, I_WFF2 };

__device__ __forceinline__ float wave_sum(float v) {
#pragma unroll
    for (int o = 1; o < 64; o <<= 1) v += __shfl_xor(v, o);
    return v;
}
__device__ __forceinline__ void p0_transpose_item(const float* W, int K, int N, bf16* WT, LAS float* scr, int item, int lane, int ldk = 0, int koff = 0) {
    if (ldk == 0) ldk = K;
    const int nblk = N / 32, kb = item / nblk, nb = item % nblk, k0 = 64 * kb, n0 = 32 * nb;
#pragma unroll
    for (int i = 0; i < 8; ++i) { const int kk = 8 * i + (lane >> 3);
        const f32x4 v = *(const f32x4*)(W + (size_t)(k0 + kk) * N + n0 + (lane & 7) * 4);
        LAS float* dd = scr + kk * 33 + (lane & 7) * 4; dd[0] = v[0]; dd[1] = v[1]; dd[2] = v[2]; dd[3] = v[3]; }
    LDS_WAIT(); asm volatile("" ::: "memory");
    const int c = lane & 7;
#pragma unroll
    for (int j = 0; j < 4; ++j) { const int n = (lane >> 3) + 8 * j; const LAS float* s = scr + (8 * c) * 33 + n;
        v4u o; o.x = pk2(s[0 * 33], s[1 * 33]); o.y = pk2(s[2 * 33], s[3 * 33]); o.z = pk2(s[4 * 33], s[5 * 33]); o.w = pk2(s[6 * 33], s[7 * 33]);
        *(v4u*)(WT + (size_t)(n0 + n) * ldk + koff + k0 + 8 * c) = o; }
    LDS_WAIT(); asm volatile("" ::: "memory");
}

__device__ __forceinline__ void phase_prep(const Args& a, LAS unsigned char* lds, int gw, int NGW, int wave, int lane, float* MOD) {
    unsigned char* ws = a.ws;
    LAS float* scr = (LAS float*)(lds + wave * 16384);
    if ((int)blockIdx.x < 192) {
        const float* wada = a.in[I_WADA]; const float* cctx = a.in[I_CCTX]; const float* cc = a.in[I_C];
        const int nb = blockIdx.x % 24, ksl = blockIdx.x / 24, n = nb * 256 + lane * 4, kbase = ksl * 128 + wave * 16;
        f32x4 a0 = {0.f, 0.f, 0.f, 0.f}, a1 = a0, a2 = a0;
#pragma unroll
        for (int kk = 0; kk < 16; ++kk) {
            const int k = kbase + kk;
            const f32x4 w = *(const f32x4*)(wada + (size_t)k * INC + n);
            const float c0 = cctx[k], c1 = cc[k], c2 = cc[D + k];
            const float s0 = c0 * pg8::sigmoid_f(c0), s1 = c1 * pg8::sigmoid_f(c1), s2 = c2 * pg8::sigmoid_f(c2);
            a0 += w * s0; a1 += w * s1; a2 += w * s2;
        }
        LAS float* red = (LAS float*)lds;
        *(LAS f32x4*)(red + (wave * 3 + 0) * 256 + lane * 4) = a0; *(LAS f32x4*)(red + (wave * 3 + 1) * 256 + lane * 4) = a1; *(LAS f32x4*)(red + (wave * 3 + 2) * 256 + lane * 4) = a2;
        __syncthreads();
        const int tid = wave * 64 + lane;
        if (tid < 192) {
            const int v = tid >> 6, c4 = (tid & 63) * 4;
            f32x4 sum = {0.f, 0.f, 0.f, 0.f};
#pragma unroll
            for (int w2 = 0; w2 < 8; ++w2) sum += *(const LAS f32x4*)(red + (w2 * 3 + v) * 256 + c4);
#pragma unroll
            for (int j = 0; j < 4; ++j) atomicAdd(MOD + v * INC + nb * 256 + c4 + j, sum[j]);
        }
        asm volatile("s_waitcnt vmcnt(0)" ::: "memory");
        __syncthreads();
        if (threadIdx.x == 0) __hip_atomic_fetch_add((unsigned*)(ws + CTL_MODCNT), 1u, __ATOMIC_RELAXED, __HIP_MEMORY_SCOPE_AGENT);
    }
    constexpr int I_IN = 16 * (INC / 32), I_SQ = 16 * (D / 32), I_F1 = 16 * (FF / 32), I_F2 = (FF / 64) * (D / 32);
    constexpr int NT = I_IN + 3 * I_SQ + I_F1 + I_F2;
    for (int it = gw; it < NT; it += NGW) {
        int r = it;
        if (r < I_IN) { p0_transpose_item(a.in[I_WIN], D, INC, (bf16*)(ws + WS_WIN), scr, r, lane); continue; } r -= I_IN;
        if (r < I_SQ) { p0_transpose_item(a.in[I_WBRG], D, D, (bf16*)(ws + WS_WBG), scr, r, lane, 2 * D, 0); continue; } r -= I_SQ;
        if (r < I_SQ) { p0_transpose_item(a.in[I_WBRR], D, D, (bf16*)(ws + WS_WBG), scr, r, lane, 2 * D, D); continue; } r -= I_SQ;
        if (r < I_SQ) { p0_transpose_item(a.in[I_WOUT], D, D, (bf16*)(ws + WS_WOUT), scr, r, lane); continue; } r -= I_SQ;
        if (r < I_F1) { p0_transpose_item(a.in[I_WFF1], D, FF, (bf16*)(ws + WS_WFF1), scr, r, lane); continue; } r -= I_F1;
        p0_transpose_item(a.in[I_WFF2], FF, D, (bf16*)(ws + WS_WFF2), scr, r, lane);
    }
    {
        const bool few = gridDim.x > 192;
        if (few && blockIdx.x < 192) return;
        const int gt = few ? ((int)blockIdx.x - 192) * NTHR + wave * 64 + lane : gw * 64 + lane, NGT = few ? ((int)gridDim.x - 192) * NTHR : NGW * 64;
        bf16* WG = (bf16*)(ws + WS_WG);
        for (int it = gt; it < 16 * 16 * 2 * 64; it += NGT) {
            const int ln = it & 63, ks = (it >> 6) & 1, cbi = (it >> 7) & 15, h = it >> 11;
            const int fr = ln & 15, fq = ln >> 4, type = cbi >> 3, d = (cbi >> 2) & 1, cb = cbi & 3;
            const float* W = type ? a.in[I_WRI] : a.in[I_WRA];
            const float* src = W + ((size_t)(d * 16 + h) * 64 + ks * 32 + fq * 8) * 64 + cb * 16 + fr;
            v4u o; o.x = pk2(-LOG2E * src[0], -LOG2E * src[64]); o.y = pk2(-LOG2E * src[128], -LOG2E * src[192]);
            o.z = pk2(-LOG2E * src[256], -LOG2E * src[320]); o.w = pk2(-LOG2E * src[384], -LOG2E * src[448]);
            *(v4u*)(WG + (size_t)it * 8) = o;
        }
        bf16* WSP = (bf16*)(ws + WS_WSP); const float* wsp = a.in[I_WSP];
        for (int it = gt; it < 8 * 128 * 128 / 8; it += NGT) {
            const f32x4 x0 = *(const f32x4*)(wsp + (size_t)it * 8), x1 = *(const f32x4*)(wsp + (size_t)it * 8 + 4);
            v4u o; o.x = pk2(x0[0], x0[1]); o.y = pk2(x0[2], x0[3]); o.z = pk2(x1[0], x1[1]); o.w = pk2(x1[2], x1[3]);
            *(v4u*)(WSP + (size_t)it * 8) = o;
        }
        float* GC = (float*)(ws + WS_GC);
        for (int it = gt; it < 2048; it += NGT) {
            const float lamv = a.in[I_LAM][it]; const float sp = log1pf(expf(-lamv));
            f32x4 o; o[0] = exp2f(-LOG2E * a.in[I_BRA][it]); o[1] = exp2f(-LOG2E * a.in[I_BRI][it]); o[2] = -8.f * sp * LOG2E; o[3] = 0.f;
            *(f32x4*)(GC + (size_t)it * 4) = o;
        }
    }
}

__device__ __forceinline__ f32x4 modv(const float* MOD, const float* bada, int cv, int part, int c) {
    return *(const f32x4*)(MOD + cv * INC + part * D + c) + *(const f32x4*)(bada + part * D + c);
}
__device__ __forceinline__ int cv_of(int m) { return m < MCTX ? 0 : (m < MCTX + 4096 ? 1 : 2); }
__device__ __forceinline__ const float* xrow_of(const Args& a, int m) { return m < MCTX ? a.in[I_XP] + (size_t)m * D : a.in[I_XS] + (size_t)(m - MCTX) * D; }
__device__ __forceinline__ void store_bf4(bf16* p, f32x4 v) { v2u o; o.x = pk2(v[0], v[1]); o.y = pk2(v[2], v[3]); *(v2u*)p = o; }

__device__ __forceinline__ void phase_norm1(const Args& a, int gw, int NGW, int lane) {
    const float* MOD = (const float*)(a.ws + CTL_MOD); const float* bada = a.in[I_BADA]; const float* g = a.in[I_GPREMIX];
    bf16* H = (bf16*)(a.ws + WS_H);
    const int RPW = M / NGW;
    if (RPW * NGW == M && (MCTX % RPW) == 0 && (4096 % RPW) == 0) {
        const int m0 = gw * RPW, cv = cv_of(m0);
        f32x4 cc[4], sh[4];
#pragma unroll
        for (int j = 0; j < 4; ++j) { const int c = 4 * lane + 256 * j; cc[j] = *(const f32x4*)(g + c) * (modv(MOD, bada, cv, 1, c) + 1.f); sh[j] = modv(MOD, bada, cv, 0, c); }
        for (int m = m0; m < m0 + RPW; ++m) {
            const float* xr = xrow_of(a, m);
            f32x4 v[4]; float s = 0.f;
#pragma unroll
            for (int j = 0; j < 4; ++j) { v[j] = *(const f32x4*)(xr + 4 * lane + 256 * j); s += (v[j][0] * v[j][0] + v[j][1] * v[j][1]) + (v[j][2] * v[j][2] + v[j][3] * v[j][3]); }
            const float rstd = rsqrtf(wave_sum(s) * (1.f / D) + EPS);
#pragma unroll
            for (int j = 0; j < 4; ++j) store_bf4(H + (size_t)m * D + 4 * lane + 256 * j, v[j] * rstd * cc[j] + sh[j]);
        }
        return;
    }
    for (int m = gw; m < M; m += NGW) {
        const float* xr = xrow_of(a, m); const int cv = cv_of(m);
        f32x4 v[4]; float s = 0.f;
#pragma unroll
        for (int j = 0; j < 4; ++j) { v[j] = *(const f32x4*)(xr + 4 * lane + 256 * j); s += (v[j][0] * v[j][0] + v[j][1] * v[j][1]) + (v[j][2] * v[j][2] + v[j][3] * v[j][3]); }
        const float rstd = rsqrtf(wave_sum(s) * (1.f / D) + EPS);
#pragma unroll
        for (int j = 0; j < 4; ++j) { const int c = 4 * lane + 256 * j;
            const f32x4 gg = *(const f32x4*)(g + c), sh = modv(MOD, bada, cv, 0, c), sc = modv(MOD, bada, cv, 1, c);
            store_bf4(H + (size_t)m * D + c, v[j] * rstd * gg * (sc + 1.f) + sh); }
    }
}
__device__ __forceinline__ void phase_mid(const Args& a, int gw, int NGW, int lane, float* xout, bf16* H) {
    const float* MOD = (const float*)(a.ws + CTL_MOD); const float* bada = a.in[I_BADA];
    const float* gpm = a.in[I_GPOSTMIX]; const float* gpl = a.in[I_GPREMLP]; const float* OSS = (const float*)(a.ws + CTL_OSS);
    const float* out = a.out;
    for (int m = gw; m < M; m += NGW) {
        const float* xr = xrow_of(a, m); const int cv = cv_of(m);
        const float rstd_o = rsqrtf(OSS[m] * (1.f / D) + EPS);
        f32x4 v[4]; float s = 0.f;
#pragma unroll
        for (int j = 0; j < 4; ++j) { const int c = 4 * lane + 256 * j;
            const f32x4 o = *(const f32x4*)(out + (size_t)m * D + c), x = *(const f32x4*)(xr + c);
            const f32x4 g1 = modv(MOD, bada, cv, 2, c), gg = *(const f32x4*)(gpm + c);
            v[j] = x + g1 * (o * rstd_o * gg);
            *(f32x4*)(xout + (size_t)m * D + c) = v[j];
            s += (v[j][0] * v[j][0] + v[j][1] * v[j][1]) + (v[j][2] * v[j][2] + v[j][3] * v[j][3]); }
        const float rstd = rsqrtf(wave_sum(s) * (1.f / D) + EPS);
#pragma unroll
        for (int j = 0; j < 4; ++j) { const int c = 4 * lane + 256 * j;
            const f32x4 gg = *(const f32x4*)(gpl + c), sh = modv(MOD, bada, cv, 3, c), sc = modv(MOD, bada, cv, 4, c);
            store_bf4(H + (size_t)m * D + c, v[j] * rstd * gg * (sc + 1.f) + sh); }
    }
}
__device__ __forceinline__ void phase_final(const Args& a, int gw, int NGW, int lane, float* yout) {
    const float* MOD = (const float*)(a.ws + CTL_MOD); const float* bada = a.in[I_BADA];
    const float* gpm = a.in[I_GPOSTMLP]; const float* FSS = (const float*)(a.ws + CTL_FSS); const float* F = (const float*)(a.ws + WS_F); const float* out = a.out;
    for (int m = gw; m < M; m += NGW) {
        const int cv = cv_of(m); const float rstd_f = rsqrtf(FSS[m] * (1.f / D) + EPS);
#pragma unroll
        for (int j = 0; j < 4; ++j) { const int c = 4 * lane + 256 * j;
            const f32x4 f = *(const f32x4*)(F + (size_t)m * D + c), x1 = *(const f32x4*)(out + (size_t)m * D + c);
            const f32x4 g2 = modv(MOD, bada, cv, 5, c), gg = *(const f32x4*)(gpm + c);
            *(f32x4*)(yout + (size_t)m * D + c) = x1 + g2 * (f * rstd_f * gg); }
    }
}

__device__ __forceinline__ void panel_sync(unsigned* cnt) {
    asm volatile("s_waitcnt vmcnt(0)" ::: "memory");
    __syncthreads();
    if (threadIdx.x == 0) {
        __hip_atomic_fetch_add(cnt, 1u, __ATOMIC_RELAXED, __HIP_MEMORY_SCOPE_AGENT);
        unsigned sp = 0;
        while (__hip_atomic_load(cnt, __ATOMIC_RELAXED, __HIP_MEMORY_SCOPE_AGENT) < 4u) { __builtin_amdgcn_s_sleep(1); if (++sp > (1u << 22)) break; }
    }
    __syncthreads();
}
__device__ __forceinline__ float ld_agent(const float* p) { return __builtin_bit_cast(float, __hip_atomic_load((const unsigned*)p, __ATOMIC_RELAXED, __HIP_MEMORY_SCOPE_AGENT)); }
__device__ __forceinline__ float sumsq4(f32x4 v) { return (v[0] * v[0] + v[1] * v[1]) + (v[2] * v[2] + v[3] * v[3]); }
template <int MODE> struct EpiFused {
    static constexpr bool PERM = true, AFTER_DRAIN = true, HOOK = false;
    float* out; const float* xp; const float* xs; bf16* H; float* SS1; float* SS2; unsigned* cnt1; unsigned* cnt2;
    const float* MOD; const float* bada; const float* gpost; const float* gpre;
    __device__ __forceinline__ void fused(f32x4 (&acc)[2][2][4][2], const pg8::Unit& u, int wr, int wc, int fr, int fq, LAS unsigned char*, int, int) const {
        const int row0 = u.pm * 256 + wr * 64 + fr, col0 = u.pn * 256 + wc * 32 + 8 * fq;
        const int cv = u.pm < 32 ? 0 : (u.pm < 48 ? 1 : 2);
#pragma unroll
        for (int ai = 0; ai < 2; ++ai)
#pragma unroll
            for (int m = 0; m < 4; ++m) {
                float ss = (sumsq4(acc[ai][0][m][0]) + sumsq4(acc[ai][0][m][1])) + (sumsq4(acc[ai][1][m][0]) + sumsq4(acc[ai][1][m][1]));
                ss += __shfl_xor(ss, 16); ss += __shfl_xor(ss, 32);
                if (fq == 0) atomicAdd(SS1 + row0 + ai * 128 + m * 16, ss);
            }
        panel_sync(cnt1 + 64 * u.pm);
        f32x4 ga[2][2];
#pragma unroll
        for (int bj = 0; bj < 2; ++bj)
#pragma unroll
            for (int n = 0; n < 2; ++n) { const int c = col0 + bj * 128 + 4 * n; ga[bj][n] = modv(MOD, bada, cv, MODE == 6 ? 2 : 5, c) * *(const f32x4*)(gpost + c); }
        float rs1[2][4];
#pragma unroll
        for (int ai = 0; ai < 2; ++ai)
#pragma unroll
            for (int m = 0; m < 4; ++m) rs1[ai][m] = ld_agent(SS1 + row0 + ai * 128 + m * 16);
#pragma unroll
        for (int ai = 0; ai < 2; ++ai)
#pragma unroll
            for (int m = 0; m < 4; ++m) {
                const int row = row0 + ai * 128 + m * 16;
                const float rstd = rsqrtf(rs1[ai][m] * (1.f / D) + EPS);
                const float* xrow = MODE == 6 ? (row < MCTX ? xp + (size_t)row * D : xs + (size_t)(row - MCTX) * D) : out + (size_t)row * D;
                float ss = 0.f;
#pragma unroll
                for (int bj = 0; bj < 2; ++bj)
#pragma unroll
                    for (int n = 0; n < 2; ++n) { const int c = col0 + bj * 128 + 4 * n;
                        const f32x4 v = *(const f32x4*)(xrow + c) + ga[bj][n] * (acc[ai][bj][m][n] * rstd);
                        *(f32x4*)(out + (size_t)row * D + c) = v; acc[ai][bj][m][n] = v; ss += sumsq4(v); }
                if constexpr (MODE == 6) { ss += __shfl_xor(ss, 16); ss += __shfl_xor(ss, 32); if (fq == 0) atomicAdd(SS2 + row, ss); }
            }
        if constexpr (MODE == 6) {
            panel_sync(cnt2 + 64 * u.pm);
            f32x4 cc[2][2], sh[2][2];
#pragma unroll
            for (int bj = 0; bj < 2; ++bj)
#pragma unroll
                for (int n = 0; n < 2; ++n) { const int c = col0 + bj * 128 + 4 * n; cc[bj][n] = *(const f32x4*)(gpre + c) * (modv(MOD, bada, cv, 4, c) + 1.f); sh[bj][n] = modv(MOD, bada, cv, 3, c); }
            float rs2[2][4];
#pragma unroll
            for (int ai = 0; ai < 2; ++ai)
#pragma unroll
                for (int m = 0; m < 4; ++m) rs2[ai][m] = ld_agent(SS2 + row0 + ai * 128 + m * 16);
#pragma unroll
            for (int ai = 0; ai < 2; ++ai)
#pragma unroll
                for (int m = 0; m < 4; ++m) {
                    const int row = row0 + ai * 128 + m * 16;
                    const float rstd = rsqrtf(rs2[ai][m] * (1.f / D) + EPS);
#pragma unroll
                    for (int bj = 0; bj < 2; ++bj) {
                        const f32x4 h0 = acc[ai][bj][m][0] * rstd * cc[bj][0] + sh[bj][0], h1 = acc[ai][bj][m][1] * rstd * cc[bj][1] + sh[bj][1];
                        v4u w; w.x = pg8::cvt_pk_bf16(h0[0], h0[1]); w.y = pg8::cvt_pk_bf16(h0[2], h0[3]); w.z = pg8::cvt_pk_bf16(h1[0], h1[1]); w.w = pg8::cvt_pk_bf16(h1[2], h1[3]);
                        *(v4u*)(H + (size_t)row * D + col0 + bj * 128) = w; }
                }
        }
    }
};

constexpr int YLD = 2048;
constexpr int SG_W = 0, SG_V = 34816, SG_U = 69632, SG_ST = 272;
__device__ __forceinline__ void sgu_load(const bf16* GV, const bf16* GU, const float* VSS, int item, int tid, v4u (&rv)[4], v4u (&ru)[4], float (&rss)[4]) {
    const int g = item & 7, t0 = (item >> 3) * 128;
#pragma unroll
    for (int i = 0; i < 4; ++i) { const int idx = tid + i * NTHR, p = idx >> 4, c8 = (idx & 15) * 8;
        rv[i] = *(const v4u*)(GV + (size_t)(t0 + p) * D + g * 128 + c8); ru[i] = *(const v4u*)(GU + (size_t)(t0 + p) * YLD + g * 128 + c8); rss[i] = VSS[t0 + p]; }
}
__device__ __forceinline__ void phase_sgu(const Args& a, LAS unsigned char* lds, int tid, int wave, int lane, bf16* YG) {
    const bf16* GV = (const bf16*)a.out; const bf16* GU = (const bf16*)(a.ws + WS_GU); const bf16* WSP = (const bf16*)(a.ws + WS_WSP);
    const float* VSS = (const float*)(a.ws + CTL_VSS); const float* gsgu = a.in[I_GSGU]; const float* bsp = a.in[I_BSP];
    const int fr = lane & 15, fq = lane >> 4;
    int last_g = -1;
    v4u rv[4], ru[4]; float rss[4];
    for (int item = blockIdx.x; item < 128 * 8; item += gridDim.x) {
        const int g = item & 7, n = item >> 3, t0 = n * 128;
        if (g != last_g) {
#pragma unroll
            for (int i = 0; i < 4; ++i) { const int idx = tid + i * NTHR, row = idx >> 4, c16 = idx & 15;
                *(LAS v4u*)(lds + SG_W + row * SG_ST + c16 * 16) = *(const v4u*)(WSP + (size_t)(g * 128 + row) * 128 + c16 * 8); }
            last_g = g;
        }
        if (item == (int)blockIdx.x) sgu_load(GV, GU, VSS, item, tid, rv, ru, rss);
#pragma unroll
        for (int i = 0; i < 4; ++i) {
            const int idx = tid + i * NTHR, p = idx >> 4, c8 = (idx & 15) * 8;
            const v4u r = rv[i]; const v4u uu = ru[i];
            const float rs = rsqrtf(rss[i] * (1.f / D) + EPS);
            const f32x4 g0 = *(const f32x4*)(gsgu + g * 128 + c8) * rs, g1 = *(const f32x4*)(gsgu + g * 128 + c8 + 4) * rs;
            v4u o; o.x = pk2(bflo(r.x) * g0[0], bfhi(r.x) * g0[1]); o.y = pk2(bflo(r.y) * g0[2], bfhi(r.y) * g0[3]);
            o.z = pk2(bflo(r.z) * g1[0], bfhi(r.z) * g1[1]); o.w = pk2(bflo(r.w) * g1[2], bfhi(r.w) * g1[3]);
            *(LAS v4u*)(lds + SG_V + p * SG_ST + c8 * 2) = o;
            *(LAS v4u*)(lds + SG_U + p * SG_ST + c8 * 2) = uu;
        }
        if (item + (int)gridDim.x < 128 * 8) sgu_load(GV, GU, VSS, item + gridDim.x, tid, rv, ru, rss);
        float bias8[8];
#pragma unroll
        for (int qb = 0; qb < 8; ++qb) bias8[qb] = bsp[g * 128 + qb * 16 + fr];
        __syncthreads();
        bf16x8 af[4];
#pragma unroll
        for (int ks = 0; ks < 4; ++ks) {
            unsigned short e[8];
#pragma unroll
            for (int j = 0; j < 8; ++j) e[j] = *(const LAS unsigned short*)(lds + SG_V + (ks * 32 + fq * 8 + j) * SG_ST + (wave * 16 + fr) * 2);
            v4u o; o.x = e[0] | ((unsigned)e[1] << 16); o.y = e[2] | ((unsigned)e[3] << 16); o.z = e[4] | ((unsigned)e[5] << 16); o.w = e[6] | ((unsigned)e[7] << 16);
            af[ks] = __builtin_bit_cast(bf16x8, o);
        }
#pragma unroll
        for (int qb = 0; qb < 8; ++qb) {
            const int q = qb * 16 + fr;
            f32x4 acc = {0.f, 0.f, 0.f, 0.f};
#pragma unroll
            for (int ks = 0; ks < 4; ++ks) { const bf16x8 b = *(const LAS bf16x8*)(lds + SG_W + q * SG_ST + (ks * 32 + fq * 8) * 2);
                acc = __builtin_amdgcn_mfma_f32_16x16x32_bf16(af[ks], b, acc, 0, 0, 0); }
            const float bias = bias8[qb];
            LAS v2u* up = (LAS v2u*)(lds + SG_U + q * SG_ST + (wave * 16 + fq * 4) * 2);
            const v2u gu = *up;
            v2u y; y.x = pk2(bflo(gu.x) * (acc[0] + bias), bfhi(gu.x) * (acc[1] + bias)); y.y = pk2(bflo(gu.y) * (acc[2] + bias), bfhi(gu.y) * (acc[3] + bias));
            *up = y;
        }
        __syncthreads();
#pragma unroll
        for (int i = 0; i < 4; ++i) { const int idx = tid + i * NTHR, p = idx >> 4, c8 = (idx & 15) * 8;
            *(v4u*)(YG + (size_t)(t0 + p) * YLD + g * 128 + c8) = *(const LAS v4u*)(lds + SG_U + p * SG_ST + c8 * 2); }
    }
}

constexpr int RG_WB = 0, RG_XA = 32768, RG_XF = 51200, RG_AGL = 86016, RG_GCL = 94208, RG_CWL = 96256, RG_CARL = 97536, RG_AGL2 = 102400;
#define RGIDX(i) (((tid >> 6) << 7) + (tid & 63) + 64 * (i))
__device__ __forceinline__ void rg_load_raw(const bf16* XR, int item, int tid, v4u (&xr)[2][4]) {
    const int h = item & 15, t0 = (item >> 4) * 128;
    const int seq_lo = t0 < MCTX ? (t0 & ~255) : MCTX + ((t0 - MCTX) & ~4095), seq_hi = seq_lo + (t0 < MCTX ? 256 : 4096);
#pragma unroll
    for (int i = 0; i < 2; ++i) {
        const int idx = RGIDX(i), tk = idx >> 3, chb = h * 64 + (idx & 7) * 8;
#pragma unroll
        for (int tap = 0; tap < 4; ++tap) {
            const int t = t0 + tk + tap - 2; const bool ok = (t >= seq_lo) && (t < seq_hi); const int tc = ok ? t : t0;
            xr[i][tap] = *(const v4u*)(XR + (size_t)tc * D + chb);
        }
    }
}
template <int MODE> __device__ __forceinline__ int rg_item(int k) {
    const int h = blockIdx.x & 15, q = blockIdx.x >> 4;
    int tt;
    if (MODE == 1) tt = k < 4 ? 2 * (q + 16 * (k >> 1)) + (k & 1) : 64 + q + 16 * (k - 4);
    else tt = k < 2 ? 2 * (q + 16 * k) + 1 : 64 + q + 16 * (k - 2);
    return tt * 16 + h;
}
__device__ __forceinline__ void agg_st(f32x2* p, f32x2 v) { __hip_atomic_store((unsigned long long*)p, __builtin_bit_cast(unsigned long long, v), __ATOMIC_RELAXED, __HIP_MEMORY_SCOPE_AGENT); }
__device__ __forceinline__ f32x2 agg_ld(const f32x2* p) { return __builtin_bit_cast(f32x2, __hip_atomic_load((const unsigned long long*)p, __ATOMIC_RELAXED, __HIP_MEMORY_SCOPE_AGENT)); }
template <int MODE>
__device__ __forceinline__ void phase_rg(const Args& a, LAS unsigned char* lds, int tid, int wave, int lane, bf16* YR) {
    const bf16* XR = (const bf16*)((const unsigned char*)a.out + 32 * MiB); const bf16* GGR = (const bf16*)(a.ws + WS_GU) + D;
    const float* GC = (const float*)(a.ws + WS_GC); const bf16* WG = (const bf16*)(a.ws + WS_WG);
    f32x2* AGG = (f32x2*)(a.ws + WS_AGG); const float* CAR = (const float*)(a.ws + WS_CAR); float* nstate = a.out + (size_t)M * D;
    const float* convw = a.in[I_CONVW]; const float* convb = a.in[I_CONVB];
    const int fr = lane & 15, fq = lane >> 4;
    int last_h = -1;
    v4u xr[2][4];
    constexpr int NK = MODE == 1 ? 8 : 6;
    rg_load_raw(XR, rg_item<MODE>(0), tid, xr);
    if constexpr (MODE == 1) {
        const float* st0 = a.in[I_STATE];
#pragma unroll 1
        for (int kk = tid >> 7; kk < 8; kk += 4) {
            const int it = rg_item<1>(kk);
            {
                const int d = (tid >> 6) & 1, cl = tid & 63, h = it & 15, tt = it >> 4;
                float hc;
                if (tt < 64) {
                    const f32x2 g = agg_ld(AGG + ((size_t)((tt | 1) * 16 + h) * 2 + 1) * 64 + cl);
                    hc = ((tt & 1) == 0 && d == 1) ? g[1] : 0.f;
                } else {
                    const int b = (tt - 64) >> 5, j = (tt - 64) & 31, tt0 = 64 + b * 32;
                    f32x2 ag[31];
#pragma unroll
                    for (int sI = 0; sI < 31; ++sI) { const int ti = d ? 31 - sI : sI; ag[sI] = agg_ld(AGG + ((size_t)((tt0 + ti) * 16 + h) * 2 + d) * 64 + cl); }
                    hc = st0[(size_t)b * 2048 + d * 1024 + h * 64 + cl];
#pragma unroll
                    for (int sI = 0; sI < 31; ++sI) { const int ti = d ? 31 - sI : sI; if (d ? (ti > j) : (ti < j)) hc = ag[sI][0] * hc + ag[sI][1]; }
                }
                *(LAS float*)(lds + RG_CARL + ((kk * 2 + d) * 64 + cl) * 4) = hc;
            }
        }
        __syncthreads();
    }
    for (int kitem = 0; kitem < NK; ++kitem) {
        const int item = rg_item<MODE>(kitem);
        const int h = item & 15, tt = item >> 4, t0 = tt * 128;
        const int AGLo = (kitem & 1) ? RG_AGL2 : RG_AGL;
        if (h != last_h) {
#pragma unroll
            for (int i = 0; i < 4; ++i) { const int o = (tid + i * NTHR) * 16; *(LAS v4u*)(lds + RG_WB + o) = *(const v4u*)((const unsigned char*)WG + (size_t)h * 32768 + o); }
            if (tid < 128) *(LAS f32x4*)(lds + RG_GCL + tid * 16) = *(const f32x4*)(GC + (size_t)((tid >> 6) * D + h * 64 + (tid & 63)) * 4);
            if (tid < 80) { const int row = tid >> 4, c4 = (tid & 15) * 4;
                *(LAS f32x4*)(lds + RG_CWL + (row * 64 + c4) * 4) = *(const f32x4*)((row < 4 ? convw + row * D : convb) + h * 64 + c4); }
            last_h = h;
            __syncthreads();
        }
        const int seq_lo = t0 < MCTX ? (t0 & ~255) : MCTX + ((t0 - MCTX) & ~4095), seq_hi = seq_lo + (t0 < MCTX ? 256 : 4096);
        float car[2][4]; v4u ggr[2];
        if constexpr (MODE == 1) {
#pragma unroll
            for (int i = 0; i < 2; ++i) { const int idx = RGIDX(i); ggr[i] = *(const v4u*)(GGR + (size_t)(t0 + (idx >> 3)) * YLD + h * 64 + (idx & 7) * 8); }
        }
        {
            const int c8 = (tid & 7) * 8;
            f32x4 w0[4], w1[4];
#pragma unroll
            for (int tap = 0; tap < 4; ++tap) { w0[tap] = *(const LAS f32x4*)(lds + RG_CWL + (tap * 64 + c8) * 4); w1[tap] = *(const LAS f32x4*)(lds + RG_CWL + (tap * 64 + c8 + 4) * 4); }
            const f32x4 b0 = *(const LAS f32x4*)(lds + RG_CWL + (4 * 64 + c8) * 4), b1 = *(const LAS f32x4*)(lds + RG_CWL + (4 * 64 + c8 + 4) * 4);
#pragma unroll
            for (int i = 0; i < 2; ++i) {
                const int idx = RGIDX(i), tk = idx >> 3, cg8 = idx & 7;
                f32x4 x0 = b0, x1 = b1;
#pragma unroll
                for (int tap = 0; tap < 4; ++tap) { const int t = t0 + tk + tap - 2; const bool ok = (t >= seq_lo) && (t < seq_hi);
                    v4u r = xr[i][tap]; r.x = ok ? r.x : 0u; r.y = ok ? r.y : 0u; r.z = ok ? r.z : 0u; r.w = ok ? r.w : 0u;
                    x0[0] += w0[tap][0] * bflo(r.x); x0[1] += w0[tap][1] * bfhi(r.x); x0[2] += w0[tap][2] * bflo(r.y); x0[3] += w0[tap][3] * bfhi(r.y);
                    x1[0] += w1[tap][0] * bflo(r.z); x1[1] += w1[tap][1] * bfhi(r.z); x1[2] += w1[tap][2] * bflo(r.w); x1[3] += w1[tap][3] * bfhi(r.w); }
                v4u o; o.x = pk2(x0[0], x0[1]); o.y = pk2(x0[2], x0[3]); o.z = pk2(x1[0], x1[1]); o.w = pk2(x1[2], x1[3]);
                *(LAS v4u*)(lds + RG_XA + tk * 144 + cg8 * 16) = o;
                *(LAS f32x4*)(lds + RG_XF + (tk * 68 + cg8 * 8) * 4) = x0; *(LAS f32x4*)(lds + RG_XF + (tk * 68 + cg8 * 8 + 4) * 4) = x1;
            }
        }
        if (kitem + 1 < NK) rg_load_raw(XR, rg_item<MODE>(kitem + 1), tid, xr);
        asm volatile("" ::: "memory");
        const int tokb = wave * 16;
        bf16x8 afr[2];
#pragma unroll
        for (int ks = 0; ks < 2; ++ks) afr[ks] = *(const LAS bf16x8*)(lds + RG_XA + (tokb + fr) * 144 + (ks * 32 + fq * 8) * 2);
        f32x4 gcv[2][4];
#pragma unroll
        for (int d = 0; d < 2; ++d)
#pragma unroll
            for (int cb = 0; cb < 4; ++cb) gcv[d][cb] = *(const LAS f32x4*)(lds + RG_GCL + (d * 64 + cb * 16 + fr) * 16);
        float av[2][4][4], bv[2][4][4], Ap[2][4], Hp[2][4];
        const bool ctx = t0 < MCTX;
#pragma unroll
        for (int d = 0; d < 2; ++d) {
            if (MODE == 0 && ctx && d != (tt & 1)) continue;
#pragma unroll
            for (int cb = 0; cb < 4; ++cb) {
                const f32x4 gc = gcv[d][cb];
                f32x4 ar = {0.f, 0.f, 0.f, 0.f}, ai = {0.f, 0.f, 0.f, 0.f};
#pragma unroll
                for (int ks = 0; ks < 2; ++ks) {
                    const bf16x8 b0 = *(const LAS bf16x8*)(lds + RG_WB + (((0 * 8 + d * 4 + cb) * 2 + ks) * 64 + lane) * 16);
                    const bf16x8 b1 = *(const LAS bf16x8*)(lds + RG_WB + (((1 * 8 + d * 4 + cb) * 2 + ks) * 64 + lane) * 16);
                    ar = __builtin_amdgcn_mfma_f32_16x16x32_bf16(afr[ks], b0, ar, 0, 0, 0);
                    ai = __builtin_amdgcn_mfma_f32_16x16x32_bf16(afr[ks], b1, ai, 0, 0, 0);
                }
#pragma unroll
                for (int r = 0; r < 4; ++r) {
                    const float xcv = *(const LAS float*)(lds + RG_XF + ((tokb + fq * 4 + r) * 68 + cb * 16 + fr) * 4);
                    const float rr = __builtin_amdgcn_rcpf(__builtin_fmaf(__builtin_amdgcn_exp2f(ar[r]), gc[0], 1.f)), ii = __builtin_amdgcn_rcpf(__builtin_fmaf(__builtin_amdgcn_exp2f(ai[r]), gc[1], 1.f));
                    const float aa = __builtin_amdgcn_exp2f(rr * gc[2]);
                    const float om = fmaxf(1.f - aa * aa, 1e-12f);
                    av[d][cb][r] = aa; bv[d][cb][r] = __builtin_amdgcn_sqrtf(om) * ii * xcv;
                }
                float A = 1.f, Hh = 0.f;
#pragma unroll
                for (int rr = 0; rr < 4; ++rr) { const int r = d ? 3 - rr : rr; Hh = av[d][cb][r] * Hh + bv[d][cb][r]; A *= av[d][cb][r]; }
                float Aw = 1.f, Hw = 0.f, Apl = 1.f, Hpl = 0.f;
#pragma unroll
                for (int gg = 0; gg < 4; ++gg) { const int g = d ? 3 - gg : gg;
                    const float Ag = __shfl(A, g * 16 + fr), Hg = __shfl(Hh, g * 16 + fr);
                    if (g == fq) { Apl = Aw; Hpl = Hw; }
                    Hw = Ag * Hw + Hg; Aw *= Ag; }
                Ap[d][cb] = Apl; Hp[d][cb] = Hpl;
                if (fq == 0) *(LAS f32x2*)(lds + AGLo + ((wave * 2 + d) * 64 + cb * 16 + fr) * 8) = (f32x2){Aw, Hw};
            }
        }
        __syncthreads();
        if constexpr (MODE == 0) {
            if (tid < 128 && !(ctx && (tid >> 6) != (tt & 1))) {
                const int d = tid >> 6, cl = tid & 63; float A = 1.f, Hh = 0.f;
#pragma unroll
                for (int ww = 0; ww < 8; ++ww) { const int w2 = d ? 7 - ww : ww; const f32x2 sg = *(const LAS f32x2*)(lds + AGLo + ((w2 * 2 + d) * 64 + cl) * 8); Hh = sg[0] * Hh + sg[1]; A *= sg[0]; }
                agg_st(AGG + ((size_t)(tt * 16 + h) * 2 + d) * 64 + cl, (f32x2){A, Hh});
            }
        } else {
            if (ctx && (tt & 1) == 0 && tid < 64) {
                float Hh = 0.f;
#pragma unroll
                for (int w2 = 0; w2 < 8; ++w2) { const f32x2 sg = *(const LAS f32x2*)(lds + AGLo + ((w2 * 2 + 0) * 64 + tid) * 8); Hh = sg[0] * Hh + sg[1]; }
                *(LAS float*)(lds + RG_CARL + (((kitem + 1) * 2 + 0) * 64 + tid) * 4) = Hh;
            }
#pragma unroll
            for (int d = 0; d < 2; ++d)
#pragma unroll
                for (int cb = 0; cb < 4; ++cb) car[d][cb] = *(const LAS float*)(lds + RG_CARL + ((kitem * 2 + d) * 64 + cb * 16 + fr) * 4);
            float hs[4][4];
#pragma unroll
            for (int cb = 0; cb < 4; ++cb)
#pragma unroll
                for (int r = 0; r < 4; ++r) hs[cb][r] = 0.f;
#pragma unroll
            for (int d = 0; d < 2; ++d)
#pragma unroll
                for (int cb = 0; cb < 4; ++cb) {
                    const int cl = cb * 16 + fr;
                    float hin = car[d][cb];
                    f32x2 sg[8];
#pragma unroll
                    for (int w2 = 0; w2 < 8; ++w2) sg[w2] = *(const LAS f32x2*)(lds + AGLo + ((w2 * 2 + d) * 64 + cl) * 8);
#pragma unroll
                    for (int ww = 0; ww < 8; ++ww) { const int w2 = d ? 7 - ww : ww; if (d ? (w2 > wave) : (w2 < wave)) hin = sg[w2][0] * hin + sg[w2][1]; }
                    float hh = Ap[d][cb] * hin + Hp[d][cb];
#pragma unroll
                    for (int rr = 0; rr < 4; ++rr) { const int r = d ? 3 - rr : rr; hh = av[d][cb][r] * hh + bv[d][cb][r]; hs[cb][r] += hh; }
                    if (ctx && (tt & 1) == (d ? 0 : 1) && wave == (d ? 0 : 7) && fq == (d ? 0 : 3)) nstate[(size_t)(tt >> 1) * 2048 + d * 1024 + h * 64 + cl] = hh;
                }
#pragma unroll
            for (int cb = 0; cb < 4; ++cb)
#pragma unroll
                for (int r = 0; r < 4; ++r) *(LAS float*)(lds + RG_XF + ((tokb + fq * 4 + r) * 68 + cb * 16 + fr) * 4) = hs[cb][r];
            asm volatile("" ::: "memory");
#pragma unroll
            for (int i = 0; i < 2; ++i) {
                const int idx = RGIDX(i), tk = idx >> 3, cg8 = idx & 7;
                const f32x4 y0 = *(const LAS f32x4*)(lds + RG_XF + (tk * 68 + cg8 * 8) * 4), y1 = *(const LAS f32x4*)(lds + RG_XF + (tk * 68 + cg8 * 8 + 4) * 4);
                const v4u g = ggr[i];
                v4u o; o.x = pk2(y0[0] * bflo(g.x), y0[1] * bfhi(g.x)); o.y = pk2(y0[2] * bflo(g.y), y0[3] * bfhi(g.y));
                o.z = pk2(y1[0] * bflo(g.z), y1[1] * bfhi(g.z)); o.w = pk2(y1[2] * bflo(g.w), y1[3] * bfhi(g.w));
                *(v4u*)(YR + (size_t)(t0 + tk) * YLD + h * 64 + cg8 * 8) = o;
            }
        }
    }
}

template <int NT>
__device__ __forceinline__ float carry_chain(const f32x2* AGG, float* CAR, int tt0, int h, int d, int cl, float h0) {
    f32x2 ag[NT];
#pragma unroll
    for (int i = 0; i < NT; ++i) ag[i] = AGG[((size_t)((tt0 + i) * 16 + h) * 2 + d) * 64 + cl];
    float hc = h0;
#pragma unroll
    for (int ii = 0; ii < NT; ++ii) { const int i = d ? NT - 1 - ii : ii;
        CAR[((size_t)((tt0 + i) * 16 + h) * 2 + d) * 64 + cl] = hc; hc = ag[i][0] * hc + ag[i][1]; }
    return hc;
}
__device__ __forceinline__ void phase_carry(const Args& a, int gw, int NGW, int lane) {
    const f32x2* AGG = (const f32x2*)(a.ws + WS_AGG); float* CAR = (float*)(a.ws + WS_CAR);
    for (int wi = gw; wi < 34 * 2 * 16; wi += NGW) {
        const int s = wi >> 5, d = (wi >> 4) & 1, h = wi & 15, ch = h * 64 + lane;
        if (s < 32) {
            const size_t i0 = ((size_t)((2 * s) * 16 + h) * 2 + d) * 64 + lane, i1 = ((size_t)((2 * s + 1) * 16 + h) * 2 + d) * 64 + lane;
            if (d == 0) { CAR[i0] = 0.f; CAR[i1] = AGG[i0][1]; }
            else { CAR[i1] = 0.f; CAR[i0] = AGG[i1][1]; }
        } else {
            const int b = s - 32; const float h0 = a.in[I_STATE][(size_t)b * 2048 + d * 1024 + ch];
            if (d == 0) (void)carry_chain<32>(AGG, CAR, 64 + b * 32, h, 0, lane, h0);
            else (void)carry_chain<32>(AGG, CAR, 64 + b * 32, h, 1, lane, h0);
        }
    }
}

#define RLX_AGENT __ATOMIC_RELAXED, __HIP_MEMORY_SCOPE_AGENT
#define XB_TMO      128
#define XB_XCNT(j)  (256  + 64 * (j))
#define XB_XSUB(j)  (1280 + 64 * (j))
#define XB_XGEN(j)  (2304 + 64 * (j))
#define XB_TOP      3328
#define XB_TOPGEN   3392
#define XCD_BAR_WORDS 3456
#define XB_SPIN_CAP (1u << 18)

__device__ __forceinline__ unsigned xb_ld(unsigned* p)              { return __hip_atomic_load(p, __ATOMIC_RELAXED, __HIP_MEMORY_SCOPE_AGENT); }
__device__ __forceinline__ unsigned xb_add(unsigned* p, unsigned v) { return __hip_atomic_fetch_add(p, v, __ATOMIC_RELAXED, __HIP_MEMORY_SCOPE_AGENT); }
__device__ __forceinline__ unsigned xb_xcc_id() { return (unsigned)__builtin_amdgcn_s_getreg((3 << 11) | 20) & 0xFu; }
#define XB_SPIN(cond, bar) do { unsigned _sp = 0; while (cond) { __builtin_amdgcn_s_sleep(1); \
    if ((++_sp & 255u) == 0u) { if (xb_ld(&(bar)[XB_TMO])) break; if (_sp > XB_SPIN_CAP) { atomicAdd(&(bar)[XB_TMO], 1u); break; } } } } while (0)

struct XcdBarrier {
    unsigned* bar; unsigned x;
    volatile LAS unsigned* st;
};

__device__ __forceinline__ XcdBarrier xcd_barrier_post(unsigned* bar, volatile LAS unsigned* st) {
    XcdBarrier b; b.bar = bar; b.x = xb_xcc_id(); b.st = st;
    if (threadIdx.x == 0) (void)xb_add(&bar[XB_XCNT(b.x)], 1u);
    return b;
}
__device__ __forceinline__ void xcd_barrier_complete(unsigned* bar, unsigned x, unsigned& nloc, unsigned& nx) {
    const unsigned G = gridDim.x * gridDim.y * gridDim.z;
    unsigned sum, cnt, mine, sp = 0u;
    for (;;) {
        sum = 0u; cnt = 0u; mine = 0u;
#pragma unroll
        for (unsigned j = 0; j < 16; ++j) { const unsigned c = xb_ld(&bar[XB_XCNT(j)]); sum += c; cnt += (c > 0u) ? 1u : 0u; mine = (j == x) ? c : mine; }
        if (sum == G) break;
        __builtin_amdgcn_s_sleep(1);
        if ((++sp & 255u) == 0u) { if (xb_ld(&bar[XB_TMO])) break; if (sp > XB_SPIN_CAP) { atomicAdd(&bar[XB_TMO], 1u); break; } }
    }
    nloc = mine > 0u ? mine : 1u; nx = cnt > 0u ? cnt : 1u;
}

__device__ __forceinline__ void xcd_barrier(const XcdBarrier& b) {
    asm volatile("s_waitcnt vmcnt(0)" ::: "memory");
    __syncthreads();
    if (threadIdx.x == 0) {
        unsigned* bar = b.bar;
        __builtin_amdgcn_s_waitcnt(0);
        unsigned nloc = b.st[0], nx = b.st[1];
        if (nloc == 0u) { xcd_barrier_complete(bar, b.x, nloc, nx); b.st[0] = nloc; b.st[1] = nx; }
        const unsigned old = xb_add(&bar[XB_XSUB(b.x)], 1u);
        const unsigned gen = old / nloc;
        if (old + 1u == (gen + 1u) * nloc) {
            __builtin_amdgcn_fence(__ATOMIC_RELEASE, "agent");
            asm volatile("s_waitcnt vmcnt(0)" ::: "memory");
            const unsigned og = xb_add(&bar[XB_TOP], 1u);
            const unsigned tg = og / nx;
            if (og + 1u == (tg + 1u) * nx) xb_add(&bar[XB_TOPGEN], 1u);
            else XB_SPIN(xb_ld(&bar[XB_TOPGEN]) == tg, bar);
            __builtin_amdgcn_fence(__ATOMIC_ACQUIRE, "agent");
            xb_add(&bar[XB_XGEN(b.x)], 1u);
            asm volatile("s_waitcnt vmcnt(0)" ::: "memory");
        } else {
            XB_SPIN(xb_ld(&bar[XB_XGEN(b.x)]) == gen, bar);
            __builtin_amdgcn_fence(__ATOMIC_ACQUIRE, "agent");
            asm volatile("s_waitcnt vmcnt(0)" ::: "memory");
        }
    }
    __syncthreads();
}

__global__ void __launch_bounds__(NTHR, 2) fwd_megakernel(Args a) {
    extern __shared__ __attribute__((aligned(16))) unsigned char lds_raw[];
    LAS unsigned char* lds = (LAS unsigned char*)lds_raw;
    const int tid = threadIdx.x, lane = tid & 63, wave = __builtin_amdgcn_readfirstlane(tid >> 6);
    const int G = gridDim.x, gw = blockIdx.x * NWAVES + wave, NGW = G * NWAVES;
    unsigned char* ws = a.ws;
    const int lo = a.ph_lo, hi = a.ph_hi;
    volatile LAS unsigned* bst = (volatile LAS unsigned*)(lds + LDS_BAR_OFF);
    if (tid < 2) bst[tid] = 0u;
    __syncthreads();
    XcdBarrier bar = xcd_barrier_post((unsigned*)(ws + WS_CTL), bst);
#define IN(k) (lo <= (k) && (k) < hi)
#define SEAM(k) do { if (IN(k) && IN((k) + 1)) { xcd_barrier(bar); if (DUP >> 12 & 1) xcd_barrier(bar); } } while (0)
    float* const DUMSS = (float*)(ws + 1 * MiB + 512 * 1024);
#define REP(k) for (int rep_ = ((DUP >> (k)) & 1); rep_ >= 0; --rep_)
#define ISDUP (rep_ > 0)
    if (IN(0)) REP(0) phase_prep(a, lds, gw, NGW, wave, lane, ISDUP ? (float*)(ws + 1 * MiB + 256 * 1024) : (float*)(ws + CTL_MOD));
    if (IN(1)) {
        if (tid == 0) { unsigned sp = 0; const unsigned need = G > 192 ? 192u : (unsigned)G;
            while (__hip_atomic_load((unsigned*)(ws + CTL_MODCNT), __ATOMIC_RELAXED, __HIP_MEMORY_SCOPE_AGENT) < need) { __builtin_amdgcn_s_sleep(1); if (++sp > (1u << 22)) break; }
            __builtin_amdgcn_fence(__ATOMIC_ACQUIRE, "agent"); asm volatile("s_waitcnt vmcnt(0)" ::: "memory"); }
        __syncthreads();
        REP(1) phase_norm1(a, gw, NGW, lane);
    }
    SEAM(1);
    if (IN(2)) REP(2) {
        pg8::Gemm g{(const pg8::bf16_t*)(ws + WS_H), (const pg8::bf16_t*)(ws + WS_WIN), M, INC, D}; pg8::StaticOrder S; S.init(M, INC, G, (int)blockIdx.x, WG_IN);
        pg8::Epi<1> E{nullptr, nullptr, nullptr, ISDUP ? DUMSS : (float*)(ws + CTL_VSS), D, (bf16*)(ws + WS_GU), (bf16*)a.out, (bf16*)((unsigned char*)a.out + 32 * MiB), (bf16*)(ws + WS_GU) + D, (bf16*)(ws + WS_SGA), (bf16*)(ws + WS_SGB)};
        pg8::gemm_phase<pg8::Epi<1>, pg8::StaticOrder, true, true>(lds, g, S, E);
    }
    SEAM(2);
    if (IN(3)) {
        REP(3) phase_rg<0>(a, lds, tid, wave, lane, nullptr);
        asm volatile("s_waitcnt vmcnt(0)" ::: "memory");
        __syncthreads();
        if (tid == 0) __hip_atomic_fetch_add((unsigned*)(ws + CTL_AGGCNT), 1u, __ATOMIC_RELAXED, __HIP_MEMORY_SCOPE_AGENT);
        REP(3) phase_sgu(a, lds, tid, wave, lane, ISDUP ? (bf16*)(ws + WS_F) : (bf16*)(ws + WS_GU));
        if (tid == 0) { unsigned sp = 0; while (__hip_atomic_load((unsigned*)(ws + CTL_AGGCNT), __ATOMIC_RELAXED, __HIP_MEMORY_SCOPE_AGENT) < (unsigned)G) { __builtin_amdgcn_s_sleep(1); if (++sp > (1u << 22)) break; } }
        __syncthreads();
    }
    if (IN(5)) REP(5) phase_rg<1>(a, lds, tid, wave, lane, ISDUP ? (bf16*)(ws + WS_F) + D : (bf16*)(ws + WS_GU) + D);
    SEAM(5);
    if (IN(6)) REP(6) {
        pg8::Gemm g{(const pg8::bf16_t*)(ws + WS_GU), (const pg8::bf16_t*)(ws + WS_WBG), M, D, 2 * D}; pg8::StaticOrder S; S.init(M, D, G, (int)blockIdx.x);
        pg8::EpiMerge E{(bf16*)(ws + WS_H), (const bf16*)(ws + WS_SGA), (const bf16*)(ws + WS_SGB)};
        pg8::gemm_phase<pg8::EpiMerge, pg8::StaticOrder, false, true>(lds, g, S, E);
    }
    SEAM(6);
    if (IN(7)) {
        pg8::Gemm g{(const pg8::bf16_t*)(ws + WS_H), (const pg8::bf16_t*)(ws + WS_WOUT), M, D, D}; pg8::StaticOrder S; S.init(M, D, G, (int)blockIdx.x);
        EpiFused<6> E{a.out, a.in[I_XP], a.in[I_XS], (bf16*)(ws + WS_H), (float*)(ws + CTL_OSS), (float*)(ws + CTL_XSS), (unsigned*)(ws + CTL_CNT), (unsigned*)(ws + CTL_CNT + 16384),
                      (const float*)(ws + CTL_MOD), a.in[I_BADA], a.in[I_GPOSTMIX], a.in[I_GPREMLP]};
        pg8::gemm_phase<EpiFused<6>, pg8::StaticOrder, false, true>(lds, g, S, E);
    }
    SEAM(7);
    if (IN(8)) REP(8) {
        pg8::Gemm g{(const pg8::bf16_t*)(ws + WS_H), (const pg8::bf16_t*)(ws + WS_WFF1), M, FF, D}; pg8::StaticOrder S; S.init(M, FF, G, (int)blockIdx.x, WG_FF1);
        pg8::Epi<5> E{(bf16*)(ws + WS_F1), nullptr, nullptr, nullptr, FF, nullptr, nullptr, nullptr, nullptr, nullptr, nullptr};
        pg8::gemm_phase<pg8::Epi<5>, pg8::StaticOrder, true, true>(lds, g, S, E);
    }
    SEAM(8);
    if (IN(9)) {
        pg8::Gemm g{(const pg8::bf16_t*)(ws + WS_F1), (const pg8::bf16_t*)(ws + WS_WFF2), M, D, FF}; pg8::StaticOrder S; S.init(M, D, G, (int)blockIdx.x);
        EpiFused<7> E{a.out, nullptr, nullptr, nullptr, (float*)(ws + CTL_FSS), nullptr, (unsigned*)(ws + CTL_CNT + 32768), nullptr,
                      (const float*)(ws + CTL_MOD), a.in[I_BADA], a.in[I_GPOSTMLP], nullptr};
        pg8::gemm_phase<EpiFused<7>, pg8::StaticOrder, false, true>(lds, g, S, E);
    }
#undef IN
#undef SEAM
}

constexpr int N_PHASES = 10;
extern "C" void kernel_launch(void* const* d_in, const int* in_sizes, int n_in, void* d_out, int out_size, void* d_ws, size_t ws_size, hipStream_t stream) {
    static int grid = 0;
    if (grid == 0) {
        if (n_in != 27 || ws_size < WS_END) { fprintf(stderr, "kernel_launch: need 27 inputs and >= %zu B of workspace; got %d, %zu\n", (size_t)WS_END, n_in, ws_size); grid = -1; return; }
        int dev = 0, cus = 0, per_cu = 0;
        if (hipGetDevice(&dev) != hipSuccess || hipDeviceGetAttribute(&cus, hipDeviceAttributeMultiprocessorCount, dev) != hipSuccess) { grid = -1; return; }
        if (hipFuncSetAttribute((const void*)fwd_megakernel, hipFuncAttributeMaxDynamicSharedMemorySize, LDS_BYTES) != hipSuccess) { fprintf(stderr, "kernel_launch: hipFuncSetAttribute failed\n"); grid = -1; return; }
        if (hipOccupancyMaxActiveBlocksPerMultiprocessor(&per_cu, (const void*)fwd_megakernel, NTHR, LDS_BYTES) != hipSuccess || per_cu < 1) { fprintf(stderr, "kernel_launch: occupancy query says %d\n", per_cu); per_cu = 1; }
        (void)hipGetLastError();
        grid = cus * per_cu;
        if (grid < 256) { fprintf(stderr, "kernel_launch: this kernel's work split needs 256 co-resident workgroups; the device offers %d\n", grid); grid = -1; return; }
        grid = 256;
    }
    if (grid < 0) return;
    (void)hipMemsetAsync((char*)d_ws + WS_CTL, 0, CTL_ZERO_BYTES, stream);
    Args a{};
    for (int i = 0; i < 27; ++i) a.in[i] = (const float*)d_in[i];
    a.out = (float*)d_out; a.ws = (unsigned char*)d_ws; a.ph_lo = 0; a.ph_hi = N_PHASES;
    void* args[] = {&a};
    hipError_t e = hipLaunchCooperativeKernel((const void*)fwd_megakernel, dim3(grid), dim3(NTHR), args, LDS_BYTES, stream);
    if (e != hipSuccess) fprintf(stderr, "kernel_launch: cooperative launch failed: %s (grid %d)\n", hipGetErrorString(e), grid);
}
```

```cpp
#include <hip/hip_runtime.h>
#include <hip/hip_cooperative_groups.h>
#include <cstdio>
#include <cstdint>
namespace cg = cooperative_groups;
namespace pg8 {
#define PG8_LAS __attribute__((address_space(3)))
typedef unsigned short bf16_t;
typedef short bf16x8 __attribute__((ext_vector_type(8)));
typedef float f32x4 __attribute__((ext_vector_type(4)));
typedef unsigned u32x4 __attribute__((ext_vector_type(4)));
constexpr int BM = 256, BK = 64, HALF = 128, HTB = HALF * BK * 2  , STAGE_BYTES = 8 * HTB, NXCD = 8, WGM = 8;

__host__ __device__ __forceinline__ int lds_byte(int r, int c) { const int st = (r >> 4) * 2 + (c >> 5), rr = r & 15, cc = c & 31, ob = rr * 64 + cc * 2; return st * 1024 + (ob ^ (((ob >> 9) & 1) << 5)); }
__host__ __device__ __forceinline__ void stage_rc(int b, int& R, int& C) { const int st = b / 1024, sb = b % 1024, swz = sb ^ (((sb >> 9) & 1) << 5); R = (st >> 1) * 16 + swz / 64; C = (st & 1) * 32 + (swz % 64) / 2; }
__host__ __device__ __forceinline__ int perm32(int rho) { const int n = rho >> 4, i = rho & 15; return 8 * (i >> 2) + 4 * n + (i & 3); }

struct Unit { int pm, pn; };
struct Gemm { const bf16_t* A; const bf16_t* Bt; int M, N, K; };

struct StaticOrder {
    int nM, nN, nwg, G, c, wgm;
    __host__ __device__ void init(int M, int N, int G_, int c_, int wgm_ = 8) { nM = M / BM; nN = N / BM; nwg = nM * nN; G = G_; c = c_; wgm = wgm_; }
    __host__ __device__ bool next(int i, Unit& u) const {
        const long L = (long)i * G + c; if (L >= nwg) return false;
        int wgid = (int)L; { const int q = nwg / NXCD, r = nwg % NXCD, xcd = wgid % NXCD, off = wgid / NXCD; wgid = (xcd < r ? xcd * (q + 1) : r * (q + 1) + (xcd - r) * q) + off; }
        const int nig = wgm * nN, gid = wgid / nig, fm = gid * wgm, gsz = (nM - fm) < wgm ? (nM - fm) : wgm;
        u.pm = fm + ((wgid % nig) % gsz); u.pn = (wgid % nig) / gsz; return true;
    }
    __device__ __forceinline__ void a_ready(const Unit&) const {}
    __device__ __forceinline__ void done(const Unit&) const {}
};

typedef __bf16 bf16x2_cvt __attribute__((ext_vector_type(2)));
typedef float f32x2_cvt __attribute__((ext_vector_type(2)));
__device__ __forceinline__ unsigned cvt_pk_bf16(float lo, float hi) { const f32x2_cvt v = {lo, hi}; const bf16x2_cvt b = __builtin_convertvector(v, bf16x2_cvt); return __builtin_bit_cast(unsigned, b); }
__device__ __forceinline__ float sigmoid_f(float x) { return __builtin_amdgcn_rcpf(1.f + __builtin_amdgcn_exp2f(-1.4426950409f * x)); }
__device__ __forceinline__ float gelu_tanh_f(float x) { const float u = x * (-2.3022081985f - 0.10294324f * (x * x)); return x * __builtin_amdgcn_rcpf(1.f + __builtin_amdgcn_exp2f(u)); }
__device__ __forceinline__ float bflo(unsigned w) { return __builtin_bit_cast(float, w << 16); }
__device__ __forceinline__ float bfhi(unsigned w) { return __builtin_bit_cast(float, w & 0xffff0000u); }
template <int MODE> struct Epi {
    static constexpr bool PERM = true, AFTER_DRAIN = false, HOOK = false;
    bf16_t* Ob; float* Of; const bf16_t* G; float* SS; int ldc;
    bf16_t *s0, *s1, *s2, *s3, *s4, *s5;
    template <int ACT> __device__ __forceinline__ void act_store(const f32x4 (&acc)[2][2][4][2], bf16_t* base, int ld, int row0, int col0, int fq) const {
#pragma unroll
        for (int ai = 0; ai < 2; ++ai)
#pragma unroll
            for (int m = 0; m < 4; ++m) {
                const int row = row0 + ai * HALF + m * 16; bf16_t* rowp = base + (size_t)row * ld + col0; float ss = 0.f;
#pragma unroll
                for (int bj = 0; bj < 2; ++bj) {
                    f32x4 v0 = acc[ai][bj][m][0], v1 = acc[ai][bj][m][1];
                    if constexpr (ACT == 2) {
#pragma unroll
                        for (int j = 0; j < 4; ++j) { v0[j] = sigmoid_f(v0[j]); v1[j] = sigmoid_f(v1[j]); }
                    } else if constexpr (ACT == 1 || ACT == 3) {
#pragma unroll
                        for (int j = 0; j < 4; ++j) { v0[j] = gelu_tanh_f(v0[j]); v1[j] = gelu_tanh_f(v1[j]); }
                    }
                    if constexpr (ACT == 3) {
#pragma unroll
                        for (int j = 0; j < 4; ++j) ss += v0[j] * v0[j] + v1[j] * v1[j];
                    }
                    u32x4 w; w.x = cvt_pk_bf16(v0[0], v0[1]); w.y = cvt_pk_bf16(v0[2], v0[3]); w.z = cvt_pk_bf16(v1[0], v1[1]); w.w = cvt_pk_bf16(v1[2], v1[3]);
                    *(u32x4*)(rowp + bj * HALF) = w;
                }
                if constexpr (ACT == 3) { ss += __shfl_xor(ss, 16); ss += __shfl_xor(ss, 32); if (fq == 0) atomicAdd(SS + row, ss); }
            }
    }
    __device__ __forceinline__ void operator()(const f32x4 (&acc)[2][2][4][2], const Unit& u, int wr, int wc, int fr, int fq) const {
        const int row0 = u.pm * BM + wr * 64 + fr;
        if constexpr (MODE == 1) {
            const int t = u.pn >> 2;
            bf16_t* base = t == 0 ? s0 : t == 1 ? s1 : t == 2 ? s2 : t == 3 ? s3 : t == 4 ? s4 : s5;
            const int ld = (t == 0 || t == 3) ? 2048 : 1024;
            const int col0 = (u.pn & 3) * BM + wc * 32 + 8 * fq;
            if (t >= 4) act_store<2>(acc, base, ld, row0, col0, fq);
            else if (t == 2) act_store<0>(acc, base, ld, row0, col0, fq);
            else if (t == 1) act_store<3>(acc, base, ld, row0, col0, fq);
            else act_store<1>(acc, base, ld, row0, col0, fq);
        } else {
            const int col0 = u.pn * BM + wc * 32 + 8 * fq;
#pragma unroll
            for (int ai = 0; ai < 2; ++ai)
#pragma unroll
                for (int m = 0; m < 4; ++m) {
                    const int row = row0 + ai * HALF + m * 16; float ss = 0.f;
#pragma unroll
                    for (int bj = 0; bj < 2; ++bj) {
                        f32x4 v0 = acc[ai][bj][m][0], v1 = acc[ai][bj][m][1];
                        const size_t off = (size_t)row * ldc + col0 + bj * HALF;
                        if constexpr (MODE == 2 || MODE == 3) {
                            const u32x4 g = *(const u32x4*)(G + off);
                            v0[0] *= bflo(g.x); v0[1] *= bfhi(g.x); v0[2] *= bflo(g.y); v0[3] *= bfhi(g.y);
                            v1[0] *= bflo(g.z); v1[1] *= bfhi(g.z); v1[2] *= bflo(g.w); v1[3] *= bfhi(g.w);
                        }
                        if constexpr (MODE == 3) { v0 = v0 + *(const f32x4*)(Of + off); v1 = v1 + *(const f32x4*)(Of + off + 4); }
                        if constexpr (MODE == 5) {
#pragma unroll
                            for (int j = 0; j < 4; ++j) { const float a = fmaxf(v0[j], 0.f), b = fmaxf(v1[j], 0.f); v0[j] = a * a; v1[j] = b * b; }
                        }
                        if constexpr (MODE == 4) {
#pragma unroll
                            for (int j = 0; j < 4; ++j) ss += v0[j] * v0[j] + v1[j] * v1[j];
                        }
                        if constexpr (MODE == 2 || MODE == 4) { *(f32x4*)(Of + off) = v0; *(f32x4*)(Of + off + 4) = v1; }
                        else { u32x4 w; w.x = cvt_pk_bf16(v0[0], v0[1]); w.y = cvt_pk_bf16(v0[2], v0[3]); w.z = cvt_pk_bf16(v1[0], v1[1]); w.w = cvt_pk_bf16(v1[2], v1[3]);
                            *(u32x4*)(Ob + off) = w; }
                    }
                    if constexpr (MODE == 4) { ss += __shfl_xor(ss, 16); ss += __shfl_xor(ss, 32); if (fq == 0) atomicAdd(SS + row, ss); }
                }
        }
    }
};

struct EpiMerge {
    static constexpr bool PERM = true, AFTER_DRAIN = false, HOOK = true;
    bf16_t* Ob; const bf16_t* GA; const bf16_t* GB;
    __device__ __forceinline__ void mid(f32x4 (&acc)[2][2][4][2], const Unit& u, int wr, int wc, int fr, int fq) const {
        int row0 = u.pm * BM + wr * 64 + fr, col0 = u.pn * BM + wc * 32 + 8 * fq;
        asm volatile("" : "+v"(row0), "+v"(col0));
#pragma unroll
        for (int ai = 0; ai < 2; ++ai)
#pragma unroll
            for (int m = 0; m < 4; ++m) {
                if ((m & 1) == 0) asm volatile("" ::: "memory");
#pragma unroll
                for (int bj = 0; bj < 2; ++bj) {
                    const size_t off = (size_t)(row0 + ai * HALF + m * 16) * 1024 + col0 + bj * HALF;
                    const u32x4 a = *(const u32x4*)(GA + off), b = *(const u32x4*)(GB + off);
                    f32x4 r0, r1;
                    r0[0] = bflo(a.x) * __builtin_amdgcn_rcpf(fmaxf(bflo(b.x), 1e-30f)); r0[1] = bfhi(a.x) * __builtin_amdgcn_rcpf(fmaxf(bfhi(b.x), 1e-30f));
                    r0[2] = bflo(a.y) * __builtin_amdgcn_rcpf(fmaxf(bflo(b.y), 1e-30f)); r0[3] = bfhi(a.y) * __builtin_amdgcn_rcpf(fmaxf(bfhi(b.y), 1e-30f));
                    r1[0] = bflo(a.z) * __builtin_amdgcn_rcpf(fmaxf(bflo(b.z), 1e-30f)); r1[1] = bfhi(a.z) * __builtin_amdgcn_rcpf(fmaxf(bfhi(b.z), 1e-30f));
                    r1[2] = bflo(a.w) * __builtin_amdgcn_rcpf(fmaxf(bflo(b.w), 1e-30f)); r1[3] = bfhi(a.w) * __builtin_amdgcn_rcpf(fmaxf(bfhi(b.w), 1e-30f));
                    acc[ai][bj][m][0] = acc[ai][bj][m][0] * r0; acc[ai][bj][m][1] = acc[ai][bj][m][1] * r1;
                }
            }
    }
    __device__ __forceinline__ void operator()(const f32x4 (&acc)[2][2][4][2], const Unit& u, int wr, int wc, int fr, int fq) const {
        const int row0 = u.pm * BM + wr * 64 + fr, col0 = u.pn * BM + wc * 32 + 8 * fq;
#pragma unroll
        for (int ai = 0; ai < 2; ++ai) {
            u32x4 gb[4][2];
#pragma unroll
            for (int m = 0; m < 4; ++m)
#pragma unroll
                for (int bj = 0; bj < 2; ++bj) gb[m][bj] = *(const u32x4*)(GB + (size_t)(row0 + ai * HALF + m * 16) * 1024 + col0 + bj * HALF);
#pragma unroll
            for (int m = 0; m < 4; ++m)
#pragma unroll
                for (int bj = 0; bj < 2; ++bj) {
                    const size_t off = (size_t)(row0 + ai * HALF + m * 16) * 1024 + col0 + bj * HALF;
                    const u32x4 b = gb[m][bj];
                    const f32x4 v0 = acc[ai][bj][m][0], v1 = acc[ai][bj][m][1];
                    u32x4 w; w.x = cvt_pk_bf16(v0[0] * bflo(b.x), v0[1] * bfhi(b.x)); w.y = cvt_pk_bf16(v0[2] * bflo(b.y), v0[3] * bfhi(b.y));
                    w.z = cvt_pk_bf16(v1[0] * bflo(b.z), v1[1] * bfhi(b.z)); w.w = cvt_pk_bf16(v1[2] * bflo(b.w), v1[3] * bfhi(b.w));
                    *(u32x4*)(Ob + off) = w;
                }
        }
    }
};

template <class Epi, class Sched, bool ALIGN_EPI = false, bool SP2 = false>
__device__ __forceinline__ void gemm_phase(PG8_LAS unsigned char* lds, const Gemm g, const Sched& S, const Epi& E) {
    const int tid = threadIdx.x, wid = __builtin_amdgcn_readfirstlane(tid >> 6), lane = tid & 63, wr = wid >> 2, wc = wid & 3, fr = lane & 15, fq = lane >> 4;
    const int K = g.K, nt = K / BK;
    unsigned voffA[2], voffB[2];
#pragma unroll
    for (int i = 0; i < 2; ++i) { int R, C; stage_rc(tid * 16 + i * 8192, R, C); const int Rb = Epi::PERM ? ((R & ~31) + perm32(R & 31)) : R;
        voffA[i] = (unsigned)(R * K + C) * 2u; voffB[i] = (unsigned)(Rb * K + C) * 2u; }
    const size_t kstep = (size_t)(BK * 2);
    const size_t hstep = (size_t)HALF * K * 2;
    const size_t tstep = 2 * hstep;
    const unsigned ldsw = (unsigned)wid * 1024u;
    const int aoff = lds_byte(wr * 64 + fr, fq * 8), boff = lds_byte(wc * 32 + fr, fq * 8);
#define PG8_SA(b, h) (((b) * 2 + (h)) * HTB)
#define PG8_SB(b, h) ((4 + (b) * 2 + (h)) * HTB)
#define PG8_STAGE(bufoff, gbase, voff) do { _Pragma("unroll") for (int _i = 0; _i < 2; ++_i) \
        __builtin_amdgcn_global_load_lds((const unsigned*)((const char*)(gbase) + (voff)[_i]), (PG8_LAS unsigned*)(lds + (bufoff) + ldsw + _i * 8192), 16, 0, 0); } while (0)
#define PG8_LDA(dst, b, h) do { _Pragma("unroll") for (int m = 0; m < 4; ++m) _Pragma("unroll") for (int k = 0; k < 2; ++k) dst[m][k] = *(const PG8_LAS bf16x8*)(lds + PG8_SA(b, h) + aoff + m * 2048 + k * 1024); } while (0)
#define PG8_LDB(dst, b, h) do { _Pragma("unroll") for (int n = 0; n < 2; ++n) _Pragma("unroll") for (int k = 0; k < 2; ++k) dst[n][k] = *(const PG8_LAS bf16x8*)(lds + PG8_SB(b, h) + boff + n * 2048 + k * 1024); } while (0)
#define PG8_MMA(ai, bj, At, Bt) do { __builtin_amdgcn_s_setprio(1); _Pragma("unroll") for (int m = 0; m < 4; ++m) _Pragma("unroll") for (int n = 0; n < 2; ++n) _Pragma("unroll") for (int k = 0; k < 2; ++k) \
        acc[ai][bj][m][n] = __builtin_amdgcn_mfma_f32_16x16x32_bf16(Bt[n][k], At[m][k], acc[ai][bj][m][n], 0, 0, 0); __builtin_amdgcn_s_setprio(0); } while (0)
#define PG8_WAIT_V(n) asm volatile("s_waitcnt vmcnt(" #n ")" ::: "memory")
#define PG8_WAIT_L(n) asm volatile("s_waitcnt lgkmcnt(" #n ")" ::: "memory")
#define PG8_BAR __builtin_amdgcn_s_barrier()
#define PG8_SCHED __builtin_amdgcn_sched_barrier(0)
    Unit cur, nxt; int ui = 0;
    if (!S.next(0, cur)) return;
    f32x4 acc[2][2][4][2];
#pragma unroll
    for (int a = 0; a < 2; ++a)
#pragma unroll
        for (int b = 0; b < 2; ++b)
#pragma unroll
            for (int m = 0; m < 4; ++m)
#pragma unroll
                for (int n = 0; n < 2; ++n) acc[a][b][m][n] = (f32x4){0.f, 0.f, 0.f, 0.f};
    bf16x8 At[4][2], B0[2][2], B1[2][2];
    const char* cA = (const char*)g.A + (size_t)cur.pm * tstep; const char* cB = (const char*)g.Bt + (size_t)cur.pn * tstep;
    S.a_ready(cur);
    if constexpr (SP2) {
        PG8_STAGE(PG8_SB(0, 0), cB, voffB); PG8_STAGE(PG8_SB(0, 1), cB + hstep, voffB); PG8_STAGE(PG8_SA(0, 0), cA, voffA); PG8_STAGE(PG8_SA(0, 1), cA + hstep, voffA);
        if (wr == 1) PG8_BAR;
        PG8_WAIT_V(2); PG8_BAR;
        PG8_STAGE(PG8_SB(1, 0), cB + kstep, voffB); PG8_STAGE(PG8_SA(1, 0), cA + kstep, voffA); PG8_STAGE(PG8_SB(1, 1), cB + hstep + kstep, voffB);
        PG8_WAIT_V(6); PG8_BAR;
    } else {
        PG8_STAGE(PG8_SB(0, 0), cB, voffB); PG8_STAGE(PG8_SA(0, 0), cA, voffA); PG8_STAGE(PG8_SB(0, 1), cB + hstep, voffB); PG8_STAGE(PG8_SA(0, 1), cA + hstep, voffA);
        if (wr == 1) PG8_BAR;
        PG8_WAIT_V(4); PG8_BAR;
        PG8_STAGE(PG8_SB(1, 0), cB + kstep, voffB); PG8_STAGE(PG8_SA(1, 0), cA + kstep, voffA); PG8_STAGE(PG8_SB(1, 1), cB + hstep + kstep, voffB);
        PG8_WAIT_V(6); PG8_BAR;
    }
    for (;;) {
        const bool has_next = S.next(ui + 1, nxt);
        const char* nA = has_next ? (const char*)g.A + (size_t)nxt.pm * tstep : cA; const char* nB = has_next ? (const char*)g.Bt + (size_t)nxt.pn * tstep : cB;
        for (int t = 0; t < nt; t += 2) {
            if constexpr (Epi::HOOK) { if (t == (nt >> 1)) E.mid(acc, cur, wr, wc, fr, fq); }
            const bool last = (t == nt - 2);
            const char* a1 = cA + (size_t)(t + 1) * kstep;
            const char* a2 = last ? nA : cA + (size_t)(t + 2) * kstep; const char* b2 = last ? nB : cB + (size_t)(t + 2) * kstep;
            const char* a3 = a2 + kstep; const char* b3 = b2 + kstep;
            if (last && has_next) S.a_ready(nxt);
            if constexpr (SP2) {
            PG8_LDB(B0, 0, 0); PG8_LDB(B1, 0, 1); PG8_SCHED; PG8_LDA(At, 0, 0); PG8_STAGE(PG8_SA(1, 1), a1 + hstep, voffA);
            PG8_WAIT_V(8); PG8_WAIT_L(0); PG8_BAR; PG8_MMA(0, 0, At, B0); PG8_MMA(0, 1, At, B1); PG8_BAR; PG8_SCHED;
            PG8_LDA(At, 0, 1); PG8_STAGE(PG8_SB(0, 0), b2, voffB); PG8_STAGE(PG8_SB(0, 1), b2 + hstep, voffB); PG8_STAGE(PG8_SA(0, 0), a2, voffA);
            PG8_WAIT_V(8); PG8_WAIT_L(0); PG8_BAR; PG8_MMA(1, 0, At, B0); PG8_MMA(1, 1, At, B1); PG8_BAR; PG8_SCHED;
            PG8_LDB(B0, 1, 0); PG8_LDB(B1, 1, 1); PG8_SCHED; PG8_LDA(At, 1, 0); PG8_STAGE(PG8_SA(0, 1), a2 + hstep, voffA);
            PG8_WAIT_V(8); PG8_WAIT_L(0); PG8_BAR; PG8_MMA(0, 0, At, B0); PG8_MMA(0, 1, At, B1); PG8_BAR; PG8_SCHED;
            PG8_LDA(At, 1, 1); PG8_STAGE(PG8_SB(1, 0), b3, voffB); PG8_STAGE(PG8_SB(1, 1), b3 + hstep, voffB); PG8_STAGE(PG8_SA(1, 0), a3, voffA);
            PG8_WAIT_V(8); PG8_WAIT_L(0); PG8_BAR; PG8_MMA(1, 0, At, B0); PG8_MMA(1, 1, At, B1); PG8_BAR; PG8_SCHED;
            } else {
            PG8_LDB(B0, 0, 0); PG8_SCHED; PG8_LDA(At, 0, 0); PG8_STAGE(PG8_SA(1, 1), a1 + hstep, voffA);
            PG8_WAIT_L(8); PG8_BAR; PG8_WAIT_L(0); PG8_MMA(0, 0, At, B0); PG8_BAR; PG8_SCHED;
            PG8_LDB(B1, 0, 1); PG8_STAGE(PG8_SB(0, 0), b2, voffB);
            PG8_BAR; PG8_WAIT_L(0); PG8_MMA(0, 1, At, B1); PG8_BAR;
            PG8_LDA(At, 0, 1); PG8_STAGE(PG8_SA(0, 0), a2, voffA);
            PG8_BAR; PG8_WAIT_L(0); PG8_MMA(1, 0, At, B0); PG8_BAR; PG8_SCHED;
            PG8_STAGE(PG8_SB(0, 1), b2 + hstep, voffB);
            PG8_WAIT_V(6); PG8_BAR; PG8_MMA(1, 1, At, B1); PG8_BAR;
            PG8_LDB(B0, 1, 0); PG8_SCHED; PG8_LDA(At, 1, 0); PG8_STAGE(PG8_SA(0, 1), a2 + hstep, voffA);
            PG8_WAIT_L(8); PG8_BAR; PG8_WAIT_L(0); PG8_MMA(0, 0, At, B0); PG8_BAR; PG8_SCHED;
            PG8_LDB(B1, 1, 1); PG8_STAGE(PG8_SB(1, 0), b3, voffB);
            PG8_BAR; PG8_WAIT_L(0); PG8_MMA(0, 1, At, B1); PG8_BAR;
            PG8_LDA(At, 1, 1); PG8_STAGE(PG8_SA(1, 0), a3, voffA);
            PG8_BAR; PG8_WAIT_L(0); PG8_MMA(1, 0, At, B0); PG8_BAR; PG8_SCHED;
            PG8_STAGE(PG8_SB(1, 1), b3 + hstep, voffB);
            PG8_WAIT_V(6); PG8_BAR; PG8_MMA(1, 1, At, B1); PG8_BAR;
            }
        }
        if constexpr (ALIGN_EPI) { if (wr == 0) PG8_BAR; }
        if constexpr (!Epi::AFTER_DRAIN) { E(acc, cur, wr, wc, fr, fq); S.done(cur); }
        if (!has_next) break;
#pragma unroll
        for (int a = 0; a < 2; ++a)
#pragma unroll
            for (int b = 0; b < 2; ++b)
#pragma unroll
                for (int m = 0; m < 4; ++m)
#pragma unroll
                    for (int n = 0; n < 2; ++n) acc[a][b][m][n] = (f32x4){0.f, 0.f, 0.f, 0.f};
        cur = nxt; cA = nA; cB = nB; ++ui;
        if constexpr (ALIGN_EPI) { if (wr == 1) PG8_BAR; }
    }
    PG8_WAIT_V(0);
    if constexpr (!ALIGN_EPI) { if (wr == 0) PG8_BAR; }
    PG8_BAR;
    if constexpr (Epi::AFTER_DRAIN) { E.fused(acc, cur, wr, wc, fr, fq, lds, wid, lane); S.done(cur); }
#undef PG8_SA
#undef PG8_SB
#undef PG8_STAGE
#undef PG8_LDA
#undef PG8_LDB
#undef PG8_MMA
#undef PG8_WAIT_V
#undef PG8_WAIT_L
#undef PG8_BAR
#undef PG8_SCHED
}
}

constexpr int NWAVES = 8, NTHR = NWAVES * 64;
constexpr int D = 1024, M = 16384, MCTX = 8192, INC = 6144, FF = 4096;
constexpr float EPS = 1e-6f, LOG2E = 1.4426950408889634f;
constexpr size_t MiB = 1u << 20;
constexpr size_t WS_CTL = 0, CTL_ZERO_BYTES = 1 * MiB;
constexpr size_t CTL_VSS = 64 * 1024, CTL_OSS = 128 * 1024, CTL_FSS = 192 * 1024, CTL_MOD = 256 * 1024, CTL_XSS = 384 * 1024;
constexpr size_t CTL_MODCNT = 14 * 1024;
constexpr size_t CTL_AGGCNT = 14 * 1024 + 256;
constexpr size_t CTL_CNT = 16 * 1024;
constexpr size_t WS_GC = 1 * MiB;
constexpr size_t WS_AGG = 2 * MiB;
constexpr size_t WS_CAR = 4 * MiB;
constexpr size_t WS_WG = 5 * MiB;
constexpr size_t WS_WSP = 5 * MiB + 512 * 1024;
constexpr size_t WS_WFF2 = 6 * MiB, WS_WFF1 = 14 * MiB, WS_WIN = 22 * MiB, WS_WBG = 34 * MiB, WS_WBR = 36 * MiB, WS_WOUT = 38 * MiB;
constexpr size_t WS_H = 40 * MiB;
constexpr size_t WS_F = 64 * MiB;
constexpr size_t WS_GU = 128 * MiB, WS_GGR = 160 * MiB, WS_SGA = 192 * MiB, WS_SGB = 224 * MiB;
constexpr size_t WS_F1 = 128 * MiB;
constexpr size_t WS_END = 256 * MiB;
constexpr int LDS_BYTES = 147456, LDS_BAR_OFF = 139264;
#ifndef WG_IN
#define WG_IN 4
#endif
#ifndef WG_FF1
#define WG_FF1 2
#endif
#ifndef DUP
#define DUP 0
#endif

#define GAS __attribute__((address_space(1)))
#define LAS __attribute__((address_space(3)))
typedef unsigned short bf16;
typedef unsigned v4u __attribute__((ext_vector_type(4)));
typedef unsigned v2u __attribute__((ext_vector_type(2)));
typedef float f32x4 __attribute__((ext_vector_type(4)));
typedef float f32x2 __attribute__((ext_vector_type(2)));
typedef short bf16x8 __attribute__((ext_vector_type(8)));
#define LDS_WAIT() asm volatile("s_waitcnt lgkmcnt(0)" ::: "memory")
__device__ __forceinline__ unsigned f2bf(float f) { unsigned u = __builtin_bit_cast(unsigned, f); return (u + 0x7fffu + ((u >> 16) & 1u)) >> 16; }
__device__ __forceinline__ unsigned pk2(float lo, float hi) { return pg8::cvt_pk_bf16(lo, hi); }
__device__ __forceinline__ float bf2f(bf16 b) { return __builtin_bit_cast(float, (unsigned)b << 16); }
using pg8::bflo; using pg8::bfhi;

struct Args { const float* in[27]; float* out; unsigned char* ws; int ph_lo, ph_hi; };
enum { I_XP = 0, I_XS, I_STATE, I_C, I_CCTX, I_WADA, I_BADA, I_GPREMIX, I_GPOSTMIX, I_GPREMLP, I_GPOSTMLP, I_WIN, I_GSGU, I_WSP, I_BSP, I_CONVW, I_CONVB,
       I_WRA, I_BRA, I_WRI, I_BRI, I_LAM, I_WBRG, I_WBRR, I_WOUT, I_WFF1, I_WFF2 };

__device__ __forceinline__ float wave_sum(float v) {
#pragma unroll
    for (int o = 1; o < 64; o <<= 1) v += __shfl_xor(v, o);
    return v;
}
__device__ __forceinline__ void p0_transpose_item(const float* W, int K, int N, bf16* WT, LAS float* scr, int item, int lane, int ldk = 0, int koff = 0) {
    if (ldk == 0) ldk = K;
    const int nblk = N / 32, kb = item / nblk, nb = item % nblk, k0 = 64 * kb, n0 = 32 * nb;
#pragma unroll
    for (int i = 0; i < 8; ++i) { const int kk = 8 * i + (lane >> 3);
        const f32x4 v = *(const f32x4*)(W + (size_t)(k0 + kk) * N + n0 + (lane & 7) * 4);
        LAS float* dd = scr + kk * 33 + (lane & 7) * 4; dd[0] = v[0]; dd[1] = v[1]; dd[2] = v[2]; dd[3] = v[3]; }
    LDS_WAIT(); asm volatile("" ::: "memory");
    const int c = lane & 7;
#pragma unroll
    for (int j = 0; j < 4; ++j) { const int n = (lane >> 3) + 8 * j; const LAS float* s = scr + (8 * c) * 33 + n;
        v4u o; o.x = pk2(s[0 * 33], s[1 * 33]); o.y = pk2(s[2 * 33], s[3 * 33]); o.z = pk2(s[4 * 33], s[5 * 33]); o.w = pk2(s[6 * 33], s[7 * 33]);
        *(v4u*)(WT + (size_t)(n0 + n) * ldk + koff + k0 + 8 * c) = o; }
    LDS_WAIT(); asm volatile("" ::: "memory");
}

__device__ __forceinline__ void phase_prep(const Args& a, LAS unsigned char* lds, int gw, int NGW, int wave, int lane, float* MOD) {
    unsigned char* ws = a.ws;
    LAS float* scr = (LAS float*)(lds + wave * 16384);
    if ((int)blockIdx.x < 192) {
        const float* wada = a.in[I_WADA]; const float* cctx = a.in[I_CCTX]; const float* cc = a.in[I_C];
        const int nb = blockIdx.x % 24, ksl = blockIdx.x / 24, n = nb * 256 + lane * 4, kbase = ksl * 128 + wave * 16;
        f32x4 a0 = {0.f, 0.f, 0.f, 0.f}, a1 = a0, a2 = a0;
#pragma unroll
        for (int kk = 0; kk < 16; ++kk) {
            const int k = kbase + kk;
            const f32x4 w = *(const f32x4*)(wada + (size_t)k * INC + n);
            const float c0 = cctx[k], c1 = cc[k], c2 = cc[D + k];
            const float s0 = c0 * pg8::sigmoid_f(c0), s1 = c1 * pg8::sigmoid_f(c1), s2 = c2 * pg8::sigmoid_f(c2);
            a0 += w * s0; a1 += w * s1; a2 += w * s2;
        }
        LAS float* red = (LAS float*)lds;
        *(LAS f32x4*)(red + (wave * 3 + 0) * 256 + lane * 4) = a0; *(LAS f32x4*)(red + (wave * 3 + 1) * 256 + lane * 4) = a1; *(LAS f32x4*)(red + (wave * 3 + 2) * 256 + lane * 4) = a2;
        __syncthreads();
        const int tid = wave * 64 + lane;
        if (tid < 192) {
            const int v = tid >> 6, c4 = (tid & 63) * 4;
            f32x4 sum = {0.f, 0.f, 0.f, 0.f};
#pragma unroll
            for (int w2 = 0; w2 < 8; ++w2) sum += *(const LAS f32x4*)(red + (w2 * 3 + v) * 256 + c4);
#pragma unroll
            for (int j = 0; j < 4; ++j) atomicAdd(MOD + v * INC + nb * 256 + c4 + j, sum[j]);
        }
        asm volatile("s_waitcnt vmcnt(0)" ::: "memory");
        __syncthreads();
        if (threadIdx.x == 0) __hip_atomic_fetch_add((unsigned*)(ws + CTL_MODCNT), 1u, __ATOMIC_RELAXED, __HIP_MEMORY_SCOPE_AGENT);
    }
    constexpr int I_IN = 16 * (INC / 32), I_SQ = 16 * (D / 32), I_F1 = 16 * (FF / 32), I_F2 = (FF / 64) * (D / 32);
    constexpr int NT = I_IN + 3 * I_SQ + I_F1 + I_F2;
    for (int it = gw; it < NT; it += NGW) {
        int r = it;
        if (r < I_IN) { p0_transpose_item(a.in[I_WIN], D, INC, (bf16*)(ws + WS_WIN), scr, r, lane); continue; } r -= I_IN;
        if (r < I_SQ) { p0_transpose_item(a.in[I_WBRG], D, D, (bf16*)(ws + WS_WBG), scr, r, lane, 2 * D, 0); continue; } r -= I_SQ;
        if (r < I_SQ) { p0_transpose_item(a.in[I_WBRR], D, D, (bf16*)(ws + WS_WBG), scr, r, lane, 2 * D, D); continue; } r -= I_SQ;
        if (r < I_SQ) { p0_transpose_item(a.in[I_WOUT], D, D, (bf16*)(ws + WS_WOUT), scr, r, lane); continue; } r -= I_SQ;
        if (r < I_F1) { p0_transpose_item(a.in[I_WFF1], D, FF, (bf16*)(ws + WS_WFF1), scr, r, lane); continue; } r -= I_F1;
        p0_transpose_item(a.in[I_WFF2], FF, D, (bf16*)(ws + WS_WFF2), scr, r, lane);
    }
    {
        const bool few = gridDim.x > 192;
        if (few && blockIdx.x < 192) return;
        const int gt = few ? ((int)blockIdx.x - 192) * NTHR + wave * 64 + lane : gw * 64 + lane, NGT = few ? ((int)gridDim.x - 192) * NTHR : NGW * 64;
        bf16* WG = (bf16*)(ws + WS_WG);
        for (int it = gt; it < 16 * 16 * 2 * 64; it += NGT) {
            const int ln = it & 63, ks = (it >> 6) & 1, cbi = (it >> 7) & 15, h = it >> 11;
            const int fr = ln & 15, fq = ln >> 4, type = cbi >> 3, d = (cbi >> 2) & 1, cb = cbi & 3;
            const float* W = type ? a.in[I_WRI] : a.in[I_WRA];
            const float* src = W + ((size_t)(d * 16 + h) * 64 + ks * 32 + fq * 8) * 64 + cb * 16 + fr;
            v4u o; o.x = pk2(-LOG2E * src[0], -LOG2E * src[64]); o.y = pk2(-LOG2E * src[128], -LOG2E * src[192]);
            o.z = pk2(-LOG2E * src[256], -LOG2E * src[320]); o.w = pk2(-LOG2E * src[384], -LOG2E * src[448]);
            *(v4u*)(WG + (size_t)it * 8) = o;
        }
        bf16* WSP = (bf16*)(ws + WS_WSP); const float* wsp = a.in[I_WSP];
        for (int it = gt; it < 8 * 128 * 128 / 8; it += NGT) {
            const f32x4 x0 = *(const f32x4*)(wsp + (size_t)it * 8), x1 = *(const f32x4*)(wsp + (size_t)it * 8 + 4);
            v4u o; o.x = pk2(x0[0], x0[1]); o.y = pk2(x0[2], x0[3]); o.z = pk2(x1[0], x1[1]); o.w = pk2(x1[2], x1[3]);
            *(v4u*)(WSP + (size_t)it * 8) = o;
        }
        float* GC = (float*)(ws + WS_GC);
        for (int it = gt; it < 2048; it += NGT) {
            const float lamv = a.in[I_LAM][it]; const float sp = log1pf(expf(-lamv));
            f32x4 o; o[0] = exp2f(-LOG2E * a.in[I_BRA][it]); o[1] = exp2f(-LOG2E * a.in[I_BRI][it]); o[2] = -8.f * sp * LOG2E; o[3] = 0.f;
            *(f32x4*)(GC + (size_t)it * 4) = o;
        }
    }
}

__device__ __forceinline__ f32x4 modv(const float* MOD, const float* bada, int cv, int part, int c) {
    return *(const f32x4*)(MOD + cv * INC + part * D + c) + *(const f32x4*)(bada + part * D + c);
}
__device__ __forceinline__ int cv_of(int m) { return m < MCTX ? 0 : (m < MCTX + 4096 ? 1 : 2); }
__device__ __forceinline__ const float* xrow_of(const Args& a, int m) { return m < MCTX ? a.in[I_XP] + (size_t)m * D : a.in[I_XS] + (size_t)(m - MCTX) * D; }
__device__ __forceinline__ void store_bf4(bf16* p, f32x4 v) { v2u o; o.x = pk2(v[0], v[1]); o.y = pk2(v[2], v[3]); *(v2u*)p = o; }

__device__ __forceinline__ void phase_norm1(const Args& a, int gw, int NGW, int lane) {
    const float* MOD = (const float*)(a.ws + CTL_MOD); const float* bada = a.in[I_BADA]; const float* g = a.in[I_GPREMIX];
    bf16* H = (bf16*)(a.ws + WS_H);
    const int RPW = M / NGW;
    if (RPW * NGW == M && (MCTX % RPW) == 0 && (4096 % RPW) == 0) {
        const int m0 = gw * RPW, cv = cv_of(m0);
        f32x4 cc[4], sh[4];
#pragma unroll
        for (int j = 0; j < 4; ++j) { const int c = 4 * lane + 256 * j; cc[j] = *(const f32x4*)(g + c) * (modv(MOD, bada, cv, 1, c) + 1.f); sh[j] = modv(MOD, bada, cv, 0, c); }
        for (int m = m0; m < m0 + RPW; ++m) {
            const float* xr = xrow_of(a, m);
            f32x4 v[4]; float s = 0.f;
#pragma unroll
            for (int j = 0; j < 4; ++j) { v[j] = *(const f32x4*)(xr + 4 * lane + 256 * j); s += (v[j][0] * v[j][0] + v[j][1] * v[j][1]) + (v[j][2] * v[j][2] + v[j][3] * v[j][3]); }
            const float rstd = rsqrtf(wave_sum(s) * (1.f / D) + EPS);
#pragma unroll
            for (int j = 0; j < 4; ++j) store_bf4(H + (size_t)m * D + 4 * lane + 256 * j, v[j] * rstd * cc[j] + sh[j]);
        }
        return;
    }
    for (int m = gw; m < M; m += NGW) {
        const float* xr = xrow_of(a, m); const int cv = cv_of(m);
        f32x4 v[4]; float s = 0.f;
#pragma unroll
        for (int j = 0; j < 4; ++j) { v[j] = *(const f32x4*)(xr + 4 * lane + 256 * j); s += (v[j][0] * v[j][0] + v[j][1] * v[j][1]) + (v[j][2] * v[j][2] + v[j][3] * v[j][3]); }
        const float rstd = rsqrtf(wave_sum(s) * (1.f / D) + EPS);
#pragma unroll
        for (int j = 0; j < 4; ++j) { const int c = 4 * lane + 256 * j;
            const f32x4 gg = *(const f32x4*)(g + c), sh = modv(MOD, bada, cv, 0, c), sc = modv(MOD, bada, cv, 1, c);
            store_bf4(H + (size_t)m * D + c, v[j] * rstd * gg * (sc + 1.f) + sh); }
    }
}
__device__ __forceinline__ void phase_mid(const Args& a, int gw, int NGW, int lane, float* xout, bf16* H) {
    const float* MOD = (const float*)(a.ws + CTL_MOD); const float* bada = a.in[I_BADA];
    const float* gpm = a.in[I_GPOSTMIX]; const float* gpl = a.in[I_GPREMLP]; const float* OSS = (const float*)(a.ws + CTL_OSS);
    const float* out = a.out;
    for (int m = gw; m < M; m += NGW) {
        const float* xr = xrow_of(a, m); const int cv = cv_of(m);
        const float rstd_o = rsqrtf(OSS[m] * (1.f / D) + EPS);
        f32x4 v[4]; float s = 0.f;
#pragma unroll
        for (int j = 0; j < 4; ++j) { const int c = 4 * lane + 256 * j;
            const f32x4 o = *(const f32x4*)(out + (size_t)m * D + c), x = *(const f32x4*)(xr + c);
            const f32x4 g1 = modv(MOD, bada, cv, 2, c), gg = *(const f32x4*)(gpm + c);
            v[j] = x + g1 * (o * rstd_o * gg);
            *(f32x4*)(xout + (size_t)m * D + c) = v[j];
            s += (v[j][0] * v[j][0] + v[j][1] * v[j][1]) + (v[j][2] * v[j][2] + v[j][3] * v[j][3]); }
        const float rstd = rsqrtf(wave_sum(s) * (1.f / D) + EPS);
#pragma unroll
        for (int j = 0; j < 4; ++j) { const int c = 4 * lane + 256 * j;
            const f32x4 gg = *(const f32x4*)(gpl + c), sh = modv(MOD, bada, cv, 3, c), sc = modv(MOD, bada, cv, 4, c);
            store_bf4(H + (size_t)m * D + c, v[j] * rstd * gg * (sc + 1.f) + sh); }
    }
}
__device__ __forceinline__ void phase_final(const Args& a, int gw, int NGW, int lane, float* yout) {
    const float* MOD = (const float*)(a.ws + CTL_MOD); const float* bada = a.in[I_BADA];
    const float* gpm = a.in[I_GPOSTMLP]; const float* FSS = (const float*)(a.ws + CTL_FSS); const float* F = (const float*)(a.ws + WS_F); const float* out = a.out;
    for (int m = gw; m < M; m += NGW) {
        const int cv = cv_of(m); const float rstd_f = rsqrtf(FSS[m] * (1.f / D) + EPS);
#pragma unroll
        for (int j = 0; j < 4; ++j) { const int c = 4 * lane + 256 * j;
            const f32x4 f = *(const f32x4*)(F + (size_t)m * D + c), x1 = *(const f32x4*)(out + (size_t)m * D + c);
            const f32x4 g2 = modv(MOD, bada, cv, 5, c), gg = *(const f32x4*)(gpm + c);
            *(f32x4*)(yout + (size_t)m * D + c) = x1 + g2 * (f * rstd_f * gg); }
    }
}

__device__ __forceinline__ void panel_sync(unsigned* cnt) {
    asm volatile("s_waitcnt vmcnt(0)" ::: "memory");
    __syncthreads();
    if (threadIdx.x == 0) {
        __hip_atomic_fetch_add(cnt, 1u, __ATOMIC_RELAXED, __HIP_MEMORY_SCOPE_AGENT);
        unsigned sp = 0;
        while (__hip_atomic_load(cnt, __ATOMIC_RELAXED, __HIP_MEMORY_SCOPE_AGENT) < 4u) { __builtin_amdgcn_s_sleep(1); if (++sp > (1u << 22)) break; }
    }
    __syncthreads();
}
__device__ __forceinline__ float ld_agent(const float* p) { return __builtin_bit_cast(float, __hip_atomic_load((const unsigned*)p, __ATOMIC_RELAXED, __HIP_MEMORY_SCOPE_AGENT)); }
__device__ __forceinline__ float sumsq4(f32x4 v) { return (v[0] * v[0] + v[1] * v[1]) + (v[2] * v[2] + v[3] * v[3]); }
template <int MODE> struct EpiFused {
    static constexpr bool PERM = true, AFTER_DRAIN = true, HOOK = false;
    float* out; const float* xp; const float* xs; bf16* H; float* SS1; float* SS2; unsigned* cnt1; unsigned* cnt2;
    const float* MOD; const float* bada; const float* gpost; const float* gpre;
    __device__ __forceinline__ void fused(f32x4 (&acc)[2][2][4][2], const pg8::Unit& u, int wr, int wc, int fr, int fq, LAS unsigned char*, int, int) const {
        const int row0 = u.pm * 256 + wr * 64 + fr, col0 = u.pn * 256 + wc * 32 + 8 * fq;
        const int cv = u.pm < 32 ? 0 : (u.pm < 48 ? 1 : 2);
#pragma unroll
        for (int ai = 0; ai < 2; ++ai)
#pragma unroll
            for (int m = 0; m < 4; ++m) {
                float ss = (sumsq4(acc[ai][0][m][0]) + sumsq4(acc[ai][0][m][1])) + (sumsq4(acc[ai][1][m][0]) + sumsq4(acc[ai][1][m][1]));
                ss += __shfl_xor(ss, 16); ss += __shfl_xor(ss, 32);
                if (fq == 0) atomicAdd(SS1 + row0 + ai * 128 + m * 16, ss);
            }
        panel_sync(cnt1 + 64 * u.pm);
        f32x4 ga[2][2];
#pragma unroll
        for (int bj = 0; bj < 2; ++bj)
#pragma unroll
            for (int n = 0; n < 2; ++n) { const int c = col0 + bj * 128 + 4 * n; ga[bj][n] = modv(MOD, bada, cv, MODE == 6 ? 2 : 5, c) * *(const f32x4*)(gpost + c); }
        float rs1[2][4];
#pragma unroll
        for (int ai = 0; ai < 2; ++ai)
#pragma unroll
            for (int m = 0; m < 4; ++m) rs1[ai][m] = ld_agent(SS1 + row0 + ai * 128 + m * 16);
#pragma unroll
        for (int ai = 0; ai < 2; ++ai)
#pragma unroll
            for (int mp = 0; mp < 4; mp += 2) {
                f32x4 xin[2][2][2];
#pragma unroll
                for (int mm = 0; mm < 2; ++mm) {
                    const int row = row0 + ai * 128 + (mp + mm) * 16;
                    const float* xrow = MODE == 6 ? (row < MCTX ? xp + (size_t)row * D : xs + (size_t)(row - MCTX) * D) : out + (size_t)row * D;
#pragma unroll
                    for (int bj = 0; bj < 2; ++bj)
#pragma unroll
                        for (int n = 0; n < 2; ++n) xin[mm][bj][n] = *(const f32x4*)(xrow + col0 + bj * 128 + 4 * n);
                }
#pragma unroll
                for (int mm = 0; mm < 2; ++mm) {
                    const int m = mp + mm, row = row0 + ai * 128 + m * 16;
                    const float rstd = rsqrtf(rs1[ai][m] * (1.f / D) + EPS);
                    float ss = 0.f;
#pragma unroll
                    for (int bj = 0; bj < 2; ++bj)
#pragma unroll
                        for (int n = 0; n < 2; ++n) { const int c = col0 + bj * 128 + 4 * n;
                            const f32x4 v = xin[mm][bj][n] + ga[bj][n] * (acc[ai][bj][m][n] * rstd);
                            *(f32x4*)(out + (size_t)row * D + c) = v; acc[ai][bj][m][n] = v; ss += sumsq4(v); }
                    if constexpr (MODE == 6) { ss += __shfl_xor(ss, 16); ss += __shfl_xor(ss, 32); if (fq == 0) atomicAdd(SS2 + row, ss); }
                }
            }
        if constexpr (MODE == 6) {
            panel_sync(cnt2 + 64 * u.pm);
            f32x4 cc[2][2], sh[2][2];
#pragma unroll
            for (int bj = 0; bj < 2; ++bj)
#pragma unroll
                for (int n = 0; n < 2; ++n) { const int c = col0 + bj * 128 + 4 * n; cc[bj][n] = *(const f32x4*)(gpre + c) * (modv(MOD, bada, cv, 4, c) + 1.f); sh[bj][n] = modv(MOD, bada, cv, 3, c); }
            float rs2[2][4];
#pragma unroll
            for (int ai = 0; ai < 2; ++ai)
#pragma unroll
                for (int m = 0; m < 4; ++m) rs2[ai][m] = ld_agent(SS2 + row0 + ai * 128 + m * 16);
#pragma unroll
            for (int ai = 0; ai < 2; ++ai)
#pragma unroll
                for (int m = 0; m < 4; ++m) {
                    const int row = row0 + ai * 128 + m * 16;
                    const float rstd = rsqrtf(rs2[ai][m] * (1.f / D) + EPS);
#pragma unroll
                    for (int bj = 0; bj < 2; ++bj) {
                        const f32x4 h0 = acc[ai][bj][m][0] * rstd * cc[bj][0] + sh[bj][0], h1 = acc[ai][bj][m][1] * rstd * cc[bj][1] + sh[bj][1];
                        v4u w; w.x = pg8::cvt_pk_bf16(h0[0], h0[1]); w.y = pg8::cvt_pk_bf16(h0[2], h0[3]); w.z = pg8::cvt_pk_bf16(h1[0], h1[1]); w.w = pg8::cvt_pk_bf16(h1[2], h1[3]);
                        *(v4u*)(H + (size_t)row * D + col0 + bj * 128) = w; }
                }
        }
    }
};

constexpr int YLD = 2048;
constexpr int SG_W = 0, SG_V = 34816, SG_U = 69632, SG_ST = 272;
__device__ __forceinline__ void sgu_load(const bf16* GV, const bf16* GU, const float* VSS, int item, int tid, v4u (&rv)[4], v4u (&ru)[4], float (&rss)[4]) {
    const int g = item & 7, t0 = (item >> 3) * 128;
#pragma unroll
    for (int i = 0; i < 4; ++i) { const int idx = tid + i * NTHR, p = idx >> 4, c8 = (idx & 15) * 8;
        rv[i] = *(const v4u*)(GV + (size_t)(t0 + p) * D + g * 128 + c8); ru[i] = *(const v4u*)(GU + (size_t)(t0 + p) * YLD + g * 128 + c8); rss[i] = VSS[t0 + p]; }
}
__device__ __forceinline__ void phase_sgu(const Args& a, LAS unsigned char* lds, int tid, int wave, int lane, bf16* YG) {
    const bf16* GV = (const bf16*)a.out; const bf16* GU = (const bf16*)(a.ws + WS_GU); const bf16* WSP = (const bf16*)(a.ws + WS_WSP);
    const float* VSS = (const float*)(a.ws + CTL_VSS); const float* gsgu = a.in[I_GSGU]; const float* bsp = a.in[I_BSP];
    const int fr = lane & 15, fq = lane >> 4;
    int last_g = -1;
    v4u rv[4], ru[4]; float rss[4];
    for (int item = blockIdx.x; item < 128 * 8; item += gridDim.x) {
        const int g = item & 7, n = item >> 3, t0 = n * 128;
        if (g != last_g) {
#pragma unroll
            for (int i = 0; i < 4; ++i) { const int idx = tid + i * NTHR, row = idx >> 4, c16 = idx & 15;
                *(LAS v4u*)(lds + SG_W + row * SG_ST + c16 * 16) = *(const v4u*)(WSP + (size_t)(g * 128 + row) * 128 + c16 * 8); }
            last_g = g;
        }
        if (item == (int)blockIdx.x) sgu_load(GV, GU, VSS, item, tid, rv, ru, rss);
#pragma unroll
        for (int i = 0; i < 4; ++i) {
            const int idx = tid + i * NTHR, p = idx >> 4, c8 = (idx & 15) * 8;
            const v4u r = rv[i]; const v4u uu = ru[i];
            const float rs = rsqrtf(rss[i] * (1.f / D) + EPS);
            const f32x4 g0 = *(const f32x4*)(gsgu + g * 128 + c8) * rs, g1 = *(const f32x4*)(gsgu + g * 128 + c8 + 4) * rs;
            v4u o; o.x = pk2(bflo(r.x) * g0[0], bfhi(r.x) * g0[1]); o.y = pk2(bflo(r.y) * g0[2], bfhi(r.y) * g0[3]);
            o.z = pk2(bflo(r.z) * g1[0], bfhi(r.z) * g1[1]); o.w = pk2(bflo(r.w) * g1[2], bfhi(r.w) * g1[3]);
            *(LAS v4u*)(lds + SG_V + p * SG_ST + c8 * 2) = o;
            *(LAS v4u*)(lds + SG_U + p * SG_ST + c8 * 2) = uu;
        }
        if (item + (int)gridDim.x < 128 * 8) sgu_load(GV, GU, VSS, item + gridDim.x, tid, rv, ru, rss);
        float bias8[8];
#pragma unroll
        for (int qb = 0; qb < 8; ++qb) bias8[qb] = bsp[g * 128 + qb * 16 + fr];
        __syncthreads();
        bf16x8 af[4];
#pragma unroll
        for (int ks = 0; ks < 4; ++ks) {
            unsigned short e[8];
#pragma unroll
            for (int j = 0; j < 8; ++j) e[j] = *(const LAS unsigned short*)(lds + SG_V + (ks * 32 + fq * 8 + j) * SG_ST + (wave * 16 + fr) * 2);
            v4u o; o.x = e[0] | ((unsigned)e[1] << 16); o.y = e[2] | ((unsigned)e[3] << 16); o.z = e[4] | ((unsigned)e[5] << 16); o.w = e[6] | ((unsigned)e[7] << 16);
            af[ks] = __builtin_bit_cast(bf16x8, o);
        }
#pragma unroll
        for (int qb = 0; qb < 8; ++qb) {
            const int q = qb * 16 + fr;
            f32x4 acc = {0.f, 0.f, 0.f, 0.f};
#pragma unroll
            for (int ks = 0; ks < 4; ++ks) { const bf16x8 b = *(const LAS bf16x8*)(lds + SG_W + q * SG_ST + (ks * 32 + fq * 8) * 2);
                acc = __builtin_amdgcn_mfma_f32_16x16x32_bf16(af[ks], b, acc, 0, 0, 0); }
            const float bias = bias8[qb];
            LAS v2u* up = (LAS v2u*)(lds + SG_U + q * SG_ST + (wave * 16 + fq * 4) * 2);
            const v2u gu = *up;
            v2u y; y.x = pk2(bflo(gu.x) * (acc[0] + bias), bfhi(gu.x) * (acc[1] + bias)); y.y = pk2(bflo(gu.y) * (acc[2] + bias), bfhi(gu.y) * (acc[3] + bias));
            *up = y;
        }
        __syncthreads();
#pragma unroll
        for (int i = 0; i < 4; ++i) { const int idx = tid + i * NTHR, p = idx >> 4, c8 = (idx & 15) * 8;
            *(v4u*)(YG + (size_t)(t0 + p) * YLD + g * 128 + c8) = *(const LAS v4u*)(lds + SG_U + p * SG_ST + c8 * 2); }
    }
}

constexpr int RG_WB = 0, RG_XA = 32768, RG_XF = 51200, RG_AGL = 86016, RG_GCL = 94208, RG_CWL = 96256, RG_CARL = 97536, RG_AGL2 = 102400;
#define RGIDX(i) (((tid >> 6) << 7) + (tid & 63) + 64 * (i))
__device__ __forceinline__ void rg_load_raw(const bf16* XR, int item, int tid, v4u (&xr)[2][4]) {
    const int h = item & 15, t0 = (item >> 4) * 128;
    const int seq_lo = t0 < MCTX ? (t0 & ~255) : MCTX + ((t0 - MCTX) & ~4095), seq_hi = seq_lo + (t0 < MCTX ? 256 : 4096);
#pragma unroll
    for (int i = 0; i < 2; ++i) {
        const int idx = RGIDX(i), tk = idx >> 3, chb = h * 64 + (idx & 7) * 8;
#pragma unroll
        for (int tap = 0; tap < 4; ++tap) {
            const int t = t0 + tk + tap - 2; const bool ok = (t >= seq_lo) && (t < seq_hi); const int tc = ok ? t : t0;
            xr[i][tap] = *(const v4u*)(XR + (size_t)tc * D + chb);
        }
    }
}
template <int MODE> __device__ __forceinline__ int rg_item(int k) {
    const int h = blockIdx.x & 15, q = blockIdx.x >> 4;
    int tt;
    if (MODE == 1) tt = k < 4 ? 2 * (q + 16 * (k >> 1)) + (k & 1) : 64 + q + 16 * (k - 4);
    else tt = k < 2 ? 2 * (q + 16 * k) + 1 : 64 + q + 16 * (k - 2);
    return tt * 16 + h;
}
__device__ __forceinline__ void agg_st(f32x2* p, f32x2 v) { __hip_atomic_store((unsigned long long*)p, __builtin_bit_cast(unsigned long long, v), __ATOMIC_RELAXED, __HIP_MEMORY_SCOPE_AGENT); }
__device__ __forceinline__ f32x2 agg_ld(const f32x2* p) { return __builtin_bit_cast(f32x2, __hip_atomic_load((const unsigned long long*)p, __ATOMIC_RELAXED, __HIP_MEMORY_SCOPE_AGENT)); }
template <int MODE>
__device__ __forceinline__ void phase_rg(const Args& a, LAS unsigned char* lds, int tid, int wave, int lane, bf16* YR) {
    const bf16* XR = (const bf16*)((const unsigned char*)a.out + 32 * MiB); const bf16* GGR = (const bf16*)(a.ws + WS_GU) + D;
    const float* GC = (const float*)(a.ws + WS_GC); const bf16* WG = (const bf16*)(a.ws + WS_WG);
    f32x2* AGG = (f32x2*)(a.ws + WS_AGG); const float* CAR = (const float*)(a.ws + WS_CAR); float* nstate = a.out + (size_t)M * D;
    const float* convw = a.in[I_CONVW]; const float* convb = a.in[I_CONVB];
    const int fr = lane & 15, fq = lane >> 4;
    int last_h = -1;
    v4u xr[2][4];
    constexpr int NK = MODE == 1 ? 8 : 6;
    rg_load_raw(XR, rg_item<MODE>(0), tid, xr);
    if constexpr (MODE == 1) {
        const float* st0 = a.in[I_STATE];
#pragma unroll 1
        for (int kk = tid >> 7; kk < 8; kk += 4) {
            const int it = rg_item<1>(kk);
            {
                const int d = (tid >> 6) & 1, cl = tid & 63, h = it & 15, tt = it >> 4;
                float hc;
                if (tt < 64) {
                    const f32x2 g = agg_ld(AGG + ((size_t)((tt | 1) * 16 + h) * 2 + 1) * 64 + cl);
                    hc = ((tt & 1) == 0 && d == 1) ? g[1] : 0.f;
                } else {
                    const int b = (tt - 64) >> 5, j = (tt - 64) & 31, tt0 = 64 + b * 32;
                    f32x2 ag[31];
#pragma unroll
                    for (int sI = 0; sI < 31; ++sI) { const int ti = d ? 31 - sI : sI; ag[sI] = agg_ld(AGG + ((size_t)((tt0 + ti) * 16 + h) * 2 + d) * 64 + cl); }
                    hc = st0[(size_t)b * 2048 + d * 1024 + h * 64 + cl];
#pragma unroll
                    for (int sI = 0; sI < 31; ++sI) { const int ti = d ? 31 - sI : sI; if (d ? (ti > j) : (ti < j)) hc = ag[sI][0] * hc + ag[sI][1]; }
                }
                *(LAS float*)(lds + RG_CARL + ((kk * 2 + d) * 64 + cl) * 4) = hc;
            }
        }
        __syncthreads();
    }
    for (int kitem = 0; kitem < NK; ++kitem) {
        const int item = rg_item<MODE>(kitem);
        const int h = item & 15, tt = item >> 4, t0 = tt * 128;
        const int AGLo = (kitem & 1) ? RG_AGL2 : RG_AGL;
        if (h != last_h) {
#pragma unroll
            for (int i = 0; i < 4; ++i) { const int o = (tid + i * NTHR) * 16; *(LAS v4u*)(lds + RG_WB + o) = *(const v4u*)((const unsigned char*)WG + (size_t)h * 32768 + o); }
            if (tid < 128) *(LAS f32x4*)(lds + RG_GCL + tid * 16) = *(const f32x4*)(GC + (size_t)((tid >> 6) * D + h * 64 + (tid & 63)) * 4);
            if (tid < 80) { const int row = tid >> 4, c4 = (tid & 15) * 4;
                *(LAS f32x4*)(lds + RG_CWL + (row * 64 + c4) * 4) = *(const f32x4*)((row < 4 ? convw + row * D : convb) + h * 64 + c4); }
            last_h = h;
            __syncthreads();
        }
        const int seq_lo = t0 < MCTX ? (t0 & ~255) : MCTX + ((t0 - MCTX) & ~4095), seq_hi = seq_lo + (t0 < MCTX ? 256 : 4096);
        float car[2][4]; v4u ggr[2];
        if constexpr (MODE == 1) {
#pragma unroll
            for (int i = 0; i < 2; ++i) { const int idx = RGIDX(i); ggr[i] = *(const v4u*)(GGR + (size_t)(t0 + (idx >> 3)) * YLD + h * 64 + (idx & 7) * 8); }
        }
        {
            const int c8 = (tid & 7) * 8;
            f32x4 w0[4], w1[4];
#pragma unroll
            for (int tap = 0; tap < 4; ++tap) { w0[tap] = *(const LAS f32x4*)(lds + RG_CWL + (tap * 64 + c8) * 4); w1[tap] = *(const LAS f32x4*)(lds + RG_CWL + (tap * 64 + c8 + 4) * 4); }
            const f32x4 b0 = *(const LAS f32x4*)(lds + RG_CWL + (4 * 64 + c8) * 4), b1 = *(const LAS f32x4*)(lds + RG_CWL + (4 * 64 + c8 + 4) * 4);
#pragma unroll
            for (int i = 0; i < 2; ++i) {
                const int idx = RGIDX(i), tk = idx >> 3, cg8 = idx & 7;
                f32x4 x0 = b0, x1 = b1;
#pragma unroll
                for (int tap = 0; tap < 4; ++tap) { const int t = t0 + tk + tap - 2; const bool ok = (t >= seq_lo) && (t < seq_hi);
                    v4u r = xr[i][tap]; r.x = ok ? r.x : 0u; r.y = ok ? r.y : 0u; r.z = ok ? r.z : 0u; r.w = ok ? r.w : 0u;
                    x0[0] += w0[tap][0] * bflo(r.x); x0[1] += w0[tap][1] * bfhi(r.x); x0[2] += w0[tap][2] * bflo(r.y); x0[3] += w0[tap][3] * bfhi(r.y);
                    x1[0] += w1[tap][0] * bflo(r.z); x1[1] += w1[tap][1] * bfhi(r.z); x1[2] += w1[tap][2] * bflo(r.w); x1[3] += w1[tap][3] * bfhi(r.w); }
                v4u o; o.x = pk2(x0[0], x0[1]); o.y = pk2(x0[2], x0[3]); o.z = pk2(x1[0], x1[1]); o.w = pk2(x1[2], x1[3]);
                *(LAS v4u*)(lds + RG_XA + tk * 144 + cg8 * 16) = o;
                *(LAS f32x4*)(lds + RG_XF + (tk * 68 + cg8 * 8) * 4) = x0; *(LAS f32x4*)(lds + RG_XF + (tk * 68 + cg8 * 8 + 4) * 4) = x1;
            }
        }
        if (kitem + 1 < NK) rg_load_raw(XR, rg_item<MODE>(kitem + 1), tid, xr);
        asm volatile("" ::: "memory");
        const int tokb = wave * 16;
        bf16x8 afr[2];
#pragma unroll
        for (int ks = 0; ks < 2; ++ks) afr[ks] = *(const LAS bf16x8*)(lds + RG_XA + (tokb + fr) * 144 + (ks * 32 + fq * 8) * 2);
        f32x4 gcv[2][4];
#pragma unroll
        for (int d = 0; d < 2; ++d)
#pragma unroll
            for (int cb = 0; cb < 4; ++cb) gcv[d][cb] = *(const LAS f32x4*)(lds + RG_GCL + (d * 64 + cb * 16 + fr) * 16);
        float av[2][4][4], bv[2][4][4], Ap[2][4], Hp[2][4];
        const bool ctx = t0 < MCTX;
#pragma unroll
        for (int d = 0; d < 2; ++d) {
            if (MODE == 0 && ctx && d != (tt & 1)) continue;
#pragma unroll
            for (int cb = 0; cb < 4; ++cb) {
                const f32x4 gc = gcv[d][cb];
                f32x4 ar = {0.f, 0.f, 0.f, 0.f}, ai = {0.f, 0.f, 0.f, 0.f};
#pragma unroll
                for (int ks = 0; ks < 2; ++ks) {
                    const bf16x8 b0 = *(const LAS bf16x8*)(lds + RG_WB + (((0 * 8 + d * 4 + cb) * 2 + ks) * 64 + lane) * 16);
                    const bf16x8 b1 = *(const LAS bf16x8*)(lds + RG_WB + (((1 * 8 + d * 4 + cb) * 2 + ks) * 64 + lane) * 16);
                    ar = __builtin_amdgcn_mfma_f32_16x16x32_bf16(afr[ks], b0, ar, 0, 0, 0);
                    ai = __builtin_amdgcn_mfma_f32_16x16x32_bf16(afr[ks], b1, ai, 0, 0, 0);
                }
#pragma unroll
                for (int r = 0; r < 4; ++r) {
                    const float xcv = *(const LAS float*)(lds + RG_XF + ((tokb + fq * 4 + r) * 68 + cb * 16 + fr) * 4);
                    const float rr = __builtin_amdgcn_rcpf(__builtin_fmaf(__builtin_amdgcn_exp2f(ar[r]), gc[0], 1.f)), ii = __builtin_amdgcn_rcpf(__builtin_fmaf(__builtin_amdgcn_exp2f(ai[r]), gc[1], 1.f));
                    const float aa = __builtin_amdgcn_exp2f(rr * gc[2]);
                    const float om = fmaxf(1.f - aa * aa, 1e-12f);
                    av[d][cb][r] = aa; bv[d][cb][r] = __builtin_amdgcn_sqrtf(om) * ii * xcv;
                }
                float A = 1.f, Hh = 0.f;
#pragma unroll
                for (int rr = 0; rr < 4; ++rr) { const int r = d ? 3 - rr : rr; Hh = av[d][cb][r] * Hh + bv[d][cb][r]; A *= av[d][cb][r]; }
                float Aw = 1.f, Hw = 0.f, Apl = 1.f, Hpl = 0.f;
#pragma unroll
                for (int gg = 0; gg < 4; ++gg) { const int g = d ? 3 - gg : gg;
                    const float Ag = __shfl(A, g * 16 + fr), Hg = __shfl(Hh, g * 16 + fr);
                    if (g == fq) { Apl = Aw; Hpl = Hw; }
                    Hw = Ag * Hw + Hg; Aw *= Ag; }
                Ap[d][cb] = Apl; Hp[d][cb] = Hpl;
                if (fq == 0) *(LAS f32x2*)(lds + AGLo + ((wave * 2 + d) * 64 + cb * 16 + fr) * 8) = (f32x2){Aw, Hw};
            }
        }
        __syncthreads();
        if constexpr (MODE == 0) {
            if (tid < 128 && !(ctx && (tid >> 6) != (tt & 1))) {
                const int d = tid >> 6, cl = tid & 63; float A = 1.f, Hh = 0.f;
#pragma unroll
                for (int ww = 0; ww < 8; ++ww) { const int w2 = d ? 7 - ww : ww; const f32x2 sg = *(const LAS f32x2*)(lds + AGLo + ((w2 * 2 + d) * 64 + cl) * 8); Hh = sg[0] * Hh + sg[1]; A *= sg[0]; }
                agg_st(AGG + ((size_t)(tt * 16 + h) * 2 + d) * 64 + cl, (f32x2){A, Hh});
            }
        } else {
            if (ctx && (tt & 1) == 0 && tid < 64) {
                float Hh = 0.f;
#pragma unroll
                for (int w2 = 0; w2 < 8; ++w2) { const f32x2 sg = *(const LAS f32x2*)(lds + AGLo + ((w2 * 2 + 0) * 64 + tid) * 8); Hh = sg[0] * Hh + sg[1]; }
                *(LAS float*)(lds + RG_CARL + (((kitem + 1) * 2 + 0) * 64 + tid) * 4) = Hh;
            }
#pragma unroll
            for (int d = 0; d < 2; ++d)
#pragma unroll
                for (int cb = 0; cb < 4; ++cb) car[d][cb] = *(const LAS float*)(lds + RG_CARL + ((kitem * 2 + d) * 64 + cb * 16 + fr) * 4);
            float hs[4][4];
#pragma unroll
            for (int cb = 0; cb < 4; ++cb)
#pragma unroll
                for (int r = 0; r < 4; ++r) hs[cb][r] = 0.f;
#pragma unroll
            for (int d = 0; d < 2; ++d)
#pragma unroll
                for (int cb = 0; cb < 4; ++cb) {
                    const int cl = cb * 16 + fr;
                    float hin = car[d][cb];
                    f32x2 sg[8];
#pragma unroll
                    for (int w2 = 0; w2 < 8; ++w2) sg[w2] = *(const LAS f32x2*)(lds + AGLo + ((w2 * 2 + d) * 64 + cl) * 8);
#pragma unroll
                    for (int ww = 0; ww < 8; ++ww) { const int w2 = d ? 7 - ww : ww; if (d ? (w2 > wave) : (w2 < wave)) hin = sg[w2][0] * hin + sg[w2][1]; }
                    float hh = Ap[d][cb] * hin + Hp[d][cb];
#pragma unroll
                    for (int rr = 0; rr < 4; ++rr) { const int r = d ? 3 - rr : rr; hh = av[d][cb][r] * hh + bv[d][cb][r]; hs[cb][r] += hh; }
                    if (ctx && (tt & 1) == (d ? 0 : 1) && wave == (d ? 0 : 7) && fq == (d ? 0 : 3)) nstate[(size_t)(tt >> 1) * 2048 + d * 1024 + h * 64 + cl] = hh;
                }
#pragma unroll
            for (int cb = 0; cb < 4; ++cb)
#pragma unroll
                for (int r = 0; r < 4; ++r) *(LAS float*)(lds + RG_XF + ((tokb + fq * 4 + r) * 68 + cb * 16 + fr) * 4) = hs[cb][r];
            asm volatile("" ::: "memory");
#pragma unroll
            for (int i = 0; i < 2; ++i) {
                const int idx = RGIDX(i), tk = idx >> 3, cg8 = idx & 7;
                const f32x4 y0 = *(const LAS f32x4*)(lds + RG_XF + (tk * 68 + cg8 * 8) * 4), y1 = *(const LAS f32x4*)(lds + RG_XF + (tk * 68 + cg8 * 8 + 4) * 4);
                const v4u g = ggr[i];
                v4u o; o.x = pk2(y0[0] * bflo(g.x), y0[1] * bfhi(g.x)); o.y = pk2(y0[2] * bflo(g.y), y0[3] * bfhi(g.y));
                o.z = pk2(y1[0] * bflo(g.z), y1[1] * bfhi(g.z)); o.w = pk2(y1[2] * bflo(g.w), y1[3] * bfhi(g.w));
                *(v4u*)(YR + (size_t)(t0 + tk) * YLD + h * 64 + cg8 * 8) = o;
            }
        }
    }
}

template <int NT>
__device__ __forceinline__ float carry_chain(const f32x2* AGG, float* CAR, int tt0, int h, int d, int cl, float h0) {
    f32x2 ag[NT];
#pragma unroll
    for (int i = 0; i < NT; ++i) ag[i] = AGG[((size_t)((tt0 + i) * 16 + h) * 2 + d) * 64 + cl];
    float hc = h0;
#pragma unroll
    for (int ii = 0; ii < NT; ++ii) { const int i = d ? NT - 1 - ii : ii;
        CAR[((size_t)((tt0 + i) * 16 + h) * 2 + d) * 64 + cl] = hc; hc = ag[i][0] * hc + ag[i][1]; }
    return hc;
}
__device__ __forceinline__ void phase_carry(const Args& a, int gw, int NGW, int lane) {
    const f32x2* AGG = (const f32x2*)(a.ws + WS_AGG); float* CAR = (float*)(a.ws + WS_CAR);
    for (int wi = gw; wi < 34 * 2 * 16; wi += NGW) {
        const int s = wi >> 5, d = (wi >> 4) & 1, h = wi & 15, ch = h * 64 + lane;
        if (s < 32) {
            const size_t i0 = ((size_t)((2 * s) * 16 + h) * 2 + d) * 64 + lane, i1 = ((size_t)((2 * s + 1) * 16 + h) * 2 + d) * 64 + lane;
            if (d == 0) { CAR[i0] = 0.f; CAR[i1] = AGG[i0][1]; }
            else { CAR[i1] = 0.f; CAR[i0] = AGG[i1][1]; }
        } else {
            const int b = s - 32; const float h0 = a.in[I_STATE][(size_t)b * 2048 + d * 1024 + ch];
            if (d == 0) (void)carry_chain<32>(AGG, CAR, 64 + b * 32, h, 0, lane, h0);
            else (void)carry_chain<32>(AGG, CAR, 64 + b * 32, h, 1, lane, h0);
        }
    }
}

#define RLX_AGENT __ATOMIC_RELAXED, __HIP_MEMORY_SCOPE_AGENT
#define XB_TMO      128
#define XB_XCNT(j)  (256  + 64 * (j))
#define XB_XSUB(j)  (1280 + 64 * (j))
#define XB_XGEN(j)  (2304 + 64 * (j))
#define XB_TOP      3328
#define XB_TOPGEN   3392
#define XCD_BAR_WORDS 3456
#define XB_SPIN_CAP (1u << 18)

__device__ __forceinline__ unsigned xb_ld(unsigned* p)              { return __hip_atomic_load(p, __ATOMIC_RELAXED, __HIP_MEMORY_SCOPE_AGENT); }
__device__ __forceinline__ unsigned xb_add(unsigned* p, unsigned v) { return __hip_atomic_fetch_add(p, v, __ATOMIC_RELAXED, __HIP_MEMORY_SCOPE_AGENT); }
__device__ __forceinline__ unsigned xb_xcc_id() { return (unsigned)__builtin_amdgcn_s_getreg((3 << 11) | 20) & 0xFu; }
#define XB_SPIN(cond, bar) do { unsigned _sp = 0; while (cond) { __builtin_amdgcn_s_sleep(1); \
    if ((++_sp & 255u) == 0u) { if (xb_ld(&(bar)[XB_TMO])) break; if (_sp > XB_SPIN_CAP) { atomicAdd(&(bar)[XB_TMO], 1u); break; } } } } while (0)

struct XcdBarrier {
    unsigned* bar; unsigned x;
    volatile LAS unsigned* st;
};

__device__ __forceinline__ XcdBarrier xcd_barrier_post(unsigned* bar, volatile LAS unsigned* st) {
    XcdBarrier b; b.bar = bar; b.x = xb_xcc_id(); b.st = st;
    if (threadIdx.x == 0) (void)xb_add(&bar[XB_XCNT(b.x)], 1u);
    return b;
}
__device__ __forceinline__ void xcd_barrier_complete(unsigned* bar, unsigned x, unsigned& nloc, unsigned& nx) {
    const unsigned G = gridDim.x * gridDim.y * gridDim.z;
    unsigned sum, cnt, mine, sp = 0u;
    for (;;) {
        sum = 0u; cnt = 0u; mine = 0u;
#pragma unroll
        for (unsigned j = 0; j < 16; ++j) { const unsigned c = xb_ld(&bar[XB_XCNT(j)]); sum += c; cnt += (c > 0u) ? 1u : 0u; mine = (j == x) ? c : mine; }
        if (sum == G) break;
        __builtin_amdgcn_s_sleep(1);
        if ((++sp & 255u) == 0u) { if (xb_ld(&bar[XB_TMO])) break; if (sp > XB_SPIN_CAP) { atomicAdd(&bar[XB_TMO], 1u); break; } }
    }
    nloc = mine > 0u ? mine : 1u; nx = cnt > 0u ? cnt : 1u;
}

__device__ __forceinline__ void xcd_barrier(const XcdBarrier& b) {
    asm volatile("s_waitcnt vmcnt(0)" ::: "memory");
    __syncthreads();
    if (threadIdx.x == 0) {
        unsigned* bar = b.bar;
        __builtin_amdgcn_s_waitcnt(0);
        unsigned nloc = b.st[0], nx = b.st[1];
        if (nloc == 0u) { xcd_barrier_complete(bar, b.x, nloc, nx); b.st[0] = nloc; b.st[1] = nx; }
        const unsigned old = xb_add(&bar[XB_XSUB(b.x)], 1u);
        const unsigned gen = old / nloc;
        if (old + 1u == (gen + 1u) * nloc) {
            __builtin_amdgcn_fence(__ATOMIC_RELEASE, "agent");
            asm volatile("s_waitcnt vmcnt(0)" ::: "memory");
            const unsigned og = xb_add(&bar[XB_TOP], 1u);
            const unsigned tg = og / nx;
            if (og + 1u == (tg + 1u) * nx) xb_add(&bar[XB_TOPGEN], 1u);
            else XB_SPIN(xb_ld(&bar[XB_TOPGEN]) == tg, bar);
            __builtin_amdgcn_fence(__ATOMIC_ACQUIRE, "agent");
            xb_add(&bar[XB_XGEN(b.x)], 1u);
            asm volatile("s_waitcnt vmcnt(0)" ::: "memory");
        } else {
            XB_SPIN(xb_ld(&bar[XB_XGEN(b.x)]) == gen, bar);
            __builtin_amdgcn_fence(__ATOMIC_ACQUIRE, "agent");
            asm volatile("s_waitcnt vmcnt(0)" ::: "memory");
        }
    }
    __syncthreads();
}

__global__ void __launch_bounds__(NTHR, 2) fwd_megakernel(Args a) {
    extern __shared__ __attribute__((aligned(16))) unsigned char lds_raw[];
    LAS unsigned char* lds = (LAS unsigned char*)lds_raw;
    const int tid = threadIdx.x, lane = tid & 63, wave = __builtin_amdgcn_readfirstlane(tid >> 6);
    const int G = gridDim.x, gw = blockIdx.x * NWAVES + wave, NGW = G * NWAVES;
    unsigned char* ws = a.ws;
    const int lo = a.ph_lo, hi = a.ph_hi;
    volatile LAS unsigned* bst = (volatile LAS unsigned*)(lds + LDS_BAR_OFF);
    if (tid < 2) bst[tid] = 0u;
    __syncthreads();
    XcdBarrier bar = xcd_barrier_post((unsigned*)(ws + WS_CTL), bst);
#define IN(k) (lo <= (k) && (k) < hi)
#define SEAM(k) do { if (IN(k) && IN((k) + 1)) { xcd_barrier(bar); if (DUP >> 12 & 1) xcd_barrier(bar); } } while (0)
    float* const DUMSS = (float*)(ws + 1 * MiB + 512 * 1024);
#define REP(k) for (int rep_ = ((DUP >> (k)) & 1); rep_ >= 0; --rep_)
#define ISDUP (rep_ > 0)
    if (IN(0)) REP(0) phase_prep(a, lds, gw, NGW, wave, lane, ISDUP ? (float*)(ws + 1 * MiB + 256 * 1024) : (float*)(ws + CTL_MOD));
    if (IN(1)) {
        if (tid == 0) { unsigned sp = 0; const unsigned need = G > 192 ? 192u : (unsigned)G;
            while (__hip_atomic_load((unsigned*)(ws + CTL_MODCNT), __ATOMIC_RELAXED, __HIP_MEMORY_SCOPE_AGENT) < need) { __builtin_amdgcn_s_sleep(1); if (++sp > (1u << 22)) break; }
            __builtin_amdgcn_fence(__ATOMIC_ACQUIRE, "agent"); asm volatile("s_waitcnt vmcnt(0)" ::: "memory"); }
        __syncthreads();
        REP(1) phase_norm1(a, gw, NGW, lane);
    }
    SEAM(1);
    if (IN(2)) REP(2) {
        pg8::Gemm g{(const pg8::bf16_t*)(ws + WS_H), (const pg8::bf16_t*)(ws + WS_WIN), M, INC, D}; pg8::StaticOrder S; S.init(M, INC, G, (int)blockIdx.x, WG_IN);
        pg8::Epi<1> E{nullptr, nullptr, nullptr, ISDUP ? DUMSS : (float*)(ws + CTL_VSS), D, (bf16*)(ws + WS_GU), (bf16*)a.out, (bf16*)((unsigned char*)a.out + 32 * MiB), (bf16*)(ws + WS_GU) + D, (bf16*)(ws + WS_SGA), (bf16*)(ws + WS_SGB)};
        pg8::gemm_phase<pg8::Epi<1>, pg8::StaticOrder, true, true>(lds, g, S, E);
    }
    SEAM(2);
    if (IN(3)) {
        REP(3) phase_rg<0>(a, lds, tid, wave, lane, nullptr);
        asm volatile("s_waitcnt vmcnt(0)" ::: "memory");
        __syncthreads();
        if (tid == 0) __hip_atomic_fetch_add((unsigned*)(ws + CTL_AGGCNT), 1u, __ATOMIC_RELAXED, __HIP_MEMORY_SCOPE_AGENT);
        REP(3) phase_sgu(a, lds, tid, wave, lane, ISDUP ? (bf16*)(ws + WS_F) : (bf16*)(ws + WS_GU));
        if (tid == 0) { unsigned sp = 0; while (__hip_atomic_load((unsigned*)(ws + CTL_AGGCNT), __ATOMIC_RELAXED, __HIP_MEMORY_SCOPE_AGENT) < (unsigned)G) { __builtin_amdgcn_s_sleep(1); if (++sp > (1u << 22)) break; } }
        __syncthreads();
    }
    if (IN(5)) REP(5) phase_rg<1>(a, lds, tid, wave, lane, ISDUP ? (bf16*)(ws + WS_F) + D : (bf16*)(ws + WS_GU) + D);
    SEAM(5);
    if (IN(6)) REP(6) {
        pg8::Gemm g{(const pg8::bf16_t*)(ws + WS_GU), (const pg8::bf16_t*)(ws + WS_WBG), M, D, 2 * D}; pg8::StaticOrder S; S.init(M, D, G, (int)blockIdx.x);
        pg8::EpiMerge E{(bf16*)(ws + WS_H), (const bf16*)(ws + WS_SGA), (const bf16*)(ws + WS_SGB)};
        pg8::gemm_phase<pg8::EpiMerge, pg8::StaticOrder, false, true>(lds, g, S, E);
    }
    SEAM(6);
    if (IN(7)) {
        pg8::Gemm g{(const pg8::bf16_t*)(ws + WS_H), (const pg8::bf16_t*)(ws + WS_WOUT), M, D, D}; pg8::StaticOrder S; S.init(M, D, G, (int)blockIdx.x);
        EpiFused<6> E{a.out, a.in[I_XP], a.in[I_XS], (bf16*)(ws + WS_H), (float*)(ws + CTL_OSS), (float*)(ws + CTL_XSS), (unsigned*)(ws + CTL_CNT), (unsigned*)(ws + CTL_CNT + 16384),
                      (const float*)(ws + CTL_MOD), a.in[I_BADA], a.in[I_GPOSTMIX], a.in[I_GPREMLP]};
        pg8::gemm_phase<EpiFused<6>, pg8::StaticOrder, false, true>(lds, g, S, E);
    }
    SEAM(7);
    if (IN(8)) REP(8) {
        pg8::Gemm g{(const pg8::bf16_t*)(ws + WS_H), (const pg8::bf16_t*)(ws + WS_WFF1), M, FF, D}; pg8::StaticOrder S; S.init(M, FF, G, (int)blockIdx.x, WG_FF1);
        pg8::Epi<5> E{(bf16*)(ws + WS_F1), nullptr, nullptr, nullptr, FF, nullptr, nullptr, nullptr, nullptr, nullptr, nullptr};
        pg8::gemm_phase<pg8::Epi<5>, pg8::StaticOrder, true, true>(lds, g, S, E);
    }
    SEAM(8);
    if (IN(9)) {
        pg8::Gemm g{(const pg8::bf16_t*)(ws + WS_F1), (const pg8::bf16_t*)(ws + WS_WFF2), M, D, FF}; pg8::StaticOrder S; S.init(M, D, G, (int)blockIdx.x);
        EpiFused<7> E{a.out, nullptr, nullptr, nullptr, (float*)(ws + CTL_FSS), nullptr, (unsigned*)(ws + CTL_CNT + 32768), nullptr,
                      (const float*)(ws + CTL_MOD), a.in[I_BADA], a.in[I_GPOSTMLP], nullptr};
        pg8::gemm_phase<EpiFused<7>, pg8::StaticOrder, false, true>(lds, g, S, E);
    }
#undef IN
#undef SEAM
}

constexpr int N_PHASES = 10;
extern "C" void kernel_launch(void* const* d_in, const int* in_sizes, int n_in, void* d_out, int out_size, void* d_ws, size_t ws_size, hipStream_t stream) {
    static int grid = 0;
    if (grid == 0) {
        if (n_in != 27 || ws_size < WS_END) { fprintf(stderr, "kernel_launch: need 27 inputs and >= %zu B of workspace; got %d, %zu\n", (size_t)WS_END, n_in, ws_size); grid = -1; return; }
        int dev = 0, cus = 0, per_cu = 0;
        if (hipGetDevice(&dev) != hipSuccess || hipDeviceGetAttribute(&cus, hipDeviceAttributeMultiprocessorCount, dev) != hipSuccess) { grid = -1; return; }
        if (hipFuncSetAttribute((const void*)fwd_megakernel, hipFuncAttributeMaxDynamicSharedMemorySize, LDS_BYTES) != hipSuccess) { fprintf(stderr, "kernel_launch: hipFuncSetAttribute failed\n"); grid = -1; return; }
        if (hipOccupancyMaxActiveBlocksPerMultiprocessor(&per_cu, (const void*)fwd_megakernel, NTHR, LDS_BYTES) != hipSuccess || per_cu < 1) { fprintf(stderr, "kernel_launch: occupancy query says %d\n", per_cu); per_cu = 1; }
        (void)hipGetLastError();
        grid = cus * per_cu;
        if (grid < 256) { fprintf(stderr, "kernel_launch: this kernel's work split needs 256 co-resident workgroups; the device offers %d\n", grid); grid = -1; return; }
        grid = 256;
    }
    if (grid < 0) return;
    (void)hipMemsetAsync((char*)d_ws + WS_CTL, 0, CTL_ZERO_BYTES, stream);
    Args a{};
    for (int i = 0; i < 27; ++i) a.in[i] = (const float*)d_in[i];
    a.out = (float*)d_out; a.ws = (unsigned char*)d_ws; a.ph_lo = 0; a.ph_hi = N_PHASES;
    void* args[] = {&a};
    hipError_t e = hipLaunchCooperativeKernel((const void*)fwd_megakernel, dim3(grid), dim3(NTHR), args, LDS_BYTES, stream);
    if (e != hipSuccess) fprintf(stderr, "kernel_launch: cooperative launch failed: %s (grid %d)\n", hipGetErrorString(e), grid);
}
```
